# Optimizing an MI355X kernel written in HIP

```python
import math
import jax
import jax.numpy as jnp
from jax import lax
import numpy as np


D_MODEL = 1024
BATCH = 16
SEQ = 4096
DEPTH = 1

MLA_HEADS = 8
MLA_NOPE_DIM = 64
MLA_ROPE_DIM = 32
MLA_V_DIM = 64
MLA_Q_LORA = 256
MLA_KV_LORA = 128
ROPE_THETA = 10000.0

NSA_HEADS = 8
NSA_KV_HEADS = 2
NSA_GROUP = NSA_HEADS // NSA_KV_HEADS
NSA_HEAD_DIM = 64
CMP_LEN = 32
CMP_STRIDE = 16
CMP_HIDDEN = 128
SLC_LEN = 64
SLC_TOPN = 16
WINDOW = 512
N_BRANCH = 3

T5_BUCKETS = 32
T5_MAX_DIST = 128

MLA_OUT = MLA_HEADS * MLA_V_DIM
NSA_OUT = NSA_HEADS * NSA_HEAD_DIM
D_MIX = MLA_OUT + NSA_OUT
D_FF = -(-8 * D_MODEL // (3 * 256)) * 256

IN_SPLITS = (
    MLA_Q_LORA,
    MLA_KV_LORA,
    MLA_ROPE_DIM,
    NSA_HEADS * NSA_HEAD_DIM,
    2 * NSA_KV_HEADS * NSA_HEAD_DIM,
    2 * NSA_KV_HEADS * NSA_HEAD_DIM,
    2 * NSA_KV_HEADS * NSA_HEAD_DIM,
    NSA_HEADS * N_BRANCH,
)
D_IN = sum(IN_SPLITS)

Q_BLOCK = 128
NSA_Q_BLOCK = 64
EPS = 1e-6
NEG_INF = -1e30
FORCE_SCORE = 1e30

kernel_name = 'hybrid_mla_nsa_block'


def rmsnorm(x, g):
    xf = x.astype(jnp.float32)
    y = xf * lax.rsqrt(jnp.mean(xf * xf, axis=-1, keepdims=True) + EPS)
    return (y * g.astype(jnp.float32)).astype(x.dtype)


def rope_tables(seq):
    pos = jnp.arange(seq, dtype=jnp.float32)
    inv = ROPE_THETA ** (-jnp.arange(0, MLA_ROPE_DIM, 2, dtype=jnp.float32) / MLA_ROPE_DIM)
    ang = pos[:, None] * inv[None, :]
    return jnp.cos(ang), jnp.sin(ang)


def apply_rope(x, cos, sin):
    half = x.shape[-1] // 2
    x1 = x[..., :half].astype(jnp.float32)
    x2 = x[..., half:].astype(jnp.float32)
    return jnp.concatenate([x1 * cos - x2 * sin, x1 * sin + x2 * cos], axis=-1).astype(x.dtype)


def t5_bucket(dist):
    n = jnp.maximum(dist, 0)
    max_exact = T5_BUCKETS // 2
    nf = jnp.maximum(n, 1).astype(jnp.float32)
    large = max_exact + (jnp.log(nf / max_exact) / math.log(T5_MAX_DIST / max_exact)
                         * (T5_BUCKETS - max_exact)).astype(jnp.int32)
    large = jnp.minimum(large, T5_BUCKETS - 1)
    return jnp.where(n < max_exact, n, large)


def mla_mixer(c_q, c_kv, k_rope, q_norm_g, w_uq, kv_norm_g, w_ukv):
    B, S, _ = c_q.shape
    cos, sin = rope_tables(S)
    q = (rmsnorm(c_q, q_norm_g) @ w_uq).reshape(B, S, MLA_HEADS, MLA_NOPE_DIM + MLA_ROPE_DIM)
    q_nope, q_pe = q[..., :MLA_NOPE_DIM], q[..., MLA_NOPE_DIM:]
    q_pe = apply_rope(q_pe, cos[None, :, None], sin[None, :, None])
    kv = (rmsnorm(c_kv, kv_norm_g) @ w_ukv).reshape(B, S, MLA_HEADS, MLA_NOPE_DIM + MLA_V_DIM)
    k_nope, v = kv[..., :MLA_NOPE_DIM], kv[..., MLA_NOPE_DIM:]
    k_pe = apply_rope(k_rope, cos[None], sin[None])
    k_pe = jnp.broadcast_to(k_pe[:, :, None, :], (B, S, MLA_HEADS, MLA_ROPE_DIM))
    q = jnp.concatenate([q_nope, q_pe], axis=-1).transpose(0, 2, 1, 3)
    k = jnp.concatenate([k_nope, k_pe], axis=-1).transpose(0, 2, 1, 3)
    v = v.transpose(0, 2, 1, 3)
    scale = (MLA_NOPE_DIM + MLA_ROPE_DIM) ** -0.5
    key_pos = jnp.arange(S)

    def attend_block(i):
        start = i * Q_BLOCK
        qb = lax.dynamic_slice_in_dim(q, start, Q_BLOCK, axis=2)
        s = jnp.einsum('bhqd,bhkd->bhqk', qb, k, preferred_element_type=jnp.float32) * scale
        q_pos = start + jnp.arange(Q_BLOCK)
        s = jnp.where(key_pos[None, :] <= q_pos[:, None], s, NEG_INF)
        p = jax.nn.softmax(s, axis=-1).astype(v.dtype)
        return jnp.einsum('bhqk,bhkd->bhqd', p, v)

    o = lax.map(attend_block, jnp.arange(S // Q_BLOCK))
    return o.transpose(1, 0, 3, 2, 4).reshape(B, S, MLA_OUT)


def nsa_compress(raw, pos_emb, w1, w2, cmp_idx):
    B = raw.shape[0]
    n_cmp = cmp_idx.shape[0]
    blk = raw[:, cmp_idx] + pos_emb[None, None, :, None, :]
    blk = blk.transpose(0, 3, 1, 2, 4).reshape(B, NSA_KV_HEADS, n_cmp, CMP_LEN * NSA_HEAD_DIM)
    return jax.nn.gelu(blk @ w1) @ w2


def nsa_mixer(q, kv_cmp, kv_slc, kv_win, gate_logits, pos_k, w1_k, w2_k, pos_v, w1_v, w2_v, t5_table):
    B, S, _ = q.shape
    Hk, G, dk = NSA_KV_HEADS, NSA_GROUP, NSA_HEAD_DIM
    q = q.reshape(B, S, Hk, G, dk).transpose(0, 2, 3, 1, 4)

    def split_kv(kv):
        kv = kv.reshape(B, S, 2, Hk, dk)
        return kv[:, :, 0], kv[:, :, 1]

    n_cmp = (S - CMP_LEN) // CMP_STRIDE + 1
    cmp_start = np.arange(n_cmp) * CMP_STRIDE
    cmp_idx = cmp_start[:, None] + np.arange(CMP_LEN)[None, :]
    cmp_end = jnp.asarray(cmp_start + CMP_LEN - 1, dtype=jnp.int32)
    k_c_raw, v_c_raw = split_kv(kv_cmp)
    k_cmp = nsa_compress(k_c_raw, pos_k, w1_k, w2_k, cmp_idx)
    v_cmp = nsa_compress(v_c_raw, pos_v, w1_v, w2_v, cmp_idx)

    n_slc = S // SLC_LEN
    n_sel = min(SLC_TOPN, n_slc)
    slc_start = np.arange(n_slc) * SLC_LEN
    overlap = np.maximum(0, np.minimum(cmp_start[:, None] + CMP_LEN, slc_start[None, :] + SLC_LEN)
                         - np.maximum(cmp_start[:, None], slc_start[None, :])).astype(np.float32) / CMP_STRIDE
    overlap = jnp.asarray(overlap)
    k_s, v_s = split_kv(kv_slc)
    k_slc = k_s.transpose(0, 2, 1, 3).reshape(B, Hk, n_slc, SLC_LEN, dk)
    v_slc = v_s.transpose(0, 2, 1, 3).reshape(B, Hk, n_slc, SLC_LEN, dk)

    k_w, v_w = split_kv(kv_win)
    pad = ((0, 0), (0, 0), (WINDOW, 0), (0, 0))
    k_win = jnp.pad(k_w.transpose(0, 2, 1, 3), pad)
    v_win = jnp.pad(v_w.transpose(0, 2, 1, 3), pad)

    gates = jax.nn.sigmoid(gate_logits.astype(jnp.float32)).reshape(B, S, Hk, G, N_BRANCH)
    gates = gates.transpose(0, 2, 3, 1, 4).astype(q.dtype)
    tbl = t5_table.T.reshape(Hk, G, T5_BUCKETS)
    scale = dk ** -0.5
    blk_ids = jnp.arange(n_slc)
    b_ix = jnp.arange(B)[:, None, None, None]
    h_ix = jnp.arange(Hk)[None, :, None, None]
    tk_ix = jnp.arange(Hk)[None, :, None, None, None]
    tg_ix = jnp.arange(G)[None, None, :, None, None]

    def nsa_block(i):
        start = i * NSA_Q_BLOCK
        q_pos = start + jnp.arange(NSA_Q_BLOCK)
        qb = lax.dynamic_slice_in_dim(q, start, NSA_Q_BLOCK, axis=3)

        dist_c = q_pos[:, None] - cmp_end[None, :]
        valid_c = dist_c >= 0
        s_c = jnp.einsum('bkgqd,bknd->bkgqn', qb, k_cmp, preferred_element_type=jnp.float32) * scale
        s_c = s_c + tbl[:, :, t5_bucket(dist_c)]
        p_c = jax.nn.softmax(jnp.where(valid_c, s_c, NEG_INF), axis=-1) * valid_c
        o_c = jnp.einsum('bkgqn,bknd->bkgqd', p_c.astype(v_cmp.dtype), v_cmp)

        imp = jnp.einsum('bkgqn,nj->bkqj', p_c, overlap)
        cur = q_pos // SLC_LEN
        forced = ((blk_ids[None, :] == 0) | (blk_ids[None, :] == cur[:, None])
                  | (blk_ids[None, :] == cur[:, None] - 1))
        causal_blk = blk_ids[None, :] <= cur[:, None]
        imp = jnp.where(forced, FORCE_SCORE, jnp.where(causal_blk, imp, NEG_INF))
        _, sel = lax.top_k(imp, n_sel)
        k_sel = k_slc[b_ix, h_ix, sel].reshape(B, Hk, NSA_Q_BLOCK, n_sel * SLC_LEN, dk)
        v_sel = v_slc[b_ix, h_ix, sel].reshape(B, Hk, NSA_Q_BLOCK, n_sel * SLC_LEN, dk)
        pos_sel = (sel[..., None] * SLC_LEN + jnp.arange(SLC_LEN)).reshape(B, Hk, NSA_Q_BLOCK, n_sel * SLC_LEN)
        dist_s = q_pos[None, None, :, None] - pos_sel
        s_s = jnp.einsum('bkgqd,bkqnd->bkgqn', qb, k_sel, preferred_element_type=jnp.float32) * scale
        s_s = s_s + tbl[tk_ix, tg_ix, t5_bucket(dist_s)[:, :, None]]
        p_s = jax.nn.softmax(jnp.where((dist_s >= 0)[:, :, None], s_s, NEG_INF), axis=-1)
        o_s = jnp.einsum('bkgqn,bkqnd->bkgqd', p_s.astype(v_sel.dtype), v_sel)

        k_band = lax.dynamic_slice_in_dim(k_win, start, NSA_Q_BLOCK + WINDOW, axis=2)
        v_band = lax.dynamic_slice_in_dim(v_win, start, NSA_Q_BLOCK + WINDOW, axis=2)
        key_pos_w = start - WINDOW + jnp.arange(NSA_Q_BLOCK + WINDOW)
        dist_w = q_pos[:, None] - key_pos_w[None, :]
        valid_w = (dist_w >= 0) & (dist_w < WINDOW) & (key_pos_w[None, :] >= 0)
        s_w = jnp.einsum('bkgqd,bknd->bkgqn', qb, k_band, preferred_element_type=jnp.float32) * scale
        s_w = s_w + tbl[:, :, t5_bucket(dist_w)]
        p_w = jax.nn.softmax(jnp.where(valid_w, s_w, NEG_INF), axis=-1)
        o_w = jnp.einsum('bkgqn,bknd->bkgqd', p_w.astype(v_band.dtype), v_band)

        g = lax.dynamic_slice_in_dim(gates, start, NSA_Q_BLOCK, axis=3)
        return g[..., 0:1] * o_c + g[..., 1:2] * o_s + g[..., 2:3] * o_w

    o = lax.map(nsa_block, jnp.arange(S // NSA_Q_BLOCK))
    return o.transpose(1, 0, 4, 2, 3, 5).reshape(B, S, NSA_OUT)


def setup_inputs(seed: int = 0) -> dict:
    key = jax.random.key(seed)
    ks = jax.random.split(key, 24)
    f32 = jnp.float32

    def nrm(k, shape, fan_in):
        return jax.random.normal(k, shape, f32) * fan_in ** -0.5

    def gain(k, shape):
        return 1.0 + 0.02 * jax.random.normal(k, shape, f32)

    L = DEPTH
    return {
        'x': jax.random.normal(ks[0], (BATCH, SEQ, D_MODEL), f32),
        'norm_mix_g': gain(ks[1], (L, D_MODEL)),
        'w_in': nrm(ks[2], (L, D_MODEL, D_IN), D_MODEL),
        'mla_q_norm_g': gain(ks[3], (L, MLA_Q_LORA)),
        'mla_w_uq': nrm(ks[4], (L, MLA_Q_LORA, MLA_HEADS * (MLA_NOPE_DIM + MLA_ROPE_DIM)), MLA_Q_LORA),
        'mla_kv_norm_g': gain(ks[5], (L, MLA_KV_LORA)),
        'mla_w_ukv': nrm(ks[6], (L, MLA_KV_LORA, MLA_HEADS * (MLA_NOPE_DIM + MLA_V_DIM)), MLA_KV_LORA),
        'nsa_cmp_pos_k': 0.1 * jax.random.normal(ks[7], (L, CMP_LEN, NSA_HEAD_DIM), f32),
        'nsa_cmp_w1_k': nrm(ks[8], (L, CMP_LEN * NSA_HEAD_DIM, CMP_HIDDEN), CMP_LEN * NSA_HEAD_DIM),
        'nsa_cmp_w2_k': nrm(ks[9], (L, CMP_HIDDEN, NSA_HEAD_DIM), CMP_HIDDEN),
        'nsa_cmp_pos_v': 0.1 * jax.random.normal(ks[10], (L, CMP_LEN, NSA_HEAD_DIM), f32),
        'nsa_cmp_w1_v': nrm(ks[11], (L, CMP_LEN * NSA_HEAD_DIM, CMP_HIDDEN), CMP_LEN * NSA_HEAD_DIM),
        'nsa_cmp_w2_v': nrm(ks[12], (L, CMP_HIDDEN, NSA_HEAD_DIM), CMP_HIDDEN),
        't5_table': 0.2 * jax.random.normal(ks[13], (T5_BUCKETS, NSA_HEADS), f32),
        'out_norm_mla_g': gain(ks[14], (L, MLA_OUT)),
        'out_norm_nsa_g': gain(ks[15], (L, NSA_OUT)),
        'w_out': nrm(ks[16], (L, D_MIX, D_MODEL), D_MIX),
        'norm_ffn_g': gain(ks[17], (L, D_MODEL)),
        'w_gate': nrm(ks[18], (L, D_MODEL, D_FF), D_MODEL),
        'w_up': nrm(ks[19], (L, D_MODEL, D_FF), D_MODEL),
        'w_down': nrm(ks[20], (L, D_FF, D_MODEL), D_FF),
        'final_norm_g': gain(ks[21], (D_MODEL,)),
    }


def reference(x, norm_mix_g, w_in, mla_q_norm_g, mla_w_uq, mla_kv_norm_g, mla_w_ukv,
              nsa_cmp_pos_k, nsa_cmp_w1_k, nsa_cmp_w2_k, nsa_cmp_pos_v, nsa_cmp_w1_v, nsa_cmp_w2_v,
              t5_table, out_norm_mla_g, out_norm_nsa_g, w_out, norm_ffn_g, w_gate, w_up, w_down,
              final_norm_g):
    cuts = [int(c) for c in np.cumsum(IN_SPLITS)[:-1]]
    h = x
    for l in range(DEPTH):
        u = rmsnorm(h, norm_mix_g[l]) @ w_in[l]
        c_q, c_kv, k_rope, q_nsa, kv_cmp, kv_slc, kv_win, gate_logits = jnp.split(u, cuts, axis=-1)
        o_mla = mla_mixer(c_q, c_kv, k_rope, mla_q_norm_g[l], mla_w_uq[l], mla_kv_norm_g[l], mla_w_ukv[l])
        o_nsa = nsa_mixer(q_nsa, kv_cmp, kv_slc, kv_win, gate_logits,
                          nsa_cmp_pos_k[l], nsa_cmp_w1_k[l], nsa_cmp_w2_k[l],
                          nsa_cmp_pos_v[l], nsa_cmp_w1_v[l], nsa_cmp_w2_v[l], t5_table)
        mixed = jnp.concatenate([rmsnorm(o_mla, out_norm_mla_g[l]), rmsnorm(o_nsa, out_norm_nsa_g[l])], axis=-1)
        h = h + mixed @ w_out[l]
        f = rmsnorm(h, norm_ffn_g[l])
        h = h + (jax.nn.silu(f @ w_gate[l]) * (f @ w_up[l])) @ w_down[l]
    return rmsnorm(h, final_norm_g)
```

```cpp
#include <hip/hip_runtime.h>
#include <cstdio>
#include <cstdint>
namespace pg8 {
#define PG8_LAS __attribute__((address_space(3)))
typedef unsigned short bf16_t;
typedef short bf16x8 __attribute__((ext_vector_type(8)));
typedef float f32x4 __attribute__((ext_vector_type(4)));
typedef unsigned u32x4 __attribute__((ext_vector_type(4)));
constexpr int BM = 256, BK = 64, HALF = 128, HTB = HALF * BK * 2  , STAGE_BYTES = 8 * HTB, NXCD = 8, WGM = 8;

__host__ __device__ __forceinline__ int lds_byte(int r, int c) { const int st = (r >> 4) * 2 + (c >> 5), rr = r & 15, cc = c & 31, ob = rr * 64 + cc * 2; return st * 1024 + (ob ^ (((ob >> 9) & 1) << 5)); }
__host__ __device__ __forceinline__ void stage_rc(int b, int& R, int& C) { const int st = b / 1024, sb = b % 1024, swz = sb ^ (((sb >> 9) & 1) << 5); R = (st >> 1) * 16 + swz / 64; C = (st & 1) * 32 + (swz % 64) / 2; }
__host__ __device__ __forceinline__ int perm32(int rho) { const int n = rho >> 4, i = rho & 15; return 8 * (i >> 2) + 4 * n + (i & 3); }

struct Unit { int pm, pn; };
struct Gemm { const bf16_t* A; const bf16_t* Bt; int M, N, K, lda, ldb; };

struct StaticOrder {
    int nM, nN, nwg, G, c;
    __host__ __device__ void init(int M, int N, int G_, int c_) { nM = M / BM; nN = N / BM; nwg = nM * nN; G = G_; c = c_; }
    __host__ __device__ bool next(int i, Unit& u) const {
        const long L = (long)i * G + c; if (L >= nwg) return false;
        int wgid = (int)L; { const int q = nwg / NXCD, r = nwg % NXCD, xcd = wgid % NXCD, off = wgid / NXCD; wgid = (xcd < r ? xcd * (q + 1) : r * (q + 1) + (xcd - r) * q) + off; }
        const int nig = WGM * nN, gid = wgid / nig, fm = gid * WGM, gsz = (nM - fm) < WGM ? (nM - fm) : WGM;
        u.pm = fm + ((wgid % nig) % gsz); u.pn = (wgid % nig) / gsz; return true;
    }
    __device__ __forceinline__ void a_ready(const Unit&) const {}
    __device__ __forceinline__ void done(const Unit&) const {}
};

__device__ __forceinline__ unsigned cvt_pk_bf16(float lo, float hi) { unsigned r; asm volatile("v_cvt_pk_bf16_f32 %0, %1, %2" : "=v"(r) : "v"(lo), "v"(hi)); return r; }
typedef float f32x2 __attribute__((ext_vector_type(2)));
template <class Epi, class Sched, bool ALIGN_EPI = false, bool SP2 = false>
__device__ __forceinline__ void gemm_phase(PG8_LAS unsigned char* lds, const Gemm g, const Sched& S, const Epi& E) {
    int tid_ = threadIdx.x; asm volatile("" : "+v"(tid_));
    const int tid = tid_, wid = __builtin_amdgcn_readfirstlane(tid >> 6), lane = tid & 63, wr = wid >> 2, wc = wid & 3, fr = lane & 15, fq = lane >> 4;
    const int K = g.K, nt = K / BK;
    unsigned voffA[2], voffB[2];
#pragma unroll
    for (int i = 0; i < 2; ++i) { int R, C; stage_rc(tid * 16 + i * 8192, R, C); const int Rb = Epi::PERM ? ((R & ~31) + perm32(R & 31)) : R;
        voffA[i] = (unsigned)(R * g.lda + C) * 2u; voffB[i] = (unsigned)(Rb * g.ldb + C) * 2u; }
    const size_t kstep = (size_t)(BK * 2);
    const size_t hstepA = (size_t)HALF * g.lda * 2, hstepB = (size_t)HALF * g.ldb * 2;
    const size_t tstepA = 2 * hstepA, tstepB = 2 * hstepB;
    const unsigned ldsw = (unsigned)wid * 1024u;
    const int aoff = lds_byte(wr * 64 + fr, fq * 8), boff = lds_byte(wc * 32 + fr, fq * 8);
#define PG8_SA(b, h) (((b) * 2 + (h)) * HTB)
#define PG8_SB(b, h) ((4 + (b) * 2 + (h)) * HTB)
#define PG8_STAGE(bufoff, gbase, voff) do { _Pragma("unroll") for (int _i = 0; _i < 2; ++_i) \
        __builtin_amdgcn_global_load_lds((const unsigned*)((const char*)(gbase) + (voff)[_i]), (PG8_LAS unsigned*)(lds + (bufoff) + ldsw + _i * 8192), 16, 0, 0); } while (0)
#define PG8_LDA(dst, b, h) do { _Pragma("unroll") for (int m = 0; m < 4; ++m) _Pragma("unroll") for (int k = 0; k < 2; ++k) dst[m][k] = *(const PG8_LAS bf16x8*)(lds + PG8_SA(b, h) + aoff + m * 2048 + k * 1024); } while (0)
#define PG8_LDB(dst, b, h) do { _Pragma("unroll") for (int n = 0; n < 2; ++n) _Pragma("unroll") for (int k = 0; k < 2; ++k) dst[n][k] = *(const PG8_LAS bf16x8*)(lds + PG8_SB(b, h) + boff + n * 2048 + k * 1024); } while (0)
#define PG8_MMA(ai, bj, At, Bt) do { __builtin_amdgcn_s_setprio(1); _Pragma("unroll") for (int m = 0; m < 4; ++m) _Pragma("unroll") for (int n = 0; n < 2; ++n) _Pragma("unroll") for (int k = 0; k < 2; ++k) \
        acc[ai][bj][m][n] = __builtin_amdgcn_mfma_f32_16x16x32_bf16(Bt[n][k], At[m][k], acc[ai][bj][m][n], 0, 0, 0); __builtin_amdgcn_s_setprio(0); } while (0)
#define PG8_WAIT_V(n) asm volatile("s_waitcnt vmcnt(" #n ")" ::: "memory")
#define PG8_WAIT_L(n) asm volatile("s_waitcnt lgkmcnt(" #n ")" ::: "memory")
#define PG8_BAR __builtin_amdgcn_s_barrier()
#define PG8_SCHED __builtin_amdgcn_sched_barrier(0)
    Unit cur, nxt; int ui = 0;
    if (!S.next(0, cur)) return;
    f32x4 acc[2][2][4][2];
#pragma unroll
    for (int a = 0; a < 2; ++a)
#pragma unroll
        for (int b = 0; b < 2; ++b)
#pragma unroll
            for (int m = 0; m < 4; ++m)
#pragma unroll
                for (int n = 0; n < 2; ++n) acc[a][b][m][n] = (f32x4){0.f, 0.f, 0.f, 0.f};
    bf16x8 At[4][2], B0[2][2], B1[2][2];
    const char* cA = (const char*)g.A + (size_t)cur.pm * tstepA; const char* cB = (const char*)g.Bt + (size_t)cur.pn * tstepB;
    S.a_ready(cur);
    if constexpr (SP2) {
        PG8_STAGE(PG8_SB(0, 0), cB, voffB); PG8_STAGE(PG8_SB(0, 1), cB + hstepB, voffB); PG8_STAGE(PG8_SA(0, 0), cA, voffA); PG8_STAGE(PG8_SA(0, 1), cA + hstepA, voffA);
        if (wr == 1) PG8_BAR;
        PG8_WAIT_V(2); PG8_BAR;
        PG8_STAGE(PG8_SB(1, 0), cB + kstep, voffB); PG8_STAGE(PG8_SA(1, 0), cA + kstep, voffA); PG8_STAGE(PG8_SB(1, 1), cB + hstepB + kstep, voffB);
        PG8_WAIT_V(6); PG8_BAR;
    } else {
        PG8_STAGE(PG8_SB(0, 0), cB, voffB); PG8_STAGE(PG8_SA(0, 0), cA, voffA); PG8_STAGE(PG8_SB(0, 1), cB + hstepB, voffB); PG8_STAGE(PG8_SA(0, 1), cA + hstepA, voffA);
        if (wr == 1) PG8_BAR;
        PG8_WAIT_V(4); PG8_BAR;
        PG8_STAGE(PG8_SB(1, 0), cB + kstep, voffB); PG8_STAGE(PG8_SA(1, 0), cA + kstep, voffA); PG8_STAGE(PG8_SB(1, 1), cB + hstepB + kstep, voffB);
        PG8_WAIT_V(6); PG8_BAR;
    }
    for (;;) {
        const bool has_next = S.next(ui + 1, nxt);
        const char* nA = has_next ? (const char*)g.A + (size_t)nxt.pm * tstepA : cA; const char* nB = has_next ? (const char*)g.Bt + (size_t)nxt.pn * tstepB : cB;
        for (int t = 0; t < nt; t += 2) {
            const bool last = (t == nt - 2);
            const char* a1 = cA + (size_t)(t + 1) * kstep;
            const char* a2 = last ? nA : cA + (size_t)(t + 2) * kstep; const char* b2 = last ? nB : cB + (size_t)(t + 2) * kstep;
            const char* a3 = a2 + kstep; const char* b3 = b2 + kstep;
            if (last && has_next) S.a_ready(nxt);
            if constexpr (SP2) {
            PG8_LDB(B0, 0, 0); PG8_LDB(B1, 0, 1); PG8_SCHED; PG8_LDA(At, 0, 0); PG8_STAGE(PG8_SA(1, 1), a1 + hstepA, voffA);
            PG8_WAIT_V(8); PG8_WAIT_L(0); PG8_BAR; PG8_MMA(0, 0, At, B0); PG8_MMA(0, 1, At, B1); PG8_BAR; PG8_SCHED;
            PG8_LDA(At, 0, 1); PG8_STAGE(PG8_SB(0, 0), b2, voffB); PG8_STAGE(PG8_SB(0, 1), b2 + hstepB, voffB); PG8_STAGE(PG8_SA(0, 0), a2, voffA);
            PG8_WAIT_V(8); PG8_WAIT_L(0); PG8_BAR; PG8_MMA(1, 0, At, B0); PG8_MMA(1, 1, At, B1); PG8_BAR; PG8_SCHED;
            PG8_LDB(B0, 1, 0); PG8_LDB(B1, 1, 1); PG8_SCHED; PG8_LDA(At, 1, 0); PG8_STAGE(PG8_SA(0, 1), a2 + hstepA, voffA);
            PG8_WAIT_V(8); PG8_WAIT_L(0); PG8_BAR; PG8_MMA(0, 0, At, B0); PG8_MMA(0, 1, At, B1); PG8_BAR; PG8_SCHED;
            PG8_LDA(At, 1, 1); PG8_STAGE(PG8_SB(1, 0), b3, voffB); PG8_STAGE(PG8_SB(1, 1), b3 + hstepB, voffB); PG8_STAGE(PG8_SA(1, 0), a3, voffA);
            PG8_WAIT_V(8); PG8_WAIT_L(0); PG8_BAR; PG8_MMA(1, 0, At, B0); PG8_MMA(1, 1, At, B1); PG8_BAR; PG8_SCHED;
            } else {
            PG8_LDB(B0, 0, 0); PG8_SCHED; PG8_LDA(At, 0, 0); PG8_STAGE(PG8_SA(1, 1), a1 + hstepA, voffA);
            PG8_WAIT_L(8); PG8_BAR; PG8_WAIT_L(0); PG8_MMA(0, 0, At, B0); PG8_BAR; PG8_SCHED;
            PG8_LDB(B1, 0, 1); PG8_STAGE(PG8_SB(0, 0), b2, voffB);
            PG8_BAR; PG8_WAIT_L(0); PG8_MMA(0, 1, At, B1); PG8_BAR;
            PG8_LDA(At, 0, 1); PG8_STAGE(PG8_SA(0, 0), a2, voffA);
            PG8_BAR; PG8_WAIT_L(0); PG8_MMA(1, 0, At, B0); PG8_BAR; PG8_SCHED;
            PG8_STAGE(PG8_SB(0, 1), b2 + hstepB, voffB);
            PG8_WAIT_V(6); PG8_BAR; PG8_MMA(1, 1, At, B1); PG8_BAR;
            PG8_LDB(B0, 1, 0); PG8_SCHED; PG8_LDA(At, 1, 0); PG8_STAGE(PG8_SA(0, 1), a2 + hstepA, voffA);
            PG8_WAIT_L(8); PG8_BAR; PG8_WAIT_L(0); PG8_MMA(0, 0, At, B0); PG8_BAR; PG8_SCHED;
            PG8_LDB(B1, 1, 1); PG8_STAGE(PG8_SB(1, 0), b3, voffB);
            PG8_BAR; PG8_WAIT_L(0); PG8_MMA(0, 1, At, B1); PG8_BAR;
            PG8_LDA(At, 1, 1); PG8_STAGE(PG8_SA(1, 0), a3, voffA);
            PG8_BAR; PG8_WAIT_L(0); PG8_MMA(1, 0, At, B0); PG8_BAR; PG8_SCHED;
            PG8_STAGE(PG8_SB(1, 1), b3 + hstepB, voffB);
            PG8_WAIT_V(6); PG8_BAR; PG8_MMA(1, 1, At, B1); PG8_BAR;
            }
        }
        if constexpr (ALIGN_EPI) { if (wr == 0) PG8_BAR; }
        if constexpr (!Epi::AFTER_DRAIN) { E(acc, cur, wr, wc, fr, fq); S.done(cur); }
        if (!has_next) break;
#pragma unroll
        for (int a = 0; a < 2; ++a)
#pragma unroll
            for (int b = 0; b < 2; ++b)
#pragma unroll
                for (int m = 0; m < 4; ++m)
#pragma unroll
                    for (int n = 0; n < 2; ++n) acc[a][b][m][n] = (f32x4){0.f, 0.f, 0.f, 0.f};
        cur = nxt; cA = nA; cB = nB; ++ui;
        if constexpr (ALIGN_EPI) { if (wr == 1) PG8_BAR; }
    }
    PG8_WAIT_V(0);
    if constexpr (!ALIGN_EPI) { if (wr == 0) PG8_BAR; }
    PG8_BAR;
    if constexpr (Epi::AFTER_DRAIN) { E.fused(acc, cur, wr, wc, fr, fq, lds, wid, lane); S.done(cur); }
#undef PG8_SA
#undef PG8_SB
#undef PG8_STAGE
#undef PG8_LDA
#undef PG8_LDB
#undef PG8_MMA
#undef PG8_WAIT_V
#undef PG8_WAIT_L
#undef PG8_BAR
#undef PG8_SCHED
}
}
#define GAS __attribute__((address_space(1)))
#define LAS __attribute__((address_space(3)))
typedef unsigned short bf16;
typedef unsigned v4u __attribute__((ext_vector_type(4)));
typedef float f32x4 __attribute__((ext_vector_type(4)));
typedef short bf16x8 __attribute__((ext_vector_type(8)));
typedef GAS unsigned gu32;
typedef GAS unsigned long long gu64;
#define RLX_AGENT __ATOMIC_RELAXED, __HIP_MEMORY_SCOPE_AGENT
#define LDS_WAIT() asm volatile("s_waitcnt lgkmcnt(0)" ::: "memory")
#define VM_WAIT() asm volatile("s_waitcnt vmcnt(0)" ::: "memory")
__device__ __forceinline__ unsigned long long rt() { return __builtin_amdgcn_s_memrealtime(); }
__device__ __forceinline__ unsigned f2bf(float f) { unsigned u = __builtin_bit_cast(unsigned, f); return (u + 0x7fffu + ((u >> 16) & 1u)) >> 16; }
__device__ __forceinline__ unsigned pk2(float lo, float hi) { return pg8::cvt_pk_bf16(lo, hi); }

#define XB_TMO      128
#define XB_XCNT(j)  (256  + 64 * (j))
#define XB_XSUB(j)  (1280 + 64 * (j))
#define XB_XGEN(j)  (2304 + 64 * (j))
#define XB_TOP      3328
#define XB_TOPGEN   3392
#define XCD_BAR_WORDS 3456
#define XB_SPIN_CAP (1u << 18)

__device__ __forceinline__ unsigned xb_ld(unsigned* p)              { return __hip_atomic_load(p, __ATOMIC_RELAXED, __HIP_MEMORY_SCOPE_AGENT); }
__device__ __forceinline__ unsigned xb_add(unsigned* p, unsigned v) { return __hip_atomic_fetch_add(p, v, __ATOMIC_RELAXED, __HIP_MEMORY_SCOPE_AGENT); }
__device__ __forceinline__ unsigned xb_xcc_id() { return (unsigned)__builtin_amdgcn_s_getreg((3 << 11) | 20) & 0xFu; }
#define XB_SPIN(cond, bar) do { unsigned _sp = 0; while (cond) { __builtin_amdgcn_s_sleep(1); \
    if ((++_sp & 255u) == 0u) { if (xb_ld(&(bar)[XB_TMO])) break; if (_sp > XB_SPIN_CAP) { atomicAdd(&(bar)[XB_TMO], 1u); break; } } } } while (0)

struct XcdBarrier {
    unsigned* bar; unsigned x;
    volatile LAS unsigned* st;
};

__device__ __forceinline__ XcdBarrier xcd_barrier_post(unsigned* bar, volatile LAS unsigned* st) {
    XcdBarrier b; b.bar = bar; b.x = xb_xcc_id(); b.st = st;
    if (threadIdx.x == 0) (void)xb_add(&bar[XB_XCNT(b.x)], 1u);
    return b;
}
__device__ __forceinline__ void xcd_barrier_complete(unsigned* bar, unsigned x, unsigned& nloc, unsigned& nx) {
    const unsigned G = gridDim.x * gridDim.y * gridDim.z;
    unsigned sum, cnt, mine, sp = 0u;
    for (;;) {
        sum = 0u; cnt = 0u; mine = 0u;
#pragma unroll
        for (unsigned j = 0; j < 16; ++j) { const unsigned c = xb_ld(&bar[XB_XCNT(j)]); sum += c; cnt += (c > 0u) ? 1u : 0u; mine = (j == x) ? c : mine; }
        if (sum == G) break;
        __builtin_amdgcn_s_sleep(1);
        if ((++sp & 255u) == 0u) { if (xb_ld(&bar[XB_TMO])) break; if (sp > XB_SPIN_CAP) { atomicAdd(&bar[XB_TMO], 1u); break; } }
    }
    nloc = mine > 0u ? mine : 1u; nx = cnt > 0u ? cnt : 1u;
}

__device__ __forceinline__ void xcd_barrier(const XcdBarrier& b) {
    asm volatile("s_waitcnt vmcnt(0)" ::: "memory");
    __syncthreads();
    if (threadIdx.x == 0) {
        unsigned* bar = b.bar;
        __builtin_amdgcn_s_waitcnt(0);
        unsigned nloc = b.st[0], nx = b.st[1];
        if (nloc == 0u) { xcd_barrier_complete(bar, b.x, nloc, nx); b.st[0] = nloc; b.st[1] = nx; }
        const unsigned old = xb_add(&bar[XB_XSUB(b.x)], 1u);
        const unsigned gen = old / nloc;
        if (old + 1u == (gen + 1u) * nloc) {
            __builtin_amdgcn_fence(__ATOMIC_RELEASE, "agent");
            asm volatile("s_waitcnt vmcnt(0)" ::: "memory");
            const unsigned og = xb_add(&bar[XB_TOP], 1u);
            const unsigned tg = og / nx;
            if (og + 1u == (tg + 1u) * nx) xb_add(&bar[XB_TOPGEN], 1u);
            else XB_SPIN(xb_ld(&bar[XB_TOPGEN]) == tg, bar);
            __builtin_amdgcn_fence(__ATOMIC_ACQUIRE, "agent");
            xb_add(&bar[XB_XGEN(b.x)], 1u);
            asm volatile("s_waitcnt vmcnt(0)" ::: "memory");
        } else {
            XB_SPIN(xb_ld(&bar[XB_XGEN(b.x)]) == gen, bar);
            __builtin_amdgcn_fence(__ATOMIC_ACQUIRE, "agent");
            asm volatile("s_waitcnt vmcnt(0)" ::: "memory");
        }
    }
    __syncthreads();
}

constexpr int NB = 16, SEQ = 4096, DM = 1024, MT = NB * SEQ;
constexpr int DINP = 1792;
constexpr int C_CQ = 0, C_CKV = 256, C_KR = 384, C_QN = 416, C_KVC = 928, C_KVS = 1184, C_KVW = 1440, C_GATE = 1696, DIN = 1720;
constexpr int DFF = 2816, NGU = 2 * DFF;
constexpr int NCMP = 255;
constexpr float EPS = 1e-6f;
constexpr float LOG2E = 1.4426950408889634f;
constexpr float C2Q = 0.10206207261596575f * 1.4426950408889634f;
constexpr float C2N = 0.125f * 1.4426950408889634f;

constexpr int NWAVES = 8, NTHR = 512;
constexpr int NPHASE = 8;
#ifndef MK_N_LAUNCHES
#define MK_N_LAUNCHES 1
#endif
constexpr int N_LAUNCHES = MK_N_LAUNCHES;

constexpr size_t MiB = 1u << 20;
constexpr size_t WS_CTL = 0, CTL_ZERO_BYTES = 1 * MiB;
constexpr size_t WS_WIN = 2 * MiB, WS_WUQ = 6 * MiB, WS_WUKV = 7 * MiB, WS_WOUT = 8 * MiB, WS_WGU = 10 * MiB, WS_WDN = 21 * MiB;
constexpr size_t WS_ROPE = 27 * MiB, WS_BIAS = 27 * MiB + 512 * 1024, WS_BIAS1 = WS_BIAS + 8192;
constexpr size_t WS_RSTDX = 28 * MiB, WS_SSQKV = 29 * MiB, WS_SSATT = 31 * MiB, WS_SSH = 35 * MiB;
constexpr size_t WS_KCMP = 39 * MiB, WS_VCMP = 40 * MiB, WS_KPE = 41 * MiB;
constexpr size_t WS_XB = 64 * MiB, WS_U = 192 * MiB, WS_QM = 420 * MiB, WS_KVM = 516 * MiB, WS_ATT = 644 * MiB, WS_H = 772 * MiB, WS_END = 900 * MiB;
constexpr size_t WS_HID = 64 * MiB;
static_assert(WS_U + (size_t)MT * DINP * 2 <= WS_QM && WS_HID + (size_t)MT * DFF * 2 <= WS_QM && WS_QM + (size_t)MT * 768 * 2 <= WS_KVM && WS_KVM + (size_t)MT * 1024 * 2 <= WS_ATT, "ws map");
constexpr int CW_TMO = 0, CW_BAR = 4096;

constexpr int LDS_BYTES = 163840;
constexpr int MISC_OFF = LDS_BYTES - 256;


typedef unsigned u32x4 __attribute__((ext_vector_type(4))); using pg8::Unit; using pg8::cvt_pk_bf16; using pg8::HALF; using pg8::BM;
typedef float f32x2v __attribute__((ext_vector_type(2)));
__device__ __forceinline__ float bf2f(unsigned short b) { return __builtin_bit_cast(float, (unsigned)b << 16); }
__device__ __forceinline__ float bflo(unsigned w) { return __builtin_bit_cast(float, w << 16); }
__device__ __forceinline__ float bfhi(unsigned w) { return __builtin_bit_cast(float, w & 0xffff0000u); }
__device__ __forceinline__ float sq4(const f32x4 v) { return (v[0] * v[0] + v[1] * v[1]) + (v[2] * v[2] + v[3] * v[3]); }

struct EpiInProj {
    static constexpr bool PERM = true, AFTER_DRAIN = false;
    pg8::bf16_t* U; const float* rstd; float* ssq;
    __device__ __forceinline__ void operator()(const f32x4 (&acc)[2][2][4][2], const Unit& u, int wr, int wc, int fr, int fq) const {
        const int row0 = u.pm * BM + wr * 64 + fr, col0 = u.pn * BM + wc * 32 + 8 * fq;
#pragma unroll
        for (int ai = 0; ai < 2; ++ai)
#pragma unroll
            for (int m = 0; m < 4; ++m) {
                const int row = row0 + ai * HALF + m * 16; const float r = rstd[row];
                pg8::bf16_t* rowp = U + (size_t)row * DINP + col0; float s0 = 0.f, s1 = 0.f;
#pragma unroll
                for (int bj = 0; bj < 2; ++bj) { const f32x4 v0 = acc[ai][bj][m][0] * r, v1 = acc[ai][bj][m][1] * r;
                    u32x4 w; w.x = cvt_pk_bf16(v0[0], v0[1]); w.y = cvt_pk_bf16(v0[2], v0[3]); w.z = cvt_pk_bf16(v1[0], v1[1]); w.w = cvt_pk_bf16(v1[2], v1[3]);
                    *(u32x4*)(rowp + bj * HALF) = w;
                    const float s = sq4(v0) + sq4(v1); if (bj == 0) s0 = s; else s1 = s; }
                if (u.pn < 2) {
                    float s = (u.pn == 0) ? (s0 + s1) : s0;
                    s += __shfl_xor(s, 16); s += __shfl_xor(s, 32);
                    if (fq == 0) ssq[(size_t)row * 8 + (u.pn == 0 ? 0 : 4) + wc] = s;
                }
            }
    }
};
struct EpiQup {
    static constexpr bool PERM = true, AFTER_DRAIN = false;
    pg8::bf16_t* Q; const float* ssq; const f32x2v* rope;
    __device__ __forceinline__ void operator()(const f32x4 (&acc)[2][2][4][2], const Unit& u, int wr, int wc, int fr, int fq) const {
        const int row0 = u.pm * BM + wr * 64 + fr, col0 = u.pn * BM + wc * 32 + 8 * fq;
#pragma unroll
        for (int ai = 0; ai < 2; ++ai)
#pragma unroll
            for (int m = 0; m < 4; ++m) {
                const int row = row0 + ai * HALF + m * 16; const int pos = row & (SEQ - 1);
                const f32x4 pp = *(const f32x4*)(ssq + (size_t)row * 8);
                const float r = __builtin_amdgcn_rsqf(((pp[0] + pp[1]) + (pp[2] + pp[3])) * (1.0f / 256.0f) + EPS) * C2Q;
#pragma unroll
                for (int bj = 0; bj < 2; ++bj) { const int c = col0 + bj * HALF; const int d = c % 96;
                    f32x4 v0 = acc[ai][bj][m][0] * r, v1 = acc[ai][bj][m][1] * r;
                    if (d >= 64) { const int i0 = (d - 64) >> 1; const f32x2v* rp = rope + pos * 16 + i0;
                        const f32x2v a = rp[0], b = rp[1], e = rp[2], f = rp[3];
                        f32x4 w0, w1;
                        w0[0] = v0[0] * a.x - v0[1] * a.y; w0[1] = v0[0] * a.y + v0[1] * a.x;
                        w0[2] = v0[2] * b.x - v0[3] * b.y; w0[3] = v0[2] * b.y + v0[3] * b.x;
                        w1[0] = v1[0] * e.x - v1[1] * e.y; w1[1] = v1[0] * e.y + v1[1] * e.x;
                        w1[2] = v1[2] * f.x - v1[3] * f.y; w1[3] = v1[2] * f.y + v1[3] * f.x;
                        v0 = w0; v1 = w1; }
                    u32x4 w; w.x = cvt_pk_bf16(v0[0], v0[1]); w.y = cvt_pk_bf16(v0[2], v0[3]); w.z = cvt_pk_bf16(v1[0], v1[1]); w.w = cvt_pk_bf16(v1[2], v1[3]);
                    *(u32x4*)(Q + (size_t)row * 768 + c) = w; }
                asm volatile("" ::: "memory");
            }
    }
};
struct EpiKVup {
    static constexpr bool PERM = true, AFTER_DRAIN = false;
    pg8::bf16_t* KV; const float* ssq;
    __device__ __forceinline__ void operator()(const f32x4 (&acc)[2][2][4][2], const Unit& u, int wr, int wc, int fr, int fq) const {
        const int row0 = u.pm * BM + wr * 64 + fr, col0 = u.pn * BM + wc * 32 + 8 * fq;
#pragma unroll
        for (int ai = 0; ai < 2; ++ai)
#pragma unroll
            for (int m = 0; m < 4; ++m) {
                const int row = row0 + ai * HALF + m * 16;
                const f32x4 pp = *(const f32x4*)(ssq + (size_t)row * 8 + 4);
                const float r = __builtin_amdgcn_rsqf(((pp[0] + pp[1]) + (pp[2] + pp[3])) * (1.0f / 128.0f) + EPS);
#pragma unroll
                for (int bj = 0; bj < 2; ++bj) { const f32x4 v0 = acc[ai][bj][m][0] * r, v1 = acc[ai][bj][m][1] * r;
                    u32x4 w; w.x = cvt_pk_bf16(v0[0], v0[1]); w.y = cvt_pk_bf16(v0[2], v0[3]); w.z = cvt_pk_bf16(v1[0], v1[1]); w.w = cvt_pk_bf16(v1[2], v1[3]);
                    *(u32x4*)(KV + (size_t)row * 1024 + col0 + bj * HALF) = w; }
                if (m & 1) asm volatile("" ::: "memory");
            }
    }
};
struct EpiOut1 {
    static constexpr bool PERM = true, AFTER_DRAIN = false;
    const float* x; float* T; const float* ssatt;
    __device__ __forceinline__ void operator()(const f32x4 (&acc)[2][2][4][2], const Unit& u, int wr, int wc, int fr, int fq) const {
        const int row0 = u.pm * BM + wr * 64 + fr, col0 = u.pn * BM + wc * 32 + 8 * fq;
#pragma unroll
        for (int ai = 0; ai < 2; ++ai)
#pragma unroll
            for (int m = 0; m < 4; ++m) {
                const int row = row0 + ai * HALF + m * 16;
                const f32x4 p0 = *(const f32x4*)(ssatt + (size_t)row * 16), p1 = *(const f32x4*)(ssatt + (size_t)row * 16 + 4);
                const float r = __builtin_amdgcn_rsqf((((p0[0] + p0[1]) + (p0[2] + p0[3])) + ((p1[0] + p1[1]) + (p1[2] + p1[3]))) * (1.0f / 512.0f) + EPS);
#pragma unroll
                for (int bj = 0; bj < 2; ++bj) { const size_t off = (size_t)row * DM + col0 + bj * HALF;
                    const f32x4 x0 = *(const f32x4*)(x + off), x1 = *(const f32x4*)(x + off + 4);
                    *(f32x4*)(T + off) = x0 + acc[ai][bj][m][0] * r; *(f32x4*)(T + off + 4) = x1 + acc[ai][bj][m][1] * r; }
                if (m & 1) asm volatile("" ::: "memory");
            }
    }
};
struct EpiOut2 {
    static constexpr bool PERM = true, AFTER_DRAIN = false;
    const float* T; pg8::bf16_t* H; const float* ssatt; float* ssh;
    __device__ __forceinline__ void operator()(const f32x4 (&acc)[2][2][4][2], const Unit& u, int wr, int wc, int fr, int fq) const {
        const int row0 = u.pm * BM + wr * 64 + fr, col0 = u.pn * BM + wc * 32 + 8 * fq;
#pragma unroll
        for (int ai = 0; ai < 2; ++ai)
#pragma unroll
            for (int m = 0; m < 4; ++m) {
                const int row = row0 + ai * HALF + m * 16;
                const f32x4 p0 = *(const f32x4*)(ssatt + (size_t)row * 16 + 8), p1 = *(const f32x4*)(ssatt + (size_t)row * 16 + 12);
                const float r = __builtin_amdgcn_rsqf((((p0[0] + p0[1]) + (p0[2] + p0[3])) + ((p1[0] + p1[1]) + (p1[2] + p1[3]))) * (1.0f / 512.0f) + EPS);
                float s = 0.f;
#pragma unroll
                for (int bj = 0; bj < 2; ++bj) { const size_t off = (size_t)row * DM + col0 + bj * HALF;
                    const f32x4 v0 = *(const f32x4*)(T + off) + acc[ai][bj][m][0] * r, v1 = *(const f32x4*)(T + off + 4) + acc[ai][bj][m][1] * r;
                    u32x4 w; w.x = cvt_pk_bf16(v0[0], v0[1]); w.y = cvt_pk_bf16(v0[2], v0[3]); w.z = cvt_pk_bf16(v1[0], v1[1]); w.w = cvt_pk_bf16(v1[2], v1[3]);
                    *(u32x4*)(H + off) = w; s += sq4(v0) + sq4(v1); }
                s += __shfl_xor(s, 16); s += __shfl_xor(s, 32);
                if (fq == 0) ssh[(size_t)row * 16 + u.pn * 4 + wc] = s;
                if (m & 1) asm volatile("" ::: "memory");
            }
    }
};
struct EpiGU {
    static constexpr bool PERM = true, AFTER_DRAIN = false;
    pg8::bf16_t* HID; const float* ssh;
    __device__ __forceinline__ void operator()(const f32x4 (&acc)[2][2][4][2], const Unit& u, int wr, int wc, int fr, int fq) const {
        const int row0 = u.pm * BM + wr * 64 + fr, col0 = u.pn * HALF + wc * 32 + 8 * fq;
#pragma unroll
        for (int ai = 0; ai < 2; ++ai)
#pragma unroll
            for (int m = 0; m < 4; ++m) {
                const int row = row0 + ai * HALF + m * 16;
                const f32x4* pp = (const f32x4*)(ssh + (size_t)row * 16); const f32x4 p0 = pp[0], p1 = pp[1], p2 = pp[2], p3 = pp[3];
                const float tot = (((p0[0] + p0[1]) + (p0[2] + p0[3])) + ((p1[0] + p1[1]) + (p1[2] + p1[3]))) + (((p2[0] + p2[1]) + (p2[2] + p2[3])) + ((p3[0] + p3[1]) + (p3[2] + p3[3])));
                const float r = __builtin_amdgcn_rsqf(tot * (1.0f / 1024.0f) + EPS);
                float o[8];
#pragma unroll
                for (int n = 0; n < 2; ++n)
#pragma unroll
                    for (int e = 0; e < 4; ++e) { const float g = acc[ai][0][m][n][e] * r, up = acc[ai][1][m][n][e] * r;
                        const float sg = g * __builtin_amdgcn_rcpf(1.0f + __builtin_amdgcn_exp2f(-g * LOG2E)); o[n * 4 + e] = sg * up; }
                u32x4 w; w.x = cvt_pk_bf16(o[0], o[1]); w.y = cvt_pk_bf16(o[2], o[3]); w.z = cvt_pk_bf16(o[4], o[5]); w.w = cvt_pk_bf16(o[6], o[7]);
                *(u32x4*)(HID + (size_t)row * DFF + col0) = w;
                if (m & 1) asm volatile("" ::: "memory");
            }
    }
};
struct EpiDown {
    static constexpr bool PERM = true, AFTER_DRAIN = false;
    const pg8::bf16_t* H; float* O;
    __device__ __forceinline__ void operator()(const f32x4 (&acc)[2][2][4][2], const Unit& u, int wr, int wc, int fr, int fq) const {
        const int row0 = u.pm * BM + wr * 64 + fr, col0 = u.pn * BM + wc * 32 + 8 * fq;
#pragma unroll
        for (int ai = 0; ai < 2; ++ai)
#pragma unroll
            for (int m = 0; m < 4; ++m) {
                const int row = row0 + ai * HALF + m * 16;
#pragma unroll
                for (int bj = 0; bj < 2; ++bj) { const size_t off = (size_t)row * DM + col0 + bj * HALF;
                    const u32x4 hw = *(const u32x4*)(H + off);
                    f32x4 h0, h1; h0[0] = bflo(hw.x); h0[1] = bfhi(hw.x); h0[2] = bflo(hw.y); h0[3] = bfhi(hw.y); h1[0] = bflo(hw.z); h1[1] = bfhi(hw.z); h1[2] = bflo(hw.w); h1[3] = bfhi(hw.w);
                    *(f32x4*)(O + off) = h0 + acc[ai][bj][m][0]; *(f32x4*)(O + off + 4) = h1 + acc[ai][bj][m][1]; }
                if (m & 1) asm volatile("" ::: "memory");
            }
    }
};

struct Args { const float* in[22]; float* out; unsigned char* ws; int ph_lo, ph_hi, li, pad; };
enum { I_X = 0, I_GMIX, I_WIN, I_GQ, I_WUQ, I_GKV, I_WUKV, I_POSK, I_W1K, I_W2K, I_POSV, I_W1V, I_W2V, I_T5, I_GOM, I_GON, I_WOUT, I_GFFN, I_WG, I_WU, I_WD, I_GFIN };

__device__ __forceinline__ float wave_sum(float v) {
#pragma unroll
    for (int o = 1; o < 64; o <<= 1) v += __shfl_xor(v, o);
    return v;
}
typedef __bf16 bf16x2_t __attribute__((ext_vector_type(2)));
__device__ __forceinline__ float dot2(unsigned a, unsigned b, float c) { return __builtin_amdgcn_fdot2_f32_bf16(__builtin_bit_cast(bf16x2_t, a), __builtin_bit_cast(bf16x2_t, b), c, false); }

template <class F> __device__ __forceinline__ void tr_item(F f, bf16* WT, int ldk, int nblk, LAS float* scr, int item, int lane) {
    const int kb = item / nblk, nb = item % nblk, k0 = 64 * kb, n0 = 32 * nb;
#pragma unroll 8
    for (int i = 0; i < 32; ++i) { const int kk = 2 * i + (lane >> 5); scr[kk * 33 + (lane & 31)] = f(k0 + kk, n0 + (lane & 31)); }
    LDS_WAIT(); asm volatile("" ::: "memory");
    const int c = lane & 7;
#pragma unroll
    for (int j = 0; j < 4; ++j) { const int n = (lane >> 3) + 8 * j; const LAS float* s = scr + (8 * c) * 33 + n;
        v4u o; o.x = pk2(s[0 * 33], s[1 * 33]); o.y = pk2(s[2 * 33], s[3 * 33]); o.z = pk2(s[4 * 33], s[5 * 33]); o.w = pk2(s[6 * 33], s[7 * 33]);
        *(GAS v4u*)(WT + (size_t)(n0 + n) * ldk + k0 + 8 * c) = o; }
    LDS_WAIT(); asm volatile("" ::: "memory");
}
__device__ __forceinline__ int t5_bucket(int n) {
    if (n < 16) return n;
    int b = 16; b += n >= 19; b += n >= 21; b += n >= 24; b += n >= 27; b += n >= 31; b += n >= 35; b += n >= 40; b += n >= 46; b += n >= 52; b += n >= 59; b += n >= 67; b += n >= 77; b += n >= 87; b += n >= 99; b += n >= 113;
    return b;
}
__device__ __forceinline__ float gelu_tanh(float x) {
    const float y = 0.7978845608028654f * (x + 0.044715f * x * x * x);
    const float e = __builtin_amdgcn_exp2f(2.0f * LOG2E * y);
    const float th = 1.0f - 2.0f * __builtin_amdgcn_rcpf(e + 1.0f);
    return 0.5f * x * (1.0f + th);
}

struct Ptrs {
    const float* in[22]; float* out; unsigned char* ws;
    bf16 *Win, *Wuq, *Wukv, *Wout, *Wgu, *Wdn; f32x2v* rope; float *bias, *bias1, *rstdx, *ssqkv, *ssatt, *ssh;
    bf16 *kcmp, *vcmp, *kpe, *XB, *U, *QM, *KVM, *ATT, *H, *HID;
};

__device__ __forceinline__ void p0_prologue(const Ptrs& P, LAS unsigned char* lds, int wg, int G, int wave, int lane, int tid) {
    LAS float* scr = (LAS float*)(lds + wave * 16384);
    const int gw = wg * NWAVES + wave, NGW = G * NWAVES;
    constexpr int I_IN = (1024 / 64) * (DINP / 32), I_UQ = (256 / 64) * (768 / 32), I_UKV = (256 / 64) * (1024 / 32), I_OUT = (1024 / 64) * (1024 / 32), I_GU = (1024 / 64) * (NGU / 32), I_DN = (DFF / 64) * (1024 / 32);
    constexpr int NITEMS = I_IN + I_UQ + I_UKV + I_OUT + I_GU + I_DN;
    for (int it = gw; it < NITEMS; it += NGW) {
        int r = it;
        if (r < I_IN) { const float* W = P.in[I_WIN]; const float* g = P.in[I_GMIX];
            tr_item([=](int k, int n) -> float { if (n >= DIN) return 0.f; const float s = (n >= C_QN && n < C_KVC) ? C2N : 1.0f; return W[(size_t)k * DIN + n] * g[k] * s; }, P.Win, 1024, DINP / 32, scr, r, lane); continue; } r -= I_IN;
        if (r < I_UQ) { const float* W = P.in[I_WUQ]; const float* g = P.in[I_GQ];
            tr_item([=](int k, int n) -> float { const int h = n / 96, d = n % 96; int src = n; if (d >= 64) { const int e = d - 64; src = h * 96 + 64 + (e & 1) * 16 + (e >> 1); } return W[(size_t)k * 768 + src] * g[k]; }, P.Wuq, 256, 768 / 32, scr, r, lane); continue; } r -= I_UQ;
        if (r < I_UKV) { const float* W = P.in[I_WUKV]; const float* g = P.in[I_GKV];
            tr_item([=](int k, int n) -> float { return k < 128 ? W[(size_t)k * 1024 + n] * g[k] : 0.f; }, P.Wukv, 256, 1024 / 32, scr, r, lane); continue; } r -= I_UKV;
        if (r < I_OUT) { const float* W = P.in[I_WOUT]; const float* g1 = P.in[I_GOM]; const float* g2 = P.in[I_GON];
            tr_item([=](int k, int n) -> float { return W[(size_t)k * 1024 + n] * (k < 512 ? g1[k] : g2[k - 512]); }, P.Wout, 1024, 1024 / 32, scr, r, lane); continue; } r -= I_OUT;
        if (r < I_GU) { const float* g = P.in[I_GFFN]; const bool up = ((r % (NGU / 32)) & 4) != 0;
            if (!up) { const float* W = P.in[I_WG]; tr_item([=](int k, int n) -> float { return W[(size_t)k * DFF + (n >> 8) * 128 + (n & 127)] * g[k]; }, P.Wgu, 1024, NGU / 32, scr, r, lane); }
            else { const float* W = P.in[I_WU]; tr_item([=](int k, int n) -> float { return W[(size_t)k * DFF + (n >> 8) * 128 + (n & 127)] * g[k]; }, P.Wgu, 1024, NGU / 32, scr, r, lane); }
            continue; } r -= I_GU;
        { const float* W = P.in[I_WD];
            tr_item([=](int k, int n) -> float { return W[(size_t)k * 1024 + n]; }, P.Wdn, DFF, 1024 / 32, scr, r, lane); }
    }
    const int gt = wg * NTHR + tid, NGT = G * NTHR;
    for (int e = gt; e < SEQ * 16; e += NGT) { const int pos = e >> 4, i = e & 15;
        const float inv = __builtin_amdgcn_exp2f(-(float)i * (13.287712379549449f / 16.0f));
        const float ang = (float)pos * inv;
        double rev = (double)ang * 0.15915494309189535; rev -= __builtin_floor(rev);
        const float fr = (float)rev;
        P.rope[e] = (f32x2v){__builtin_amdgcn_cosf(fr), __builtin_amdgcn_sinf(fr)}; }
    for (int e = gt; e < 8 * 128; e += NGT) { const int h = e >> 7, d = e & 127; P.bias[e] = P.in[I_T5][t5_bucket(d) * 8 + h] * LOG2E; }
    for (int o = gw; o < 256; o += NGW) { const int kv = o >> 7, j = o & 127; const float* pos = P.in[kv ? I_POSV : I_POSK]; const float* w1 = P.in[kv ? I_W1V : I_W1K];
        float s = 0.f; for (int k = lane; k < 2048; k += 64) s += pos[k] * w1[(size_t)k * 128 + j];
        s = wave_sum(s); if (lane == 0) P.bias1[o] = s; }
    for (int m = gw; m < MT; m += NGW) {
        const GAS f32x4* xr = (const GAS f32x4*)(P.in[I_X] + (size_t)m * DM) + lane;
        f32x4 v[4]; float s = 0.f;
#pragma unroll
        for (int j = 0; j < 4; ++j) { v[j] = xr[64 * j]; s += sq4(v[j]); }
        s = wave_sum(s);
        if (lane == 0) P.rstdx[m] = __builtin_amdgcn_rsqf(s * (1.0f / DM) + EPS);
        GAS unsigned long long* o8 = (GAS unsigned long long*)(P.XB + (size_t)m * DM) + lane;
#pragma unroll
        for (int j = 0; j < 4; ++j) o8[64 * j] = (unsigned long long)pk2(v[j][0], v[j][1]) | ((unsigned long long)pk2(v[j][2], v[j][3]) << 32);
    }
}

__device__ __forceinline__ void p2_kpe(const Ptrs& P, int wg, int G, int tid) {
    const int gt = wg * NTHR + tid, NGT = G * NTHR;
    for (int e = gt; e < MT * 16; e += NGT) { const int row = e >> 4, i = e & 15; const int pos = row & (SEQ - 1);
        const float x1 = bf2f(P.U[(size_t)row * DINP + C_KR + i]), x2 = bf2f(P.U[(size_t)row * DINP + C_KR + 16 + i]);
        const f32x2v cs = P.rope[pos * 16 + i];
        *(unsigned*)(P.kpe + (size_t)row * 32 + 2 * i) = pk2(x1 * cs.x - x2 * cs.y, x1 * cs.y + x2 * cs.x); }
}
__device__ __forceinline__ void p2_compress(const Ptrs& P, LAS unsigned char* lds, int wg, int G, int tid) {
    LAS float* raw = (LAS float*)lds;
    LAS float* part = raw + 144 * 64;
    LAS float* hg = part + 4 * 8 * 128;
    for (int unit = wg; unit < 2048; unit += G) {
        const int kv = unit & 1, grp = (unit >> 1) & 31, bh = unit >> 6, b = bh >> 1, hk = bh & 1;
        const int i0 = grp * 8, nblk = (NCMP - i0) < 8 ? (NCMP - i0) : 8, ntok = 16 * (nblk - 1) + 32;
        const float* w1 = P.in[kv ? I_W1V : I_W1K]; const float* w2 = P.in[kv ? I_W2V : I_W2K];
        for (int idx = tid; idx < 144 * 64; idx += NTHR) { const int tok = idx >> 6, d = idx & 63;
            raw[idx] = tok < ntok ? bf2f(P.U[(size_t)(b * SEQ + 16 * i0 + tok) * DINP + C_KVC + kv * 128 + hk * 64 + d]) : 0.f; }
        __syncthreads();
        { const int j = tid & 127, kq = tid >> 7; float acc[8];
#pragma unroll
            for (int ii = 0; ii < 8; ++ii) acc[ii] = 0.f;
            for (int k = kq * 512; k < kq * 512 + 512; ++k) { const float w = w1[(size_t)k * 128 + j]; const int l = k >> 6, d = k & 63;
#pragma unroll
                for (int ii = 0; ii < 8; ++ii) acc[ii] += raw[(16 * ii + l) * 64 + d] * w; }
#pragma unroll
            for (int ii = 0; ii < 8; ++ii) part[(kq * 8 + ii) * 128 + j] = acc[ii]; }
        __syncthreads();
        for (int e = tid; e < 8 * 128; e += NTHR) { const int ii = e >> 7, j = e & 127;
            const float s = (part[(0 * 8 + ii) * 128 + j] + part[(1 * 8 + ii) * 128 + j]) + (part[(2 * 8 + ii) * 128 + j] + part[(3 * 8 + ii) * 128 + j]) + P.bias1[kv * 128 + j];
            hg[e] = gelu_tanh(s); }
        __syncthreads();
        { const int ii = tid >> 6, d = tid & 63; float o = 0.f;
            for (int j = 0; j < 128; ++j) o += hg[ii * 128 + j] * w2[j * 64 + d];
            if (ii < nblk) (kv ? P.vcmp : P.kcmp)[((size_t)bh * 256 + i0 + ii) * 64 + d] = (bf16)(pk2(o, 0.f) & 0xffffu); }
        __syncthreads();
    }
}

__device__ __forceinline__ void p3_mla_naive(const Ptrs& P, int wg, int G, int tid, int wave) {
    const int c = tid & 3, ql = tid >> 2;
    for (int L = wg; L < 4096; L += G) {
        int bh, chunk;
        if (G == 256) { const int i = L >> 8, p = wg & 1; bh = wg >> 1; chunk = 4 * (i >> 1) + ((i & 1) ? (p ? 2 : 3) : (p ? 1 : 0)); }
        else { bh = L >> 5; chunk = L & 31; }
        const int b = bh >> 3, h = bh & 7, t = chunk * 128 + ql; const size_t row = (size_t)b * SEQ + t;
        unsigned qp[12];
        { const v4u* qs = (const v4u*)(P.QM + row * 768 + h * 96 + 16 * c); const v4u a = qs[0], bq = qs[1]; const v4u e = *(const v4u*)(P.QM + row * 768 + h * 96 + 64 + 8 * c);
            qp[0] = a.x; qp[1] = a.y; qp[2] = a.z; qp[3] = a.w; qp[4] = bq.x; qp[5] = bq.y; qp[6] = bq.z; qp[7] = bq.w; qp[8] = e.x; qp[9] = e.y; qp[10] = e.z; qp[11] = e.w; }
        float o[16];
#pragma unroll
        for (int d = 0; d < 16; ++d) o[d] = 0.f;
        float m = -1e29f, l = 0.f;
        const int jend = chunk * 128 + wave * 16 + 15;
        for (int j0 = 0; j0 <= jend; j0 += 8) {
            float s[8];
#pragma unroll
            for (int jj = 0; jj < 8; ++jj) { const int j = j0 + jj;
                const v4u* kp = (const v4u*)(P.KVM + ((size_t)b * SEQ + j) * 1024 + h * 128 + 16 * c); const v4u k0 = kp[0], k1 = kp[1]; const v4u k2 = *(const v4u*)(P.kpe + ((size_t)b * SEQ + j) * 32 + 8 * c);
                float sc = 0.f;
                sc = dot2(qp[0], k0.x, sc); sc = dot2(qp[1], k0.y, sc); sc = dot2(qp[2], k0.z, sc); sc = dot2(qp[3], k0.w, sc);
                sc = dot2(qp[4], k1.x, sc); sc = dot2(qp[5], k1.y, sc); sc = dot2(qp[6], k1.z, sc); sc = dot2(qp[7], k1.w, sc);
                sc = dot2(qp[8], k2.x, sc); sc = dot2(qp[9], k2.y, sc); sc = dot2(qp[10], k2.z, sc); sc = dot2(qp[11], k2.w, sc);
                sc += __shfl_xor(sc, 1); sc += __shfl_xor(sc, 2);
                s[jj] = (j <= t) ? sc : -1e30f; }
            const float gm = fmaxf(fmaxf(fmaxf(s[0], s[1]), fmaxf(s[2], s[3])), fmaxf(fmaxf(s[4], s[5]), fmaxf(s[6], s[7])));
            const float mn = fmaxf(m, gm), a = __builtin_amdgcn_exp2f(m - mn); m = mn; l *= a;
#pragma unroll
            for (int d = 0; d < 16; ++d) o[d] *= a;
#pragma unroll
            for (int jj = 0; jj < 8; ++jj) { const int j = j0 + jj; const float p = __builtin_amdgcn_exp2f(s[jj] - mn); l += p;
                const v4u* vp = (const v4u*)(P.KVM + ((size_t)b * SEQ + j) * 1024 + h * 128 + 64 + 16 * c);
#pragma unroll
                for (int i = 0; i < 2; ++i) { const v4u vw = vp[i];
                    o[8 * i + 0] += p * bflo(vw.x); o[8 * i + 1] += p * bfhi(vw.x); o[8 * i + 2] += p * bflo(vw.y); o[8 * i + 3] += p * bfhi(vw.y);
                    o[8 * i + 4] += p * bflo(vw.z); o[8 * i + 5] += p * bfhi(vw.z); o[8 * i + 6] += p * bflo(vw.w); o[8 * i + 7] += p * bfhi(vw.w); } }
        }
        const float inv = 1.0f / l; float ss = 0.f;
        v4u* op = (v4u*)(P.ATT + row * 1024 + h * 64 + 16 * c);
#pragma unroll
        for (int i = 0; i < 2; ++i) { float v[8];
#pragma unroll
            for (int e = 0; e < 8; ++e) { v[e] = o[8 * i + e] * inv; ss += v[e] * v[e]; }
            v4u w; w.x = pk2(v[0], v[1]); w.y = pk2(v[2], v[3]); w.z = pk2(v[4], v[5]); w.w = pk2(v[6], v[7]); op[i] = w; }
        ss += __shfl_xor(ss, 1); ss += __shfl_xor(ss, 2);
        if (c == 0) P.ssatt[row * 16 + h] = ss;
    }
}

#define NSA_GROUP_UPDATE(VROW_EXPR) do { \
        const float gm_ = fmaxf(fmaxf(fmaxf(s[0], s[1]), fmaxf(s[2], s[3])), fmaxf(fmaxf(s[4], s[5]), fmaxf(s[6], s[7]))); \
        const float mn_ = fmaxf(m, gm_), a_ = __builtin_amdgcn_exp2f(m - mn_); m = mn_; l *= a_; \
        _Pragma("unroll") for (int d = 0; d < 16; ++d) o[d] *= a_; \
        _Pragma("unroll") for (int jj = 0; jj < 8; ++jj) { const float p_ = __builtin_amdgcn_exp2f(s[jj] - mn_); l += p_; const v4u* vp_ = (const v4u*)(VROW_EXPR); \
            _Pragma("unroll") for (int i = 0; i < 2; ++i) { const v4u vw = vp_[i]; \
                o[8 * i + 0] += p_ * bflo(vw.x); o[8 * i + 1] += p_ * bfhi(vw.x); o[8 * i + 2] += p_ * bflo(vw.y); o[8 * i + 3] += p_ * bfhi(vw.y); \
                o[8 * i + 4] += p_ * bflo(vw.z); o[8 * i + 5] += p_ * bfhi(vw.z); o[8 * i + 6] += p_ * bflo(vw.w); o[8 * i + 7] += p_ * bfhi(vw.w); } } } while (0)
#define NSA_DOT(KROW_EXPR, OUT) do { const v4u* kp_ = (const v4u*)(KROW_EXPR); const v4u k0_ = kp_[0], k1_ = kp_[1]; float sc_ = 0.f; \
        sc_ = dot2(qp[0], k0_.x, sc_); sc_ = dot2(qp[1], k0_.y, sc_); sc_ = dot2(qp[2], k0_.z, sc_); sc_ = dot2(qp[3], k0_.w, sc_); \
        sc_ = dot2(qp[4], k1_.x, sc_); sc_ = dot2(qp[5], k1_.y, sc_); sc_ = dot2(qp[6], k1_.z, sc_); sc_ = dot2(qp[7], k1_.w, sc_); \
        sc_ += __shfl_xor(sc_, 1); sc_ += __shfl_xor(sc_, 2); OUT = sc_; } while (0)

__device__ __forceinline__ void p3_nsa_naive(const Ptrs& P, LAS unsigned char* lds, int wg, int G, int tid, int wave) {
    LAS float* C = (LAS float*)lds;
    LAS float* Linv = C + 32 * 4 * 64;
    LAS int* SEL = (LAS int*)(Linv + 32 * 4);
    LAS int* NSEL = SEL + 32 * 16;
    LAS float* LB = (LAS float*)(NSEL + 32);
    for (int e = tid; e < 1024; e += NTHR) LB[e] = P.bias[e];
    __syncthreads();
    const int c = tid & 3, g = (tid >> 2) & 3, ql = tid >> 4;
    for (int unit = wg; unit < 4096; unit += G) {
        const int qblk = unit & 127, bh = unit >> 7, b = bh >> 1, hk = bh & 1, hq = hk * 4 + g;
        const int t = qblk * 32 + ql; const size_t row = (size_t)b * SEQ + t; const size_t rowb = (size_t)b * SEQ;
        const LAS float* lb = LB + hq * 128;
        unsigned qp[8];
        { const v4u* qs = (const v4u*)(P.U + row * DINP + C_QN + hq * 64 + 16 * c); const v4u a = qs[0], bq = qs[1];
            qp[0] = a.x; qp[1] = a.y; qp[2] = a.z; qp[3] = a.w; qp[4] = bq.x; qp[5] = bq.y; qp[6] = bq.z; qp[7] = bq.w; }
        float gate[3];
#pragma unroll
        for (int br = 0; br < 3; ++br) { const float x = bf2f(P.U[row * DINP + C_GATE + hq * 3 + br]); gate[br] = __builtin_amdgcn_rcpf(1.0f + __builtin_amdgcn_exp2f(-x * LOG2E)); }
        float out[16], o[16];
#pragma unroll
        for (int d = 0; d < 16; ++d) { out[d] = 0.f; o[d] = 0.f; }
        const int nv = t >= 31 ? ((t - 31) >> 4) + 1 : 0;
        const int tw_max = qblk * 32 + wave * 4 + 3; const int nvw = tw_max >= 31 ? ((tw_max - 31) >> 4) + 1 : 0;
        const bf16* kc = P.kcmp + (size_t)bh * 256 * 64 + 16 * c; const bf16* vc = P.vcmp + (size_t)bh * 256 * 64 + 16 * c;
        float m = -1e30f, l = 0.f;
        for (int i = 0; i < nvw; ++i) { float sc; NSA_DOT(kc + i * 64, sc); if (i < nv) { int dist = t - 16 * i - 31; dist = dist > 127 ? 127 : dist; m = fmaxf(m, sc + lb[dist]); } }
        float eprev = 0.f;
        for (int j4 = 0; j4 < 64; ++j4) {
            float e4[4];
#pragma unroll
            for (int ii = 0; ii < 4; ++ii) e4[ii] = 0.f;
            if (4 * j4 < nvw) {
#pragma unroll
                for (int ii = 0; ii < 4; ++ii) { const int i = 4 * j4 + ii;
                    if (i < nvw) { float sc; NSA_DOT(kc + i * 64, sc); float e = 0.f;
                        if (i < nv) { int dist = t - 16 * i - 31; dist = dist > 127 ? 127 : dist; e = __builtin_amdgcn_exp2f(sc + lb[dist] - m); }
                        l += e; const v4u* vp = (const v4u*)(vc + i * 64);
#pragma unroll
                        for (int q = 0; q < 2; ++q) { const v4u vw = vp[q];
                            o[8 * q + 0] += e * bflo(vw.x); o[8 * q + 1] += e * bfhi(vw.x); o[8 * q + 2] += e * bflo(vw.y); o[8 * q + 3] += e * bfhi(vw.y);
                            o[8 * q + 4] += e * bflo(vw.z); o[8 * q + 5] += e * bfhi(vw.z); o[8 * q + 6] += e * bflo(vw.w); o[8 * q + 7] += e * bfhi(vw.w); }
                        e4[ii] = e; } }
            }
            if (c == 0) C[(ql * 4 + g) * 64 + j4] = 2.0f * (e4[0] + e4[1] + e4[2]) + e4[3] + eprev;
            eprev = e4[3];
        }
        { const float li = nv > 0 ? 1.0f / l : 0.f; if (c == 0) Linv[ql * 4 + g] = li; const float f = gate[0] * li;
#pragma unroll
            for (int d = 0; d < 16; ++d) { out[d] = o[d] * f; o[d] = 0.f; } }
        __syncthreads();
        { const float l0 = Linv[ql * 4 + 0], l1 = Linv[ql * 4 + 1], l2 = Linv[ql * 4 + 2], l3 = Linv[ql * 4 + 3];
            float imp[4];
#pragma unroll
            for (int jj = 0; jj < 4; ++jj) { const int j = g * 16 + c * 4 + jj; imp[jj] = (C[(ql * 4 + 0) * 64 + j] * l0 + C[(ql * 4 + 1) * 64 + j] * l1) + (C[(ql * 4 + 2) * 64 + j] * l2 + C[(ql * 4 + 3) * 64 + j] * l3); }
            __syncthreads();
#pragma unroll
            for (int jj = 0; jj < 4; ++jj) C[(ql * 4 + 0) * 64 + g * 16 + c * 4 + jj] = imp[jj]; }
        __syncthreads();
        const int cur = t >> 6;
        if (g == 0 && c == 0) {
            unsigned long long taken = 0ull; int ns = 0;
            for (int r = 0; r < 16; ++r) { float best = -3e38f; int bi = -1;
                for (int j = 0; j < 64; ++j) { if ((taken >> j) & 1ull) continue;
                    const float v = (j == 0 || j == cur || j + 1 == cur) ? 1e30f : (j <= cur ? C[(ql * 4 + 0) * 64 + j] : -1e30f);
                    if (v > best) { best = v; bi = j; } }
                if (best <= -1e30f) break;
                taken |= 1ull << bi; SEL[ql * 16 + r] = bi; ns = r + 1; }
            NSEL[ql] = ns;
        }
        __syncthreads();
        m = -1e29f; l = 0.f;
        { const int ns = NSEL[ql]; const int nsw = __builtin_amdgcn_readfirstlane(ns);
            const bf16* kb = P.U + rowb * DINP + C_KVS + hk * 64 + 16 * c; const bf16* vb = kb + 128;
            for (int r = 0; r < nsw; ++r) { const int blk = SEL[ql * 16 + (r < ns ? r : 0)];
                for (int k0 = 0; k0 < 64; k0 += 8) { float s[8];
#pragma unroll
                    for (int jj = 0; jj < 8; ++jj) { const int pos = blk * 64 + k0 + jj; float sc; NSA_DOT(kb + (size_t)pos * DINP, sc);
                        int dist = t - pos; const bool ok = dist >= 0 && r < ns; dist = dist < 0 ? 0 : (dist > 127 ? 127 : dist); s[jj] = ok ? sc + lb[dist] : -1e30f; }
                    NSA_GROUP_UPDATE(vb + (size_t)(blk * 64 + k0 + jj) * DINP); } }
            const float f = gate[1] / l;
#pragma unroll
            for (int d = 0; d < 16; ++d) { out[d] += o[d] * f; o[d] = 0.f; } }
        m = -1e29f; l = 0.f;
        { const int tw0 = qblk * 32 + wave * 4; const int lo = tw0 - 511 > 0 ? tw0 - 511 : 0, hi = tw0 + 3;
            const bf16* kb = P.U + rowb * DINP + C_KVW + hk * 64 + 16 * c; const bf16* vb = kb + 128;
            for (int p0 = lo; p0 <= hi; p0 += 8) { float s[8];
#pragma unroll
                for (int jj = 0; jj < 8; ++jj) { const int pos = p0 + jj; float sc; NSA_DOT(kb + (size_t)pos * DINP, sc);
                    int dist = t - pos; const bool ok = dist >= 0 && dist < 512; dist = dist < 0 ? 0 : (dist > 127 ? 127 : dist); s[jj] = ok ? sc + lb[dist] : -1e30f; }
                NSA_GROUP_UPDATE(vb + (size_t)(p0 + jj) * DINP); }
            const float f = gate[2] / l;
#pragma unroll
            for (int d = 0; d < 16; ++d) out[d] += o[d] * f; }
        { float ss = 0.f; v4u* op = (v4u*)(P.ATT + row * 1024 + 512 + hq * 64 + 16 * c);
#pragma unroll
            for (int i = 0; i < 2; ++i) { v4u w; w.x = pk2(out[8 * i], out[8 * i + 1]); w.y = pk2(out[8 * i + 2], out[8 * i + 3]); w.z = pk2(out[8 * i + 4], out[8 * i + 5]); w.w = pk2(out[8 * i + 6], out[8 * i + 7]); op[i] = w;
#pragma unroll
                for (int e = 0; e < 8; ++e) ss += out[8 * i + e] * out[8 * i + e]; }
            ss += __shfl_xor(ss, 1); ss += __shfl_xor(ss, 2);
            if (c == 0) P.ssatt[row * 16 + 8 + hq] = ss; }
        __syncthreads();
    }
}

__device__ __forceinline__ void p7_final(const Ptrs& P, int wg, int G, int wave, int lane) {
    const int gw = wg * NWAVES + wave, NGW = G * NWAVES;
    const GAS f32x4* gp = (const GAS f32x4*)P.in[I_GFIN] + lane; f32x4 gg[4];
#pragma unroll
    for (int j = 0; j < 4; ++j) gg[j] = gp[64 * j];
    for (int m = gw; m < MT; m += NGW) {
        GAS f32x4* xr = (GAS f32x4*)(P.out + (size_t)m * DM) + lane;
        f32x4 v[4]; float s = 0.f;
#pragma unroll
        for (int j = 0; j < 4; ++j) { v[j] = xr[64 * j]; s += sq4(v[j]); }
        s = wave_sum(s); const float r = __builtin_amdgcn_rsqf(s * (1.0f / DM) + EPS);
#pragma unroll
        for (int j = 0; j < 4; ++j) xr[64 * j] = v[j] * r * gg[j];
    }
}

__global__ void __launch_bounds__(NTHR, 2) mega_fwd(Args args) {
    extern __shared__ __attribute__((aligned(16))) unsigned char lds_raw[];
    LAS unsigned char* lds = (LAS unsigned char*)lds_raw;
    volatile LAS unsigned* MISC = (volatile LAS unsigned*)(lds + MISC_OFF);
    const int tid0 = threadIdx.x;
#define LAUNDER_TID() int tid = tid0; asm volatile("" : "+v"(tid)); const int lane = tid & 63, wave = __builtin_amdgcn_readfirstlane(tid >> 6); (void)lane; (void)wave
    const int G = gridDim.x, wg = blockIdx.x;
    unsigned char* ws = args.ws;
    Ptrs P;
#pragma unroll
    for (int i = 0; i < 22; ++i) P.in[i] = args.in[i];
    P.out = args.out; P.ws = ws;
    P.Win = (bf16*)(ws + WS_WIN); P.Wuq = (bf16*)(ws + WS_WUQ); P.Wukv = (bf16*)(ws + WS_WUKV); P.Wout = (bf16*)(ws + WS_WOUT); P.Wgu = (bf16*)(ws + WS_WGU); P.Wdn = (bf16*)(ws + WS_WDN);
    P.rope = (f32x2v*)(ws + WS_ROPE); P.bias = (float*)(ws + WS_BIAS); P.bias1 = (float*)(ws + WS_BIAS1); P.rstdx = (float*)(ws + WS_RSTDX);
    P.ssqkv = (float*)(ws + WS_SSQKV); P.ssatt = (float*)(ws + WS_SSATT); P.ssh = (float*)(ws + WS_SSH);
    P.kcmp = (bf16*)(ws + WS_KCMP); P.vcmp = (bf16*)(ws + WS_VCMP); P.kpe = (bf16*)(ws + WS_KPE);
    P.XB = (bf16*)(ws + WS_XB); P.U = (bf16*)(ws + WS_U); P.QM = (bf16*)(ws + WS_QM); P.KVM = (bf16*)(ws + WS_KVM); P.ATT = (bf16*)(ws + WS_ATT); P.H = (bf16*)(ws + WS_H); P.HID = (bf16*)(ws + WS_HID);
    gu32* ctl = (gu32*)(ws + WS_CTL);

    if (tid0 < 64) MISC[tid0] = 0u;
    __syncthreads();
    XcdBarrier bar; bar.bar = (unsigned*)(ctl + CW_BAR); bar.x = 0; bar.st = nullptr;
    if (N_LAUNCHES == 1) bar = xcd_barrier_post((unsigned*)(ctl + CW_BAR), MISC + 8);
#define GRID_BAR() do { if (N_LAUNCHES == 1) xcd_barrier(bar); } while (0)
    const int lo = args.ph_lo, hi = args.ph_hi;
#ifndef PHASE_MASK
#define PHASE_MASK 0xff
#endif
#define IN(k) (((PHASE_MASK >> (k)) & 1) && lo <= (k) && (k) < hi)
#define BOTH(k) (IN(k) && IN((k) + 1))

    if (IN(0)) { LAUNDER_TID(); p0_prologue(P, lds, wg, G, wave, lane, tid); if (BOTH(0)) GRID_BAR(); }

    if (IN(1)) {
        pg8::Gemm g{P.XB, P.Win, MT, DINP, 1024, 1024, 1024}; pg8::StaticOrder S; S.init(MT, DINP, G, wg);
        EpiInProj E{P.U, P.rstdx, P.ssqkv};
        pg8::gemm_phase<EpiInProj, pg8::StaticOrder, true, true>(lds, g, S, E);
        if (BOTH(1)) GRID_BAR();
    }

    if (IN(2)) {
        { LAUNDER_TID();
        p2_kpe(P, wg, G, tid);
        p2_compress(P, lds, wg, G, tid); }
        __syncthreads();
        { pg8::Gemm g{P.U + C_CQ, P.Wuq, MT, 768, 256, DINP, 256}; pg8::StaticOrder S; S.init(MT, 768, G, wg);
          EpiQup E{P.QM, P.ssqkv, P.rope};
          pg8::gemm_phase<EpiQup, pg8::StaticOrder, true, true>(lds, g, S, E); }
        { pg8::Gemm g{P.U + C_CKV, P.Wukv, MT, 1024, 256, DINP, 256}; pg8::StaticOrder S; S.init(MT, 1024, G, wg);
          EpiKVup E{P.KVM, P.ssqkv};
          pg8::gemm_phase<EpiKVup, pg8::StaticOrder, true, true>(lds, g, S, E); }
        if (BOTH(2)) GRID_BAR();
    }

    if (IN(3)) {
        { LAUNDER_TID(); p3_mla_naive(P, wg, G, tid, wave); }
        { LAUNDER_TID(); p3_nsa_naive(P, lds, wg, G, tid, wave); }
        if (BOTH(3)) GRID_BAR();
    }

    if (IN(4)) {
        { pg8::Gemm g{P.ATT, P.Wout, MT, 1024, 512, 1024, 1024}; pg8::StaticOrder S; S.init(MT, 1024, G, wg);
          EpiOut1 E{P.in[I_X], P.out, P.ssatt};
          pg8::gemm_phase<EpiOut1, pg8::StaticOrder, true, true>(lds, g, S, E); }
        { pg8::Gemm g{P.ATT + 512, P.Wout + 512, MT, 1024, 512, 1024, 1024}; pg8::StaticOrder S; S.init(MT, 1024, G, wg);
          EpiOut2 E{P.out, P.H, P.ssatt, P.ssh};
          pg8::gemm_phase<EpiOut2, pg8::StaticOrder, true, true>(lds, g, S, E); }
        if (BOTH(4)) GRID_BAR();
    }

    if (IN(5)) {
        pg8::Gemm g{P.H, P.Wgu, MT, NGU, 1024, 1024, 1024}; pg8::StaticOrder S; S.init(MT, NGU, G, wg);
        EpiGU E{P.HID, P.ssh};
        pg8::gemm_phase<EpiGU, pg8::StaticOrder, true, true>(lds, g, S, E);
        if (BOTH(5)) GRID_BAR();
    }

    if (IN(6)) {
        pg8::Gemm g{P.HID, P.Wdn, MT, 1024, DFF, DFF, DFF}; pg8::StaticOrder S; S.init(MT, 1024, G, wg);
        EpiDown E{P.H, P.out};
        pg8::gemm_phase<EpiDown, pg8::StaticOrder, true, true>(lds, g, S, E);
        if (BOTH(6)) GRID_BAR();
    }

    if (IN(7)) { LAUNDER_TID(); p7_final(P, wg, G, wave, lane); }
#undef IN
#undef BOTH
#undef GRID_BAR
}

extern "C" void kernel_launch(void* const* d_in, const int* in_sizes, int n_in, void* d_out, int out_size, void* d_ws, size_t ws_size, hipStream_t stream) {
    static int grid = 0;
    if (grid == 0) {
        if (n_in != 22 || in_sizes[0] != MT * DM || out_size != MT * DM || ws_size < WS_END) { fprintf(stderr, "kernel_launch: unexpected shapes (n_in %d, in0 %d, out %d, ws %zu); nothing launched\n", n_in, n_in > 0 ? in_sizes[0] : -1, out_size, ws_size); grid = -1; return; }
        int dev = 0, cus = 0, per_cu = 0;
        if (hipGetDevice(&dev) != hipSuccess || hipDeviceGetAttribute(&cus, hipDeviceAttributeMultiprocessorCount, dev) != hipSuccess) { fprintf(stderr, "kernel_launch: device query failed\n"); grid = -1; return; }
        if (hipFuncSetAttribute((const void*)mega_fwd, hipFuncAttributeMaxDynamicSharedMemorySize, LDS_BYTES) != hipSuccess) { fprintf(stderr, "kernel_launch: hipFuncSetAttribute failed\n"); grid = -1; return; }
        if (hipOccupancyMaxActiveBlocksPerMultiprocessor(&per_cu, (const void*)mega_fwd, NTHR, LDS_BYTES) != hipSuccess || per_cu < 1)
            fprintf(stderr, "kernel_launch: note: occupancy query reports %d workgroups per CU\n", per_cu);
        (void)hipGetLastError();
        grid = cus;
    }
    if (grid < 0) return;
    if (hipMemsetAsync((char*)d_ws + WS_CTL, 0, CTL_ZERO_BYTES, stream) != hipSuccess) { fprintf(stderr, "kernel_launch: memset failed\n"); return; }
    Args a{};
    for (int i = 0; i < 22; ++i) a.in[i] = (const float*)d_in[i];
    a.out = (float*)d_out; a.ws = (unsigned char*)d_ws;
    for (int li = 0; li < N_LAUNCHES; ++li) {
        a.ph_lo = (N_LAUNCHES == 1) ? 0 : li; a.ph_hi = (N_LAUNCHES == 1) ? NPHASE : li + 1; a.li = li; a.pad = 0;
        hipLaunchKernelGGL(mega_fwd, dim3(grid), dim3(NTHR), LDS_BYTES, stream, a);
        const hipError_t le = hipPeekAtLastError();
        if (le != hipSuccess) { fprintf(stderr, "kernel_launch: launch %d failed: %s\n", li, hipGetErrorName(le)); break; }
    }
}
```

```cpp
#include <hip/hip_runtime.h>
#include <cstdio>
#include <cstdint>
namespace pg8 {
#define PG8_LAS __attribute__((address_space(3)))
typedef unsigned short bf16_t;
typedef short bf16x8 __attribute__((ext_vector_type(8)));
typedef float f32x4 __attribute__((ext_vector_type(4)));
typedef unsigned u32x4 __attribute__((ext_vector_type(4)));
constexpr int BM = 256, BK = 64, HALF = 128, HTB = HALF * BK * 2  , STAGE_BYTES = 8 * HTB, NXCD = 8, WGM = 8;

__host__ __device__ __forceinline__ int lds_byte(int r, int c) { const int st = (r >> 4) * 2 + (c >> 5), rr = r & 15, cc = c & 31, ob = rr * 64 + cc * 2; return st * 1024 + (ob ^ (((ob >> 9) & 1) << 5)); }
__host__ __device__ __forceinline__ void stage_rc(int b, int& R, int& C) { const int st = b / 1024, sb = b % 1024, swz = sb ^ (((sb >> 9) & 1) << 5); R = (st >> 1) * 16 + swz / 64; C = (st & 1) * 32 + (swz % 64) / 2; }
__host__ __device__ __forceinline__ int perm32(int rho) { const int n = rho >> 4, i = rho & 15; return 8 * (i >> 2) + 4 * n + (i & 3); }

struct Unit { int pm, pn, ui; };
struct Gemm { const bf16_t* A; const bf16_t* Bt; int M, N, K, lda, ldb, kstepA; };

struct StaticOrder {
    int nM, nN, nwg, G, c;
    __host__ __device__ void init(int M, int N, int G_, int c_) { nM = M / BM; nN = N / BM; nwg = nM * nN; G = G_; c = c_; }
    __host__ __device__ bool next(int i, Unit& u) const {
        const long L = (long)i * G + c; if (L >= nwg) return false;
        int wgid = (int)L; { const int q = nwg / NXCD, r = nwg % NXCD, xcd = wgid % NXCD, off = wgid / NXCD; wgid = (xcd < r ? xcd * (q + 1) : r * (q + 1) + (xcd - r) * q) + off; }
        const int nig = WGM * nN, gid = wgid / nig, fm = gid * WGM, gsz = (nM - fm) < WGM ? (nM - fm) : WGM;
        u.pm = fm + ((wgid % nig) % gsz); u.pn = (wgid % nig) / gsz; u.ui = i; return true;
    }
    __device__ __forceinline__ void a_ready(const Unit&) const {}
    __device__ __forceinline__ void done(const Unit&) const {}
    __device__ __forceinline__ const char* a_base(const Gemm& g, const Unit& u, size_t tstepA) const { return (const char*)g.A + (size_t)u.pm * tstepA; }
    __device__ __forceinline__ const char* b_base(const Gemm& g, const Unit& u, size_t tstepB) const { return (const char*)g.Bt + (size_t)u.pn * tstepB; }
};

__device__ __forceinline__ unsigned cvt_pk_bf16(float lo, float hi) { unsigned r; asm volatile("v_cvt_pk_bf16_f32 %0, %1, %2" : "=v"(r) : "v"(lo), "v"(hi)); return r; }
typedef float f32x2 __attribute__((ext_vector_type(2)));
template <class Epi, class Sched, bool ALIGN_EPI = false, bool SP2 = false>
__device__ __forceinline__ void gemm_phase(PG8_LAS unsigned char* lds, const Gemm g, const Sched& S, const Epi& E) {
    int tid_ = threadIdx.x; asm volatile("" : "+v"(tid_));
    const int tid = tid_, wid = __builtin_amdgcn_readfirstlane(tid >> 6), lane = tid & 63, wr = wid >> 2, wc = wid & 3, fr = lane & 15, fq = lane >> 4;
    const int K = g.K, nt = K / BK;
    unsigned voffA[2], voffB[2];
#pragma unroll
    for (int i = 0; i < 2; ++i) { int R, C; stage_rc(tid * 16 + i * 8192, R, C); const int Rb = Epi::PERM ? ((R & ~31) + perm32(R & 31)) : R;
        voffA[i] = (unsigned)(R * g.lda + C) * 2u; voffB[i] = (unsigned)(Rb * g.ldb + C) * 2u; }
    const size_t kstepA = g.kstepA ? (size_t)g.kstepA : (size_t)(BK * 2), kstepB = (size_t)(BK * 2);
    const size_t hstepA = (size_t)HALF * g.lda * 2, hstepB = (size_t)HALF * g.ldb * 2;
    const size_t tstepA = 2 * hstepA, tstepB = 2 * hstepB;
    const unsigned ldsw = (unsigned)wid * 1024u;
    const int aoff = lds_byte(wr * 64 + fr, fq * 8), boff = lds_byte(wc * 32 + fr, fq * 8);
#define PG8_SA(b, h) (((b) * 2 + (h)) * HTB)
#define PG8_SB(b, h) ((4 + (b) * 2 + (h)) * HTB)
#define PG8_STAGE(bufoff, gbase, voff) do { _Pragma("unroll") for (int _i = 0; _i < 2; ++_i) \
        __builtin_amdgcn_global_load_lds((const unsigned*)((const char*)(gbase) + (voff)[_i]), (PG8_LAS unsigned*)(lds + (bufoff) + ldsw + _i * 8192), 16, 0, 0); } while (0)
#define PG8_LDA(dst, b, h) do { _Pragma("unroll") for (int m = 0; m < 4; ++m) _Pragma("unroll") for (int k = 0; k < 2; ++k) dst[m][k] = *(const PG8_LAS bf16x8*)(lds + PG8_SA(b, h) + aoff + m * 2048 + k * 1024); } while (0)
#define PG8_LDB(dst, b, h) do { _Pragma("unroll") for (int n = 0; n < 2; ++n) _Pragma("unroll") for (int k = 0; k < 2; ++k) dst[n][k] = *(const PG8_LAS bf16x8*)(lds + PG8_SB(b, h) + boff + n * 2048 + k * 1024); } while (0)
#define PG8_MMA(ai, bj, At, Bt) do { __builtin_amdgcn_s_setprio(1); _Pragma("unroll") for (int m = 0; m < 4; ++m) _Pragma("unroll") for (int n = 0; n < 2; ++n) _Pragma("unroll") for (int k = 0; k < 2; ++k) \
        acc[ai][bj][m][n] = __builtin_amdgcn_mfma_f32_16x16x32_bf16(Bt[n][k], At[m][k], acc[ai][bj][m][n], 0, 0, 0); __builtin_amdgcn_s_setprio(0); } while (0)
#define PG8_WAIT_V(n) asm volatile("s_waitcnt vmcnt(" #n ")" ::: "memory")
#define PG8_WAIT_L(n) asm volatile("s_waitcnt lgkmcnt(" #n ")" ::: "memory")
#define PG8_BAR __builtin_amdgcn_s_barrier()
#define PG8_SCHED __builtin_amdgcn_sched_barrier(0)
    Unit cur, nxt; int ui = 0;
    if (!S.next(0, cur)) return;
    f32x4 acc[2][2][4][2];
#pragma unroll
    for (int a = 0; a < 2; ++a)
#pragma unroll
        for (int b = 0; b < 2; ++b)
#pragma unroll
            for (int m = 0; m < 4; ++m)
#pragma unroll
                for (int n = 0; n < 2; ++n) acc[a][b][m][n] = (f32x4){0.f, 0.f, 0.f, 0.f};
    bf16x8 At[4][2], B0[2][2], B1[2][2];
    const char* cA = S.a_base(g, cur, tstepA); const char* cB = S.b_base(g, cur, tstepB);
    S.a_ready(cur);
    if constexpr (SP2) {
        PG8_STAGE(PG8_SB(0, 0), cB, voffB); PG8_STAGE(PG8_SB(0, 1), cB + hstepB, voffB); PG8_STAGE(PG8_SA(0, 0), cA, voffA); PG8_STAGE(PG8_SA(0, 1), cA + hstepA, voffA);
        if (wr == 1) PG8_BAR;
        PG8_WAIT_V(2); PG8_BAR;
        PG8_STAGE(PG8_SB(1, 0), cB + kstepB, voffB); PG8_STAGE(PG8_SA(1, 0), cA + kstepA, voffA); PG8_STAGE(PG8_SB(1, 1), cB + hstepB + kstepB, voffB);
        PG8_WAIT_V(6); PG8_BAR;
    } else {
        PG8_STAGE(PG8_SB(0, 0), cB, voffB); PG8_STAGE(PG8_SA(0, 0), cA, voffA); PG8_STAGE(PG8_SB(0, 1), cB + hstepB, voffB); PG8_STAGE(PG8_SA(0, 1), cA + hstepA, voffA);
        if (wr == 1) PG8_BAR;
        PG8_WAIT_V(4); PG8_BAR;
        PG8_STAGE(PG8_SB(1, 0), cB + kstepB, voffB); PG8_STAGE(PG8_SA(1, 0), cA + kstepA, voffA); PG8_STAGE(PG8_SB(1, 1), cB + hstepB + kstepB, voffB);
        PG8_WAIT_V(6); PG8_BAR;
    }
    for (;;) {
        const bool has_next = S.next(ui + 1, nxt);
        const char* nA = has_next ? S.a_base(g, nxt, tstepA) : cA; const char* nB = has_next ? S.b_base(g, nxt, tstepB) : cB;
        for (int t = 0; t < nt; t += 2) {
            if constexpr (Epi::MIDK) { if (t == (nt >> 1)) E.midk(acc, cur, wr, fr); }
            const bool last = (t == nt - 2);
            const char* a1 = cA + (size_t)(t + 1) * kstepA;
            const char* a2 = last ? nA : cA + (size_t)(t + 2) * kstepA; const char* b2 = last ? nB : cB + (size_t)(t + 2) * kstepB;
            const char* a3 = a2 + kstepA; const char* b3 = b2 + kstepB;
            if (last && has_next) S.a_ready(nxt);
            if constexpr (SP2) {
            PG8_LDB(B0, 0, 0); PG8_LDB(B1, 0, 1); PG8_SCHED; PG8_LDA(At, 0, 0); PG8_STAGE(PG8_SA(1, 1), a1 + hstepA, voffA);
            PG8_WAIT_V(8); PG8_WAIT_L(0); PG8_BAR; PG8_MMA(0, 0, At, B0); PG8_MMA(0, 1, At, B1); PG8_BAR; PG8_SCHED;
            PG8_LDA(At, 0, 1); PG8_STAGE(PG8_SB(0, 0), b2, voffB); PG8_STAGE(PG8_SB(0, 1), b2 + hstepB, voffB); PG8_STAGE(PG8_SA(0, 0), a2, voffA);
            PG8_WAIT_V(8); PG8_WAIT_L(0); PG8_BAR; PG8_MMA(1, 0, At, B0); PG8_MMA(1, 1, At, B1); PG8_BAR; PG8_SCHED;
            PG8_LDB(B0, 1, 0); PG8_LDB(B1, 1, 1); PG8_SCHED; PG8_LDA(At, 1, 0); PG8_STAGE(PG8_SA(0, 1), a2 + hstepA, voffA);
            PG8_WAIT_V(8); PG8_WAIT_L(0); PG8_BAR; PG8_MMA(0, 0, At, B0); PG8_MMA(0, 1, At, B1); PG8_BAR; PG8_SCHED;
            PG8_LDA(At, 1, 1); PG8_STAGE(PG8_SB(1, 0), b3, voffB); PG8_STAGE(PG8_SB(1, 1), b3 + hstepB, voffB); PG8_STAGE(PG8_SA(1, 0), a3, voffA);
            PG8_WAIT_V(8); PG8_WAIT_L(0); PG8_BAR; PG8_MMA(1, 0, At, B0); PG8_MMA(1, 1, At, B1); PG8_BAR; PG8_SCHED;
            } else {
            PG8_LDB(B0, 0, 0); PG8_SCHED; PG8_LDA(At, 0, 0); PG8_STAGE(PG8_SA(1, 1), a1 + hstepA, voffA);
            PG8_WAIT_L(8); PG8_BAR; PG8_WAIT_L(0); PG8_MMA(0, 0, At, B0); PG8_BAR; PG8_SCHED;
            PG8_LDB(B1, 0, 1); PG8_STAGE(PG8_SB(0, 0), b2, voffB);
            PG8_BAR; PG8_WAIT_L(0); PG8_MMA(0, 1, At, B1); PG8_BAR;
            PG8_LDA(At, 0, 1); PG8_STAGE(PG8_SA(0, 0), a2, voffA);
            PG8_BAR; PG8_WAIT_L(0); PG8_MMA(1, 0, At, B0); PG8_BAR; PG8_SCHED;
            PG8_STAGE(PG8_SB(0, 1), b2 + hstepB, voffB);
            PG8_WAIT_V(6); PG8_BAR; PG8_MMA(1, 1, At, B1); PG8_BAR;
            PG8_LDB(B0, 1, 0); PG8_SCHED; PG8_LDA(At, 1, 0); PG8_STAGE(PG8_SA(0, 1), a2 + hstepA, voffA);
            PG8_WAIT_L(8); PG8_BAR; PG8_WAIT_L(0); PG8_MMA(0, 0, At, B0); PG8_BAR; PG8_SCHED;
            PG8_LDB(B1, 1, 1); PG8_STAGE(PG8_SB(1, 0), b3, voffB);
            PG8_BAR; PG8_WAIT_L(0); PG8_MMA(0, 1, At, B1); PG8_BAR;
            PG8_LDA(At, 1, 1); PG8_STAGE(PG8_SA(1, 0), a3, voffA);
            PG8_BAR; PG8_WAIT_L(0); PG8_MMA(1, 0, At, B0); PG8_BAR; PG8_SCHED;
            PG8_STAGE(PG8_SB(1, 1), b3 + hstepB, voffB);
            PG8_WAIT_V(6); PG8_BAR; PG8_MMA(1, 1, At, B1); PG8_BAR;
            }
        }
        if constexpr (ALIGN_EPI) { if (wr == 0) PG8_BAR; }
        if constexpr (!Epi::AFTER_DRAIN) { E(acc, cur, wr, wc, fr, fq); S.done(cur); }
        if (!has_next) break;
#pragma unroll
        for (int a = 0; a < 2; ++a)
#pragma unroll
            for (int b = 0; b < 2; ++b)
#pragma unroll
                for (int m = 0; m < 4; ++m)
#pragma unroll
                    for (int n = 0; n < 2; ++n) acc[a][b][m][n] = (f32x4){0.f, 0.f, 0.f, 0.f};
        cur = nxt; cA = nA; cB = nB; ++ui;
        if constexpr (ALIGN_EPI) { if (wr == 1) PG8_BAR; }
    }
    PG8_WAIT_V(0);
    if constexpr (!ALIGN_EPI) { if (wr == 0) PG8_BAR; }
    PG8_BAR;
    if constexpr (Epi::AFTER_DRAIN) { E.fused(acc, cur, wr, wc, fr, fq, lds, wid, lane); S.done(cur); }
#undef PG8_SA
#undef PG8_SB
#undef PG8_STAGE
#undef PG8_LDA
#undef PG8_LDB
#undef PG8_MMA
#undef PG8_WAIT_V
#undef PG8_WAIT_L
#undef PG8_BAR
#undef PG8_SCHED
}
}
#define GAS __attribute__((address_space(1)))
#define LAS __attribute__((address_space(3)))
typedef unsigned short bf16;
typedef unsigned v4u __attribute__((ext_vector_type(4)));
typedef float f32x4 __attribute__((ext_vector_type(4)));
typedef short bf16x8 __attribute__((ext_vector_type(8)));
typedef GAS unsigned gu32;
typedef GAS unsigned long long gu64;
#define RLX_AGENT __ATOMIC_RELAXED, __HIP_MEMORY_SCOPE_AGENT
#define LDS_WAIT() asm volatile("s_waitcnt lgkmcnt(0)" ::: "memory")
#define VM_WAIT() asm volatile("s_waitcnt vmcnt(0)" ::: "memory")
__device__ __forceinline__ unsigned long long rt() { return __builtin_amdgcn_s_memrealtime(); }
__device__ __forceinline__ unsigned f2bf(float f) { unsigned u = __builtin_bit_cast(unsigned, f); return (u + 0x7fffu + ((u >> 16) & 1u)) >> 16; }
__device__ __forceinline__ unsigned pk2(float lo, float hi) { return pg8::cvt_pk_bf16(lo, hi); }

#define XB_TMO      128
#define XB_XCNT(j)  (256  + 64 * (j))
#define XB_XSUB(j)  (1280 + 64 * (j))
#define XB_XGEN(j)  (2304 + 64 * (j))
#define XB_TOP      3328
#define XB_TOPGEN   3392
#define XCD_BAR_WORDS 3456
#define XB_SPIN_CAP (1u << 18)

__device__ __forceinline__ unsigned xb_ld(unsigned* p)              { return __hip_atomic_load(p, __ATOMIC_RELAXED, __HIP_MEMORY_SCOPE_AGENT); }
__device__ __forceinline__ unsigned xb_add(unsigned* p, unsigned v) { return __hip_atomic_fetch_add(p, v, __ATOMIC_RELAXED, __HIP_MEMORY_SCOPE_AGENT); }
__device__ __forceinline__ unsigned xb_xcc_id() { return (unsigned)__builtin_amdgcn_s_getreg((3 << 11) | 20) & 0xFu; }
#define XB_SPIN(cond, bar) do { unsigned _sp = 0; while (cond) { __builtin_amdgcn_s_sleep(1); \
    if ((++_sp & 255u) == 0u) { if (xb_ld(&(bar)[XB_TMO])) break; if (_sp > XB_SPIN_CAP) { atomicAdd(&(bar)[XB_TMO], 1u); break; } } } } while (0)

struct XcdBarrier {
    unsigned* bar; unsigned x;
    volatile LAS unsigned* st;
};

__device__ __forceinline__ XcdBarrier xcd_barrier_post(unsigned* bar, volatile LAS unsigned* st) {
    XcdBarrier b; b.bar = bar; b.x = xb_xcc_id(); b.st = st;
    if (threadIdx.x == 0) (void)xb_add(&bar[XB_XCNT(b.x)], 1u);
    return b;
}
__device__ __forceinline__ void xcd_barrier_complete(unsigned* bar, unsigned x, unsigned& nloc, unsigned& nx) {
    const unsigned G = gridDim.x * gridDim.y * gridDim.z;
    unsigned sum, cnt, mine, sp = 0u;
    for (;;) {
        sum = 0u; cnt = 0u; mine = 0u;
#pragma unroll
        for (unsigned j = 0; j < 16; ++j) { const unsigned c = xb_ld(&bar[XB_XCNT(j)]); sum += c; cnt += (c > 0u) ? 1u : 0u; mine = (j == x) ? c : mine; }
        if (sum == G) break;
        __builtin_amdgcn_s_sleep(1);
        if ((++sp & 255u) == 0u) { if (xb_ld(&bar[XB_TMO])) break; if (sp > XB_SPIN_CAP) { atomicAdd(&bar[XB_TMO], 1u); break; } }
    }
    nloc = mine > 0u ? mine : 1u; nx = cnt > 0u ? cnt : 1u;
}

__device__ __forceinline__ void xcd_barrier(const XcdBarrier& b) {
    asm volatile("s_waitcnt vmcnt(0)" ::: "memory");
    __syncthreads();
    if (threadIdx.x == 0) {
        unsigned* bar = b.bar;
        __builtin_amdgcn_s_waitcnt(0);
        unsigned nloc = b.st[0], nx = b.st[1];
        if (nloc == 0u) { xcd_barrier_complete(bar, b.x, nloc, nx); b.st[0] = nloc; b.st[1] = nx; }
        const unsigned old = xb_add(&bar[XB_XSUB(b.x)], 1u);
        const unsigned gen = old / nloc;
        if (old + 1u == (gen + 1u) * nloc) {
            __builtin_amdgcn_fence(__ATOMIC_RELEASE, "agent");
            asm volatile("s_waitcnt vmcnt(0)" ::: "memory");
            const unsigned og = xb_add(&bar[XB_TOP], 1u);
            const unsigned tg = og / nx;
            if (og + 1u == (tg + 1u) * nx) xb_add(&bar[XB_TOPGEN], 1u);
            else XB_SPIN(xb_ld(&bar[XB_TOPGEN]) == tg, bar);
            __builtin_amdgcn_fence(__ATOMIC_ACQUIRE, "agent");
            xb_add(&bar[XB_XGEN(b.x)], 1u);
            asm volatile("s_waitcnt vmcnt(0)" ::: "memory");
        } else {
            XB_SPIN(xb_ld(&bar[XB_XGEN(b.x)]) == gen, bar);
            __builtin_amdgcn_fence(__ATOMIC_ACQUIRE, "agent");
            asm volatile("s_waitcnt vmcnt(0)" ::: "memory");
        }
    }
    __syncthreads();
}

constexpr int NB = 16, SEQ = 4096, DM = 1024, MT = NB * SEQ;
constexpr int DINP = 1792;
constexpr int C_CQ = 0, C_CKV = 256, C_KR = 384, C_QN = 416, C_KVC = 928, C_KVS = 1184, C_KVW = 1440, C_GATE = 1696, DIN = 1720;
constexpr int DFF = 2816, NGU = 2 * DFF;
constexpr int NCMP = 255;
constexpr float EPS = 1e-6f;
constexpr float LOG2E = 1.4426950408889634f;
constexpr float C2Q = 0.10206207261596575f * 1.4426950408889634f;
constexpr float C2N = 0.125f * 1.4426950408889634f;

constexpr int NWAVES = 8, NTHR = 512;
constexpr int NPHASE = 8;
#ifndef MK_N_LAUNCHES
#define MK_N_LAUNCHES 1
#endif
constexpr int N_LAUNCHES = MK_N_LAUNCHES;

constexpr size_t MiB = 1u << 20;
constexpr size_t WS_CTL = 0, CTL_ZERO_BYTES = 1 * MiB;
constexpr size_t WS_WIN = 2 * MiB, WS_WUQ = 6 * MiB, WS_WUKV = 7 * MiB, WS_WOUT = 8 * MiB, WS_WGU = 10 * MiB, WS_WDN = 21 * MiB;
constexpr size_t WS_ROPE = 27 * MiB, WS_BIAS = 27 * MiB + 512 * 1024, WS_BIAS1 = WS_BIAS + 8192;
constexpr size_t WS_RSTDX = 28 * MiB, WS_SSQKV = 29 * MiB, WS_SSATT = 31 * MiB, WS_SSH = 35 * MiB;
constexpr size_t WS_KCMP = 39 * MiB, WS_VCMP = 40 * MiB, WS_KPE = 41 * MiB, WS_OVT = 45 * MiB, WS_W1C = 46 * MiB, WS_W2T = 47 * MiB;
constexpr size_t WS_XB = 64 * MiB, WS_U = 192 * MiB, WS_QM = 420 * MiB, WS_KVM = 516 * MiB, WS_ATT = 644 * MiB, WS_H = 772 * MiB, WS_END = 900 * MiB;
constexpr size_t WS_HID = 64 * MiB;
static_assert(WS_U + (size_t)MT * DINP * 2 <= WS_QM && WS_HID + (size_t)MT * DFF * 2 <= WS_QM && WS_QM + (size_t)MT * 768 * 2 <= WS_KVM && WS_KVM + (size_t)MT * 1024 * 2 <= WS_ATT, "ws map");
constexpr int CW_TMO = 0, CW_BAR = 4096;

constexpr int LDS_BYTES = 163840;
constexpr int MISC_OFF = LDS_BYTES - 256;


typedef unsigned u32x4 __attribute__((ext_vector_type(4))); using pg8::Unit; using pg8::cvt_pk_bf16; using pg8::HALF; using pg8::BM;
typedef float f32x2v __attribute__((ext_vector_type(2)));
__device__ __forceinline__ float bf2f(unsigned short b) { return __builtin_bit_cast(float, (unsigned)b << 16); }
__device__ __forceinline__ float bflo(unsigned w) { return __builtin_bit_cast(float, w << 16); }
__device__ __forceinline__ float bfhi(unsigned w) { return __builtin_bit_cast(float, w & 0xffff0000u); }
__device__ __forceinline__ float sq4(const f32x4 v) { return (v[0] * v[0] + v[1] * v[1]) + (v[2] * v[2] + v[3] * v[3]); }

struct EpiInProj {
    static constexpr bool PERM = true, AFTER_DRAIN = false, MIDK = false;
    pg8::bf16_t* U; const float* rstd; float* ssq;
    __device__ __forceinline__ void operator()(const f32x4 (&acc)[2][2][4][2], const Unit& u, int wr, int wc, int fr, int fq) const {
        const int row0 = u.pm * BM + wr * 64 + fr, col0 = u.pn * BM + wc * 32 + 8 * fq;
#pragma unroll
        for (int ai = 0; ai < 2; ++ai)
#pragma unroll
            for (int m = 0; m < 4; ++m) {
                const int row = row0 + ai * HALF + m * 16; const float r = rstd[row];
                pg8::bf16_t* rowp = U + (size_t)row * DINP + col0; float s0 = 0.f, s1 = 0.f;
#pragma unroll
                for (int bj = 0; bj < 2; ++bj) { const f32x4 v0 = acc[ai][bj][m][0] * r, v1 = acc[ai][bj][m][1] * r;
                    u32x4 w; w.x = cvt_pk_bf16(v0[0], v0[1]); w.y = cvt_pk_bf16(v0[2], v0[3]); w.z = cvt_pk_bf16(v1[0], v1[1]); w.w = cvt_pk_bf16(v1[2], v1[3]);
                    *(u32x4*)(rowp + bj * HALF) = w;
                    const float s = sq4(v0) + sq4(v1); if (bj == 0) s0 = s; else s1 = s; }
                if (u.pn < 2) {
                    float s = (u.pn == 0) ? (s0 + s1) : s0;
                    s += __shfl_xor(s, 16); s += __shfl_xor(s, 32);
                    if (fq == 0) ssq[(size_t)row * 8 + (u.pn == 0 ? 0 : 4) + wc] = s;
                }
            }
    }
};
struct EpiQup {
    static constexpr bool PERM = true, AFTER_DRAIN = false, MIDK = false;
    pg8::bf16_t* Q; const float* ssq; const f32x2v* rope;
    __device__ __forceinline__ void operator()(const f32x4 (&acc)[2][2][4][2], const Unit& u, int wr, int wc, int fr, int fq) const {
        const int row0 = u.pm * BM + wr * 64 + fr, col0 = u.pn * BM + wc * 32 + 8 * fq;
#pragma unroll
        for (int ai = 0; ai < 2; ++ai)
#pragma unroll
            for (int m = 0; m < 4; ++m) {
                const int row = row0 + ai * HALF + m * 16; const int pos = row & (SEQ - 1);
                const f32x4 pp = *(const f32x4*)(ssq + (size_t)row * 8);
                const float r = __builtin_amdgcn_rsqf(((pp[0] + pp[1]) + (pp[2] + pp[3])) * (1.0f / 256.0f) + EPS) * C2Q;
#pragma unroll
                for (int bj = 0; bj < 2; ++bj) { const int c = col0 + bj * HALF; const int d = c % 96;
                    f32x4 v0 = acc[ai][bj][m][0] * r, v1 = acc[ai][bj][m][1] * r;
                    if (d >= 64) { const int i0 = (d - 64) >> 1; const f32x2v* rp = rope + pos * 16 + i0;
                        const f32x2v a = rp[0], b = rp[1], e = rp[2], f = rp[3];
                        f32x4 w0, w1;
                        w0[0] = v0[0] * a.x - v0[1] * a.y; w0[1] = v0[0] * a.y + v0[1] * a.x;
                        w0[2] = v0[2] * b.x - v0[3] * b.y; w0[3] = v0[2] * b.y + v0[3] * b.x;
                        w1[0] = v1[0] * e.x - v1[1] * e.y; w1[1] = v1[0] * e.y + v1[1] * e.x;
                        w1[2] = v1[2] * f.x - v1[3] * f.y; w1[3] = v1[2] * f.y + v1[3] * f.x;
                        v0 = w0; v1 = w1; }
                    u32x4 w; w.x = cvt_pk_bf16(v0[0], v0[1]); w.y = cvt_pk_bf16(v0[2], v0[3]); w.z = cvt_pk_bf16(v1[0], v1[1]); w.w = cvt_pk_bf16(v1[2], v1[3]);
                    *(u32x4*)(Q + (size_t)row * 768 + c) = w; }
                asm volatile("" ::: "memory");
            }
    }
};
struct EpiKVup {
    static constexpr bool PERM = true, AFTER_DRAIN = false, MIDK = false;
    pg8::bf16_t* KV; const float* ssq;
    __device__ __forceinline__ void operator()(const f32x4 (&acc)[2][2][4][2], const Unit& u, int wr, int wc, int fr, int fq) const {
        const int row0 = u.pm * BM + wr * 64 + fr, col0 = u.pn * BM + wc * 32 + 8 * fq;
#pragma unroll
        for (int ai = 0; ai < 2; ++ai)
#pragma unroll
            for (int m = 0; m < 4; ++m) {
                const int row = row0 + ai * HALF + m * 16;
                const f32x4 pp = *(const f32x4*)(ssq + (size_t)row * 8 + 4);
                const float r = __builtin_amdgcn_rsqf(((pp[0] + pp[1]) + (pp[2] + pp[3])) * (1.0f / 128.0f) + EPS);
#pragma unroll
                for (int bj = 0; bj < 2; ++bj) { const f32x4 v0 = acc[ai][bj][m][0] * r, v1 = acc[ai][bj][m][1] * r;
                    u32x4 w; w.x = cvt_pk_bf16(v0[0], v0[1]); w.y = cvt_pk_bf16(v0[2], v0[3]); w.z = cvt_pk_bf16(v1[0], v1[1]); w.w = cvt_pk_bf16(v1[2], v1[3]);
                    *(u32x4*)(KV + (size_t)row * 1024 + col0 + bj * HALF) = w; }
                if (m & 1) asm volatile("" ::: "memory");
            }
    }
};
constexpr int OUT_TAB_OFF = 131072;
struct OutOrder : pg8::StaticOrder {
    const float* ssatt; LAS float* tab;
    __device__ __forceinline__ void a_ready(const Unit& u) const {
        const int tid = threadIdx.x, row = tid >> 1, which = tid & 1;
        const f32x4* pp = (const f32x4*)(ssatt + (size_t)(u.pm * BM + row) * 16 + which * 8); const f32x4 a = pp[0], b = pp[1];
        const float r = __builtin_amdgcn_rsqf((((a[0] + a[1]) + (a[2] + a[3])) + ((b[0] + b[1]) + (b[2] + b[3]))) * (1.0f / 512.0f) + EPS);
        const float o = __shfl_xor(r, 1);
        if (which == 0) { LAS float* t = tab + (u.ui & 1) * 512 + row * 2; t[0] = r / o; t[1] = o; }
    }
};
struct EpiOut {
    static constexpr bool PERM = true, AFTER_DRAIN = false, MIDK = true;
    const pg8::bf16_t* xb; pg8::bf16_t* H; float* ssh; const LAS float* tab;
    __device__ __forceinline__ void midk(f32x4 (&acc)[2][2][4][2], const Unit& u, int wr, int fr) const {
        const LAS float* t = tab + (u.ui & 1) * 512 + (wr * 64 + fr) * 2;
#pragma unroll
        for (int ai = 0; ai < 2; ++ai)
#pragma unroll
            for (int m = 0; m < 4; ++m) { const float ratio = t[(ai * HALF + m * 16) * 2];
#pragma unroll
                for (int bj = 0; bj < 2; ++bj) { acc[ai][bj][m][0] *= ratio; acc[ai][bj][m][1] *= ratio; } }
    }
    __device__ __forceinline__ void operator()(const f32x4 (&acc)[2][2][4][2], const Unit& u, int wr, int wc, int fr, int fq) const {
        const int row0 = u.pm * BM + wr * 64 + fr, col0 = u.pn * BM + wc * 32 + 8 * fq;
        const LAS float* t = tab + (u.ui & 1) * 512 + (wr * 64 + fr) * 2 + 1;
#pragma unroll
        for (int ai = 0; ai < 2; ++ai)
#pragma unroll
            for (int m = 0; m < 4; ++m) {
                const int row = row0 + ai * HALF + m * 16; const float r = t[(ai * HALF + m * 16) * 2];
                float s = 0.f;
#pragma unroll
                for (int bj = 0; bj < 2; ++bj) { const size_t off = (size_t)row * DM + col0 + bj * HALF;
                    const u32x4 xw = *(const u32x4*)(xb + off);
                    f32x4 x0, x1; x0[0] = bflo(xw.x); x0[1] = bfhi(xw.x); x0[2] = bflo(xw.y); x0[3] = bfhi(xw.y); x1[0] = bflo(xw.z); x1[1] = bfhi(xw.z); x1[2] = bflo(xw.w); x1[3] = bfhi(xw.w);
                    const f32x4 v0 = x0 + acc[ai][bj][m][0] * r, v1 = x1 + acc[ai][bj][m][1] * r;
                    u32x4 w; w.x = cvt_pk_bf16(v0[0], v0[1]); w.y = cvt_pk_bf16(v0[2], v0[3]); w.z = cvt_pk_bf16(v1[0], v1[1]); w.w = cvt_pk_bf16(v1[2], v1[3]);
                    *(u32x4*)(H + off) = w; s += sq4(v0) + sq4(v1); }
                s += __shfl_xor(s, 16); s += __shfl_xor(s, 32);
                if (fq == 0) ssh[(size_t)row * 16 + u.pn * 4 + wc] = s;
                if (m & 1) asm volatile("" ::: "memory");
            }
    }
};
struct GUOrder : pg8::StaticOrder {
    const float* ssh; LAS float* tab;
    __device__ __forceinline__ void a_ready(const Unit& u) const {
        const int tid = threadIdx.x, row = tid >> 1, which = tid & 1;
        const f32x4* pp = (const f32x4*)(ssh + (size_t)(u.pm * BM + row) * 16 + which * 8); const f32x4 a = pp[0], b = pp[1];
        float s = ((a[0] + a[1]) + (a[2] + a[3])) + ((b[0] + b[1]) + (b[2] + b[3]));
        s += __shfl_xor(s, 1);
        if (which == 0) tab[(u.ui & 1) * 256 + row] = __builtin_amdgcn_rsqf(s * (1.0f / 1024.0f) + EPS);
    }
};
struct EpiGU {
    static constexpr bool PERM = true, AFTER_DRAIN = false, MIDK = false;
    pg8::bf16_t* HID; const LAS float* tab;
    __device__ __forceinline__ void operator()(const f32x4 (&acc)[2][2][4][2], const Unit& u, int wr, int wc, int fr, int fq) const {
        const int row0 = u.pm * BM + wr * 64 + fr, col0 = u.pn * HALF + wc * 32 + 8 * fq;
        const LAS float* t = tab + (u.ui & 1) * 256 + wr * 64 + fr;
#pragma unroll
        for (int ai = 0; ai < 2; ++ai)
#pragma unroll
            for (int m = 0; m < 4; ++m) {
                const int row = row0 + ai * HALF + m * 16; const float r = t[ai * HALF + m * 16];
                float o[8];
#pragma unroll
                for (int n = 0; n < 2; ++n)
#pragma unroll
                    for (int e = 0; e < 4; ++e) { const float g = acc[ai][0][m][n][e] * r, up = acc[ai][1][m][n][e] * r;
                        const float sg = g * __builtin_amdgcn_rcpf(1.0f + __builtin_amdgcn_exp2f(-g * LOG2E)); o[n * 4 + e] = sg * up; }
                u32x4 w; w.x = cvt_pk_bf16(o[0], o[1]); w.y = cvt_pk_bf16(o[2], o[3]); w.z = cvt_pk_bf16(o[4], o[5]); w.w = cvt_pk_bf16(o[6], o[7]);
                __builtin_nontemporal_store(w, (u32x4*)(HID + (size_t)row * DFF + col0));
            }
    }
};
struct EpiDown {
    static constexpr bool PERM = true, AFTER_DRAIN = false, MIDK = false;
    const pg8::bf16_t* H; pg8::bf16_t* H2; float* ss2;
    __device__ __forceinline__ void operator()(const f32x4 (&acc)[2][2][4][2], const Unit& u, int wr, int wc, int fr, int fq) const {
        const int row0 = u.pm * BM + wr * 64 + fr, col0 = u.pn * BM + wc * 32 + 8 * fq;
#pragma unroll
        for (int ai = 0; ai < 2; ++ai)
#pragma unroll
            for (int m = 0; m < 4; ++m) {
                const int row = row0 + ai * HALF + m * 16; float s = 0.f;
#pragma unroll
                for (int bj = 0; bj < 2; ++bj) { const size_t off = (size_t)row * DM + col0 + bj * HALF;
                    const u32x4 hw = *(const u32x4*)(H + off);
                    f32x4 h0, h1; h0[0] = bflo(hw.x); h0[1] = bfhi(hw.x); h0[2] = bflo(hw.y); h0[3] = bfhi(hw.y); h1[0] = bflo(hw.z); h1[1] = bfhi(hw.z); h1[2] = bflo(hw.w); h1[3] = bfhi(hw.w);
                    h0 += acc[ai][bj][m][0]; h1 += acc[ai][bj][m][1];
                    u32x4 w; w.x = cvt_pk_bf16(h0[0], h0[1]); w.y = cvt_pk_bf16(h0[2], h0[3]); w.z = cvt_pk_bf16(h1[0], h1[1]); w.w = cvt_pk_bf16(h1[2], h1[3]);
                    *(u32x4*)(H2 + off) = w; s += sq4(h0) + sq4(h1); }
                s += __shfl_xor(s, 16); s += __shfl_xor(s, 32);
                if (fq == 0) ss2[(size_t)row * 16 + u.pn * 4 + wc] = s;
                if (m & 1) asm volatile("" ::: "memory");
            }
    }
};

struct Args { const float* in[22]; float* out; unsigned char* ws; int ph_lo, ph_hi, li, pad; };
enum { I_X = 0, I_GMIX, I_WIN, I_GQ, I_WUQ, I_GKV, I_WUKV, I_POSK, I_W1K, I_W2K, I_POSV, I_W1V, I_W2V, I_T5, I_GOM, I_GON, I_WOUT, I_GFFN, I_WG, I_WU, I_WD, I_GFIN };

__device__ __forceinline__ float wave_sum(float v) {
#pragma unroll
    for (int o = 1; o < 64; o <<= 1) v += __shfl_xor(v, o);
    return v;
}
typedef __bf16 bf16x2_t __attribute__((ext_vector_type(2)));
__device__ __forceinline__ float dot2(unsigned a, unsigned b, float c) { return __builtin_amdgcn_fdot2_f32_bf16(__builtin_bit_cast(bf16x2_t, a), __builtin_bit_cast(bf16x2_t, b), c, false); }

template <class F> __device__ __forceinline__ void tr_item(F f, bf16* WT, int ldk, int nblk, LAS float* scr, int item, int lane) {
    const int kb = item / nblk, nb = item % nblk, k0 = 64 * kb, n0 = 32 * nb;
#pragma unroll 8
    for (int i = 0; i < 32; ++i) { const int kk = 2 * i + (lane >> 5); scr[kk * 33 + (lane & 31)] = f(k0 + kk, n0 + (lane & 31)); }
    LDS_WAIT(); asm volatile("" ::: "memory");
    const int c = lane & 7;
#pragma unroll
    for (int j = 0; j < 4; ++j) { const int n = (lane >> 3) + 8 * j; const LAS float* s = scr + (8 * c) * 33 + n;
        v4u o; o.x = pk2(s[0 * 33], s[1 * 33]); o.y = pk2(s[2 * 33], s[3 * 33]); o.z = pk2(s[4 * 33], s[5 * 33]); o.w = pk2(s[6 * 33], s[7 * 33]);
        *(GAS v4u*)(WT + (size_t)(n0 + n) * ldk + k0 + 8 * c) = o; }
    LDS_WAIT(); asm volatile("" ::: "memory");
}
__device__ __forceinline__ int t5_bucket(int n) {
    if (n < 16) return n;
    int b = 16; b += n >= 19; b += n >= 21; b += n >= 24; b += n >= 27; b += n >= 31; b += n >= 35; b += n >= 40; b += n >= 46; b += n >= 52; b += n >= 59; b += n >= 67; b += n >= 77; b += n >= 87; b += n >= 99; b += n >= 113;
    return b;
}
__device__ __forceinline__ float gelu_tanh(float x) {
    const float y = 0.7978845608028654f * (x + 0.044715f * x * x * x);
    const float e = __builtin_amdgcn_exp2f(2.0f * LOG2E * y);
    const float th = 1.0f - 2.0f * __builtin_amdgcn_rcpf(e + 1.0f);
    return 0.5f * x * (1.0f + th);
}

struct Ptrs {
    const float* in[22]; float* out; unsigned char* ws;
    bf16 *Win, *Wuq, *Wukv, *Wout, *Wgu, *Wdn; f32x2v* rope; float *bias, *bias1, *rstdx, *ssqkv, *ssatt, *ssh;
    bf16 *kcmp, *vcmp, *kpe, *ovt, *W1c, *W2t, *XB, *U, *QM, *KVM, *ATT, *H, *HID;
};

__device__ __forceinline__ void p0_prologue(const Ptrs& P, LAS unsigned char* lds, int wg, int G, int wave, int lane, int tid) {
    LAS float* scr = (LAS float*)(lds + wave * 16384);
    const int gw = wg * NWAVES + wave, NGW = G * NWAVES;
    constexpr int I_IN = (1024 / 64) * (DINP / 32), I_UQ = (256 / 64) * (768 / 32), I_UKV = (256 / 64) * (1024 / 32), I_OUT = (1024 / 64) * (1024 / 32), I_GU = (1024 / 64) * (NGU / 32), I_DN = (DFF / 64) * (1024 / 32);
    constexpr int I_W1C = 2 * (1024 / 64) * (256 / 32), I_W2T = 2 * (128 / 64) * (64 / 32);
    constexpr int NITEMS = I_IN + I_UQ + I_UKV + I_OUT + I_GU + I_DN + I_W1C + I_W2T;
    for (int it = gw; it < NITEMS; it += NGW) {
        int r = it;
        if (r < I_IN) { const float* W = P.in[I_WIN]; const float* g = P.in[I_GMIX];
            tr_item([=](int k, int n) -> float { if (n >= DIN) return 0.f; const float s = (n >= C_QN && n < C_KVC) ? C2N : 1.0f; return W[(size_t)k * DIN + n] * g[k] * s; }, P.Win, 1024, DINP / 32, scr, r, lane); continue; } r -= I_IN;
        if (r < I_UQ) { const float* W = P.in[I_WUQ]; const float* g = P.in[I_GQ];
            tr_item([=](int k, int n) -> float { const int h = n / 96, d = n % 96; int src = n; if (d >= 64) { const int e = d - 64; src = h * 96 + 64 + (e & 1) * 16 + (e >> 1); } return W[(size_t)k * 768 + src] * g[k]; }, P.Wuq, 256, 768 / 32, scr, r, lane); continue; } r -= I_UQ;
        if (r < I_UKV) { const float* W = P.in[I_WUKV]; const float* g = P.in[I_GKV];
            tr_item([=](int k, int n) -> float { return k < 128 ? W[(size_t)k * 1024 + n] * g[k] : 0.f; }, P.Wukv, 256, 1024 / 32, scr, r, lane); continue; } r -= I_UKV;
        if (r < I_OUT) { const float* W = P.in[I_WOUT]; const float* g1 = P.in[I_GOM]; const float* g2 = P.in[I_GON];
            tr_item([=](int k, int n) -> float { return W[(size_t)k * 1024 + n] * (k < 512 ? g1[k] : g2[k - 512]); }, P.Wout, 1024, 1024 / 32, scr, r, lane); continue; } r -= I_OUT;
        if (r < I_GU) { const float* g = P.in[I_GFFN]; const bool up = ((r % (NGU / 32)) & 4) != 0;
            if (!up) { const float* W = P.in[I_WG]; tr_item([=](int k, int n) -> float { return W[(size_t)k * DFF + (n >> 8) * 128 + (n & 127)] * g[k]; }, P.Wgu, 1024, NGU / 32, scr, r, lane); }
            else { const float* W = P.in[I_WU]; tr_item([=](int k, int n) -> float { return W[(size_t)k * DFF + (n >> 8) * 128 + (n & 127)] * g[k]; }, P.Wgu, 1024, NGU / 32, scr, r, lane); }
            continue; } r -= I_GU;
        if (r < I_DN) { const float* W = P.in[I_WD];
            tr_item([=](int k, int n) -> float { return W[(size_t)k * 1024 + n]; }, P.Wdn, DFF, 1024 / 32, scr, r, lane); continue; } r -= I_DN;
        if (r < I_W1C) { const int kv = r >= I_W1C / 2; if (kv) r -= I_W1C / 2;
            if (!kv) { const float* W = P.in[I_W1K]; tr_item([=](int k, int n) -> float { return W[(size_t)(k + ((n >> 7) << 10)) * 128 + (n & 127)]; }, P.W1c, 1024, 256 / 32, scr, r, lane); }
            else { const float* W = P.in[I_W1V]; tr_item([=](int k, int n) -> float { return W[(size_t)(k + ((n >> 7) << 10)) * 128 + (n & 127)]; }, P.W1c + 256 * 1024, 1024, 256 / 32, scr, r, lane); }
            continue; } r -= I_W1C;
        { const int kv = r >= I_W2T / 2; if (kv) r -= I_W2T / 2;
            if (!kv) { const float* W = P.in[I_W2K]; tr_item([=](int k, int n) -> float { return W[(size_t)k * 64 + n]; }, P.W2t, 128, 64 / 32, scr, r, lane); }
            else { const float* W = P.in[I_W2V]; tr_item([=](int k, int n) -> float { return W[(size_t)k * 64 + n]; }, P.W2t + 64 * 128, 128, 64 / 32, scr, r, lane); } }
    }
    const int gt = wg * NTHR + tid, NGT = G * NTHR;
    for (int e = gt; e < SEQ * 16; e += NGT) { const int pos = e >> 4, i = e & 15;
        const float inv = __builtin_amdgcn_exp2f(-(float)i * (13.287712379549449f / 16.0f));
        const float ang = (float)pos * inv;
        double rev = (double)ang * 0.15915494309189535; rev -= __builtin_floor(rev);
        const float fr = (float)rev;
        P.rope[e] = (f32x2v){__builtin_amdgcn_cosf(fr), __builtin_amdgcn_sinf(fr)}; }
    for (int e = gt; e < 8 * 128; e += NGT) { const int h = e >> 7, d = e & 127; P.bias[e] = P.in[I_T5][t5_bucket(d) * 8 + h] * LOG2E; }
    for (int e = gt; e < 256 * 64; e += NGT) { const int i = e >> 6, j = e & 63; float w = 0.f; if (j == (i >> 2)) w += ((i & 3) == 3) ? 1.f : 2.f; if ((i & 3) == 3 && j == (i >> 2) + 1) w += 1.f;
        P.ovt[e] = (bf16)(__float_as_uint(w) >> 16); }
    for (int o = gw; o < 256; o += NGW) { const int kv = o >> 7, j = o & 127; const float* pos = P.in[kv ? I_POSV : I_POSK]; const float* w1 = P.in[kv ? I_W1V : I_W1K];
        float s = 0.f; for (int k = lane; k < 2048; k += 64) s += pos[k] * w1[(size_t)k * 128 + j];
        s = wave_sum(s); if (lane == 0) P.bias1[o] = s; }
    for (int m0 = gw * 4; m0 < MT; m0 += NGW * 4) {
        f32x4 v[4][4];
#pragma unroll
        for (int q = 0; q < 4; ++q) { const GAS f32x4* xr = (const GAS f32x4*)(P.in[I_X] + (size_t)(m0 + q) * DM) + lane;
#pragma unroll
            for (int j = 0; j < 4; ++j) v[q][j] = __builtin_nontemporal_load(xr + 64 * j); }
#pragma unroll
        for (int q = 0; q < 4; ++q) { float s = 0.f;
#pragma unroll
            for (int j = 0; j < 4; ++j) s += sq4(v[q][j]);
            s = wave_sum(s);
            if (lane == 0) P.rstdx[m0 + q] = __builtin_amdgcn_rsqf(s * (1.0f / DM) + EPS);
            GAS unsigned long long* o8 = (GAS unsigned long long*)(P.XB + (size_t)(m0 + q) * DM) + lane;
#pragma unroll
            for (int j = 0; j < 4; ++j) o8[64 * j] = (unsigned long long)pk2(v[q][j][0], v[q][j][1]) | ((unsigned long long)pk2(v[q][j][2], v[q][j][3]) << 32); }
    }
}

__device__ __forceinline__ void p2_kpe(const Ptrs& P, int wg, int G, int tid) {
    const int gt = wg * NTHR + tid, NGT = G * NTHR;
    for (int e = gt; e < MT * 16; e += NGT) { const int row = e >> 4, i = e & 15; const int pos = row & (SEQ - 1);
        const float x1 = bf2f(P.U[(size_t)row * DINP + C_KR + i]), x2 = bf2f(P.U[(size_t)row * DINP + C_KR + 16 + i]);
        const f32x2v cs = P.rope[pos * 16 + i];
        *(unsigned*)(P.kpe + (size_t)row * 32 + 2 * i) = pk2(x1 * cs.x - x2 * cs.y, x1 * cs.y + x2 * cs.x); }
}
__device__ __forceinline__ void p7_final(const Ptrs& P, int wg, int G, int wave, int lane) {
    const int gw = wg * NWAVES + wave, NGW = G * NWAVES;
    const GAS f32x4* gp = (const GAS f32x4*)P.in[I_GFIN] + 2 * lane; f32x4 gg[4][2];
#pragma unroll
    for (int j = 0; j < 2; ++j) { gg[j][0] = gp[128 * j]; gg[j][1] = gp[128 * j + 1]; }
    for (int m0 = gw * 4; m0 < MT; m0 += NGW * 4) {
        u32x4 w0[4], w1[4]; float pv[4];
#pragma unroll
        for (int q = 0; q < 4; ++q) { const GAS u32x4* hr = (const GAS u32x4*)(P.ATT + (size_t)(m0 + q) * DM) + lane;
            w0[q] = __builtin_nontemporal_load(hr); w1[q] = __builtin_nontemporal_load(hr + 64); pv[q] = (lane < 16) ? P.ssatt[(size_t)(m0 + q) * 16 + lane] : 0.f; }
#pragma unroll
        for (int q = 0; q < 4; ++q) {
            const float r = __builtin_amdgcn_rsqf(wave_sum(pv[q]) * (1.0f / DM) + EPS);
            GAS f32x4* o = (GAS f32x4*)(P.out + (size_t)(m0 + q) * DM) + 2 * lane;
            { const u32x4 w = w0[q]; f32x4 a, b; a[0] = bflo(w.x); a[1] = bfhi(w.x); a[2] = bflo(w.y); a[3] = bfhi(w.y); b[0] = bflo(w.z); b[1] = bfhi(w.z); b[2] = bflo(w.w); b[3] = bfhi(w.w);
              __builtin_nontemporal_store(a * r * gg[0][0], o); __builtin_nontemporal_store(b * r * gg[0][1], o + 1); }
            { const u32x4 w = w1[q]; f32x4 a, b; a[0] = bflo(w.x); a[1] = bfhi(w.x); a[2] = bflo(w.y); a[3] = bfhi(w.y); b[0] = bflo(w.z); b[1] = bfhi(w.z); b[2] = bflo(w.w); b[3] = bfhi(w.w);
              __builtin_nontemporal_store(a * r * gg[1][0], o + 128); __builtin_nontemporal_store(b * r * gg[1][1], o + 129); } }
    }
}

struct CmpOrder {
    int G, c; const bf16* U; const bf16* W1c;
    __device__ __forceinline__ bool next(int i, Unit& u) const { const int un = c + i * G; if (un >= 64) return false; u.pm = un; u.pn = 0; u.ui = i; return true; }
    __device__ __forceinline__ void a_ready(const Unit&) const {}
    __device__ __forceinline__ void done(const Unit&) const {}
    __device__ __forceinline__ const char* a_base(const pg8::Gemm&, const Unit& u, size_t) const { const int bh = u.pm >> 1, kv = u.pm & 1;
        return (const char*)(U + (size_t)(bh >> 1) * SEQ * DINP + C_KVC + kv * 128 + (bh & 1) * 64); }
    __device__ __forceinline__ const char* b_base(const pg8::Gemm&, const Unit& u, size_t) const { return (const char*)(W1c + (size_t)(u.pm & 1) * 256 * 1024); }
};
struct EpiCmp {
    static constexpr bool PERM = true, AFTER_DRAIN = true, MIDK = false;
    const float* bias1; const bf16* W2t; bf16* kcmp; bf16* vcmp;
    __device__ __forceinline__ void operator()(const f32x4 (&)[2][2][4][2], const Unit&, int, int, int, int) const {}
    __device__ __forceinline__ void fused(f32x4 (&acc)[2][2][4][2], const Unit& u, int wr, int wc, int fr, int fq, LAS unsigned char* lds, int wid, int lane) const {
        typedef short bf16x8_t __attribute__((ext_vector_type(8))); typedef float f32x16_t __attribute__((ext_vector_type(16)));
        const int bh = u.pm >> 1, kv = u.pm & 1; const int col = wc * 32 + 8 * fq;
        LAS float* OB = (LAS float*)lds;
#pragma unroll
        for (int ai = 0; ai < 2; ++ai)
#pragma unroll
            for (int m = 0; m < 4; ++m) { const int r = ai * HALF + wr * 64 + m * 16 + fr;
                *(LAS f32x4*)(OB + r * 132 + col) = acc[ai][1][m][0]; *(LAS f32x4*)(OB + r * 132 + col + 4) = acc[ai][1][m][1]; }
        const f32x4 bs0 = *(const f32x4*)(bias1 + kv * 128 + col), bs1 = *(const f32x4*)(bias1 + kv * 128 + col + 4);
        asm volatile("s_waitcnt lgkmcnt(0)" ::: "memory"); __builtin_amdgcn_s_barrier(); asm volatile("" ::: "memory");
#pragma unroll
        for (int ai = 0; ai < 2; ++ai)
#pragma unroll
            for (int m = 0; m < 4; ++m) { const int r = ai * HALF + wr * 64 + m * 16 + fr, r1 = r < 255 ? r + 1 : 255;
                const f32x4 b0 = *(const LAS f32x4*)(OB + r1 * 132 + col), b1 = *(const LAS f32x4*)(OB + r1 * 132 + col + 4);
                f32x4 h0 = acc[ai][0][m][0] + b0 + bs0, h1 = acc[ai][0][m][1] + b1 + bs1;
#pragma unroll
                for (int e = 0; e < 4; ++e) { h0[e] = gelu_tanh(h0[e]); h1[e] = gelu_tanh(h1[e]); }
                acc[ai][0][m][0] = h0; acc[ai][0][m][1] = h1; }
        asm volatile("s_waitcnt lgkmcnt(0)" ::: "memory"); __builtin_amdgcn_s_barrier(); asm volatile("" ::: "memory");
        LAS bf16* GB = (LAS bf16*)lds;
#pragma unroll
        for (int ai = 0; ai < 2; ++ai)
#pragma unroll
            for (int m = 0; m < 4; ++m) { const int r = ai * HALF + wr * 64 + m * 16 + fr; const f32x4 h0 = acc[ai][0][m][0], h1 = acc[ai][0][m][1];
                u32x4 w; w.x = pk2(h0[0], h0[1]); w.y = pk2(h0[2], h0[3]); w.z = pk2(h1[0], h1[1]); w.w = pk2(h1[2], h1[3]);
                *(LAS u32x4*)(GB + r * 136 + col) = w; }
        asm volatile("s_waitcnt lgkmcnt(0)" ::: "memory"); __builtin_amdgcn_s_barrier(); asm volatile("" ::: "memory");
        const int r32 = lane & 31, hi = lane >> 5, c = wid * 32 + r32;
        f32x16_t o[2]; o[0] = f32x16_t{}; o[1] = f32x16_t{};
        const bf16* w2 = W2t + (size_t)kv * 64 * 128;
#pragma unroll
        for (int s = 0; s < 8; ++s) { const bf16x8_t gb = *(const LAS bf16x8_t*)(GB + c * 136 + 16 * s + 8 * hi);
#pragma unroll
            for (int dt = 0; dt < 2; ++dt) { const bf16x8_t wa = *(const bf16x8_t*)(w2 + (size_t)(32 * dt + r32) * 128 + 16 * s + 8 * hi);
                o[dt] = __builtin_amdgcn_mfma_f32_32x32x16_bf16(wa, gb, o[dt], 0, 0, 0); } }
        if (c < NCMP) { bf16* op = (kv ? vcmp : kcmp) + ((size_t)bh * 256 + c) * 64 + 4 * hi;
#pragma unroll
            for (int dt = 0; dt < 2; ++dt)
#pragma unroll
                for (int k = 0; k < 4; ++k) *(unsigned long long*)(op + 32 * dt + 8 * k) = (unsigned long long)pk2(o[dt][4 * k], o[dt][4 * k + 1]) | ((unsigned long long)pk2(o[dt][4 * k + 2], o[dt][4 * k + 3]) << 32); }
        asm volatile("s_waitcnt lgkmcnt(0)" ::: "memory"); __builtin_amdgcn_s_barrier();
    }
};

namespace att {
typedef short bf16x8 __attribute__((ext_vector_type(8)));
typedef short s16x4 __attribute__((ext_vector_type(4)));
typedef float f32x16 __attribute__((ext_vector_type(16)));
typedef __attribute__((address_space(3))) const char* lds_cptr;
constexpr float THR = 8.0f;
constexpr float NEG_INF = -__builtin_inff();
__device__ __forceinline__ int crow(int r, int hi) { return (r & 3) + 8 * (r >> 2) + 4 * hi; }
__device__ __forceinline__ float swap_max(float x) { auto rr = __builtin_amdgcn_permlane32_swap(__float_as_uint(x), __float_as_uint(x), false, false); return fmaxf(__uint_as_float(rr[0]), __uint_as_float(rr[1])); }
__device__ __forceinline__ float swap_sum(float x) { auto rr = __builtin_amdgcn_permlane32_swap(__float_as_uint(x), __float_as_uint(x), false, false); return __uint_as_float(rr[0]) + __uint_as_float(rr[1]); }
__device__ __forceinline__ float partner32(float x, int hi) { auto rr = __builtin_amdgcn_permlane32_swap(__float_as_uint(x), __float_as_uint(x), false, false); return __uint_as_float(hi ? rr[0] : rr[1]); }
__device__ __forceinline__ unsigned partner32u(unsigned x, int hi) { auto rr = __builtin_amdgcn_permlane32_swap(x, x, false, false); return hi ? rr[0] : rr[1]; }
__device__ __forceinline__ void dma16(const void* g, LAS unsigned char* l) { unsigned keep; const unsigned dst = (unsigned)__builtin_amdgcn_readfirstlane((int)(unsigned)(uintptr_t)l);
    asm volatile("s_mov_b32 %0, m0\n\ts_mov_b32 m0, %2\n\ts_nop 0\n\tglobal_load_lds_dwordx4 %1, off\n\ts_mov_b32 m0, %0" : "=&s"(keep) : "v"(g), "s"(dst) : "memory"); }
template <int N> __device__ __forceinline__ void wait_bar() { if (N == 3) asm volatile("s_waitcnt vmcnt(3) lgkmcnt(0)\n\ts_barrier" ::: "memory"); else if (N == 2) asm volatile("s_waitcnt vmcnt(2) lgkmcnt(0)\n\ts_barrier" ::: "memory"); else asm volatile("s_waitcnt vmcnt(0) lgkmcnt(0)\n\ts_barrier" ::: "memory"); }

struct SrcMLA {
    static constexpr int DK = 96, NDMA = 3, NV = 1;
    const bf16* kn; const bf16* kp; const bf16* v;
    __device__ __forceinline__ void init(const bf16* KVM, const bf16* KPE, size_t rowb, int h, int wid, int lane) {
        kn = KVM + (rowb + lane) * 1024 + h * 128 + 8 * wid;
        kp = KPE + (rowb + lane) * 32 + 8 * (wid & 3);
        v = KVM + (rowb + 16 * (wid & 3) + (lane >> 2)) * 1024 + h * 128 + 64 + (wid >> 2) * 32 + (lane & 3) * 8; }
    static constexpr int NKD = 2;
    __device__ __forceinline__ void issueK(int tile, LAS unsigned char* ks, int wid) const {
        dma16(kn + (size_t)tile * 64 * 1024, ks + wid * 1024);
        dma16(kp + (size_t)tile * 64 * 32, ks + (8 + (wid & 3)) * 1024); }
    __device__ __forceinline__ void issueV(int tile, LAS unsigned char* vs, int wid) const { dma16(v + (size_t)tile * 64 * 1024, vs + wid * 1024); }
    __device__ __forceinline__ void issue(int tile, LAS unsigned char* ks, LAS unsigned char* vs, int wid) const { issueK(tile, ks, wid); issueV(tile, vs, wid); }
};
struct SrcRows {
    static constexpr int DK = 64, NDMA = 2, NV = 1;
    const bf16* k; const bf16* v; size_t pitch;
    __device__ __forceinline__ void init(const bf16* K0, const bf16* V0, size_t pitch_, int wid, int lane) {
        pitch = pitch_; k = K0 + (size_t)lane * pitch + 8 * wid; v = V0 + (size_t)(16 * (wid & 3) + (lane >> 2)) * pitch + (wid >> 2) * 32 + (lane & 3) * 8; }
    static constexpr int NKD = 1;
    __device__ __forceinline__ void issueK(int tile, LAS unsigned char* ks, int wid) const { dma16(k + (size_t)tile * 64 * pitch, ks + wid * 1024); }
    __device__ __forceinline__ void issueV(int tile, LAS unsigned char* vs, int wid) const { dma16(v + (size_t)tile * 64 * pitch, vs + wid * 1024); }
    __device__ __forceinline__ void issue(int tile, LAS unsigned char* ks, LAS unsigned char* vs, int wid) const { issueK(tile, ks, wid); issueV(tile, vs, wid); }
};

struct SrcCmp {
    static constexpr int DK = 64, NDMA = 3, NV = 2;
    const bf16* k; const bf16* v; const bf16* ov;
    __device__ __forceinline__ void init(const bf16* K0, const bf16* V0, const bf16* OV, int wid, int lane) {
        k = K0 + (size_t)lane * 64 + 8 * wid; const size_t vo = (size_t)(16 * (wid & 3) + (lane >> 2)) * 64 + (wid >> 2) * 32 + (lane & 3) * 8; v = V0 + vo; ov = OV + vo; }
    __device__ __forceinline__ void issue(int tile, LAS unsigned char* ks, LAS unsigned char* vs, int wid) const {
        dma16(k + (size_t)tile * 4096, ks + wid * 1024);
        dma16(v + (size_t)tile * 4096, vs + wid * 1024);
        dma16(ov + (size_t)tile * 4096, vs + 8192 + wid * 1024); }
};

template <int NV> struct RowT { float m, l; f32x16 o[2 * NV]; };
typedef RowT<1> Row;
template <int NV> __device__ __forceinline__ void row_reset(RowT<NV>& R) { R.m = -1e30f; R.l = 0.f;
#pragma unroll
    for (int i = 0; i < 2 * NV; ++i) R.o[i] = f32x16{}; }

template <int DK> __device__ __forceinline__ void qk_tile(f32x16& p0, f32x16& p1, LAS unsigned char* kslot, const bf16x8 (&qr)[DK / 16], int r32, int hi) {
    const LAS unsigned char* kb = kslot + hi * 1024 + r32 * 16;
    p0 = f32x16{}; p1 = f32x16{};
#pragma unroll
    for (int d0 = 0; d0 < DK / 16; ++d0) {
        const bf16x8 b0 = *(const LAS bf16x8*)(kb + d0 * 2048), b1 = *(const LAS bf16x8*)(kb + d0 * 2048 + 512);
        p0 = __builtin_amdgcn_mfma_f32_32x32x16_bf16(b0, qr[d0], p0, 0, 0, 0);
        p1 = __builtin_amdgcn_mfma_f32_32x32x16_bf16(b1, qr[d0], p1, 0, 0, 0); }
}
template <int NV> __device__ __forceinline__ void softmax_tile(f32x16& p0, f32x16& p1, RowT<NV>& R) {
    float a = fmaxf(fmaxf(p0[0], p0[1]), fmaxf(p1[0], p1[1]));
#pragma unroll
    for (int r = 2; r < 16; r += 2) a = fmaxf(a, fmaxf(fmaxf(p0[r], p0[r + 1]), fmaxf(p1[r], p1[r + 1])));
    const float mt = swap_max(a);
    if (__any(mt > R.m + THR)) { const float mn = fmaxf(R.m, mt), f = __builtin_amdgcn_exp2f(R.m - mn); R.m = mn; R.l *= f;
#pragma unroll
        for (int i = 0; i < 2 * NV; ++i) R.o[i] *= f; }
    const float m = R.m; float s = 0.f;
#pragma unroll
    for (int r = 0; r < 16; ++r) { p0[r] = __builtin_amdgcn_exp2f(p0[r] - m); p1[r] = __builtin_amdgcn_exp2f(p1[r] - m); s += p0[r] + p1[r]; }
    R.l += s;
}
template <int NV> __device__ __forceinline__ void pv_tile(const f32x16& p0, const f32x16& p1, RowT<NV>& R, LAS unsigned char* vslot, int lane, int hi) {
    bf16x8 pa[4];
#pragma unroll
    for (int k = 0; k < 4; ++k) { const f32x16& P = (k < 2) ? p0 : p1; const int b = (k & 1) * 8;
        u32x4 w; w.x = pk2(P[b], P[b + 1]); w.y = pk2(P[b + 2], P[b + 3]); w.z = pk2(P[b + 4], P[b + 5]); w.w = pk2(P[b + 6], P[b + 7]); pa[k] = __builtin_bit_cast(bf16x8, w); }
    const int vb = (int)(unsigned)(uintptr_t)vslot + ((lane >> 4) & 1) * 32 + (lane & 3) * 8 + (4 * hi + ((lane & 15) >> 2)) * 64;
#pragma unroll
    for (int d0 = 0; d0 < 2 * NV; ++d0) { s16x4 lo[4], hh[4];
#pragma unroll
        for (int ks = 0; ks < 4; ++ks) {
            asm volatile("ds_read_b64_tr_b16 %0,%1 offset:%c2" : "=&v"(lo[ks]) : "v"(vb), "i"(d0 * 4096 + ks * 1024) : "memory");
            asm volatile("ds_read_b64_tr_b16 %0,%1 offset:%c2" : "=&v"(hh[ks]) : "v"(vb), "i"(d0 * 4096 + ks * 1024 + 512) : "memory"); }
        asm volatile("s_waitcnt lgkmcnt(0)" ::: "memory"); __builtin_amdgcn_sched_barrier(0);
#pragma unroll
        for (int ks = 0; ks < 4; ++ks) { const bf16x8 vf = (bf16x8){lo[ks][0], lo[ks][1], lo[ks][2], lo[ks][3], hh[ks][0], hh[ks][1], hh[ks][2], hh[ks][3]};
            R.o[d0] = __builtin_amdgcn_mfma_f32_32x32x16_bf16(vf, pa[ks], R.o[d0], 0, 0, 0); } }
}

template <class RowPtr>
__device__ __forceinline__ void store_rows(LAS unsigned char* stg, const f32x16& o0, const f32x16& o1, float scale, float& ss, int lane, const RowPtr& rowptr) {
    const int r32 = lane & 31, hi = lane >> 5;
    LAS unsigned char* wp = stg + r32 * 144 + 8 * hi;
#pragma unroll
    for (int d0 = 0; d0 < 2; ++d0)
#pragma unroll
        for (int k = 0; k < 4; ++k) { const f32x16& o = d0 ? o1 : o0;
            const float v0 = o[4 * k] * scale, v1 = o[4 * k + 1] * scale, v2 = o[4 * k + 2] * scale, v3 = o[4 * k + 3] * scale;
            ss += (v0 * v0 + v1 * v1) + (v2 * v2 + v3 * v3);
            *(LAS unsigned long long*)(wp + 64 * d0 + 16 * k) = (unsigned long long)pk2(v0, v1) | ((unsigned long long)pk2(v2, v3) << 32); }
    asm volatile("s_waitcnt lgkmcnt(0)" ::: "memory");
#pragma unroll
    for (int i = 0; i < 4; ++i) { const int row = i * 8 + (lane >> 3), ch = lane & 7;
        const u32x4 v = *(const LAS u32x4*)(stg + row * 144 + ch * 16);
        *(u32x4*)(rowptr(row) + ch * 8) = v; }
}

template <class Src, class Fix, class Skip>
__device__ __forceinline__ void run_tiles(LAS unsigned char* ring, const Src& src, int kt0, int kt1, const bf16x8 (&qr)[Src::DK / 16], RowT<Src::NV>& R, const Fix& fix, const Skip& skip, int wid, int lane) {
    constexpr int KB = Src::DK * 128, SLOT = KB + 8192 * Src::NV;
    const int r32 = lane & 31, hi = lane >> 5; const int nt = kt1 - kt0;
    if (nt <= 0) return;
    src.issue(kt0, ring, ring + KB, wid);
    if (nt > 1) src.issue(kt0 + 1, ring + SLOT, ring + SLOT + KB, wid);
    int s_cur = 0, s_nn = 2 * SLOT;
    for (int i = 0; i < nt; ++i) {
        if (i + 1 < nt) wait_bar<Src::NDMA>(); else wait_bar<0>();
        if (i + 2 < nt) src.issue(kt0 + i + 2, ring + s_nn, ring + s_nn + KB, wid);
        const int tile = kt0 + i;
        if (!skip(tile)) {
            f32x16 p0, p1;
            qk_tile<Src::DK>(p0, p1, ring + s_cur, qr, r32, hi);
            fix(p0, p1, tile);
            softmax_tile(p0, p1, R);
            pv_tile(p0, p1, R, ring + s_cur + KB, lane, hi);
        }
        s_cur = (s_cur == 2 * SLOT) ? 0 : s_cur + SLOT; s_nn = (s_nn == 2 * SLOT) ? 0 : s_nn + SLOT;
    }
    asm volatile("s_waitcnt lgkmcnt(0)\n\ts_barrier" ::: "memory");
}
}


namespace att {
template <int N> __device__ __forceinline__ void wait_bar_n() {
    static_assert(N == 0 || N == 3 || N == 4 || N == 5 || N == 6 || N == 8, "wait_bar_n: add the count");
    if (N == 8) asm volatile("s_waitcnt vmcnt(8) lgkmcnt(0)\n\ts_barrier" ::: "memory"); else if (N == 6) asm volatile("s_waitcnt vmcnt(6) lgkmcnt(0)\n\ts_barrier" ::: "memory");
    else if (N == 5) asm volatile("s_waitcnt vmcnt(5) lgkmcnt(0)\n\ts_barrier" ::: "memory"); else if (N == 4) asm volatile("s_waitcnt vmcnt(4) lgkmcnt(0)\n\ts_barrier" ::: "memory");
    else if (N == 3) asm volatile("s_waitcnt vmcnt(3) lgkmcnt(0)\n\ts_barrier" ::: "memory"); else asm volatile("s_waitcnt vmcnt(0) lgkmcnt(0)\n\ts_barrier" ::: "memory"); }
typedef short v4i16_t __attribute__((ext_vector_type(4)));
typedef float f32x2_t __attribute__((ext_vector_type(2)));
__device__ __forceinline__ s16x4 vtr(const LAS unsigned char* p) { return __builtin_bit_cast(s16x4, __builtin_amdgcn_ds_read_tr16_b64_v4i16((LAS v4i16_t*)p)); }
__device__ __forceinline__ unsigned cvtpk(float lo, float hi) { f32x2_t v = {lo, hi}; bf16x2_t b = __builtin_convertvector(v, bf16x2_t); return __builtin_bit_cast(unsigned, b); }
#define SBAR() __builtin_amdgcn_sched_barrier(0)
#define PIN(x) asm volatile("" : "+v"(x))
#define MX3(a, b, c) __builtin_fmaxf(__builtin_fmaxf((a), (b)), (c))

template <class Src, class Fix>
__device__ __forceinline__ void run_pipe(LAS unsigned char* ring, const Src& src, int kt0, int kt1, const bf16x8 (&qr)[Src::DK / 16], Row& R, const Fix& fix, float bfar, int near_from, int wid, int lane) {
    constexpr int DK = Src::DK, NKS = DK / 16, NK = 2 * NKS, KB = DK * 128, VB = 8192, NKD = Src::NKD, NDMA = NKD + 1;
    const int NT = kt1 - kt0;
    constexpr bool ALT = false;
    if (wid >= 4) __builtin_amdgcn_s_setprio(1);
    const int r32 = lane & 31, hi = lane >> 5;
    LAS unsigned char* kring = ring; LAS unsigned char* vring = ring + 4 * KB;
    const LAS unsigned char* kp0 = kring + hi * 1024 + r32 * 16;
    const LAS unsigned char* vp0 = vring + ((lane >> 4) & 1) * 32 + (lane & 3) * 8 + (4 * hi + ((lane & 15) >> 2)) * 64;
#define TILE(tt) (kt0 + ((tt) < NT ? (tt) : NT - 1))
    src.issueK(TILE(0), kring, wid); src.issueV(TILE(0), vring, wid); src.issueK(TILE(1), kring + KB, wid); src.issueK(TILE(2), kring + 2 * KB, wid);
    src.issueK(TILE(3), kring + 3 * KB, wid); src.issueV(TILE(1), vring + VB, wid);
    bf16x8 kf[NK];
    f32x16 A0, A1, B0, B1, cin;
    float m = 0.f, l = 0.f, csh = 0.f; f32x16 o0 = f32x16{}, o1 = f32x16{};
    wait_bar_n<3 * NKD + 2>();
#define KLOAD(kslot) do { _Pragma("unroll") for (int d0 = 0; d0 < NKS; ++d0) { kf[2 * d0] = *(const LAS bf16x8*)(kp0 + (kslot) + d0 * 2048); kf[2 * d0 + 1] = *(const LAS bf16x8*)(kp0 + (kslot) + d0 * 2048 + 512); } } while (0)
#define ROWMAX(C0, C1, out) do { float a_ = MX3(C0[0], C0[1], C1[0]), b_ = MX3(C0[2], C0[3], C1[1]); a_ = MX3(a_, C1[2], C1[3]); \
        _Pragma("unroll") for (int r = 4; r < 16; r += 4) { a_ = MX3(a_, C0[r], C0[r + 1]); b_ = MX3(b_, C0[r + 2], C0[r + 3]); a_ = MX3(a_, C1[r], C1[r + 1]); b_ = MX3(b_, C1[r + 2], C1[r + 3]); } \
        out = swap_max(__builtin_fmaxf(a_, b_)); } while (0)
    KLOAD(0);
    A0 = f32x16{}; A1 = f32x16{};
#pragma unroll
    for (int d0 = 0; d0 < NKS; ++d0) { A0 = __builtin_amdgcn_mfma_f32_32x32x16_bf16(kf[2 * d0], qr[d0], A0, 0, 0, 0); A1 = __builtin_amdgcn_mfma_f32_32x32x16_bf16(kf[2 * d0 + 1], qr[d0], A1, 0, 0, 0); }
    fix(A0, A1, kt0);
    { float rm; ROWMAX(A0, A1, rm);
      const float sh0 = (kt0 < near_from) ? bfar : 0.f;
      const float dl = (rm > NEG_INF) ? rm + sh0 : 0.f; m = dl; const float c0 = sh0 - dl;
#pragma unroll
      for (int r = 0; r < 16; ++r) { A0[r] = __builtin_amdgcn_exp2f(A0[r] + c0); A1[r] = __builtin_amdgcn_exp2f(A1[r] + c0); }
      csh = (kt0 + 1 < near_from) ? bfar : 0.f;
#pragma unroll
      for (int r = 0; r < 16; ++r) cin[r] = csh - m;
      asm volatile("" : "+v"(cin)); }
    float fpend = 1.0f; bool resc = false;
    wait_bar_n<2 * NKD + 1>();
    src.issueK(TILE(4), kring, wid); src.issueV(TILE(2), vring + 2 * VB, wid);
    KLOAD(KB);
    wait_bar_n<2 * NDMA>();
    int kcur = KB, knext = 2 * KB, vprev = 0, vnext = 3 * VB;
    u32x4 pw0, pw1, pw2, pw3; s16x4 vlo[8], vhi[8];
#define PKW(P, b) cvtpk(P[b], P[(b) + 1])
#define VRD(i) do { vlo[i] = vtr(vp_ + (((i) >> 2) * 4096 + ((i) & 3) * 1024)); vhi[i] = vtr(vp_ + (((i) >> 2) * 4096 + ((i) & 3) * 1024 + 512)); } while (0)
#define VFR(i) (bf16x8){vlo[i][0], vlo[i][1], vlo[i][2], vlo[i][3], vhi[i][0], vhi[i][1], vhi[i][2], vhi[i][3]}
#define PAF(k) __builtin_bit_cast(bf16x8, pw##k)
#define QKM(i, C, first) C = __builtin_amdgcn_mfma_f32_32x32x16_bf16(kf[i], qr[(i) >> 1], (first) ? cin : C, 0, 0, 0)
#define GAPA(MF, a0_, a1_, a2_, a3_, W0, W1, PW) do { MF; sacc += a0_; sacc += a1_; sacc += a2_; sacc += a3_; PIN(sacc); W0; W1; PIN(PW); SBAR(); } while (0)
#define GAPB(MF, X, b) do { MF; X[b] = __builtin_amdgcn_exp2f(X[b]); X[(b) + 1] = __builtin_amdgcn_exp2f(X[(b) + 1]); X[(b) + 2] = __builtin_amdgcn_exp2f(X[(b) + 2]); X[(b) + 3] = __builtin_amdgcn_exp2f(X[(b) + 3]); PIN(X); SBAR(); } while (0)
#define PHASE_A(C0, C1, P0, P1) do { SBAR(); const LAS unsigned char* vp_ = vp0 + vprev; \
        VRD(0); SBAR(); float sacc = P0[0] + P0[1]; \
        GAPA(QKM(0, C0, true), P0[2], P0[3], P0[4], P0[5], pw0[0] = PKW(P0, 0), pw0[1] = PKW(P0, 2), pw0); \
        GAPA(QKM(1, C1, true), P0[6], P0[7], P0[8], P0[9], pw0[2] = PKW(P0, 4), pw0[3] = PKW(P0, 6), pw0); \
        VRD(1); SBAR(); GAPA(QKM(2, C0, false), P0[10], P0[11], P0[12], P0[13], pw1[0] = PKW(P0, 8), pw1[1] = PKW(P0, 10), pw1); \
        GAPA(QKM(3, C1, false), P0[14], P0[15], P1[0], P1[1], pw1[2] = PKW(P0, 12), pw1[3] = PKW(P0, 14), pw1); \
        VRD(2); SBAR(); GAPA(QKM(4, C0, false), P1[2], P1[3], P1[4], P1[5], pw2[0] = PKW(P1, 0), pw2[1] = PKW(P1, 2), pw2); \
        GAPA(QKM(5, C1, false), P1[6], P1[7], P1[8], P1[9], pw2[2] = PKW(P1, 4), pw2[3] = PKW(P1, 6), pw2); \
        VRD(3); SBAR(); GAPA(QKM(6, C0, false), P1[10], P1[11], P1[12], P1[13], pw3[0] = PKW(P1, 8), pw3[1] = PKW(P1, 10), pw3); \
        GAPA(QKM(7, C1, false), P1[14], P1[15], 0.f, 0.f, pw3[2] = PKW(P1, 12), pw3[3] = PKW(P1, 14), pw3); \
        if (NK > 8) { _Pragma("unroll") for (int i_ = 8; i_ < NK; i_ += 2) { QKM(i_, C0, false); QKM(i_ + 1, C1, false); } SBAR(); } \
        l += sacc; } while (0)
#define KRD(j) do { kf[2 * (j)] = *(const LAS bf16x8*)(kp0 + knext + (j) * 2048); kf[2 * (j) + 1] = *(const LAS bf16x8*)(kp0 + knext + (j) * 2048 + 512); SBAR(); } while (0)
#define PHASE_B(C0, C1) do { SBAR(); const LAS unsigned char* vp_ = vp0 + vprev; \
        VRD(4); SBAR(); GAPB(o0 = __builtin_amdgcn_mfma_f32_32x32x16_bf16(VFR(0), PAF(0), o0, 0, 0, 0), C0, 0); \
        VRD(5); SBAR(); GAPB(o0 = __builtin_amdgcn_mfma_f32_32x32x16_bf16(VFR(1), PAF(1), o0, 0, 0, 0), C0, 4); \
        VRD(6); SBAR(); KRD(0); GAPB(o0 = __builtin_amdgcn_mfma_f32_32x32x16_bf16(VFR(2), PAF(2), o0, 0, 0, 0), C0, 8); \
        VRD(7); SBAR(); KRD(1); GAPB(o0 = __builtin_amdgcn_mfma_f32_32x32x16_bf16(VFR(3), PAF(3), o0, 0, 0, 0), C0, 12); \
        KRD(2); GAPB(o1 = __builtin_amdgcn_mfma_f32_32x32x16_bf16(VFR(4), PAF(0), o1, 0, 0, 0), C1, 0); \
        KRD(3); GAPB(o1 = __builtin_amdgcn_mfma_f32_32x32x16_bf16(VFR(5), PAF(1), o1, 0, 0, 0), C1, 4); \
        if (NKS > 4) { KRD(4); } GAPB(o1 = __builtin_amdgcn_mfma_f32_32x32x16_bf16(VFR(6), PAF(2), o1, 0, 0, 0), C1, 8); \
        if (NKS > 5) { KRD(5); } GAPB(o1 = __builtin_amdgcn_mfma_f32_32x32x16_bf16(VFR(7), PAF(3), o1, 0, 0, 0), C1, 12); \
        } while (0)
#define DECIDE(C0, C1, tt) do { \
        fix(C0, C1, kt0 + (tt)); \
        float rm_; ROWMAX(C0, C1, rm_); resc = false; \
        const bool up_ = (rm_ > THR) || (l == 0.f && rm_ < -THR && rm_ > NEG_INF); \
        const float nsh_ = (kt0 + (tt) + 1 < near_from) ? bfar : 0.f; \
        if (__any(up_)) { const float dl_ = up_ ? rm_ : __builtin_fmaxf(rm_, 0.f); m += dl_; fpend = __builtin_amdgcn_exp2f(-dl_); l *= fpend; resc = true; \
            _Pragma("unroll") for (int r = 0; r < 16; ++r) { C0[r] -= dl_; C1[r] -= dl_; } \
            csh = nsh_; _Pragma("unroll") for (int r = 0; r < 16; ++r) cin[r] = csh - m; asm volatile("" : "+v"(cin)); } \
        else if (nsh_ != csh) { csh = nsh_; _Pragma("unroll") for (int r = 0; r < 16; ++r) cin[r] = csh - m; asm volatile("" : "+v"(cin)); } } while (0)
#define STEP(C0, C1, P0, P1, tt) do { \
        if (ALT && wid >= 4) asm volatile("s_barrier" ::: "memory"); \
        PHASE_A(C0, C1, P0, P1); \
        src.issueK(TILE((tt) + 4), kring + kcur, wid); src.issueV(TILE((tt) + 2), vring + vnext, wid); \
        DECIDE(C0, C1, tt); \
        PHASE_B(C0, C1); \
        if (ALT && wid < 4) asm volatile("s_waitcnt lgkmcnt(0)\n\ts_barrier" ::: "memory"); \
        wait_bar_n<2 * NDMA>();                                          \
        if (resc) { o0 *= fpend; o1 *= fpend; } \
        kcur = knext; knext = (knext == 3 * KB) ? 0 : knext + KB; \
        vprev = (vprev == 3 * VB) ? 0 : vprev + VB; vnext = (vnext == 3 * VB) ? 0 : vnext + VB; } while (0)
    int t = 1;
    for (; t + 1 < NT; t += 2) { STEP(B0, B1, A0, A1, t); STEP(A0, A1, B0, B1, t + 1); }
    if (t < NT) { STEP(B0, B1, A0, A1, t); A0 = B0; A1 = B1; }
    { float sacc = 0.f;
#pragma unroll
      for (int r = 0; r < 16; ++r) sacc += A0[r] + A1[r];
      l += sacc;
      pw0 = (u32x4){PKW(A0, 0), PKW(A0, 2), PKW(A0, 4), PKW(A0, 6)}; pw1 = (u32x4){PKW(A0, 8), PKW(A0, 10), PKW(A0, 12), PKW(A0, 14)};
      pw2 = (u32x4){PKW(A1, 0), PKW(A1, 2), PKW(A1, 4), PKW(A1, 6)}; pw3 = (u32x4){PKW(A1, 8), PKW(A1, 10), PKW(A1, 12), PKW(A1, 14)};
      const LAS unsigned char* vp_ = vp0 + vprev;
#pragma unroll
      for (int i = 0; i < 8; ++i) VRD(i);
      o0 = __builtin_amdgcn_mfma_f32_32x32x16_bf16(VFR(0), PAF(0), o0, 0, 0, 0); o1 = __builtin_amdgcn_mfma_f32_32x32x16_bf16(VFR(4), PAF(0), o1, 0, 0, 0);
      o0 = __builtin_amdgcn_mfma_f32_32x32x16_bf16(VFR(1), PAF(1), o0, 0, 0, 0); o1 = __builtin_amdgcn_mfma_f32_32x32x16_bf16(VFR(5), PAF(1), o1, 0, 0, 0);
      o0 = __builtin_amdgcn_mfma_f32_32x32x16_bf16(VFR(2), PAF(2), o0, 0, 0, 0); o1 = __builtin_amdgcn_mfma_f32_32x32x16_bf16(VFR(6), PAF(2), o1, 0, 0, 0);
      o0 = __builtin_amdgcn_mfma_f32_32x32x16_bf16(VFR(3), PAF(3), o0, 0, 0, 0); o1 = __builtin_amdgcn_mfma_f32_32x32x16_bf16(VFR(7), PAF(3), o1, 0, 0, 0); }
    wait_bar_n<0>();
    R.m = m; R.l = l; R.o[0] = o0; R.o[1] = o1;
    __builtin_amdgcn_s_setprio(0);
#undef TILE
#undef KLOAD
#undef ROWMAX
#undef DECIDE
#undef PKW
#undef VRD
#undef VFR
#undef PAF
#undef QKM
#undef GAPA
#undef GAPB
#undef PHASE_A
#undef KRD
#undef PHASE_B
#undef STEP
}
#undef SBAR
#undef PIN
#undef MX3
}
constexpr int MLA_STG_OFF = 98304;
__device__ __forceinline__ void p3_mla(const Ptrs& P, LAS unsigned char* lds, int vcu, int G, int tid, int wid) {
    using namespace att;
    for (int L = vcu; L < 2048; L += G) {
        int lane_u = tid & 63; asm volatile("" : "+v"(lane_u));
        const int lane = lane_u, r32 = lane & 31, hi = lane >> 5;
        int bh, qb;
        if (G == 256) { const int i = L >> 8, s8 = vcu & 7; bh = (vcu >> 3) + 32 * (i >> 1); qb = (i & 1) ? 15 - s8 : s8; }
        else { bh = L >> 4; qb = L & 15; }
        const int b = bh >> 3, h = bh & 7; const size_t rowb = (size_t)b * SEQ;
        const int q0 = qb * 256 + wid * 32, t = q0 + r32; const size_t row = rowb + t;
        bf16x8 qr[6];
#pragma unroll
        for (int d0 = 0; d0 < 6; ++d0) qr[d0] = *(const bf16x8*)(P.QM + row * 768 + h * 96 + d0 * 16 + hi * 8);
        SrcMLA src; src.init(P.KVM, P.kpe, rowb, h, wid, lane);
        Row R; row_reset(R);
        auto fix = [&](f32x16& p0, f32x16& p1, int tile) {
            if (tile * 64 + 63 > q0) {
                const int kb = tile * 64 + 4 * hi;
#pragma unroll
                for (int r = 0; r < 16; ++r) { const int kv = kb + (r & 3) + 8 * (r >> 2); if (kv > t) p0[r] = NEG_INF; if (kv + 32 > t) p1[r] = NEG_INF; } } };
        run_pipe(lds, src, 0, 4 * qb + 4, qr, R, fix, 0.f, 0x7fffffff, wid, lane);
        const float inv = 1.0f / swap_sum(R.l); float ss = 0.f;
        { bf16* const ob = P.ATT + (rowb + q0) * 1024 + h * 64;
          store_rows(lds + MLA_STG_OFF + wid * 4608, R.o[0], R.o[1], inv, ss, lane, [&](int r) -> bf16* { return ob + (size_t)r * 1024; }); }
        ss = swap_sum(ss);
        if (hi == 0) P.ssatt[row * 16 + h] = ss;
    }
}

constexpr int NSA_LB_OFF = 81920;
constexpr int NSA_OUT_OFF = 86016;
__device__ __forceinline__ float dpp_xor1(float x) { return __builtin_bit_cast(float, __builtin_amdgcn_update_dpp(0, __builtin_bit_cast(int, x), 0xB1, 0xF, 0xF, false)); }
__device__ __forceinline__ float dpp_xor2(float x) { return __builtin_bit_cast(float, __builtin_amdgcn_update_dpp(0, __builtin_bit_cast(int, x), 0x4E, 0xF, 0xF, false)); }
__device__ __forceinline__ unsigned dpp_xor1u(unsigned x) { return (unsigned)__builtin_amdgcn_update_dpp(0, (int)x, 0xB1, 0xF, 0xF, false); }
__device__ __forceinline__ unsigned dpp_xor2u(unsigned x) { return (unsigned)__builtin_amdgcn_update_dpp(0, (int)x, 0x4E, 0xF, 0xF, false); }
template <int STEP, int YOFF> __device__ __forceinline__ void add_bias(att::f32x16& p, const LAS float* lb, int D) {
#pragma unroll
    for (int r = 0; r < 16; ++r) { int d = D - STEP * ((r & 3) + 8 * (r >> 2) + YOFF); d = d < 0 ? 0 : (d > 127 ? 127 : d); p[r] += lb[d]; }
}
__device__ __forceinline__ void p3_nsa(const Ptrs& P, LAS unsigned char* lds, int vcu, int G, int tid, int wid) {
    using namespace att;
    LAS float* LB = (LAS float*)(lds + NSA_LB_OFF);
    for (int e = tid; e < 1024; e += NTHR) LB[e] = P.bias[e];
    __syncthreads();
    for (int L = vcu; L < 2048; L += G) {
        int bhk, c;
        if (G == 256) { const int i = L >> 8, sub = vcu & 7; bhk = vcu >> 3; const int base = 16 * (i >> 1); c = (i & 1) ? base + 15 - sub : base + sub; }
        else { bhk = L >> 6; c = L & 63; }
        int lane_u = tid & 63; asm volatile("" : "+v"(lane_u));
        const int lane = lane_u, r32 = lane & 31, hi = lane >> 5, ql = r32 >> 2, g = r32 & 3;
        const int b = bhk >> 1, hk = bhk & 1, hq = hk * 4 + g; const size_t rowb = (size_t)b * SEQ;
        const int t = c * 64 + wid * 8 + ql; const size_t row = rowb + t;
        const LAS float* lb = LB + hq * 128; const float b31 = lb[127];
        bf16x8 qr[4];
#pragma unroll
        for (int d0 = 0; d0 < 4; ++d0) qr[d0] = *(const bf16x8*)(P.U + row * DINP + C_QN + hq * 64 + d0 * 16 + hi * 8);
        float gate[3];
#pragma unroll
        for (int br = 0; br < 3; ++br) { const float x = bf2f(P.U[row * DINP + C_GATE + hq * 3 + br]); gate[br] = __builtin_amdgcn_rcpf(1.0f + __builtin_amdgcn_exp2f(-x * LOG2E)); }
        LAS float* outp = (LAS float*)(lds + NSA_OUT_OFF) + wid * 2048 + lane;
        unsigned mlo, mhi;
        {
            const int nv = t >= 31 ? ((t - 31) >> 4) + 1 : 0;
            int ln = lane_u; asm volatile("" : "+v"(ln));
            SrcCmp src; src.init(P.kcmp + (size_t)bhk * 256 * 64, P.vcmp + (size_t)bhk * 256 * 64, P.ovt, wid, ln);
            RowT<2> R; row_reset(R);
            auto fix = [&](f32x16& p0, f32x16& p1, int tile) {
                const int D = t - 31 - 16 * (64 * tile + 4 * hi);
                add_bias<16, 0>(p0, lb, D); add_bias<16, 32>(p1, lb, D);
                const int ib = 64 * tile + 4 * hi;
#pragma unroll
                for (int r = 0; r < 16; ++r) { const int i = ib + (r & 3) + 8 * (r >> 2); if (i >= nv) p0[r] = NEG_INF; if (i + 32 >= nv) p1[r] = NEG_INF; } };
            auto skip = [&](int) -> bool { return false; };
            run_tiles(lds, src, 0, (4 * c + 3 + 63) >> 6, qr, R, fix, skip, wid, lane);
            const float lt = swap_sum(R.l); const float inv = lt > 0.f ? 1.0f / lt : 0.f;
            { const float f = gate[0] * inv;
#pragma unroll
              for (int i = 0; i < 16; ++i) { outp[64 * i] = R.o[0][i] * f; outp[64 * (16 + i)] = R.o[1][i] * f; } }
            mlo = 0u; mhi = 0u;
            if (c <= 15) { const unsigned long long mk = (2ull << c) - 1ull; mlo = (unsigned)mk; mhi = (unsigned)(mk >> 32); }
            else {
                float cand[8];
#pragma unroll
                for (int rr = 0; rr < 8; ++rr) {
                    float v00 = R.o[2][rr] * inv, v01 = R.o[2][8 + rr] * inv, v10 = R.o[3][rr] * inv, v11 = R.o[3][8 + rr] * inv;
                    v00 += dpp_xor1(v00); v00 += dpp_xor2(v00); v01 += dpp_xor1(v01); v01 += dpp_xor2(v01); v10 += dpp_xor1(v10); v10 += dpp_xor2(v10); v11 += dpp_xor1(v11); v11 += dpp_xor2(v11);
                    cand[rr] = (g & 2) ? ((g & 1) ? v11 : v10) : ((g & 1) ? v01 : v00); }
                unsigned key[8];
#pragma unroll
                for (int rr = 0; rr < 8; ++rr) { const int j = 32 * (g >> 1) + (rr & 3) + 8 * (2 * (g & 1) + (rr >> 2)) + 4 * hi;
                    const bool ok = j >= 1 && j <= c - 2; key[rr] = ok ? ((__float_as_uint(fmaxf(cand[rr], 0.f)) & ~63u) | (unsigned)(63 - j)) : 0u; }
                unsigned long long mk = 1ull | (1ull << c) | (1ull << (c - 1));
                for (int round = 0; round < 13; ++round) {
                    unsigned best = key[0];
#pragma unroll
                    for (int rr = 1; rr < 8; ++rr) best = best > key[rr] ? best : key[rr];
                    { const unsigned o1 = dpp_xor1u(best); best = best > o1 ? best : o1; const unsigned o2 = dpp_xor2u(best); best = best > o2 ? best : o2;
                      auto rr2 = __builtin_amdgcn_permlane32_swap(best, best, false, false); best = rr2[0] > rr2[1] ? rr2[0] : rr2[1]; }
                    if (best != 0u) mk |= 1ull << (63u - (best & 63u));
#pragma unroll
                    for (int rr = 0; rr < 8; ++rr) key[rr] = (key[rr] == best) ? 0u : key[rr];
                }
                mlo = (unsigned)mk; mhi = (unsigned)(mk >> 32);
            }
        }
        {
            int ln = lane_u; asm volatile("" : "+v"(ln));
            SrcRows src; src.init(P.U + rowb * DINP + C_KVS + hk * 64, P.U + rowb * DINP + C_KVS + 128 + hk * 64, DINP, wid, ln);
            Row R; row_reset(R);
            auto fix = [&](f32x16& p0, f32x16& p1, int tile) {
                if (tile >= c - 2) { const int D = t - 64 * tile - 4 * hi; add_bias<1, 0>(p0, lb, D); asm volatile("" ::: "memory"); add_bias<1, 32>(p1, lb, D); }
                const bool sel = ((tile < 32 ? (mlo >> tile) : (mhi >> (tile - 32))) & 1u) != 0u;
                if (tile == c) { const int kb = tile * 64 + 4 * hi;
#pragma unroll
                    for (int r = 0; r < 16; ++r) { const int kv = kb + (r & 3) + 8 * (r >> 2); if (kv > t || !sel) p0[r] = NEG_INF; if (kv + 32 > t || !sel) p1[r] = NEG_INF; } }
                else if (!sel) {
#pragma unroll
                    for (int r = 0; r < 16; ++r) { p0[r] = NEG_INF; p1[r] = NEG_INF; } } };
            run_pipe(lds, src, 0, c + 1, qr, R, fix, b31, c - 2, wid, lane);
            const float f = gate[1] / swap_sum(R.l);
#pragma unroll
            for (int i = 0; i < 16; ++i) { outp[64 * i] += R.o[0][i] * f; outp[64 * (16 + i)] += R.o[1][i] * f; }
        }
        f32x16 out[2];
        {
            int ln = lane_u; asm volatile("" : "+v"(ln));
            SrcRows src; src.init(P.U + rowb * DINP + C_KVW + hk * 64, P.U + rowb * DINP + C_KVW + 128 + hk * 64, DINP, wid, ln);
            Row R; row_reset(R);
            auto fix = [&](f32x16& p0, f32x16& p1, int tile) {
                if (tile >= c - 2) { const int D = t - 64 * tile - 4 * hi; add_bias<1, 0>(p0, lb, D); asm volatile("" ::: "memory"); add_bias<1, 32>(p1, lb, D); }
                if (tile == c || tile == c - 8) { const int kb = tile * 64 + 4 * hi;
#pragma unroll
                    for (int r = 0; r < 16; ++r) { const int kv = kb + (r & 3) + 8 * (r >> 2); const int d0_ = t - kv, d1_ = d0_ - 32;
                        if (d0_ < 0 || d0_ >= 512) p0[r] = NEG_INF; if (d1_ < 0 || d1_ >= 512) p1[r] = NEG_INF; } } };
            run_pipe(lds, src, c >= 8 ? c - 8 : 0, c + 1, qr, R, fix, b31, c - 2, wid, lane);
            const float f = gate[2] / swap_sum(R.l);
#pragma unroll
            for (int i = 0; i < 16; ++i) { out[0][i] = outp[64 * i] + R.o[0][i] * f; out[1][i] = outp[64 * (16 + i)] + R.o[1][i] * f; }
        }
        { float ss = 0.f; bf16* const ob = P.ATT + (rowb + c * 64 + wid * 8) * 1024 + 512 + hk * 256;
            store_rows(lds + NSA_OUT_OFF + wid * 8192, out[0], out[1], 1.0f, ss, lane, [&](int r) -> bf16* { return ob + (size_t)(r >> 2) * 1024 + (r & 3) * 64; });
            ss = swap_sum(ss);
            if (hi == 0) P.ssatt[row * 16 + 8 + hq] = ss; }
    }
}

__global__ void __launch_bounds__(NTHR, 2) mega_fwd(Args args) {
    extern __shared__ __attribute__((aligned(16))) unsigned char lds_raw[];
    LAS unsigned char* lds = (LAS unsigned char*)lds_raw;
    volatile LAS unsigned* MISC = (volatile LAS unsigned*)(lds + MISC_OFF);
    const int tid0 = threadIdx.x;
#define LAUNDER_TID() int tid = tid0; asm volatile("" : "+v"(tid)); const int lane = tid & 63, wave = __builtin_amdgcn_readfirstlane(tid >> 6); (void)lane; (void)wave
    const int G = gridDim.x, wg = blockIdx.x;
    const int vcu = (G % 8 == 0) ? (wg % 8) * (G / 8) + wg / 8 : wg;
    unsigned char* ws = args.ws;
    Ptrs P;
#pragma unroll
    for (int i = 0; i < 22; ++i) P.in[i] = args.in[i];
    P.out = args.out; P.ws = ws;
    P.Win = (bf16*)(ws + WS_WIN); P.Wuq = (bf16*)(ws + WS_WUQ); P.Wukv = (bf16*)(ws + WS_WUKV); P.Wout = (bf16*)(ws + WS_WOUT); P.Wgu = (bf16*)(ws + WS_WGU); P.Wdn = (bf16*)(ws + WS_WDN);
    P.rope = (f32x2v*)(ws + WS_ROPE); P.bias = (float*)(ws + WS_BIAS); P.bias1 = (float*)(ws + WS_BIAS1); P.rstdx = (float*)(ws + WS_RSTDX);
    P.ssqkv = (float*)(ws + WS_SSQKV); P.ssatt = (float*)(ws + WS_SSATT); P.ssh = (float*)(ws + WS_SSH);
    P.kcmp = (bf16*)(ws + WS_KCMP); P.vcmp = (bf16*)(ws + WS_VCMP); P.kpe = (bf16*)(ws + WS_KPE); P.ovt = (bf16*)(ws + WS_OVT); P.W1c = (bf16*)(ws + WS_W1C); P.W2t = (bf16*)(ws + WS_W2T);
    P.XB = (bf16*)(ws + WS_XB); P.U = (bf16*)(ws + WS_U); P.QM = (bf16*)(ws + WS_QM); P.KVM = (bf16*)(ws + WS_KVM); P.ATT = (bf16*)(ws + WS_ATT); P.H = (bf16*)(ws + WS_H); P.HID = (bf16*)(ws + WS_HID);
    gu32* ctl = (gu32*)(ws + WS_CTL);

    if (tid0 < 64) MISC[tid0] = 0u;
    __syncthreads();
    XcdBarrier bar; bar.bar = (unsigned*)(ctl + CW_BAR); bar.x = 0; bar.st = nullptr;
    if (N_LAUNCHES == 1) bar = xcd_barrier_post((unsigned*)(ctl + CW_BAR), MISC + 8);
#define GRID_BAR() do { if (N_LAUNCHES == 1) xcd_barrier(bar); } while (0)
    const int lo = args.ph_lo, hi = args.ph_hi;
#ifndef PHASE_MASK
#define PHASE_MASK 0xff
#endif
#define IN(k) (((PHASE_MASK >> (k)) & 1) && lo <= (k) && (k) < hi)
#define BOTH(k) (IN(k) && IN((k) + 1))
#ifndef REPEAT_MASK
#define REPEAT_MASK 0
#endif
#define REP(k) for (int rep_ = 0; rep_ < (((REPEAT_MASK >> (k)) & 1) ? 2 : 1); ++rep_)

    if (IN(0)) { REP(0) { LAUNDER_TID(); p0_prologue(P, lds, wg, G, wave, lane, tid); } if (BOTH(0)) GRID_BAR(); }

    if (IN(1)) {
        REP(1) {
        pg8::Gemm g{P.XB, P.Win, MT, DINP, 1024, 1024, 1024, 0}; pg8::StaticOrder S; S.init(MT, DINP, G, wg);
        EpiInProj E{P.U, P.rstdx, P.ssqkv};
        pg8::gemm_phase<EpiInProj, pg8::StaticOrder, true, true>(lds, g, S, E); }
        if (BOTH(1)) GRID_BAR();
    }

    if (IN(2)) {
        REP(2) {
        { LAUNDER_TID(); p2_kpe(P, wg, G, tid); }
        { pg8::Gemm g{P.U, P.W1c, 64 * 256, 256, 1024, 16 * DINP, 1024, DINP * 2}; CmpOrder S{G, wg, P.U, P.W1c};
          EpiCmp E{P.bias1, P.W2t, P.kcmp, P.vcmp};
          pg8::gemm_phase<EpiCmp, CmpOrder, false, true>(lds, g, S, E); }
        { const int gq = G > 64 ? G - 64 : G, cq = G > 64 ? wg - 64 : wg;
          if (cq >= 0) { pg8::Gemm g{P.U + C_CQ, P.Wuq, MT, 768, 256, DINP, 256, 0}; pg8::StaticOrder S; S.init(MT, 768, gq, cq);
            EpiQup E{P.QM, P.ssqkv, P.rope};
            pg8::gemm_phase<EpiQup, pg8::StaticOrder, true, true>(lds, g, S, E); } }
        { pg8::Gemm g{P.U + C_CKV, P.Wukv, MT, 1024, 128, DINP, 256, 0}; pg8::StaticOrder S; S.init(MT, 1024, G, wg);
          EpiKVup E{P.KVM, P.ssqkv};
          pg8::gemm_phase<EpiKVup, pg8::StaticOrder, true, true>(lds, g, S, E); }
        }
        if (BOTH(2)) GRID_BAR();
    }

    if (IN(3)) {
        REP(3) {
        REP(8) { LAUNDER_TID(); p3_mla(P, lds, vcu, G, tid, wave); }
        REP(9) { LAUNDER_TID(); p3_nsa(P, lds, vcu, G, tid, wave); }
        }
        if (BOTH(3)) GRID_BAR();
    }

    if (IN(4)) {
        REP(4) {
        { pg8::Gemm g{P.ATT, P.Wout, MT, 1024, 1024, 1024, 1024, 0}; OutOrder S; S.init(MT, 1024, G, wg); S.ssatt = P.ssatt; S.tab = (LAS float*)(lds + OUT_TAB_OFF);
          EpiOut E{P.XB, P.H, P.ssh, (const LAS float*)(lds + OUT_TAB_OFF)};
          pg8::gemm_phase<EpiOut, OutOrder, true, true>(lds, g, S, E); }
        }
        if (BOTH(4)) GRID_BAR();
    }

    if (IN(5)) {
        REP(5) {
        pg8::Gemm g{P.H, P.Wgu, MT, NGU, 1024, 1024, 1024, 0}; GUOrder S; S.init(MT, NGU, G, wg); S.ssh = P.ssh; S.tab = (LAS float*)(lds + OUT_TAB_OFF);
        EpiGU E{P.HID, (const LAS float*)(lds + OUT_TAB_OFF)};
        pg8::gemm_phase<EpiGU, GUOrder, true, true>(lds, g, S, E); }
        if (BOTH(5)) GRID_BAR();
    }

    if (IN(6)) {
        REP(6) {
        pg8::Gemm g{P.HID, P.Wdn, MT, 1024, DFF, DFF, DFF, 0}; pg8::StaticOrder S; S.init(MT, 1024, G, wg);
        EpiDown E{P.H, P.ATT, P.ssatt};
        pg8::gemm_phase<EpiDown, pg8::StaticOrder, true, true>(lds, g, S, E); }
        if (BOTH(6)) GRID_BAR();
    }

    if (IN(7)) { LAUNDER_TID(); p7_final(P, wg, G, wave, lane); }
#undef IN
#undef BOTH
#undef GRID_BAR
}

extern "C" void kernel_launch(void* const* d_in, const int* in_sizes, int n_in, void* d_out, int out_size, void* d_ws, size_t ws_size, hipStream_t stream) {
    static int grid = 0;
    if (grid == 0) {
        if (n_in != 22 || in_sizes[0] != MT * DM || out_size != MT * DM || ws_size < WS_END) { fprintf(stderr, "kernel_launch: unexpected shapes (n_in %d, in0 %d, out %d, ws %zu); nothing launched\n", n_in, n_in > 0 ? in_sizes[0] : -1, out_size, ws_size); grid = -1; return; }
        int dev = 0, cus = 0, per_cu = 0;
        if (hipGetDevice(&dev) != hipSuccess || hipDeviceGetAttribute(&cus, hipDeviceAttributeMultiprocessorCount, dev) != hipSuccess) { fprintf(stderr, "kernel_launch: device query failed\n"); grid = -1; return; }
        if (hipFuncSetAttribute((const void*)mega_fwd, hipFuncAttributeMaxDynamicSharedMemorySize, LDS_BYTES) != hipSuccess) { fprintf(stderr, "kernel_launch: hipFuncSetAttribute failed\n"); grid = -1; return; }
        if (hipOccupancyMaxActiveBlocksPerMultiprocessor(&per_cu, (const void*)mega_fwd, NTHR, LDS_BYTES) != hipSuccess || per_cu < 1)
            fprintf(stderr, "kernel_launch: note: occupancy query reports %d workgroups per CU\n", per_cu);
        (void)hipGetLastError();
        grid = cus;
    }
    if (grid < 0) return;
    if (hipMemsetAsync((char*)d_ws + WS_CTL, 0, CTL_ZERO_BYTES, stream) != hipSuccess) { fprintf(stderr, "kernel_launch: memset failed\n"); return; }
    Args a{};
    for (int i = 0; i < 22; ++i) a.in[i] = (const float*)d_in[i];
    a.out = (float*)d_out; a.ws = (unsigned char*)d_ws;
    for (int li = 0; li < N_LAUNCHES; ++li) {
        a.ph_lo = (N_LAUNCHES == 1) ? 0 : li; a.ph_hi = (N_LAUNCHES == 1) ? NPHASE : li + 1; a.li = li; a.pad = 0;
        hipLaunchKernelGGL(mega_fwd, dim3(grid), dim3(NTHR), LDS_BYTES, stream, a);
        const hipError_t le = hipPeekAtLastError();
        if (le != hipSuccess) { fprintf(stderr, "kernel_launch: launch %d failed: %s\n", li, hipGetErrorName(le)); break; }
    }
}
```

```cpp
#include <hip/hip_runtime.h>
#include <cstdio>
#include <cstdint>
namespace pg8 {
#define PG8_LAS __attribute__((address_space(3)))
typedef unsigned short bf16_t;
typedef short bf16x8 __attribute__((ext_vector_type(8)));
typedef float f32x4 __attribute__((ext_vector_type(4)));
typedef unsigned u32x4 __attribute__((ext_vector_type(4)));
constexpr int BM = 256, BK = 64, HALF = 128, HTB = HALF * BK * 2  , STAGE_BYTES = 8 * HTB, NXCD = 8, WGM = 8;

__host__ __device__ __forceinline__ int lds_byte(int r, int c) { const int st = (r >> 4) * 2 + (c >> 5), rr = r & 15, cc = c & 31, ob = rr * 64 + cc * 2; return st * 1024 + (ob ^ (((ob >> 9) & 1) << 5)); }
__host__ __device__ __forceinline__ void stage_rc(int b, int& R, int& C) { const int st = b / 1024, sb = b % 1024, swz = sb ^ (((sb >> 9) & 1) << 5); R = (st >> 1) * 16 + swz / 64; C = (st & 1) * 32 + (swz % 64) / 2; }
__host__ __device__ __forceinline__ int perm32(int rho) { const int n = rho >> 4, i = rho & 15; return 8 * (i >> 2) + 4 * n + (i & 3); }

struct Unit { int pm, pn, ui; };
struct Gemm { const bf16_t* A; const bf16_t* Bt; int M, N, K, lda, ldb, kstepA; };

struct StaticOrder {
    int nM, nN, nwg, G, c;
    __host__ __device__ void init(int M, int N, int G_, int c_) { nM = M / BM; nN = N / BM; nwg = nM * nN; G = G_; c = c_; }
    __host__ __device__ bool next(int i, Unit& u) const {
        const long L = (long)i * G + c; if (L >= nwg) return false;
        int wgid = (int)L; { const int q = nwg / NXCD, r = nwg % NXCD, xcd = wgid % NXCD, off = wgid / NXCD; wgid = (xcd < r ? xcd * (q + 1) : r * (q + 1) + (xcd - r) * q) + off; }
        const int nig = WGM * nN, gid = wgid / nig, fm = gid * WGM, gsz = (nM - fm) < WGM ? (nM - fm) : WGM;
        u.pm = fm + ((wgid % nig) % gsz); u.pn = (wgid % nig) / gsz; u.ui = i; return true;
    }
    __device__ __forceinline__ void a_ready(const Unit&) const {}
    __device__ __forceinline__ void done(const Unit&) const {}
    __device__ __forceinline__ const char* a_base(const Gemm& g, const Unit& u, size_t tstepA) const { return (const char*)g.A + (size_t)u.pm * tstepA; }
    __device__ __forceinline__ const char* b_base(const Gemm& g, const Unit& u, size_t tstepB) const { return (const char*)g.Bt + (size_t)u.pn * tstepB; }
};

__device__ __forceinline__ unsigned cvt_pk_bf16(float lo, float hi) { unsigned r; asm volatile("v_cvt_pk_bf16_f32 %0, %1, %2" : "=v"(r) : "v"(lo), "v"(hi)); return r; }
typedef float f32x2 __attribute__((ext_vector_type(2)));
template <class Epi, class Sched, bool ALIGN_EPI = false, bool SP2 = false>
__device__ __forceinline__ void gemm_phase(PG8_LAS unsigned char* lds, const Gemm g, const Sched& S, const Epi& E) {
    int tid_ = threadIdx.x; asm volatile("" : "+v"(tid_));
    const int tid = tid_, wid = __builtin_amdgcn_readfirstlane(tid >> 6), lane = tid & 63, wr = wid >> 2, wc = wid & 3, fr = lane & 15, fq = lane >> 4;
    const int K = g.K, nt = K / BK;
    unsigned voffA[2], voffB[2];
#pragma unroll
    for (int i = 0; i < 2; ++i) { int R, C; stage_rc(tid * 16 + i * 8192, R, C); const int Rb = Epi::PERM ? ((R & ~31) + perm32(R & 31)) : R;
        voffA[i] = (unsigned)(R * g.lda + C) * 2u; voffB[i] = (unsigned)(Rb * g.ldb + C) * 2u; }
    const size_t kstepA = g.kstepA ? (size_t)g.kstepA : (size_t)(BK * 2), kstepB = (size_t)(BK * 2);
    const size_t hstepA = (size_t)HALF * g.lda * 2, hstepB = (size_t)HALF * g.ldb * 2;
    const size_t tstepA = 2 * hstepA, tstepB = 2 * hstepB;
    const unsigned ldsw = (unsigned)wid * 1024u;
    const int aoff = lds_byte(wr * 64 + fr, fq * 8), boff = lds_byte(wc * 32 + fr, fq * 8);
#define PG8_SA(b, h) (((b) * 2 + (h)) * HTB)
#define PG8_SB(b, h) ((4 + (b) * 2 + (h)) * HTB)
#define PG8_STAGE(bufoff, gbase, voff) do { _Pragma("unroll") for (int _i = 0; _i < 2; ++_i) \
        __builtin_amdgcn_global_load_lds((const unsigned*)((const char*)(gbase) + (voff)[_i]), (PG8_LAS unsigned*)(lds + (bufoff) + ldsw + _i * 8192), 16, 0, 0); } while (0)
#define PG8_LDA(dst, b, h) do { _Pragma("unroll") for (int m = 0; m < 4; ++m) _Pragma("unroll") for (int k = 0; k < 2; ++k) dst[m][k] = *(const PG8_LAS bf16x8*)(lds + PG8_SA(b, h) + aoff + m * 2048 + k * 1024); } while (0)
#define PG8_LDB(dst, b, h) do { _Pragma("unroll") for (int n = 0; n < 2; ++n) _Pragma("unroll") for (int k = 0; k < 2; ++k) dst[n][k] = *(const PG8_LAS bf16x8*)(lds + PG8_SB(b, h) + boff + n * 2048 + k * 1024); } while (0)
#define PG8_MMA(ai, bj, At, Bt) do { __builtin_amdgcn_s_setprio(1); _Pragma("unroll") for (int m = 0; m < 4; ++m) _Pragma("unroll") for (int n = 0; n < 2; ++n) _Pragma("unroll") for (int k = 0; k < 2; ++k) \
        acc[ai][bj][m][n] = __builtin_amdgcn_mfma_f32_16x16x32_bf16(Bt[n][k], At[m][k], acc[ai][bj][m][n], 0, 0, 0); __builtin_amdgcn_s_setprio(0); } while (0)
#define PG8_WAIT_V(n) asm volatile("s_waitcnt vmcnt(" #n ")" ::: "memory")
#define PG8_WAIT_L(n) asm volatile("s_waitcnt lgkmcnt(" #n ")" ::: "memory")
#define PG8_BAR __builtin_amdgcn_s_barrier()
#define PG8_SCHED __builtin_amdgcn_sched_barrier(0)
    Unit cur, nxt; int ui = 0;
    if (!S.next(0, cur)) return;
    f32x4 acc[2][2][4][2];
#pragma unroll
    for (int a = 0; a < 2; ++a)
#pragma unroll
        for (int b = 0; b < 2; ++b)
#pragma unroll
            for (int m = 0; m < 4; ++m)
#pragma unroll
                for (int n = 0; n < 2; ++n) acc[a][b][m][n] = (f32x4){0.f, 0.f, 0.f, 0.f};
    bf16x8 At[4][2], B0[2][2], B1[2][2];
    const char* cA = S.a_base(g, cur, tstepA); const char* cB = S.b_base(g, cur, tstepB);
    S.a_ready(cur);
    if constexpr (SP2) {
        PG8_STAGE(PG8_SB(0, 0), cB, voffB); PG8_STAGE(PG8_SB(0, 1), cB + hstepB, voffB); PG8_STAGE(PG8_SA(0, 0), cA, voffA); PG8_STAGE(PG8_SA(0, 1), cA + hstepA, voffA);
        if (wr == 1) PG8_BAR;
        PG8_WAIT_V(2); PG8_BAR;
        PG8_STAGE(PG8_SB(1, 0), cB + kstepB, voffB); PG8_STAGE(PG8_SA(1, 0), cA + kstepA, voffA); PG8_STAGE(PG8_SB(1, 1), cB + hstepB + kstepB, voffB);
        PG8_WAIT_V(6); PG8_BAR;
    } else {
        PG8_STAGE(PG8_SB(0, 0), cB, voffB); PG8_STAGE(PG8_SA(0, 0), cA, voffA); PG8_STAGE(PG8_SB(0, 1), cB + hstepB, voffB); PG8_STAGE(PG8_SA(0, 1), cA + hstepA, voffA);
        if (wr == 1) PG8_BAR;
        PG8_WAIT_V(4); PG8_BAR;
        PG8_STAGE(PG8_SB(1, 0), cB + kstepB, voffB); PG8_STAGE(PG8_SA(1, 0), cA + kstepA, voffA); PG8_STAGE(PG8_SB(1, 1), cB + hstepB + kstepB, voffB);
        PG8_WAIT_V(6); PG8_BAR;
    }
    for (;;) {
        const bool has_next = S.next(ui + 1, nxt);
        const char* nA = has_next ? S.a_base(g, nxt, tstepA) : cA; const char* nB = has_next ? S.b_base(g, nxt, tstepB) : cB;
        for (int t = 0; t < nt; t += 2) {
            if constexpr (Epi::MIDK) { if (t == (nt >> 1)) E.midk(acc, cur, wr, fr); }
            const bool last = (t == nt - 2);
            const char* a1 = cA + (size_t)(t + 1) * kstepA;
            const char* a2 = last ? nA : cA + (size_t)(t + 2) * kstepA; const char* b2 = last ? nB : cB + (size_t)(t + 2) * kstepB;
            const char* a3 = a2 + kstepA; const char* b3 = b2 + kstepB;
            if (last && has_next) S.a_ready(nxt);
            if constexpr (SP2) {
            PG8_LDB(B0, 0, 0); PG8_LDB(B1, 0, 1); PG8_SCHED; PG8_LDA(At, 0, 0); PG8_STAGE(PG8_SA(1, 1), a1 + hstepA, voffA);
            PG8_WAIT_V(8); PG8_WAIT_L(0); PG8_BAR; PG8_MMA(0, 0, At, B0); PG8_MMA(0, 1, At, B1); PG8_BAR; PG8_SCHED;
            PG8_LDA(At, 0, 1); PG8_STAGE(PG8_SB(0, 0), b2, voffB); PG8_STAGE(PG8_SB(0, 1), b2 + hstepB, voffB); PG8_STAGE(PG8_SA(0, 0), a2, voffA);
            PG8_WAIT_V(8); PG8_WAIT_L(0); PG8_BAR; PG8_MMA(1, 0, At, B0); PG8_MMA(1, 1, At, B1); PG8_BAR; PG8_SCHED;
            PG8_LDB(B0, 1, 0); PG8_LDB(B1, 1, 1); PG8_SCHED; PG8_LDA(At, 1, 0); PG8_STAGE(PG8_SA(0, 1), a2 + hstepA, voffA);
            PG8_WAIT_V(8); PG8_WAIT_L(0); PG8_BAR; PG8_MMA(0, 0, At, B0); PG8_MMA(0, 1, At, B1); PG8_BAR; PG8_SCHED;
            PG8_LDA(At, 1, 1); PG8_STAGE(PG8_SB(1, 0), b3, voffB); PG8_STAGE(PG8_SB(1, 1), b3 + hstepB, voffB); PG8_STAGE(PG8_SA(1, 0), a3, voffA);
            PG8_WAIT_V(8); PG8_WAIT_L(0); PG8_BAR; PG8_MMA(1, 0, At, B0); PG8_MMA(1, 1, At, B1); PG8_BAR; PG8_SCHED;
            } else {
            PG8_LDB(B0, 0, 0); PG8_SCHED; PG8_LDA(At, 0, 0); PG8_STAGE(PG8_SA(1, 1), a1 + hstepA, voffA);
            PG8_WAIT_L(8); PG8_BAR; PG8_WAIT_L(0); PG8_MMA(0, 0, At, B0); PG8_BAR; PG8_SCHED;
            PG8_LDB(B1, 0, 1); PG8_STAGE(PG8_SB(0, 0), b2, voffB);
            PG8_BAR; PG8_WAIT_L(0); PG8_MMA(0, 1, At, B1); PG8_BAR;
            PG8_LDA(At, 0, 1); PG8_STAGE(PG8_SA(0, 0), a2, voffA);
            PG8_BAR; PG8_WAIT_L(0); PG8_MMA(1, 0, At, B0); PG8_BAR; PG8_SCHED;
            PG8_STAGE(PG8_SB(0, 1), b2 + hstepB, voffB);
            PG8_WAIT_V(6); PG8_BAR; PG8_MMA(1, 1, At, B1); PG8_BAR;
            PG8_LDB(B0, 1, 0); PG8_SCHED; PG8_LDA(At, 1, 0); PG8_STAGE(PG8_SA(0, 1), a2 + hstepA, voffA);
            PG8_WAIT_L(8); PG8_BAR; PG8_WAIT_L(0); PG8_MMA(0, 0, At, B0); PG8_BAR; PG8_SCHED;
            PG8_LDB(B1, 1, 1); PG8_STAGE(PG8_SB(1, 0), b3, voffB);
            PG8_BAR; PG8_WAIT_L(0); PG8_MMA(0, 1, At, B1); PG8_BAR;
            PG8_LDA(At, 1, 1); PG8_STAGE(PG8_SA(1, 0), a3, voffA);
            PG8_BAR; PG8_WAIT_L(0); PG8_MMA(1, 0, At, B0); PG8_BAR; PG8_SCHED;
            PG8_STAGE(PG8_SB(1, 1), b3 + hstepB, voffB);
            PG8_WAIT_V(6); PG8_BAR; PG8_MMA(1, 1, At, B1); PG8_BAR;
            }
        }
        if constexpr (ALIGN_EPI) { if (wr == 0) PG8_BAR; }
        if constexpr (!Epi::AFTER_DRAIN) { E(acc, cur, wr, wc, fr, fq); S.done(cur); }
        if (!has_next) break;
#pragma unroll
        for (int a = 0; a < 2; ++a)
#pragma unroll
            for (int b = 0; b < 2; ++b)
#pragma unroll
                for (int m = 0; m < 4; ++m)
#pragma unroll
                    for (int n = 0; n < 2; ++n) acc[a][b][m][n] = (f32x4){0.f, 0.f, 0.f, 0.f};
        cur = nxt; cA = nA; cB = nB; ++ui;
        if constexpr (ALIGN_EPI) { if (wr == 1) PG8_BAR; }
    }
    PG8_WAIT_V(0);
    if constexpr (!ALIGN_EPI) { if (wr == 0) PG8_BAR; }
    PG8_BAR;
    if constexpr (Epi::AFTER_DRAIN) { E.fused(acc, cur, wr, wc, fr, fq, lds, wid, lane); S.done(cur); }
#undef PG8_SA
#undef PG8_SB
#undef PG8_STAGE
#undef PG8_LDA
#undef PG8_LDB
#undef PG8_MMA
#undef PG8_WAIT_V
#undef PG8_WAIT_L
#undef PG8_BAR
#undef PG8_SCHED
}
}
#define GAS __attribute__((address_space(1)))
#define LAS __attribute__((address_space(3)))
typedef unsigned short bf16;
typedef unsigned v4u __attribute__((ext_vector_type(4)));
typedef float f32x4 __attribute__((ext_vector_type(4)));
typedef short bf16x8 __attribute__((ext_vector_type(8)));
typedef GAS unsigned gu32;
typedef GAS unsigned long long gu64;
#define RLX_AGENT __ATOMIC_RELAXED, __HIP_MEMORY_SCOPE_AGENT
#define LDS_WAIT() asm volatile("s_waitcnt lgkmcnt(0)" ::: "memory")
#define VM_WAIT() asm volatile("s_waitcnt vmcnt(0)" ::: "memory")
__device__ __forceinline__ unsigned long long rt() { return __builtin_amdgcn_s_memrealtime(); }
__device__ __forceinline__ unsigned f2bf(float f) { unsigned u = __builtin_bit_cast(unsigned, f); return (u + 0x7fffu + ((u >> 16) & 1u)) >> 16; }
__device__ __forceinline__ unsigned pk2(float lo, float hi) { return pg8::cvt_pk_bf16(lo, hi); }

#define XB_TMO      128
#define XB_XCNT(j)  (256  + 64 * (j))
#define XB_XSUB(j)  (1280 + 64 * (j))
#define XB_XGEN(j)  (2304 + 64 * (j))
#define XB_TOP      3328
#define XB_TOPGEN   3392
#define XCD_BAR_WORDS 3456
#define XB_SPIN_CAP (1u << 18)

__device__ __forceinline__ unsigned xb_ld(unsigned* p)              { return __hip_atomic_load(p, __ATOMIC_RELAXED, __HIP_MEMORY_SCOPE_AGENT); }
__device__ __forceinline__ unsigned xb_add(unsigned* p, unsigned v) { return __hip_atomic_fetch_add(p, v, __ATOMIC_RELAXED, __HIP_MEMORY_SCOPE_AGENT); }
__device__ __forceinline__ unsigned xb_xcc_id() { return (unsigned)__builtin_amdgcn_s_getreg((3 << 11) | 20) & 0xFu; }
#define XB_SPIN(cond, bar) do { unsigned _sp = 0; while (cond) { __builtin_amdgcn_s_sleep(1); \
    if ((++_sp & 255u) == 0u) { if (xb_ld(&(bar)[XB_TMO])) break; if (_sp > XB_SPIN_CAP) { atomicAdd(&(bar)[XB_TMO], 1u); break; } } } } while (0)

struct XcdBarrier {
    unsigned* bar; unsigned x;
    volatile LAS unsigned* st;
};

__device__ __forceinline__ XcdBarrier xcd_barrier_post(unsigned* bar, volatile LAS unsigned* st) {
    XcdBarrier b; b.bar = bar; b.x = xb_xcc_id(); b.st = st;
    if (threadIdx.x == 0) (void)xb_add(&bar[XB_XCNT(b.x)], 1u);
    return b;
}
__device__ __forceinline__ void xcd_barrier_complete(unsigned* bar, unsigned x, unsigned& nloc, unsigned& nx) {
    const unsigned G = gridDim.x * gridDim.y * gridDim.z;
    unsigned sum, cnt, mine, sp = 0u;
    for (;;) {
        sum = 0u; cnt = 0u; mine = 0u;
#pragma unroll
        for (unsigned j = 0; j < 16; ++j) { const unsigned c = xb_ld(&bar[XB_XCNT(j)]); sum += c; cnt += (c > 0u) ? 1u : 0u; mine = (j == x) ? c : mine; }
        if (sum == G) break;
        __builtin_amdgcn_s_sleep(1);
        if ((++sp & 255u) == 0u) { if (xb_ld(&bar[XB_TMO])) break; if (sp > XB_SPIN_CAP) { atomicAdd(&bar[XB_TMO], 1u); break; } }
    }
    nloc = mine > 0u ? mine : 1u; nx = cnt > 0u ? cnt : 1u;
}

__device__ __forceinline__ void xcd_barrier(const XcdBarrier& b) {
    asm volatile("s_waitcnt vmcnt(0)" ::: "memory");
    __syncthreads();
    if (threadIdx.x == 0) {
        unsigned* bar = b.bar;
        __builtin_amdgcn_s_waitcnt(0);
        unsigned nloc = b.st[0], nx = b.st[1];
        if (nloc == 0u) { xcd_barrier_complete(bar, b.x, nloc, nx); b.st[0] = nloc; b.st[1] = nx; }
        const unsigned old = xb_add(&bar[XB_XSUB(b.x)], 1u);
        const unsigned gen = old / nloc;
        if (old + 1u == (gen + 1u) * nloc) {
            __builtin_amdgcn_fence(__ATOMIC_RELEASE, "agent");
            asm volatile("s_waitcnt vmcnt(0)" ::: "memory");
            const unsigned og = xb_add(&bar[XB_TOP], 1u);
            const unsigned tg = og / nx;
            if (og + 1u == (tg + 1u) * nx) xb_add(&bar[XB_TOPGEN], 1u);
            else XB_SPIN(xb_ld(&bar[XB_TOPGEN]) == tg, bar);
            __builtin_amdgcn_fence(__ATOMIC_ACQUIRE, "agent");
            xb_add(&bar[XB_XGEN(b.x)], 1u);
            asm volatile("s_waitcnt vmcnt(0)" ::: "memory");
        } else {
            XB_SPIN(xb_ld(&bar[XB_XGEN(b.x)]) == gen, bar);
            __builtin_amdgcn_fence(__ATOMIC_ACQUIRE, "agent");
            asm volatile("s_waitcnt vmcnt(0)" ::: "memory");
        }
    }
    __syncthreads();
}

constexpr int NB = 16, SEQ = 4096, DM = 1024, MT = NB * SEQ;
constexpr int DINP = 1792;
constexpr int C_CQ = 0, C_CKV = 256, C_KR = 384, C_QN = 416, C_KVC = 928, C_KVS = 1184, C_KVW = 1440, C_GATE = 1696, DIN = 1720;
constexpr int DFF = 2816, NGU = 2 * DFF;
constexpr int NCMP = 255;
constexpr float EPS = 1e-6f;
constexpr float LOG2E = 1.4426950408889634f;
constexpr float C2Q = 0.10206207261596575f * 1.4426950408889634f;
constexpr float C2N = 0.125f * 1.4426950408889634f;

constexpr int NWAVES = 8, NTHR = 512;
constexpr int NPHASE = 8;
#ifndef MK_N_LAUNCHES
#define MK_N_LAUNCHES 1
#endif
constexpr int N_LAUNCHES = MK_N_LAUNCHES;

constexpr size_t MiB = 1u << 20;
constexpr size_t WS_CTL = 0, CTL_ZERO_BYTES = 1 * MiB;
constexpr size_t WS_WIN = 2 * MiB, WS_WUQ = 6 * MiB, WS_WUKV = 7 * MiB, WS_WOUT = 8 * MiB, WS_WGU = 10 * MiB, WS_WDN = 21 * MiB;
constexpr size_t WS_ROPE = 27 * MiB, WS_BIAS = 27 * MiB + 512 * 1024, WS_BIAS1 = WS_BIAS + 8192;
constexpr size_t WS_RSTDX = 28 * MiB, WS_SSQKV = 29 * MiB, WS_SSATT = 31 * MiB, WS_SSH = 35 * MiB;
constexpr size_t WS_KCMP = 39 * MiB, WS_VCMP = 40 * MiB, WS_KPE = 41 * MiB, WS_OVT = 45 * MiB, WS_W1C = 46 * MiB, WS_W2T = 47 * MiB;
constexpr size_t WS_XB = 64 * MiB, WS_U = 192 * MiB, WS_QM = 420 * MiB, WS_KVM = 516 * MiB, WS_ATT = 644 * MiB, WS_H = 772 * MiB, WS_END = 900 * MiB;
constexpr size_t WS_HID = 64 * MiB;
static_assert(WS_U + (size_t)MT * DINP * 2 <= WS_QM && WS_HID + (size_t)MT * DFF * 2 <= WS_QM && WS_QM + (size_t)MT * 768 * 2 <= WS_KVM && WS_KVM + (size_t)MT * 1024 * 2 <= WS_ATT, "ws map");
constexpr int CW_TMO = 0, CW_BAR = 4096;

constexpr int LDS_BYTES = 163840;
constexpr int MISC_OFF = LDS_BYTES - 256;


typedef unsigned u32x4 __attribute__((ext_vector_type(4))); using pg8::Unit; using pg8::cvt_pk_bf16; using pg8::HALF; using pg8::BM;
typedef float f32x2v __attribute__((ext_vector_type(2)));
__device__ __forceinline__ float bf2f(unsigned short b) { return __builtin_bit_cast(float, (unsigned)b << 16); }
__device__ __forceinline__ float bflo(unsigned w) { return __builtin_bit_cast(float, w << 16); }
__device__ __forceinline__ float bfhi(unsigned w) { return __builtin_bit_cast(float, w & 0xffff0000u); }
__device__ __forceinline__ float sq4(const f32x4 v) { return (v[0] * v[0] + v[1] * v[1]) + (v[2] * v[2] + v[3] * v[3]); }

struct EpiInProj {
    static constexpr bool PERM = true, AFTER_DRAIN = false, MIDK = false;
    pg8::bf16_t* U; const float* rstd; float* ssq;
    __device__ __forceinline__ void operator()(const f32x4 (&acc)[2][2][4][2], const Unit& u, int wr, int wc, int fr, int fq) const {
        const int row0 = u.pm * BM + wr * 64 + fr, col0 = u.pn * BM + wc * 32 + 8 * fq;
#pragma unroll
        for (int ai = 0; ai < 2; ++ai)
#pragma unroll
            for (int m = 0; m < 4; ++m) {
                const int row = row0 + ai * HALF + m * 16; const float r = rstd[row];
                pg8::bf16_t* rowp = U + (size_t)row * DINP + col0; float s0 = 0.f, s1 = 0.f;
#pragma unroll
                for (int bj = 0; bj < 2; ++bj) { const f32x4 v0 = acc[ai][bj][m][0] * r, v1 = acc[ai][bj][m][1] * r;
                    u32x4 w; w.x = cvt_pk_bf16(v0[0], v0[1]); w.y = cvt_pk_bf16(v0[2], v0[3]); w.z = cvt_pk_bf16(v1[0], v1[1]); w.w = cvt_pk_bf16(v1[2], v1[3]);
                    *(u32x4*)(rowp + bj * HALF) = w;
                    const float s = sq4(v0) + sq4(v1); if (bj == 0) s0 = s; else s1 = s; }
                if (u.pn < 2) {
                    float s = (u.pn == 0) ? (s0 + s1) : s0;
                    s += __shfl_xor(s, 16); s += __shfl_xor(s, 32);
                    if (fq == 0) ssq[(size_t)row * 8 + (u.pn == 0 ? 0 : 4) + wc] = s;
                }
            }
    }
};
struct EpiQup {
    static constexpr bool PERM = true, AFTER_DRAIN = false, MIDK = false;
    pg8::bf16_t* Q; const float* ssq; const f32x2v* rope;
    __device__ __forceinline__ void operator()(const f32x4 (&acc)[2][2][4][2], const Unit& u, int wr, int wc, int fr, int fq) const {
        const int row0 = u.pm * BM + wr * 64 + fr, col0 = u.pn * BM + wc * 32 + 8 * fq;
#pragma unroll
        for (int ai = 0; ai < 2; ++ai)
#pragma unroll
            for (int m = 0; m < 4; ++m) {
                const int row = row0 + ai * HALF + m * 16; const int pos = row & (SEQ - 1);
                const f32x4 pp = *(const f32x4*)(ssq + (size_t)row * 8);
                const float r = __builtin_amdgcn_rsqf(((pp[0] + pp[1]) + (pp[2] + pp[3])) * (1.0f / 256.0f) + EPS) * C2Q;
#pragma unroll
                for (int bj = 0; bj < 2; ++bj) { const int c = col0 + bj * HALF; const int d = c % 96;
                    f32x4 v0 = acc[ai][bj][m][0] * r, v1 = acc[ai][bj][m][1] * r;
                    if (d >= 64) { const int i0 = (d - 64) >> 1; const f32x2v* rp = rope + pos * 16 + i0;
                        const f32x2v a = rp[0], b = rp[1], e = rp[2], f = rp[3];
                        f32x4 w0, w1;
                        w0[0] = v0[0] * a.x - v0[1] * a.y; w0[1] = v0[0] * a.y + v0[1] * a.x;
                        w0[2] = v0[2] * b.x - v0[3] * b.y; w0[3] = v0[2] * b.y + v0[3] * b.x;
                        w1[0] = v1[0] * e.x - v1[1] * e.y; w1[1] = v1[0] * e.y + v1[1] * e.x;
                        w1[2] = v1[2] * f.x - v1[3] * f.y; w1[3] = v1[2] * f.y + v1[3] * f.x;
                        v0 = w0; v1 = w1; }
                    u32x4 w; w.x = cvt_pk_bf16(v0[0], v0[1]); w.y = cvt_pk_bf16(v0[2], v0[3]); w.z = cvt_pk_bf16(v1[0], v1[1]); w.w = cvt_pk_bf16(v1[2], v1[3]);
                    *(u32x4*)(Q + (size_t)row * 768 + c) = w; }
                asm volatile("" ::: "memory");
            }
    }
};
struct EpiKVup {
    static constexpr bool PERM = true, AFTER_DRAIN = false, MIDK = false;
    pg8::bf16_t* KV; const float* ssq;
    __device__ __forceinline__ void operator()(const f32x4 (&acc)[2][2][4][2], const Unit& u, int wr, int wc, int fr, int fq) const {
        const int row0 = u.pm * BM + wr * 64 + fr, col0 = u.pn * BM + wc * 32 + 8 * fq;
#pragma unroll
        for (int ai = 0; ai < 2; ++ai)
#pragma unroll
            for (int m = 0; m < 4; ++m) {
                const int row = row0 + ai * HALF + m * 16;
                const f32x4 pp = *(const f32x4*)(ssq + (size_t)row * 8 + 4);
                const float r = __builtin_amdgcn_rsqf(((pp[0] + pp[1]) + (pp[2] + pp[3])) * (1.0f / 128.0f) + EPS);
#pragma unroll
                for (int bj = 0; bj < 2; ++bj) { const f32x4 v0 = acc[ai][bj][m][0] * r, v1 = acc[ai][bj][m][1] * r;
                    u32x4 w; w.x = cvt_pk_bf16(v0[0], v0[1]); w.y = cvt_pk_bf16(v0[2], v0[3]); w.z = cvt_pk_bf16(v1[0], v1[1]); w.w = cvt_pk_bf16(v1[2], v1[3]);
                    *(u32x4*)(KV + (size_t)row * 1024 + col0 + bj * HALF) = w; }
                if (m & 1) asm volatile("" ::: "memory");
            }
    }
};
constexpr int OUT_TAB_OFF = 131072;
struct OutOrder : pg8::StaticOrder {
    const float* ssatt; LAS float* tab;
    __device__ __forceinline__ void a_ready(const Unit& u) const {
        const int tid = threadIdx.x, row = tid >> 1, which = tid & 1;
        const f32x4* pp = (const f32x4*)(ssatt + (size_t)(u.pm * BM + row) * 16 + which * 8); const f32x4 a = pp[0], b = pp[1];
        const float r = __builtin_amdgcn_rsqf((((a[0] + a[1]) + (a[2] + a[3])) + ((b[0] + b[1]) + (b[2] + b[3]))) * (1.0f / 512.0f) + EPS);
        const float o = __shfl_xor(r, 1);
        if (which == 0) { LAS float* t = tab + (u.ui & 1) * 512 + row * 2; t[0] = r / o; t[1] = o; }
    }
};
struct EpiOut {
    static constexpr bool PERM = true, AFTER_DRAIN = false, MIDK = true;
    const pg8::bf16_t* xb; pg8::bf16_t* H; float* ssh; const LAS float* tab;
    __device__ __forceinline__ void midk(f32x4 (&acc)[2][2][4][2], const Unit& u, int wr, int fr) const {
        const LAS float* t = tab + (u.ui & 1) * 512 + (wr * 64 + fr) * 2;
#pragma unroll
        for (int ai = 0; ai < 2; ++ai)
#pragma unroll
            for (int m = 0; m < 4; ++m) { const float ratio = t[(ai * HALF + m * 16) * 2];
#pragma unroll
                for (int bj = 0; bj < 2; ++bj) { acc[ai][bj][m][0] *= ratio; acc[ai][bj][m][1] *= ratio; } }
    }
    __device__ __forceinline__ void operator()(const f32x4 (&acc)[2][2][4][2], const Unit& u, int wr, int wc, int fr, int fq) const {
        const int row0 = u.pm * BM + wr * 64 + fr, col0 = u.pn * BM + wc * 32 + 8 * fq;
        const LAS float* t = tab + (u.ui & 1) * 512 + (wr * 64 + fr) * 2 + 1;
#pragma unroll
        for (int ai = 0; ai < 2; ++ai)
#pragma unroll
            for (int m = 0; m < 4; ++m) {
                const int row = row0 + ai * HALF + m * 16; const float r = t[(ai * HALF + m * 16) * 2];
                float s = 0.f;
#pragma unroll
                for (int bj = 0; bj < 2; ++bj) { const size_t off = (size_t)row * DM + col0 + bj * HALF;
                    const u32x4 xw = *(const u32x4*)(xb + off);
                    f32x4 x0, x1; x0[0] = bflo(xw.x); x0[1] = bfhi(xw.x); x0[2] = bflo(xw.y); x0[3] = bfhi(xw.y); x1[0] = bflo(xw.z); x1[1] = bfhi(xw.z); x1[2] = bflo(xw.w); x1[3] = bfhi(xw.w);
                    const f32x4 v0 = x0 + acc[ai][bj][m][0] * r, v1 = x1 + acc[ai][bj][m][1] * r;
                    u32x4 w; w.x = cvt_pk_bf16(v0[0], v0[1]); w.y = cvt_pk_bf16(v0[2], v0[3]); w.z = cvt_pk_bf16(v1[0], v1[1]); w.w = cvt_pk_bf16(v1[2], v1[3]);
                    *(u32x4*)(H + off) = w; s += sq4(v0) + sq4(v1); }
                s += __shfl_xor(s, 16); s += __shfl_xor(s, 32);
                if (fq == 0) ssh[(size_t)row * 16 + u.pn * 4 + wc] = s;
                if (m & 1) asm volatile("" ::: "memory");
            }
    }
};
struct GUOrder : pg8::StaticOrder {
    const float* ssh; LAS float* tab;
    __device__ __forceinline__ void a_ready(const Unit& u) const {
        const int tid = threadIdx.x, row = tid >> 1, which = tid & 1;
        const f32x4* pp = (const f32x4*)(ssh + (size_t)(u.pm * BM + row) * 16 + which * 8); const f32x4 a = pp[0], b = pp[1];
        float s = ((a[0] + a[1]) + (a[2] + a[3])) + ((b[0] + b[1]) + (b[2] + b[3]));
        s += __shfl_xor(s, 1);
        if (which == 0) tab[(u.ui & 1) * 256 + row] = __builtin_amdgcn_rsqf(s * (1.0f / 1024.0f) + EPS);
    }
};
struct EpiGU {
    static constexpr bool PERM = true, AFTER_DRAIN = false, MIDK = false;
    pg8::bf16_t* HID; const LAS float* tab;
    __device__ __forceinline__ void operator()(const f32x4 (&acc)[2][2][4][2], const Unit& u, int wr, int wc, int fr, int fq) const {
        const int row0 = u.pm * BM + wr * 64 + fr, col0 = u.pn * HALF + wc * 32 + 8 * fq;
        const LAS float* t = tab + (u.ui & 1) * 256 + wr * 64 + fr;
#pragma unroll
        for (int ai = 0; ai < 2; ++ai)
#pragma unroll
            for (int m = 0; m < 4; ++m) {
                const int row = row0 + ai * HALF + m * 16; const float r = t[ai * HALF + m * 16];
                float o[8];
#pragma unroll
                for (int n = 0; n < 2; ++n)
#pragma unroll
                    for (int e = 0; e < 4; ++e) { const float g = acc[ai][0][m][n][e] * r, up = acc[ai][1][m][n][e] * r;
                        const float sg = g * __builtin_amdgcn_rcpf(1.0f + __builtin_amdgcn_exp2f(-g * LOG2E)); o[n * 4 + e] = sg * up; }
                u32x4 w; w.x = cvt_pk_bf16(o[0], o[1]); w.y = cvt_pk_bf16(o[2], o[3]); w.z = cvt_pk_bf16(o[4], o[5]); w.w = cvt_pk_bf16(o[6], o[7]);
                __builtin_nontemporal_store(w, (u32x4*)(HID + (size_t)row * DFF + col0));
            }
    }
};
struct EpiDown {
    static constexpr bool PERM = true, AFTER_DRAIN = false, MIDK = false;
    const pg8::bf16_t* H; pg8::bf16_t* H2; float* ss2;
    __device__ __forceinline__ void operator()(const f32x4 (&acc)[2][2][4][2], const Unit& u, int wr, int wc, int fr, int fq) const {
        const int row0 = u.pm * BM + wr * 64 + fr, col0 = u.pn * BM + wc * 32 + 8 * fq;
#pragma unroll
        for (int ai = 0; ai < 2; ++ai)
#pragma unroll
            for (int m = 0; m < 4; ++m) {
                const int row = row0 + ai * HALF + m * 16; float s = 0.f;
#pragma unroll
                for (int bj = 0; bj < 2; ++bj) { const size_t off = (size_t)row * DM + col0 + bj * HALF;
                    const u32x4 hw = *(const u32x4*)(H + off);
                    f32x4 h0, h1; h0[0] = bflo(hw.x); h0[1] = bfhi(hw.x); h0[2] = bflo(hw.y); h0[3] = bfhi(hw.y); h1[0] = bflo(hw.z); h1[1] = bfhi(hw.z); h1[2] = bflo(hw.w); h1[3] = bfhi(hw.w);
                    h0 += acc[ai][bj][m][0]; h1 += acc[ai][bj][m][1];
                    u32x4 w; w.x = cvt_pk_bf16(h0[0], h0[1]); w.y = cvt_pk_bf16(h0[2], h0[3]); w.z = cvt_pk_bf16(h1[0], h1[1]); w.w = cvt_pk_bf16(h1[2], h1[3]);
                    *(u32x4*)(H2 + off) = w; s += sq4(h0) + sq4(h1); }
                s += __shfl_xor(s, 16); s += __shfl_xor(s, 32);
                if (fq == 0) ss2[(size_t)row * 16 + u.pn * 4 + wc] = s;
                if (m & 1) asm volatile("" ::: "memory");
            }
    }
};

struct Args { const float* in[22]; float* out; unsigned char* ws; int ph_lo, ph_hi, li, pad; };
enum { I_X = 0, I_GMIX, I_WIN, I_GQ, I_WUQ, I_GKV, I_WUKV, I_POSK, I_W1K, I_W2K, I_POSV, I_W1V, I_W2V, I_T5, I_GOM, I_GON, I_WOUT, I_GFFN, I_WG, I_WU, I_WD, I_GFIN };

__device__ __forceinline__ float wave_sum(float v) {
#pragma unroll
    for (int o = 1; o < 64; o <<= 1) v += __shfl_xor(v, o);
    return v;
}
typedef __bf16 bf16x2_t __attribute__((ext_vector_type(2)));
__device__ __forceinline__ float dot2(unsigned a, unsigned b, float c) { return __builtin_amdgcn_fdot2_f32_bf16(__builtin_bit_cast(bf16x2_t, a), __builtin_bit_cast(bf16x2_t, b), c, false); }

template <class F> __device__ __forceinline__ void tr_item(F f, bf16* WT, int ldk, int nblk, LAS float* scr, int item, int lane) {
    const int kb = item / nblk, nb = item % nblk, k0 = 64 * kb, n0 = 32 * nb;
#pragma unroll 8
    for (int i = 0; i < 32; ++i) { const int kk = 2 * i + (lane >> 5); scr[kk * 33 + (lane & 31)] = f(k0 + kk, n0 + (lane & 31)); }
    LDS_WAIT(); asm volatile("" ::: "memory");
    const int c = lane & 7;
#pragma unroll
    for (int j = 0; j < 4; ++j) { const int n = (lane >> 3) + 8 * j; const LAS float* s = scr + (8 * c) * 33 + n;
        v4u o; o.x = pk2(s[0 * 33], s[1 * 33]); o.y = pk2(s[2 * 33], s[3 * 33]); o.z = pk2(s[4 * 33], s[5 * 33]); o.w = pk2(s[6 * 33], s[7 * 33]);
        *(GAS v4u*)(WT + (size_t)(n0 + n) * ldk + k0 + 8 * c) = o; }
    LDS_WAIT(); asm volatile("" ::: "memory");
}
__device__ __forceinline__ int t5_bucket(int n) {
    if (n < 16) return n;
    int b = 16; b += n >= 19; b += n >= 21; b += n >= 24; b += n >= 27; b += n >= 31; b += n >= 35; b += n >= 40; b += n >= 46; b += n >= 52; b += n >= 59; b += n >= 67; b += n >= 77; b += n >= 87; b += n >= 99; b += n >= 113;
    return b;
}
__device__ __forceinline__ float gelu_tanh(float x) {
    const float y = 0.7978845608028654f * (x + 0.044715f * x * x * x);
    const float e = __builtin_amdgcn_exp2f(2.0f * LOG2E * y);
    const float th = 1.0f - 2.0f * __builtin_amdgcn_rcpf(e + 1.0f);
    return 0.5f * x * (1.0f + th);
}

struct Ptrs {
    const float* in[22]; float* out; unsigned char* ws;
    bf16 *Win, *Wuq, *Wukv, *Wout, *Wgu, *Wdn; f32x2v* rope; float *bias, *bias1, *rstdx, *ssqkv, *ssatt, *ssh;
    bf16 *kcmp, *vcmp, *kpe, *ovt, *W1c, *W2t, *XB, *U, *QM, *KVM, *ATT, *H, *HID;
};

__device__ __forceinline__ void p0_prologue(const Ptrs& P, LAS unsigned char* lds, int wg, int G, int wave, int lane, int tid) {
    LAS float* scr = (LAS float*)(lds + wave * 16384);
    const int gw = wg * NWAVES + wave, NGW = G * NWAVES;
    constexpr int I_IN = (1024 / 64) * (DINP / 32), I_UQ = (256 / 64) * (768 / 32), I_UKV = (256 / 64) * (1024 / 32), I_OUT = (1024 / 64) * (1024 / 32), I_GU = (1024 / 64) * (NGU / 32), I_DN = (DFF / 64) * (1024 / 32);
    constexpr int I_W1C = 2 * (1024 / 64) * (256 / 32), I_W2T = 2 * (128 / 64) * (64 / 32);
    constexpr int NITEMS = I_IN + I_UQ + I_UKV + I_OUT + I_GU + I_DN + I_W1C + I_W2T;
    for (int it = gw; it < NITEMS; it += NGW) {
        int r = it;
        if (r < I_IN) { const float* W = P.in[I_WIN]; const float* g = P.in[I_GMIX];
            tr_item([=](int k, int n) -> float { if (n >= DIN) return 0.f; const float s = (n >= C_QN && n < C_KVC) ? C2N : 1.0f; return W[(size_t)k * DIN + n] * g[k] * s; }, P.Win, 1024, DINP / 32, scr, r, lane); continue; } r -= I_IN;
        if (r < I_UQ) { const float* W = P.in[I_WUQ]; const float* g = P.in[I_GQ];
            tr_item([=](int k, int n) -> float { const int h = n / 96, d = n % 96; int src = n; if (d >= 64) { const int e = d - 64; src = h * 96 + 64 + (e & 1) * 16 + (e >> 1); } return W[(size_t)k * 768 + src] * g[k]; }, P.Wuq, 256, 768 / 32, scr, r, lane); continue; } r -= I_UQ;
        if (r < I_UKV) { const float* W = P.in[I_WUKV]; const float* g = P.in[I_GKV];
            tr_item([=](int k, int n) -> float { return k < 128 ? W[(size_t)k * 1024 + n] * g[k] : 0.f; }, P.Wukv, 256, 1024 / 32, scr, r, lane); continue; } r -= I_UKV;
        if (r < I_OUT) { const float* W = P.in[I_WOUT]; const float* g1 = P.in[I_GOM]; const float* g2 = P.in[I_GON];
            tr_item([=](int k, int n) -> float { return W[(size_t)k * 1024 + n] * (k < 512 ? g1[k] : g2[k - 512]); }, P.Wout, 1024, 1024 / 32, scr, r, lane); continue; } r -= I_OUT;
        if (r < I_GU) { const float* g = P.in[I_GFFN]; const bool up = ((r % (NGU / 32)) & 4) != 0;
            if (!up) { const float* W = P.in[I_WG]; tr_item([=](int k, int n) -> float { return W[(size_t)k * DFF + (n >> 8) * 128 + (n & 127)] * g[k]; }, P.Wgu, 1024, NGU / 32, scr, r, lane); }
            else { const float* W = P.in[I_WU]; tr_item([=](int k, int n) -> float { return W[(size_t)k * DFF + (n >> 8) * 128 + (n & 127)] * g[k]; }, P.Wgu, 1024, NGU / 32, scr, r, lane); }
            continue; } r -= I_GU;
        if (r < I_DN) { const float* W = P.in[I_WD];
            tr_item([=](int k, int n) -> float { return W[(size_t)k * 1024 + n]; }, P.Wdn, DFF, 1024 / 32, scr, r, lane); continue; } r -= I_DN;
        if (r < I_W1C) { const int kv = r >= I_W1C / 2; if (kv) r -= I_W1C / 2;
            if (!kv) { const float* W = P.in[I_W1K]; tr_item([=](int k, int n) -> float { return W[(size_t)(k + ((n >> 7) << 10)) * 128 + (n & 127)]; }, P.W1c, 1024, 256 / 32, scr, r, lane); }
            else { const float* W = P.in[I_W1V]; tr_item([=](int k, int n) -> float { return W[(size_t)(k + ((n >> 7) << 10)) * 128 + (n & 127)]; }, P.W1c + 256 * 1024, 1024, 256 / 32, scr, r, lane); }
            continue; } r -= I_W1C;
        { const int kv = r >= I_W2T / 2; if (kv) r -= I_W2T / 2;
            if (!kv) { const float* W = P.in[I_W2K]; tr_item([=](int k, int n) -> float { return W[(size_t)k * 64 + n]; }, P.W2t, 128, 64 / 32, scr, r, lane); }
            else { const float* W = P.in[I_W2V]; tr_item([=](int k, int n) -> float { return W[(size_t)k * 64 + n]; }, P.W2t + 64 * 128, 128, 64 / 32, scr, r, lane); } }
    }
    const int gt = wg * NTHR + tid, NGT = G * NTHR;
    for (int e = gt; e < SEQ * 16; e += NGT) { const int pos = e >> 4, i = e & 15;
        const float inv = __builtin_amdgcn_exp2f(-(float)i * (13.287712379549449f / 16.0f));
        const float ang = (float)pos * inv;
        double rev = (double)ang * 0.15915494309189535; rev -= __builtin_floor(rev);
        const float fr = (float)rev;
        P.rope[e] = (f32x2v){__builtin_amdgcn_cosf(fr), __builtin_amdgcn_sinf(fr)}; }
    for (int e = gt; e < 8 * 128; e += NGT) { const int h = e >> 7, d = e & 127; P.bias[e] = P.in[I_T5][t5_bucket(d) * 8 + h] * LOG2E; }
    for (int e = gt; e < 256 * 64; e += NGT) { const int i = e >> 6, j = e & 63; float w = 0.f; if (j == (i >> 2)) w += ((i & 3) == 3) ? 1.f : 2.f; if ((i & 3) == 3 && j == (i >> 2) + 1) w += 1.f;
        P.ovt[e] = (bf16)(__float_as_uint(w) >> 16); }
    for (int o = gw; o < 256; o += NGW) { const int kv = o >> 7, j = o & 127; const float* pos = P.in[kv ? I_POSV : I_POSK]; const float* w1 = P.in[kv ? I_W1V : I_W1K];
        float s = 0.f; for (int k = lane; k < 2048; k += 64) s += pos[k] * w1[(size_t)k * 128 + j];
        s = wave_sum(s); if (lane == 0) P.bias1[o] = s; }
    for (int m0 = gw * 4; m0 < MT; m0 += NGW * 4) {
        f32x4 v[4][4];
#pragma unroll
        for (int q = 0; q < 4; ++q) { const GAS f32x4* xr = (const GAS f32x4*)(P.in[I_X] + (size_t)(m0 + q) * DM) + lane;
#pragma unroll
            for (int j = 0; j < 4; ++j) v[q][j] = xr[64 * j]; }
#pragma unroll
        for (int q = 0; q < 4; ++q) { float s = 0.f;
#pragma unroll
            for (int j = 0; j < 4; ++j) s += sq4(v[q][j]);
            s = wave_sum(s);
            if (lane == 0) P.rstdx[m0 + q] = __builtin_amdgcn_rsqf(s * (1.0f / DM) + EPS);
            GAS unsigned long long* o8 = (GAS unsigned long long*)(P.XB + (size_t)(m0 + q) * DM) + lane;
#pragma unroll
            for (int j = 0; j < 4; ++j) o8[64 * j] = (unsigned long long)pk2(v[q][j][0], v[q][j][1]) | ((unsigned long long)pk2(v[q][j][2], v[q][j][3]) << 32); }
    }
}

__device__ __forceinline__ void p2_kpe(const Ptrs& P, int wg, int G, int tid) {
    const int gt = wg * NTHR + tid, NGT = G * NTHR;
    for (int e = gt; e < MT * 16; e += NGT) { const int row = e >> 4, i = e & 15; const int pos = row & (SEQ - 1);
        const float x1 = bf2f(P.U[(size_t)row * DINP + C_KR + i]), x2 = bf2f(P.U[(size_t)row * DINP + C_KR + 16 + i]);
        const f32x2v cs = P.rope[pos * 16 + i];
        *(unsigned*)(P.kpe + (size_t)row * 32 + 2 * i) = pk2(x1 * cs.x - x2 * cs.y, x1 * cs.y + x2 * cs.x); }
}
__device__ __forceinline__ void p7_final(const Ptrs& P, int wg, int G, int wave, int lane) {
    const int gw = wg * NWAVES + wave, NGW = G * NWAVES;
    const GAS f32x4* gp = (const GAS f32x4*)P.in[I_GFIN] + 2 * lane; f32x4 gg[4][2];
#pragma unroll
    for (int j = 0; j < 2; ++j) { gg[j][0] = gp[128 * j]; gg[j][1] = gp[128 * j + 1]; }
    for (int m0 = gw * 4; m0 < MT; m0 += NGW * 4) {
        u32x4 w0[4], w1[4]; float pv[4];
#pragma unroll
        for (int q = 0; q < 4; ++q) { const GAS u32x4* hr = (const GAS u32x4*)(P.ATT + (size_t)(m0 + q) * DM) + lane;
            w0[q] = hr[0]; w1[q] = hr[64]; pv[q] = (lane < 16) ? P.ssatt[(size_t)(m0 + q) * 16 + lane] : 0.f; }
#pragma unroll
        for (int q = 0; q < 4; ++q) {
            const float r = __builtin_amdgcn_rsqf(wave_sum(pv[q]) * (1.0f / DM) + EPS);
            GAS f32x4* o = (GAS f32x4*)(P.out + (size_t)(m0 + q) * DM) + 2 * lane;
            { const u32x4 w = w0[q]; f32x4 a, b; a[0] = bflo(w.x); a[1] = bfhi(w.x); a[2] = bflo(w.y); a[3] = bfhi(w.y); b[0] = bflo(w.z); b[1] = bfhi(w.z); b[2] = bflo(w.w); b[3] = bfhi(w.w);
              o[0] = a * r * gg[0][0]; o[1] = b * r * gg[0][1]; }
            { const u32x4 w = w1[q]; f32x4 a, b; a[0] = bflo(w.x); a[1] = bfhi(w.x); a[2] = bflo(w.y); a[3] = bfhi(w.y); b[0] = bflo(w.z); b[1] = bfhi(w.z); b[2] = bflo(w.w); b[3] = bfhi(w.w);
              o[128] = a * r * gg[1][0]; o[129] = b * r * gg[1][1]; } }
    }
}

struct CmpOrder {
    int G, c; const bf16* U; const bf16* W1c;
    __device__ __forceinline__ bool next(int i, Unit& u) const { const int un = c + i * G; if (un >= 64) return false; u.pm = un; u.pn = 0; u.ui = i; return true; }
    __device__ __forceinline__ void a_ready(const Unit&) const {}
    __device__ __forceinline__ void done(const Unit&) const {}
    __device__ __forceinline__ const char* a_base(const pg8::Gemm&, const Unit& u, size_t) const { const int bh = u.pm >> 1, kv = u.pm & 1;
        return (const char*)(U + (size_t)(bh >> 1) * SEQ * DINP + C_KVC + kv * 128 + (bh & 1) * 64); }
    __device__ __forceinline__ const char* b_base(const pg8::Gemm&, const Unit& u, size_t) const { return (const char*)(W1c + (size_t)(u.pm & 1) * 256 * 1024); }
};
struct EpiCmp {
    static constexpr bool PERM = true, AFTER_DRAIN = true, MIDK = false;
    const float* bias1; const bf16* W2t; bf16* kcmp; bf16* vcmp;
    __device__ __forceinline__ void operator()(const f32x4 (&)[2][2][4][2], const Unit&, int, int, int, int) const {}
    __device__ __forceinline__ void fused(f32x4 (&acc)[2][2][4][2], const Unit& u, int wr, int wc, int fr, int fq, LAS unsigned char* lds, int wid, int lane) const {
        typedef short bf16x8_t __attribute__((ext_vector_type(8))); typedef float f32x16_t __attribute__((ext_vector_type(16)));
        const int bh = u.pm >> 1, kv = u.pm & 1; const int col = wc * 32 + 8 * fq;
        LAS float* OB = (LAS float*)lds;
#pragma unroll
        for (int ai = 0; ai < 2; ++ai)
#pragma unroll
            for (int m = 0; m < 4; ++m) { const int r = ai * HALF + wr * 64 + m * 16 + fr;
                *(LAS f32x4*)(OB + r * 132 + col) = acc[ai][1][m][0]; *(LAS f32x4*)(OB + r * 132 + col + 4) = acc[ai][1][m][1]; }
        const f32x4 bs0 = *(const f32x4*)(bias1 + kv * 128 + col), bs1 = *(const f32x4*)(bias1 + kv * 128 + col + 4);
        asm volatile("s_waitcnt lgkmcnt(0)" ::: "memory"); __builtin_amdgcn_s_barrier(); asm volatile("" ::: "memory");
#pragma unroll
        for (int ai = 0; ai < 2; ++ai)
#pragma unroll
            for (int m = 0; m < 4; ++m) { const int r = ai * HALF + wr * 64 + m * 16 + fr, r1 = r < 255 ? r + 1 : 255;
                const f32x4 b0 = *(const LAS f32x4*)(OB + r1 * 132 + col), b1 = *(const LAS f32x4*)(OB + r1 * 132 + col + 4);
                f32x4 h0 = acc[ai][0][m][0] + b0 + bs0, h1 = acc[ai][0][m][1] + b1 + bs1;
#pragma unroll
                for (int e = 0; e < 4; ++e) { h0[e] = gelu_tanh(h0[e]); h1[e] = gelu_tanh(h1[e]); }
                acc[ai][0][m][0] = h0; acc[ai][0][m][1] = h1; }
        asm volatile("s_waitcnt lgkmcnt(0)" ::: "memory"); __builtin_amdgcn_s_barrier(); asm volatile("" ::: "memory");
        LAS bf16* GB = (LAS bf16*)lds;
#pragma unroll
        for (int ai = 0; ai < 2; ++ai)
#pragma unroll
            for (int m = 0; m < 4; ++m) { const int r = ai * HALF + wr * 64 + m * 16 + fr; const f32x4 h0 = acc[ai][0][m][0], h1 = acc[ai][0][m][1];
                u32x4 w; w.x = pk2(h0[0], h0[1]); w.y = pk2(h0[2], h0[3]); w.z = pk2(h1[0], h1[1]); w.w = pk2(h1[2], h1[3]);
                *(LAS u32x4*)(GB + r * 136 + col) = w; }
        asm volatile("s_waitcnt lgkmcnt(0)" ::: "memory"); __builtin_amdgcn_s_barrier(); asm volatile("" ::: "memory");
        const int r32 = lane & 31, hi = lane >> 5, c = wid * 32 + r32;
        f32x16_t o[2]; o[0] = f32x16_t{}; o[1] = f32x16_t{};
        const bf16* w2 = W2t + (size_t)kv * 64 * 128;
#pragma unroll
        for (int s = 0; s < 8; ++s) { const bf16x8_t gb = *(const LAS bf16x8_t*)(GB + c * 136 + 16 * s + 8 * hi);
#pragma unroll
            for (int dt = 0; dt < 2; ++dt) { const bf16x8_t wa = *(const bf16x8_t*)(w2 + (size_t)(32 * dt + r32) * 128 + 16 * s + 8 * hi);
                o[dt] = __builtin_amdgcn_mfma_f32_32x32x16_bf16(wa, gb, o[dt], 0, 0, 0); } }
        if (c < NCMP) { bf16* op = (kv ? vcmp : kcmp) + ((size_t)bh * 256 + c) * 64 + 4 * hi;
#pragma unroll
            for (int dt = 0; dt < 2; ++dt)
#pragma unroll
                for (int k = 0; k < 4; ++k) *(unsigned long long*)(op + 32 * dt + 8 * k) = (unsigned long long)pk2(o[dt][4 * k], o[dt][4 * k + 1]) | ((unsigned long long)pk2(o[dt][4 * k + 2], o[dt][4 * k + 3]) << 32); }
        asm volatile("s_waitcnt lgkmcnt(0)" ::: "memory"); __builtin_amdgcn_s_barrier();
    }
};

namespace att {
typedef short bf16x8 __attribute__((ext_vector_type(8)));
typedef short s16x4 __attribute__((ext_vector_type(4)));
typedef float f32x16 __attribute__((ext_vector_type(16)));
typedef __attribute__((address_space(3))) const char* lds_cptr;
constexpr float THR = 8.0f;
constexpr float NEG_INF = -__builtin_inff();
__device__ __forceinline__ int crow(int r, int hi) { return (r & 3) + 8 * (r >> 2) + 4 * hi; }
__device__ __forceinline__ float swap_max(float x) { auto rr = __builtin_amdgcn_permlane32_swap(__float_as_uint(x), __float_as_uint(x), false, false); return fmaxf(__uint_as_float(rr[0]), __uint_as_float(rr[1])); }
__device__ __forceinline__ float swap_sum(float x) { auto rr = __builtin_amdgcn_permlane32_swap(__float_as_uint(x), __float_as_uint(x), false, false); return __uint_as_float(rr[0]) + __uint_as_float(rr[1]); }
__device__ __forceinline__ float partner32(float x, int hi) { auto rr = __builtin_amdgcn_permlane32_swap(__float_as_uint(x), __float_as_uint(x), false, false); return __uint_as_float(hi ? rr[0] : rr[1]); }
__device__ __forceinline__ unsigned partner32u(unsigned x, int hi) { auto rr = __builtin_amdgcn_permlane32_swap(x, x, false, false); return hi ? rr[0] : rr[1]; }
__device__ __forceinline__ void dma16(const void* g, LAS unsigned char* l) { unsigned keep; const unsigned dst = (unsigned)__builtin_amdgcn_readfirstlane((int)(unsigned)(uintptr_t)l);
    asm volatile("s_mov_b32 %0, m0\n\ts_mov_b32 m0, %2\n\ts_nop 0\n\tglobal_load_lds_dwordx4 %1, off\n\ts_mov_b32 m0, %0" : "=&s"(keep) : "v"(g), "s"(dst) : "memory"); }
template <int N> __device__ __forceinline__ void wait_bar() { if (N == 3) asm volatile("s_waitcnt vmcnt(3) lgkmcnt(0)\n\ts_barrier" ::: "memory"); else if (N == 2) asm volatile("s_waitcnt vmcnt(2) lgkmcnt(0)\n\ts_barrier" ::: "memory"); else asm volatile("s_waitcnt vmcnt(0) lgkmcnt(0)\n\ts_barrier" ::: "memory"); }

struct SrcMLA {
    static constexpr int DK = 96, NDMA = 3, NV = 1;
    const bf16* kn; const bf16* kp; const bf16* v;
    __device__ __forceinline__ void init(const bf16* KVM, const bf16* KPE, size_t rowb, int h, int wid, int lane) {
        kn = KVM + (rowb + lane) * 1024 + h * 128 + 8 * wid;
        kp = KPE + (rowb + lane) * 32 + 8 * (wid & 3);
        v = KVM + (rowb + 16 * (wid & 3) + (lane >> 2)) * 1024 + h * 128 + 64 + (wid >> 2) * 32 + (lane & 3) * 8; }
    static constexpr int NKD = 2;
    __device__ __forceinline__ void issueK(int tile, LAS unsigned char* ks, int wid) const {
        dma16(kn + (size_t)tile * 64 * 1024, ks + wid * 1024);
        dma16(kp + (size_t)tile * 64 * 32, ks + (8 + (wid & 3)) * 1024); }
    __device__ __forceinline__ void issueV(int tile, LAS unsigned char* vs, int wid) const { dma16(v + (size_t)tile * 64 * 1024, vs + wid * 1024); }
    __device__ __forceinline__ void issue(int tile, LAS unsigned char* ks, LAS unsigned char* vs, int wid) const { issueK(tile, ks, wid); issueV(tile, vs, wid); }
};
struct SrcRows {
    static constexpr int DK = 64, NDMA = 2, NV = 1;
    const bf16* k; const bf16* v; size_t pitch;
    __device__ __forceinline__ void init(const bf16* K0, const bf16* V0, size_t pitch_, int wid, int lane) {
        pitch = pitch_; k = K0 + (size_t)lane * pitch + 8 * wid; v = V0 + (size_t)(16 * (wid & 3) + (lane >> 2)) * pitch + (wid >> 2) * 32 + (lane & 3) * 8; }
    static constexpr int NKD = 1;
    __device__ __forceinline__ void issueK(int tile, LAS unsigned char* ks, int wid) const { dma16(k + (size_t)tile * 64 * pitch, ks + wid * 1024); }
    __device__ __forceinline__ void issueV(int tile, LAS unsigned char* vs, int wid) const { dma16(v + (size_t)tile * 64 * pitch, vs + wid * 1024); }
    __device__ __forceinline__ void issue(int tile, LAS unsigned char* ks, LAS unsigned char* vs, int wid) const { issueK(tile, ks, wid); issueV(tile, vs, wid); }
};

struct SrcCmp {
    static constexpr int DK = 64, NDMA = 3, NV = 2;
    const bf16* k; const bf16* v; const bf16* ov;
    __device__ __forceinline__ void init(const bf16* K0, const bf16* V0, const bf16* OV, int wid, int lane) {
        k = K0 + (size_t)lane * 64 + 8 * wid; const size_t vo = (size_t)(16 * (wid & 3) + (lane >> 2)) * 64 + (wid >> 2) * 32 + (lane & 3) * 8; v = V0 + vo; ov = OV + vo; }
    __device__ __forceinline__ void issue(int tile, LAS unsigned char* ks, LAS unsigned char* vs, int wid) const {
        dma16(k + (size_t)tile * 4096, ks + wid * 1024);
        dma16(v + (size_t)tile * 4096, vs + wid * 1024);
        dma16(ov + (size_t)tile * 4096, vs + 8192 + wid * 1024); }
};

template <int NV> struct RowT { float m, l; f32x16 o[2 * NV]; };
typedef RowT<1> Row;
template <int NV> __device__ __forceinline__ void row_reset(RowT<NV>& R) { R.m = -1e30f; R.l = 0.f;
#pragma unroll
    for (int i = 0; i < 2 * NV; ++i) R.o[i] = f32x16{}; }

template <int DK> __device__ __forceinline__ void qk_tile(f32x16& p0, f32x16& p1, LAS unsigned char* kslot, const bf16x8 (&qr)[DK / 16], int r32, int hi) {
    const LAS unsigned char* kb = kslot + hi * 1024 + r32 * 16;
    p0 = f32x16{}; p1 = f32x16{};
#pragma unroll
    for (int d0 = 0; d0 < DK / 16; ++d0) {
        const bf16x8 b0 = *(const LAS bf16x8*)(kb + d0 * 2048), b1 = *(const LAS bf16x8*)(kb + d0 * 2048 + 512);
        p0 = __builtin_amdgcn_mfma_f32_32x32x16_bf16(b0, qr[d0], p0, 0, 0, 0);
        p1 = __builtin_amdgcn_mfma_f32_32x32x16_bf16(b1, qr[d0], p1, 0, 0, 0); }
}
template <int NV> __device__ __forceinline__ void softmax_tile(f32x16& p0, f32x16& p1, RowT<NV>& R) {
    float a = fmaxf(fmaxf(p0[0], p0[1]), fmaxf(p1[0], p1[1]));
#pragma unroll
    for (int r = 2; r < 16; r += 2) a = fmaxf(a, fmaxf(fmaxf(p0[r], p0[r + 1]), fmaxf(p1[r], p1[r + 1])));
    const float mt = swap_max(a);
    if (__any(mt > R.m + THR)) { const float mn = fmaxf(R.m, mt), f = __builtin_amdgcn_exp2f(R.m - mn); R.m = mn; R.l *= f;
#pragma unroll
        for (int i = 0; i < 2 * NV; ++i) R.o[i] *= f; }
    const float m = R.m; float s = 0.f;
#pragma unroll
    for (int r = 0; r < 16; ++r) { p0[r] = __builtin_amdgcn_exp2f(p0[r] - m); p1[r] = __builtin_amdgcn_exp2f(p1[r] - m); s += p0[r] + p1[r]; }
    R.l += s;
}
template <int NV> __device__ __forceinline__ void pv_tile(const f32x16& p0, const f32x16& p1, RowT<NV>& R, LAS unsigned char* vslot, int lane, int hi) {
    bf16x8 pa[4];
#pragma unroll
    for (int k = 0; k < 4; ++k) { const f32x16& P = (k < 2) ? p0 : p1; const int b = (k & 1) * 8;
        u32x4 w; w.x = pk2(P[b], P[b + 1]); w.y = pk2(P[b + 2], P[b + 3]); w.z = pk2(P[b + 4], P[b + 5]); w.w = pk2(P[b + 6], P[b + 7]); pa[k] = __builtin_bit_cast(bf16x8, w); }
    const int vb = (int)(unsigned)(uintptr_t)vslot + ((lane >> 4) & 1) * 32 + (lane & 3) * 8 + (4 * hi + ((lane & 15) >> 2)) * 64;
#pragma unroll
    for (int d0 = 0; d0 < 2 * NV; ++d0) { s16x4 lo[4], hh[4];
#pragma unroll
        for (int ks = 0; ks < 4; ++ks) {
            asm volatile("ds_read_b64_tr_b16 %0,%1 offset:%c2" : "=&v"(lo[ks]) : "v"(vb), "i"(d0 * 4096 + ks * 1024) : "memory");
            asm volatile("ds_read_b64_tr_b16 %0,%1 offset:%c2" : "=&v"(hh[ks]) : "v"(vb), "i"(d0 * 4096 + ks * 1024 + 512) : "memory"); }
        asm volatile("s_waitcnt lgkmcnt(0)" ::: "memory"); __builtin_amdgcn_sched_barrier(0);
#pragma unroll
        for (int ks = 0; ks < 4; ++ks) { const bf16x8 vf = (bf16x8){lo[ks][0], lo[ks][1], lo[ks][2], lo[ks][3], hh[ks][0], hh[ks][1], hh[ks][2], hh[ks][3]};
            R.o[d0] = __builtin_amdgcn_mfma_f32_32x32x16_bf16(vf, pa[ks], R.o[d0], 0, 0, 0); } }
}

template <class RowPtr>
__device__ __forceinline__ void store_rows(LAS unsigned char* stg, const f32x16& o0, const f32x16& o1, float scale, float& ss, int lane, const RowPtr& rowptr) {
    const int r32 = lane & 31, hi = lane >> 5;
    LAS unsigned char* wp = stg + r32 * 144 + 8 * hi;
#pragma unroll
    for (int d0 = 0; d0 < 2; ++d0)
#pragma unroll
        for (int k = 0; k < 4; ++k) { const f32x16& o = d0 ? o1 : o0;
            const float v0 = o[4 * k] * scale, v1 = o[4 * k + 1] * scale, v2 = o[4 * k + 2] * scale, v3 = o[4 * k + 3] * scale;
            ss += (v0 * v0 + v1 * v1) + (v2 * v2 + v3 * v3);
            *(LAS unsigned long long*)(wp + 64 * d0 + 16 * k) = (unsigned long long)pk2(v0, v1) | ((unsigned long long)pk2(v2, v3) << 32); }
    asm volatile("s_waitcnt lgkmcnt(0)" ::: "memory");
#pragma unroll
    for (int i = 0; i < 4; ++i) { const int row = i * 8 + (lane >> 3), ch = lane & 7;
        const u32x4 v = *(const LAS u32x4*)(stg + row * 144 + ch * 16);
        __builtin_nontemporal_store(v, (u32x4*)(rowptr(row) + ch * 8)); }
}

template <class Src, class Fix, class Skip>
__device__ __forceinline__ void run_tiles(LAS unsigned char* ring, const Src& src, int kt0, int kt1, const bf16x8 (&qr)[Src::DK / 16], RowT<Src::NV>& R, const Fix& fix, const Skip& skip, int wid, int lane) {
    constexpr int KB = Src::DK * 128, SLOT = KB + 8192 * Src::NV;
    const int r32 = lane & 31, hi = lane >> 5; const int nt = kt1 - kt0;
    if (nt <= 0) return;
    src.issue(kt0, ring, ring + KB, wid);
    if (nt > 1) src.issue(kt0 + 1, ring + SLOT, ring + SLOT + KB, wid);
    int s_cur = 0, s_nn = 2 * SLOT;
    for (int i = 0; i < nt; ++i) {
        if (i + 1 < nt) wait_bar<Src::NDMA>(); else wait_bar<0>();
        if (i + 2 < nt) src.issue(kt0 + i + 2, ring + s_nn, ring + s_nn + KB, wid);
        const int tile = kt0 + i;
        if (!skip(tile)) {
            f32x16 p0, p1;
            qk_tile<Src::DK>(p0, p1, ring + s_cur, qr, r32, hi);
            fix(p0, p1, tile);
            softmax_tile(p0, p1, R);
            pv_tile(p0, p1, R, ring + s_cur + KB, lane, hi);
        }
        s_cur = (s_cur == 2 * SLOT) ? 0 : s_cur + SLOT; s_nn = (s_nn == 2 * SLOT) ? 0 : s_nn + SLOT;
    }
    asm volatile("s_waitcnt lgkmcnt(0)\n\ts_barrier" ::: "memory");
}
}


namespace att {
template <int N> __device__ __forceinline__ void wait_bar_n() {
    static_assert(N == 0 || N == 3 || N == 4 || N == 5 || N == 6 || N == 8, "wait_bar_n: add the count");
    if (N == 8) asm volatile("s_waitcnt vmcnt(8) lgkmcnt(0)\n\ts_barrier" ::: "memory"); else if (N == 6) asm volatile("s_waitcnt vmcnt(6) lgkmcnt(0)\n\ts_barrier" ::: "memory");
    else if (N == 5) asm volatile("s_waitcnt vmcnt(5) lgkmcnt(0)\n\ts_barrier" ::: "memory"); else if (N == 4) asm volatile("s_waitcnt vmcnt(4) lgkmcnt(0)\n\ts_barrier" ::: "memory");
    else if (N == 3) asm volatile("s_waitcnt vmcnt(3) lgkmcnt(0)\n\ts_barrier" ::: "memory"); else asm volatile("s_waitcnt vmcnt(0) lgkmcnt(0)\n\ts_barrier" ::: "memory"); }
typedef short v4i16_t __attribute__((ext_vector_type(4)));
typedef float f32x2_t __attribute__((ext_vector_type(2)));
__device__ __forceinline__ s16x4 vtr(const LAS unsigned char* p) { return __builtin_bit_cast(s16x4, __builtin_amdgcn_ds_read_tr16_b64_v4i16((LAS v4i16_t*)p)); }
__device__ __forceinline__ unsigned cvtpk(float lo, float hi) { f32x2_t v = {lo, hi}; bf16x2_t b = __builtin_convertvector(v, bf16x2_t); return __builtin_bit_cast(unsigned, b); }
#define SBAR() __builtin_amdgcn_sched_barrier(0)
#define PIN(x) asm volatile("" : "+v"(x))
#define MX3(a, b, c) __builtin_fmaxf(__builtin_fmaxf((a), (b)), (c))

template <class Src, class Fix>
__device__ __forceinline__ void run_pipe(LAS unsigned char* ring, const Src& src, int kt0, int kt1, const bf16x8 (&qr)[Src::DK / 16], Row& R, const Fix& fix, float bfar, int near_from, int wid, int lane) {
    constexpr int DK = Src::DK, NKS = DK / 16, NK = 2 * NKS, KB = DK * 128, VB = 8192, NKD = Src::NKD, NDMA = NKD + 1;
    const int NT = kt1 - kt0;
    constexpr bool ALT = false;
    if (wid >= 4) __builtin_amdgcn_s_setprio(1);
    const int r32 = lane & 31, hi = lane >> 5;
    LAS unsigned char* kring = ring; LAS unsigned char* vring = ring + 4 * KB;
    const LAS unsigned char* kp0 = kring + hi * 1024 + r32 * 16;
    const LAS unsigned char* vp0 = vring + ((lane >> 4) & 1) * 32 + (lane & 3) * 8 + (4 * hi + ((lane & 15) >> 2)) * 64;
#define TILE(tt) (kt0 + ((tt) < NT ? (tt) : NT - 1))
    src.issueK(TILE(0), kring, wid); src.issueV(TILE(0), vring, wid); src.issueK(TILE(1), kring + KB, wid); src.issueK(TILE(2), kring + 2 * KB, wid);
    src.issueK(TILE(3), kring + 3 * KB, wid); src.issueV(TILE(1), vring + VB, wid);
    bf16x8 kf[NK];
    f32x16 A0, A1, B0, B1, cin;
    float m = 0.f, l = 0.f, csh = 0.f; f32x16 o0 = f32x16{}, o1 = f32x16{};
    wait_bar_n<3 * NKD + 2>();
#define KLOAD(kslot) do { _Pragma("unroll") for (int d0 = 0; d0 < NKS; ++d0) { kf[2 * d0] = *(const LAS bf16x8*)(kp0 + (kslot) + d0 * 2048); kf[2 * d0 + 1] = *(const LAS bf16x8*)(kp0 + (kslot) + d0 * 2048 + 512); } } while (0)
#define ROWMAX(C0, C1, out) do { float a_ = MX3(C0[0], C0[1], C1[0]), b_ = MX3(C0[2], C0[3], C1[1]); a_ = MX3(a_, C1[2], C1[3]); \
        _Pragma("unroll") for (int r = 4; r < 16; r += 4) { a_ = MX3(a_, C0[r], C0[r + 1]); b_ = MX3(b_, C0[r + 2], C0[r + 3]); a_ = MX3(a_, C1[r], C1[r + 1]); b_ = MX3(b_, C1[r + 2], C1[r + 3]); } \
        out = swap_max(__builtin_fmaxf(a_, b_)); } while (0)
    KLOAD(0);
    A0 = f32x16{}; A1 = f32x16{};
#pragma unroll
    for (int d0 = 0; d0 < NKS; ++d0) { A0 = __builtin_amdgcn_mfma_f32_32x32x16_bf16(kf[2 * d0], qr[d0], A0, 0, 0, 0); A1 = __builtin_amdgcn_mfma_f32_32x32x16_bf16(kf[2 * d0 + 1], qr[d0], A1, 0, 0, 0); }
    fix(A0, A1, kt0);
    { float rm; ROWMAX(A0, A1, rm);
      const float sh0 = (kt0 < near_from) ? bfar : 0.f;
      const float dl = (rm > NEG_INF) ? rm + sh0 : 0.f; m = dl; const float c0 = sh0 - dl;
#pragma unroll
      for (int r = 0; r < 16; ++r) { A0[r] = __builtin_amdgcn_exp2f(A0[r] + c0); A1[r] = __builtin_amdgcn_exp2f(A1[r] + c0); }
      csh = (kt0 + 1 < near_from) ? bfar : 0.f;
#pragma unroll
      for (int r = 0; r < 16; ++r) cin[r] = csh - m;
      asm volatile("" : "+v"(cin)); }
    float fpend = 1.0f; bool resc = false;
    wait_bar_n<2 * NKD + 1>();
    src.issueK(TILE(4), kring, wid); src.issueV(TILE(2), vring + 2 * VB, wid);
    KLOAD(KB);
    wait_bar_n<2 * NDMA>();
    int kcur = KB, knext = 2 * KB, vprev = 0, vnext = 3 * VB;
    u32x4 pw0, pw1, pw2, pw3; s16x4 vlo[8], vhi[8];
#define PKW(P, b) cvtpk(P[b], P[(b) + 1])
#define VRD(i) do { vlo[i] = vtr(vp_ + (((i) >> 2) * 4096 + ((i) & 3) * 1024)); vhi[i] = vtr(vp_ + (((i) >> 2) * 4096 + ((i) & 3) * 1024 + 512)); } while (0)
#define VFR(i) (bf16x8){vlo[i][0], vlo[i][1], vlo[i][2], vlo[i][3], vhi[i][0], vhi[i][1], vhi[i][2], vhi[i][3]}
#define PAF(k) __builtin_bit_cast(bf16x8, pw##k)
#define QKM(i, C, first) C = __builtin_amdgcn_mfma_f32_32x32x16_bf16(kf[i], qr[(i) >> 1], (first) ? cin : C, 0, 0, 0)
#define GAPA(MF, a0_, a1_, a2_, a3_, W0, W1, PW) do { MF; sacc += a0_; sacc += a1_; sacc += a2_; sacc += a3_; PIN(sacc); W0; W1; PIN(PW); SBAR(); } while (0)
#define GAPB(MF, X, b) do { MF; X[b] = __builtin_amdgcn_exp2f(X[b]); X[(b) + 1] = __builtin_amdgcn_exp2f(X[(b) + 1]); X[(b) + 2] = __builtin_amdgcn_exp2f(X[(b) + 2]); X[(b) + 3] = __builtin_amdgcn_exp2f(X[(b) + 3]); PIN(X); SBAR(); } while (0)
#define PHASE_A(C0, C1, P0, P1) do { SBAR(); const LAS unsigned char* vp_ = vp0 + vprev; \
        VRD(0); SBAR(); float sacc = P0[0] + P0[1]; \
        GAPA(QKM(0, C0, true), P0[2], P0[3], P0[4], P0[5], pw0[0] = PKW(P0, 0), pw0[1] = PKW(P0, 2), pw0); \
        GAPA(QKM(1, C1, true), P0[6], P0[7], P0[8], P0[9], pw0[2] = PKW(P0, 4), pw0[3] = PKW(P0, 6), pw0); \
        VRD(1); SBAR(); GAPA(QKM(2, C0, false), P0[10], P0[11], P0[12], P0[13], pw1[0] = PKW(P0, 8), pw1[1] = PKW(P0, 10), pw1); \
        GAPA(QKM(3, C1, false), P0[14], P0[15], P1[0], P1[1], pw1[2] = PKW(P0, 12), pw1[3] = PKW(P0, 14), pw1); \
        VRD(2); SBAR(); GAPA(QKM(4, C0, false), P1[2], P1[3], P1[4], P1[5], pw2[0] = PKW(P1, 0), pw2[1] = PKW(P1, 2), pw2); \
        GAPA(QKM(5, C1, false), P1[6], P1[7], P1[8], P1[9], pw2[2] = PKW(P1, 4), pw2[3] = PKW(P1, 6), pw2); \
        VRD(3); SBAR(); GAPA(QKM(6, C0, false), P1[10], P1[11], P1[12], P1[13], pw3[0] = PKW(P1, 8), pw3[1] = PKW(P1, 10), pw3); \
        GAPA(QKM(7, C1, false), P1[14], P1[15], 0.f, 0.f, pw3[2] = PKW(P1, 12), pw3[3] = PKW(P1, 14), pw3); \
        if (NK > 8) { _Pragma("unroll") for (int i_ = 8; i_ < NK; i_ += 2) { QKM(i_, C0, false); QKM(i_ + 1, C1, false); } SBAR(); } \
        l += sacc; } while (0)
#define KRD(j) do { kf[2 * (j)] = *(const LAS bf16x8*)(kp0 + knext + (j) * 2048); kf[2 * (j) + 1] = *(const LAS bf16x8*)(kp0 + knext + (j) * 2048 + 512); SBAR(); } while (0)
#define PHASE_B(C0, C1) do { SBAR(); const LAS unsigned char* vp_ = vp0 + vprev; \
        VRD(4); SBAR(); GAPB(o0 = __builtin_amdgcn_mfma_f32_32x32x16_bf16(VFR(0), PAF(0), o0, 0, 0, 0), C0, 0); \
        VRD(5); SBAR(); GAPB(o0 = __builtin_amdgcn_mfma_f32_32x32x16_bf16(VFR(1), PAF(1), o0, 0, 0, 0), C0, 4); \
        VRD(6); SBAR(); KRD(0); GAPB(o0 = __builtin_amdgcn_mfma_f32_32x32x16_bf16(VFR(2), PAF(2), o0, 0, 0, 0), C0, 8); \
        VRD(7); SBAR(); KRD(1); GAPB(o0 = __builtin_amdgcn_mfma_f32_32x32x16_bf16(VFR(3), PAF(3), o0, 0, 0, 0), C0, 12); \
        KRD(2); GAPB(o1 = __builtin_amdgcn_mfma_f32_32x32x16_bf16(VFR(4), PAF(0), o1, 0, 0, 0), C1, 0); \
        KRD(3); GAPB(o1 = __builtin_amdgcn_mfma_f32_32x32x16_bf16(VFR(5), PAF(1), o1, 0, 0, 0), C1, 4); \
        if (NKS > 4) { KRD(4); } GAPB(o1 = __builtin_amdgcn_mfma_f32_32x32x16_bf16(VFR(6), PAF(2), o1, 0, 0, 0), C1, 8); \
        if (NKS > 5) { KRD(5); } GAPB(o1 = __builtin_amdgcn_mfma_f32_32x32x16_bf16(VFR(7), PAF(3), o1, 0, 0, 0), C1, 12); \
        } while (0)
#define DECIDE(C0, C1, tt) do { \
        fix(C0, C1, kt0 + (tt)); \
        float rm_; ROWMAX(C0, C1, rm_); resc = false; \
        const bool up_ = (rm_ > THR) || (l == 0.f && rm_ < -THR && rm_ > NEG_INF); \
        const float nsh_ = (kt0 + (tt) + 1 < near_from) ? bfar : 0.f; \
        if (__any(up_)) { const float dl_ = up_ ? rm_ : __builtin_fmaxf(rm_, 0.f); m += dl_; fpend = __builtin_amdgcn_exp2f(-dl_); l *= fpend; resc = true; \
            _Pragma("unroll") for (int r = 0; r < 16; ++r) { C0[r] -= dl_; C1[r] -= dl_; } \
            csh = nsh_; _Pragma("unroll") for (int r = 0; r < 16; ++r) cin[r] = csh - m; asm volatile("" : "+v"(cin)); } \
        else if (nsh_ != csh) { csh = nsh_; _Pragma("unroll") for (int r = 0; r < 16; ++r) cin[r] = csh - m; asm volatile("" : "+v"(cin)); } } while (0)
#define STEP(C0, C1, P0, P1, tt) do { \
        if (ALT && wid >= 4) asm volatile("s_barrier" ::: "memory"); \
        PHASE_A(C0, C1, P0, P1); \
        src.issueK(TILE((tt) + 4), kring + kcur, wid); src.issueV(TILE((tt) + 2), vring + vnext, wid); \
        DECIDE(C0, C1, tt); \
        PHASE_B(C0, C1); \
        if (ALT && wid < 4) asm volatile("s_waitcnt lgkmcnt(0)\n\ts_barrier" ::: "memory"); \
        wait_bar_n<2 * NDMA>();                                          \
        if (resc) { o0 *= fpend; o1 *= fpend; } \
        kcur = knext; knext = (knext == 3 * KB) ? 0 : knext + KB; \
        vprev = (vprev == 3 * VB) ? 0 : vprev + VB; vnext = (vnext == 3 * VB) ? 0 : vnext + VB; } while (0)
    int t = 1;
    for (; t + 1 < NT; t += 2) { STEP(B0, B1, A0, A1, t); STEP(A0, A1, B0, B1, t + 1); }
    if (t < NT) { STEP(B0, B1, A0, A1, t); A0 = B0; A1 = B1; }
    { float sacc = 0.f;
#pragma unroll
      for (int r = 0; r < 16; ++r) sacc += A0[r] + A1[r];
      l += sacc;
      pw0 = (u32x4){PKW(A0, 0), PKW(A0, 2), PKW(A0, 4), PKW(A0, 6)}; pw1 = (u32x4){PKW(A0, 8), PKW(A0, 10), PKW(A0, 12), PKW(A0, 14)};
      pw2 = (u32x4){PKW(A1, 0), PKW(A1, 2), PKW(A1, 4), PKW(A1, 6)}; pw3 = (u32x4){PKW(A1, 8), PKW(A1, 10), PKW(A1, 12), PKW(A1, 14)};
      const LAS unsigned char* vp_ = vp0 + vprev;
#pragma unroll
      for (int i = 0; i < 8; ++i) VRD(i);
      o0 = __builtin_amdgcn_mfma_f32_32x32x16_bf16(VFR(0), PAF(0), o0, 0, 0, 0); o1 = __builtin_amdgcn_mfma_f32_32x32x16_bf16(VFR(4), PAF(0), o1, 0, 0, 0);
      o0 = __builtin_amdgcn_mfma_f32_32x32x16_bf16(VFR(1), PAF(1), o0, 0, 0, 0); o1 = __builtin_amdgcn_mfma_f32_32x32x16_bf16(VFR(5), PAF(1), o1, 0, 0, 0);
      o0 = __builtin_amdgcn_mfma_f32_32x32x16_bf16(VFR(2), PAF(2), o0, 0, 0, 0); o1 = __builtin_amdgcn_mfma_f32_32x32x16_bf16(VFR(6), PAF(2), o1, 0, 0, 0);
      o0 = __builtin_amdgcn_mfma_f32_32x32x16_bf16(VFR(3), PAF(3), o0, 0, 0, 0); o1 = __builtin_amdgcn_mfma_f32_32x32x16_bf16(VFR(7), PAF(3), o1, 0, 0, 0); }
    wait_bar_n<0>();
    R.m = m; R.l = l; R.o[0] = o0; R.o[1] = o1;
    __builtin_amdgcn_s_setprio(0);
#undef TILE
#undef KLOAD
#undef ROWMAX
#undef DECIDE
#undef PKW
#undef VRD
#undef VFR
#undef PAF
#undef QKM
#undef GAPA
#undef GAPB
#undef PHASE_A
#undef KRD
#undef PHASE_B
#undef STEP
}
#undef SBAR
#undef PIN
#undef MX3
}
constexpr int MLA_STG_OFF = 98304;
__device__ __forceinline__ void p3_mla(const Ptrs& P, LAS unsigned char* lds, int vcu, int G, int tid, int wid) {
    using namespace att;
    for (int L = vcu; L < 2048; L += G) {
        int lane_u = tid & 63; asm volatile("" : "+v"(lane_u));
        const int lane = lane_u, r32 = lane & 31, hi = lane >> 5;
        int bh, qb;
        if (G == 256) { const int i = L >> 8, s8 = vcu & 7; bh = (vcu >> 3) + 32 * (i >> 1); qb = (i & 1) ? 15 - s8 : s8; }
        else { bh = L >> 4; qb = L & 15; }
        const int b = bh >> 3, h = bh & 7; const size_t rowb = (size_t)b * SEQ;
        const int q0 = qb * 256 + wid * 32, t = q0 + r32; const size_t row = rowb + t;
        bf16x8 qr[6];
#pragma unroll
        for (int d0 = 0; d0 < 6; ++d0) qr[d0] = *(const bf16x8*)(P.QM + row * 768 + h * 96 + d0 * 16 + hi * 8);
        SrcMLA src; src.init(P.KVM, P.kpe, rowb, h, wid, lane);
        Row R; row_reset(R);
        auto fix = [&](f32x16& p0, f32x16& p1, int tile) {
            if (tile * 64 + 63 > q0) {
                const int kb = tile * 64 + 4 * hi;
#pragma unroll
                for (int r = 0; r < 16; ++r) { const int kv = kb + (r & 3) + 8 * (r >> 2); if (kv > t) p0[r] = NEG_INF; if (kv + 32 > t) p1[r] = NEG_INF; } } };
        run_pipe(lds, src, 0, 4 * qb + 4, qr, R, fix, 0.f, 0x7fffffff, wid, lane);
        const float inv = 1.0f / swap_sum(R.l); float ss = 0.f;
        { bf16* const ob = P.ATT + (rowb + q0) * 1024 + h * 64;
          store_rows(lds + MLA_STG_OFF + wid * 4608, R.o[0], R.o[1], inv, ss, lane, [&](int r) -> bf16* { return ob + (size_t)r * 1024; }); }
        ss = swap_sum(ss);
        if (hi == 0) P.ssatt[row * 16 + h] = ss;
    }
}

constexpr int NSA_LB_OFF = 81920;
constexpr int NSA_OUT_OFF = 86016;
__device__ __forceinline__ float dpp_xor1(float x) { return __builtin_bit_cast(float, __builtin_amdgcn_update_dpp(0, __builtin_bit_cast(int, x), 0xB1, 0xF, 0xF, false)); }
__device__ __forceinline__ float dpp_xor2(float x) { return __builtin_bit_cast(float, __builtin_amdgcn_update_dpp(0, __builtin_bit_cast(int, x), 0x4E, 0xF, 0xF, false)); }
__device__ __forceinline__ unsigned dpp_xor1u(unsigned x) { return (unsigned)__builtin_amdgcn_update_dpp(0, (int)x, 0xB1, 0xF, 0xF, false); }
__device__ __forceinline__ unsigned dpp_xor2u(unsigned x) { return (unsigned)__builtin_amdgcn_update_dpp(0, (int)x, 0x4E, 0xF, 0xF, false); }
template <int STEP, int YOFF> __device__ __forceinline__ void add_bias(att::f32x16& p, const LAS float* lb, int D) {
#pragma unroll
    for (int r = 0; r < 16; ++r) { int d = D - STEP * ((r & 3) + 8 * (r >> 2) + YOFF); d = d < 0 ? 0 : (d > 127 ? 127 : d); p[r] += lb[d]; }
}
__device__ __forceinline__ void p3_nsa(const Ptrs& P, LAS unsigned char* lds, int vcu, int G, int tid, int wid) {
    using namespace att;
    LAS float* LB = (LAS float*)(lds + NSA_LB_OFF);
    for (int e = tid; e < 1024; e += NTHR) LB[e] = P.bias[e];
    __syncthreads();
    for (int L = vcu; L < 2048; L += G) {
        int bhk, c;
        if (G == 256) { const int i = L >> 8, sub = vcu & 7; bhk = vcu >> 3; const int base = 16 * (i >> 1); c = (i & 1) ? base + 15 - sub : base + sub; }
        else { bhk = L >> 6; c = L & 63; }
        int lane_u = tid & 63; asm volatile("" : "+v"(lane_u));
        const int lane = lane_u, r32 = lane & 31, hi = lane >> 5, ql = r32 >> 2, g = r32 & 3;
        const int b = bhk >> 1, hk = bhk & 1, hq = hk * 4 + g; const size_t rowb = (size_t)b * SEQ;
        const int t = c * 64 + wid * 8 + ql; const size_t row = rowb + t;
        const LAS float* lb = LB + hq * 128; const float b31 = lb[127];
        bf16x8 qr[4];
#pragma unroll
        for (int d0 = 0; d0 < 4; ++d0) qr[d0] = *(const bf16x8*)(P.U + row * DINP + C_QN + hq * 64 + d0 * 16 + hi * 8);
        float gate[3];
#pragma unroll
        for (int br = 0; br < 3; ++br) { const float x = bf2f(P.U[row * DINP + C_GATE + hq * 3 + br]); gate[br] = __builtin_amdgcn_rcpf(1.0f + __builtin_amdgcn_exp2f(-x * LOG2E)); }
        LAS float* outp = (LAS float*)(lds + NSA_OUT_OFF) + wid * 2048 + lane;
        unsigned mlo, mhi;
        {
            const int nv = t >= 31 ? ((t - 31) >> 4) + 1 : 0;
            int ln = lane_u; asm volatile("" : "+v"(ln));
            SrcCmp src; src.init(P.kcmp + (size_t)bhk * 256 * 64, P.vcmp + (size_t)bhk * 256 * 64, P.ovt, wid, ln);
            RowT<2> R; row_reset(R);
            auto fix = [&](f32x16& p0, f32x16& p1, int tile) {
                const int D = t - 31 - 16 * (64 * tile + 4 * hi);
                add_bias<16, 0>(p0, lb, D); add_bias<16, 32>(p1, lb, D);
                const int ib = 64 * tile + 4 * hi;
#pragma unroll
                for (int r = 0; r < 16; ++r) { const int i = ib + (r & 3) + 8 * (r >> 2); if (i >= nv) p0[r] = NEG_INF; if (i + 32 >= nv) p1[r] = NEG_INF; } };
            auto skip = [&](int) -> bool { return false; };
            run_tiles(lds, src, 0, (4 * c + 3 + 63) >> 6, qr, R, fix, skip, wid, lane);
            const float lt = swap_sum(R.l); const float inv = lt > 0.f ? 1.0f / lt : 0.f;
            { const float f = gate[0] * inv;
#pragma unroll
              for (int i = 0; i < 16; ++i) { outp[64 * i] = R.o[0][i] * f; outp[64 * (16 + i)] = R.o[1][i] * f; } }
            mlo = 0u; mhi = 0u;
            if (c <= 15) { const unsigned long long mk = (2ull << c) - 1ull; mlo = (unsigned)mk; mhi = (unsigned)(mk >> 32); }
            else {
                float cand[8];
#pragma unroll
                for (int rr = 0; rr < 8; ++rr) {
                    float v00 = R.o[2][rr] * inv, v01 = R.o[2][8 + rr] * inv, v10 = R.o[3][rr] * inv, v11 = R.o[3][8 + rr] * inv;
                    v00 += dpp_xor1(v00); v00 += dpp_xor2(v00); v01 += dpp_xor1(v01); v01 += dpp_xor2(v01); v10 += dpp_xor1(v10); v10 += dpp_xor2(v10); v11 += dpp_xor1(v11); v11 += dpp_xor2(v11);
                    cand[rr] = (g & 2) ? ((g & 1) ? v11 : v10) : ((g & 1) ? v01 : v00); }
                unsigned key[8];
#pragma unroll
                for (int rr = 0; rr < 8; ++rr) { const int j = 32 * (g >> 1) + (rr & 3) + 8 * (2 * (g & 1) + (rr >> 2)) + 4 * hi;
                    const bool ok = j >= 1 && j <= c - 2; key[rr] = ok ? ((__float_as_uint(fmaxf(cand[rr], 0.f)) & ~63u) | (unsigned)(63 - j)) : 0u; }
                unsigned long long mk = 1ull | (1ull << c) | (1ull << (c - 1));
                for (int round = 0; round < 13; ++round) {
                    unsigned best = key[0];
#pragma unroll
                    for (int rr = 1; rr < 8; ++rr) best = best > key[rr] ? best : key[rr];
                    { const unsigned o1 = dpp_xor1u(best); best = best > o1 ? best : o1; const unsigned o2 = dpp_xor2u(best); best = best > o2 ? best : o2;
                      auto rr2 = __builtin_amdgcn_permlane32_swap(best, best, false, false); best = rr2[0] > rr2[1] ? rr2[0] : rr2[1]; }
                    if (best != 0u) mk |= 1ull << (63u - (best & 63u));
#pragma unroll
                    for (int rr = 0; rr < 8; ++rr) key[rr] = (key[rr] == best) ? 0u : key[rr];
                }
                mlo = (unsigned)mk; mhi = (unsigned)(mk >> 32);
            }
        }
        {
            int ln = lane_u; asm volatile("" : "+v"(ln));
            SrcRows src; src.init(P.U + rowb * DINP + C_KVS + hk * 64, P.U + rowb * DINP + C_KVS + 128 + hk * 64, DINP, wid, ln);
            Row R; row_reset(R);
            auto fix = [&](f32x16& p0, f32x16& p1, int tile) {
                if (tile >= c - 2) { const int D = t - 64 * tile - 4 * hi; add_bias<1, 0>(p0, lb, D); asm volatile("" ::: "memory"); add_bias<1, 32>(p1, lb, D); }
                const bool sel = ((tile < 32 ? (mlo >> tile) : (mhi >> (tile - 32))) & 1u) != 0u;
                if (tile == c) { const int kb = tile * 64 + 4 * hi;
#pragma unroll
                    for (int r = 0; r < 16; ++r) { const int kv = kb + (r & 3) + 8 * (r >> 2); if (kv > t || !sel) p0[r] = NEG_INF; if (kv + 32 > t || !sel) p1[r] = NEG_INF; } }
                else if (!sel) {
#pragma unroll
                    for (int r = 0; r < 16; ++r) { p0[r] = NEG_INF; p1[r] = NEG_INF; } } };
            run_pipe(lds, src, 0, c + 1, qr, R, fix, b31, c - 2, wid, lane);
            const float f = gate[1] / swap_sum(R.l);
#pragma unroll
            for (int i = 0; i < 16; ++i) { outp[64 * i] += R.o[0][i] * f; outp[64 * (16 + i)] += R.o[1][i] * f; }
        }
        f32x16 out[2];
        {
            int ln = lane_u; asm volatile("" : "+v"(ln));
            SrcRows src; src.init(P.U + rowb * DINP + C_KVW + hk * 64, P.U + rowb * DINP + C_KVW + 128 + hk * 64, DINP, wid, ln);
            Row R; row_reset(R);
            auto fix = [&](f32x16& p0, f32x16& p1, int tile) {
                if (tile >= c - 2) { const int D = t - 64 * tile - 4 * hi; add_bias<1, 0>(p0, lb, D); asm volatile("" ::: "memory"); add_bias<1, 32>(p1, lb, D); }
                if (tile == c || tile == c - 8) { const int kb = tile * 64 + 4 * hi;
#pragma unroll
                    for (int r = 0; r < 16; ++r) { const int kv = kb + (r & 3) + 8 * (r >> 2); const int d0_ = t - kv, d1_ = d0_ - 32;
                        if (d0_ < 0 || d0_ >= 512) p0[r] = NEG_INF; if (d1_ < 0 || d1_ >= 512) p1[r] = NEG_INF; } } };
            run_pipe(lds, src, c >= 8 ? c - 8 : 0, c + 1, qr, R, fix, b31, c - 2, wid, lane);
            const float f = gate[2] / swap_sum(R.l);
#pragma unroll
            for (int i = 0; i < 16; ++i) { out[0][i] = outp[64 * i] + R.o[0][i] * f; out[1][i] = outp[64 * (16 + i)] + R.o[1][i] * f; }
        }
        { float ss = 0.f; bf16* const ob = P.ATT + (rowb + c * 64 + wid * 8) * 1024 + 512 + hk * 256;
            store_rows(lds + NSA_OUT_OFF + wid * 8192, out[0], out[1], 1.0f, ss, lane, [&](int r) -> bf16* { return ob + (size_t)(r >> 2) * 1024 + (r & 3) * 64; });
            ss = swap_sum(ss);
            if (hi == 0) P.ssatt[row * 16 + 8 + hq] = ss; }
    }
}

__global__ void __launch_bounds__(NTHR, 2) mega_fwd(Args args) {
    extern __shared__ __attribute__((aligned(16))) unsigned char lds_raw[];
    LAS unsigned char* lds = (LAS unsigned char*)lds_raw;
    volatile LAS unsigned* MISC = (volatile LAS unsigned*)(lds + MISC_OFF);
    const int tid0 = threadIdx.x;
#define LAUNDER_TID() int tid = tid0; asm volatile("" : "+v"(tid)); const int lane = tid & 63, wave = __builtin_amdgcn_readfirstlane(tid >> 6); (void)lane; (void)wave
    const int G = gridDim.x, wg = blockIdx.x;
    const int vcu = (G % 8 == 0) ? (wg % 8) * (G / 8) + wg / 8 : wg;
    unsigned char* ws = args.ws;
    Ptrs P;
#pragma unroll
    for (int i = 0; i < 22; ++i) P.in[i] = args.in[i];
    P.out = args.out; P.ws = ws;
    P.Win = (bf16*)(ws + WS_WIN); P.Wuq = (bf16*)(ws + WS_WUQ); P.Wukv = (bf16*)(ws + WS_WUKV); P.Wout = (bf16*)(ws + WS_WOUT); P.Wgu = (bf16*)(ws + WS_WGU); P.Wdn = (bf16*)(ws + WS_WDN);
    P.rope = (f32x2v*)(ws + WS_ROPE); P.bias = (float*)(ws + WS_BIAS); P.bias1 = (float*)(ws + WS_BIAS1); P.rstdx = (float*)(ws + WS_RSTDX);
    P.ssqkv = (float*)(ws + WS_SSQKV); P.ssatt = (float*)(ws + WS_SSATT); P.ssh = (float*)(ws + WS_SSH);
    P.kcmp = (bf16*)(ws + WS_KCMP); P.vcmp = (bf16*)(ws + WS_VCMP); P.kpe = (bf16*)(ws + WS_KPE); P.ovt = (bf16*)(ws + WS_OVT); P.W1c = (bf16*)(ws + WS_W1C); P.W2t = (bf16*)(ws + WS_W2T);
    P.XB = (bf16*)(ws + WS_XB); P.U = (bf16*)(ws + WS_U); P.QM = (bf16*)(ws + WS_QM); P.KVM = (bf16*)(ws + WS_KVM); P.ATT = (bf16*)(ws + WS_ATT); P.H = (bf16*)(ws + WS_H); P.HID = (bf16*)(ws + WS_HID);
    gu32* ctl = (gu32*)(ws + WS_CTL);

    if (tid0 < 64) MISC[tid0] = 0u;
    __syncthreads();
    XcdBarrier bar; bar.bar = (unsigned*)(ctl + CW_BAR); bar.x = 0; bar.st = nullptr;
    if (N_LAUNCHES == 1) bar = xcd_barrier_post((unsigned*)(ctl + CW_BAR), MISC + 8);
#define GRID_BAR() do { if (N_LAUNCHES == 1) xcd_barrier(bar); } while (0)
    const int lo = args.ph_lo, hi = args.ph_hi;
#ifndef PHASE_MASK
#define PHASE_MASK 0xff
#endif
#define IN(k) (((PHASE_MASK >> (k)) & 1) && lo <= (k) && (k) < hi)
#define BOTH(k) (IN(k) && IN((k) + 1))
#ifndef REPEAT_MASK
#define REPEAT_MASK 0
#endif
#define REP(k) for (int rep_ = 0; rep_ < (((REPEAT_MASK >> (k)) & 1) ? 2 : 1); ++rep_)

    if (IN(0)) { REP(0) { LAUNDER_TID(); p0_prologue(P, lds, wg, G, wave, lane, tid); } if (BOTH(0)) GRID_BAR(); }

    if (IN(1)) {
        REP(1) {
        pg8::Gemm g{P.XB, P.Win, MT, DINP, 1024, 1024, 1024, 0}; pg8::StaticOrder S; S.init(MT, DINP, G, wg);
        EpiInProj E{P.U, P.rstdx, P.ssqkv};
        pg8::gemm_phase<EpiInProj, pg8::StaticOrder, true, true>(lds, g, S, E); }
        if (BOTH(1)) GRID_BAR();
    }

    if (IN(2)) {
        REP(2) {
        { LAUNDER_TID(); p2_kpe(P, wg, G, tid); }
        { pg8::Gemm g{P.U, P.W1c, 64 * 256, 256, 1024, 16 * DINP, 1024, DINP * 2}; CmpOrder S{G, wg, P.U, P.W1c};
          EpiCmp E{P.bias1, P.W2t, P.kcmp, P.vcmp};
          pg8::gemm_phase<EpiCmp, CmpOrder, false, true>(lds, g, S, E); }
        { const int gq = G > 64 ? G - 64 : G, cq = G > 64 ? wg - 64 : wg;
          if (cq >= 0) { pg8::Gemm g{P.U + C_CQ, P.Wuq, MT, 768, 256, DINP, 256, 0}; pg8::StaticOrder S; S.init(MT, 768, gq, cq);
            EpiQup E{P.QM, P.ssqkv, P.rope};
            pg8::gemm_phase<EpiQup, pg8::StaticOrder, true, true>(lds, g, S, E); } }
        { pg8::Gemm g{P.U + C_CKV, P.Wukv, MT, 1024, 128, DINP, 256, 0}; pg8::StaticOrder S; S.init(MT, 1024, G, wg);
          EpiKVup E{P.KVM, P.ssqkv};
          pg8::gemm_phase<EpiKVup, pg8::StaticOrder, true, true>(lds, g, S, E); }
        }
        if (BOTH(2)) GRID_BAR();
    }

    if (IN(3)) {
        REP(3) {
        REP(8) { LAUNDER_TID(); p3_mla(P, lds, vcu, G, tid, wave); }
        REP(9) { LAUNDER_TID(); p3_nsa(P, lds, vcu, G, tid, wave); }
        }
        if (BOTH(3)) GRID_BAR();
    }

    if (IN(4)) {
        REP(4) {
        { pg8::Gemm g{P.ATT, P.Wout, MT, 1024, 1024, 1024, 1024, 0}; OutOrder S; S.init(MT, 1024, G, wg); S.ssatt = P.ssatt; S.tab = (LAS float*)(lds + OUT_TAB_OFF);
          EpiOut E{P.XB, P.H, P.ssh, (const LAS float*)(lds + OUT_TAB_OFF)};
          pg8::gemm_phase<EpiOut, OutOrder, true, true>(lds, g, S, E); }
        }
        if (BOTH(4)) GRID_BAR();
    }

    if (IN(5)) {
        REP(5) {
        pg8::Gemm g{P.H, P.Wgu, MT, NGU, 1024, 1024, 1024, 0}; GUOrder S; S.init(MT, NGU, G, wg); S.ssh = P.ssh; S.tab = (LAS float*)(lds + OUT_TAB_OFF);
        EpiGU E{P.HID, (const LAS float*)(lds + OUT_TAB_OFF)};
        pg8::gemm_phase<EpiGU, GUOrder, true, true>(lds, g, S, E); }
        if (BOTH(5)) GRID_BAR();
    }

    if (IN(6)) {
        REP(6) {
        pg8::Gemm g{P.HID, P.Wdn, MT, 1024, DFF, DFF, DFF, 0}; pg8::StaticOrder S; S.init(MT, 1024, G, wg);
        EpiDown E{P.H, P.ATT, P.ssatt};
        pg8::gemm_phase<EpiDown, pg8::StaticOrder, true, true>(lds, g, S, E); }
        if (BOTH(6)) GRID_BAR();
    }

    if (IN(7)) { LAUNDER_TID(); p7_final(P, wg, G, wave, lane); }
#undef IN
#undef BOTH
#undef GRID_BAR
}

extern "C" void kernel_launch(void* const* d_in, const int* in_sizes, int n_in, void* d_out, int out_size, void* d_ws, size_t ws_size, hipStream_t stream) {
    static int grid = 0;
    if (grid == 0) {
        if (n_in != 22 || in_sizes[0] != MT * DM || out_size != MT * DM || ws_size < WS_END) { fprintf(stderr, "kernel_launch: unexpected shapes (n_in %d, in0 %d, out %d, ws %zu); nothing launched\n", n_in, n_in > 0 ? in_sizes[0] : -1, out_size, ws_size); grid = -1; return; }
        int dev = 0, cus = 0, per_cu = 0;
        if (hipGetDevice(&dev) != hipSuccess || hipDeviceGetAttribute(&cus, hipDeviceAttributeMultiprocessorCount, dev) != hipSuccess) { fprintf(stderr, "kernel_launch: device query failed\n"); grid = -1; return; }
        if (hipFuncSetAttribute((const void*)mega_fwd, hipFuncAttributeMaxDynamicSharedMemorySize, LDS_BYTES) != hipSuccess) { fprintf(stderr, "kernel_launch: hipFuncSetAttribute failed\n"); grid = -1; return; }
        if (hipOccupancyMaxActiveBlocksPerMultiprocessor(&per_cu, (const void*)mega_fwd, NTHR, LDS_BYTES) != hipSuccess || per_cu < 1)
            fprintf(stderr, "kernel_launch: note: occupancy query reports %d workgroups per CU\n", per_cu);
        (void)hipGetLastError();
        grid = cus;
    }
    if (grid < 0) return;
    if (hipMemsetAsync((char*)d_ws + WS_CTL, 0, CTL_ZERO_BYTES, stream) != hipSuccess) { fprintf(stderr, "kernel_launch: memset failed\n"); return; }
    Args a{};
    for (int i = 0; i < 22; ++i) a.in[i] = (const float*)d_in[i];
    a.out = (float*)d_out; a.ws = (unsigned char*)d_ws;
    for (int li = 0; li < N_LAUNCHES; ++li) {
        a.ph_lo = (N_LAUNCHES == 1) ? 0 : li; a.ph_hi = (N_LAUNCHES == 1) ? NPHASE : li + 1; a.li = li; a.pad = 0;
        hipLaunchKernelGGL(mega_fwd, dim3(grid), dim3(NTHR), LDS_BYTES, stream, a);
        const hipError_t le = hipPeekAtLastError();
        if (le != hipSuccess) { fprintf(stderr, "kernel_launch: launch %d failed: %s\n", li, hipGetErrorName(le)); break; }
    }
}
```

```cpp
#include <hip/hip_runtime.h>
#include <cstdio>
#include <cstdint>
namespace pg8 {
#define PG8_LAS __attribute__((address_space(3)))
typedef unsigned short bf16_t;
typedef short bf16x8 __attribute__((ext_vector_type(8)));
typedef float f32x4 __attribute__((ext_vector_type(4)));
typedef unsigned u32x4 __attribute__((ext_vector_type(4)));
constexpr int BM = 256, BK = 64, HALF = 128, HTB = HALF * BK * 2  , STAGE_BYTES = 8 * HTB, NXCD = 8, WGM = 8;

__host__ __device__ __forceinline__ int lds_byte(int r, int c) { const int st = (r >> 4) * 2 + (c >> 5), rr = r & 15, cc = c & 31, ob = rr * 64 + cc * 2; return st * 1024 + (ob ^ (((ob >> 9) & 1) << 5)); }
__host__ __device__ __forceinline__ void stage_rc(int b, int& R, int& C) { const int st = b / 1024, sb = b % 1024, swz = sb ^ (((sb >> 9) & 1) << 5); R = (st >> 1) * 16 + swz / 64; C = (st & 1) * 32 + (swz % 64) / 2; }
__host__ __device__ __forceinline__ int perm32(int rho) { const int n = rho >> 4, i = rho & 15; return 8 * (i >> 2) + 4 * n + (i & 3); }

struct Unit { int pm, pn, ui; };
struct Gemm { const bf16_t* A; const bf16_t* Bt; int M, N, K, lda, ldb, kstepA; };

struct StaticOrder {
    int nM, nN, nwg, G, c;
    __host__ __device__ void init(int M, int N, int G_, int c_) { nM = M / BM; nN = N / BM; nwg = nM * nN; G = G_; c = c_; }
    __host__ __device__ bool next(int i, Unit& u) const {
        const long L = (long)i * G + c; if (L >= nwg) return false;
        int wgid = (int)L; { const int q = nwg / NXCD, r = nwg % NXCD, xcd = wgid % NXCD, off = wgid / NXCD; wgid = (xcd < r ? xcd * (q + 1) : r * (q + 1) + (xcd - r) * q) + off; }
        const int nig = WGM * nN, gid = wgid / nig, fm = gid * WGM, gsz = (nM - fm) < WGM ? (nM - fm) : WGM;
        u.pm = fm + ((wgid % nig) % gsz); u.pn = (wgid % nig) / gsz; u.ui = i; return true;
    }
    __device__ __forceinline__ void a_ready(const Unit&) const {}
    __device__ __forceinline__ void done(const Unit&) const {}
    __device__ __forceinline__ const char* a_base(const Gemm& g, const Unit& u, size_t tstepA) const { return (const char*)g.A + (size_t)u.pm * tstepA; }
    __device__ __forceinline__ const char* b_base(const Gemm& g, const Unit& u, size_t tstepB) const { return (const char*)g.Bt + (size_t)u.pn * tstepB; }
};

__device__ __forceinline__ unsigned cvt_pk_bf16(float lo, float hi) { unsigned r; asm volatile("v_cvt_pk_bf16_f32 %0, %1, %2" : "=v"(r) : "v"(lo), "v"(hi)); return r; }
typedef float f32x2 __attribute__((ext_vector_type(2)));
template <class Epi, class Sched, bool ALIGN_EPI = false, bool SP2 = false>
__device__ __forceinline__ void gemm_phase(PG8_LAS unsigned char* lds, const Gemm g, const Sched& S, const Epi& E) {
    int tid_ = threadIdx.x; asm volatile("" : "+v"(tid_));
    const int tid = tid_, wid = __builtin_amdgcn_readfirstlane(tid >> 6), lane = tid & 63, wr = wid >> 2, wc = wid & 3, fr = lane & 15, fq = lane >> 4;
    const int K = g.K, nt = K / BK;
    unsigned voffA[2], voffB[2];
#pragma unroll
    for (int i = 0; i < 2; ++i) { int R, C; stage_rc(tid * 16 + i * 8192, R, C); const int Rb = Epi::PERM ? ((R & ~31) + perm32(R & 31)) : R;
        voffA[i] = (unsigned)(R * g.lda + C) * 2u; voffB[i] = (unsigned)(Rb * g.ldb + C) * 2u; }
    const size_t kstepA = g.kstepA ? (size_t)g.kstepA : (size_t)(BK * 2), kstepB = (size_t)(BK * 2);
    const size_t hstepA = (size_t)HALF * g.lda * 2, hstepB = (size_t)HALF * g.ldb * 2;
    const size_t tstepA = 2 * hstepA, tstepB = 2 * hstepB;
    const unsigned ldsw = (unsigned)wid * 1024u;
    const int aoff = lds_byte(wr * 64 + fr, fq * 8), boff = lds_byte(wc * 32 + fr, fq * 8);
#define PG8_SA(b, h) (((b) * 2 + (h)) * HTB)
#define PG8_SB(b, h) ((4 + (b) * 2 + (h)) * HTB)
#define PG8_STAGE(bufoff, gbase, voff) do { _Pragma("unroll") for (int _i = 0; _i < 2; ++_i) \
        __builtin_amdgcn_global_load_lds((const unsigned*)((const char*)(gbase) + (voff)[_i]), (PG8_LAS unsigned*)(lds + (bufoff) + ldsw + _i * 8192), 16, 0, 0); } while (0)
#define PG8_LDA(dst, b, h) do { _Pragma("unroll") for (int m = 0; m < 4; ++m) _Pragma("unroll") for (int k = 0; k < 2; ++k) dst[m][k] = *(const PG8_LAS bf16x8*)(lds + PG8_SA(b, h) + aoff + m * 2048 + k * 1024); } while (0)
#define PG8_LDB(dst, b, h) do { _Pragma("unroll") for (int n = 0; n < 2; ++n) _Pragma("unroll") for (int k = 0; k < 2; ++k) dst[n][k] = *(const PG8_LAS bf16x8*)(lds + PG8_SB(b, h) + boff + n * 2048 + k * 1024); } while (0)
#define PG8_MMA(ai, bj, At, Bt) do { __builtin_amdgcn_s_setprio(1); _Pragma("unroll") for (int m = 0; m < 4; ++m) _Pragma("unroll") for (int n = 0; n < 2; ++n) _Pragma("unroll") for (int k = 0; k < 2; ++k) \
        acc[ai][bj][m][n] = __builtin_amdgcn_mfma_f32_16x16x32_bf16(Bt[n][k], At[m][k], acc[ai][bj][m][n], 0, 0, 0); __builtin_amdgcn_s_setprio(0); } while (0)
#define PG8_WAIT_V(n) asm volatile("s_waitcnt vmcnt(" #n ")" ::: "memory")
#define PG8_WAIT_L(n) asm volatile("s_waitcnt lgkmcnt(" #n ")" ::: "memory")
#define PG8_BAR __builtin_amdgcn_s_barrier()
#define PG8_SCHED __builtin_amdgcn_sched_barrier(0)
    Unit cur, nxt; int ui = 0;
    if (!S.next(0, cur)) return;
    f32x4 acc[2][2][4][2];
#pragma unroll
    for (int a = 0; a < 2; ++a)
#pragma unroll
        for (int b = 0; b < 2; ++b)
#pragma unroll
            for (int m = 0; m < 4; ++m)
#pragma unroll
                for (int n = 0; n < 2; ++n) acc[a][b][m][n] = (f32x4){0.f, 0.f, 0.f, 0.f};
    bf16x8 At[4][2], B0[2][2], B1[2][2];
    const char* cA = S.a_base(g, cur, tstepA); const char* cB = S.b_base(g, cur, tstepB);
    S.a_ready(cur);
    if constexpr (SP2) {
        PG8_STAGE(PG8_SB(0, 0), cB, voffB); PG8_STAGE(PG8_SB(0, 1), cB + hstepB, voffB); PG8_STAGE(PG8_SA(0, 0), cA, voffA); PG8_STAGE(PG8_SA(0, 1), cA + hstepA, voffA);
        if (wr == 1) PG8_BAR;
        PG8_WAIT_V(2); PG8_BAR;
        PG8_STAGE(PG8_SB(1, 0), cB + kstepB, voffB); PG8_STAGE(PG8_SA(1, 0), cA + kstepA, voffA); PG8_STAGE(PG8_SB(1, 1), cB + hstepB + kstepB, voffB);
        PG8_WAIT_V(6); PG8_BAR;
    } else {
        PG8_STAGE(PG8_SB(0, 0), cB, voffB); PG8_STAGE(PG8_SA(0, 0), cA, voffA); PG8_STAGE(PG8_SB(0, 1), cB + hstepB, voffB); PG8_STAGE(PG8_SA(0, 1), cA + hstepA, voffA);
        if (wr == 1) PG8_BAR;
        PG8_WAIT_V(4); PG8_BAR;
        PG8_STAGE(PG8_SB(1, 0), cB + kstepB, voffB); PG8_STAGE(PG8_SA(1, 0), cA + kstepA, voffA); PG8_STAGE(PG8_SB(1, 1), cB + hstepB + kstepB, voffB);
        PG8_WAIT_V(6); PG8_BAR;
    }
    for (;;) {
        const bool has_next = S.next(ui + 1, nxt);
        const char* nA = has_next ? S.a_base(g, nxt, tstepA) : cA; const char* nB = has_next ? S.b_base(g, nxt, tstepB) : cB;
        for (int t = 0; t < nt; t += 2) {
            if constexpr (Epi::MIDK) { if (t == (nt >> 1)) E.midk(acc, cur, wr, fr); }
            const bool last = (t == nt - 2);
            const char* a1 = cA + (size_t)(t + 1) * kstepA;
            const char* a2 = last ? nA : cA + (size_t)(t + 2) * kstepA; const char* b2 = last ? nB : cB + (size_t)(t + 2) * kstepB;
            const char* a3 = a2 + kstepA; const char* b3 = b2 + kstepB;
            if (last && has_next) S.a_ready(nxt);
            if constexpr (SP2) {
            PG8_LDB(B0, 0, 0); PG8_LDB(B1, 0, 1); PG8_SCHED; PG8_LDA(At, 0, 0); PG8_STAGE(PG8_SA(1, 1), a1 + hstepA, voffA);
            PG8_WAIT_V(8); PG8_WAIT_L(0); PG8_BAR; PG8_MMA(0, 0, At, B0); PG8_MMA(0, 1, At, B1); PG8_BAR; PG8_SCHED;
            PG8_LDA(At, 0, 1); PG8_STAGE(PG8_SB(0, 0), b2, voffB); PG8_STAGE(PG8_SB(0, 1), b2 + hstepB, voffB); PG8_STAGE(PG8_SA(0, 0), a2, voffA);
            PG8_WAIT_V(8); PG8_WAIT_L(0); PG8_BAR; PG8_MMA(1, 0, At, B0); PG8_MMA(1, 1, At, B1); PG8_BAR; PG8_SCHED;
            PG8_LDB(B0, 1, 0); PG8_LDB(B1, 1, 1); PG8_SCHED; PG8_LDA(At, 1, 0); PG8_STAGE(PG8_SA(0, 1), a2 + hstepA, voffA);
            PG8_WAIT_V(8); PG8_WAIT_L(0); PG8_BAR; PG8_MMA(0, 0, At, B0); PG8_MMA(0, 1, At, B1); PG8_BAR; PG8_SCHED;
            PG8_LDA(At, 1, 1); PG8_STAGE(PG8_SB(1, 0), b3, voffB); PG8_STAGE(PG8_SB(1, 1), b3 + hstepB, voffB); PG8_STAGE(PG8_SA(1, 0), a3, voffA);
            PG8_WAIT_V(8); PG8_WAIT_L(0); PG8_BAR; PG8_MMA(1, 0, At, B0); PG8_MMA(1, 1, At, B1); PG8_BAR; PG8_SCHED;
            } else {
            PG8_LDB(B0, 0, 0); PG8_SCHED; PG8_LDA(At, 0, 0); PG8_STAGE(PG8_SA(1, 1), a1 + hstepA, voffA);
            PG8_WAIT_L(8); PG8_BAR; PG8_WAIT_L(0); PG8_MMA(0, 0, At, B0); PG8_BAR; PG8_SCHED;
            PG8_LDB(B1, 0, 1); PG8_STAGE(PG8_SB(0, 0), b2, voffB);
            PG8_BAR; PG8_WAIT_L(0); PG8_MMA(0, 1, At, B1); PG8_BAR;
            PG8_LDA(At, 0, 1); PG8_STAGE(PG8_SA(0, 0), a2, voffA);
            PG8_BAR; PG8_WAIT_L(0); PG8_MMA(1, 0, At, B0); PG8_BAR; PG8_SCHED;
            PG8_STAGE(PG8_SB(0, 1), b2 + hstepB, voffB);
            PG8_WAIT_V(6); PG8_BAR; PG8_MMA(1, 1, At, B1); PG8_BAR;
            PG8_LDB(B0, 1, 0); PG8_SCHED; PG8_LDA(At, 1, 0); PG8_STAGE(PG8_SA(0, 1), a2 + hstepA, voffA);
            PG8_WAIT_L(8); PG8_BAR; PG8_WAIT_L(0); PG8_MMA(0, 0, At, B0); PG8_BAR; PG8_SCHED;
            PG8_LDB(B1, 1, 1); PG8_STAGE(PG8_SB(1, 0), b3, voffB);
            PG8_BAR; PG8_WAIT_L(0); PG8_MMA(0, 1, At, B1); PG8_BAR;
            PG8_LDA(At, 1, 1); PG8_STAGE(PG8_SA(1, 0), a3, voffA);
            PG8_BAR; PG8_WAIT_L(0); PG8_MMA(1, 0, At, B0); PG8_BAR; PG8_SCHED;
            PG8_STAGE(PG8_SB(1, 1), b3 + hstepB, voffB);
            PG8_WAIT_V(6); PG8_BAR; PG8_MMA(1, 1, At, B1); PG8_BAR;
            }
        }
        if constexpr (ALIGN_EPI) { if (wr == 0) PG8_BAR; }
        if constexpr (!Epi::AFTER_DRAIN) { E(acc, cur, wr, wc, fr, fq); S.done(cur); }
        if (!has_next) break;
#pragma unroll
        for (int a = 0; a < 2; ++a)
#pragma unroll
            for (int b = 0; b < 2; ++b)
#pragma unroll
                for (int m = 0; m < 4; ++m)
#pragma unroll
                    for (int n = 0; n < 2; ++n) acc[a][b][m][n] = (f32x4){0.f, 0.f, 0.f, 0.f};
        cur = nxt; cA = nA; cB = nB; ++ui;
        if constexpr (ALIGN_EPI) { if (wr == 1) PG8_BAR; }
    }
    PG8_WAIT_V(0);
    if constexpr (!ALIGN_EPI) { if (wr == 0) PG8_BAR; }
    PG8_BAR;
    if constexpr (Epi::AFTER_DRAIN) { E.fused(acc, cur, wr, wc, fr, fq, lds, wid, lane); S.done(cur); }
#undef PG8_SA
#undef PG8_SB
#undef PG8_STAGE
#undef PG8_LDA
#undef PG8_LDB
#undef PG8_MMA
#undef PG8_WAIT_V
#undef PG8_WAIT_L
#undef PG8_BAR
#undef PG8_SCHED
}
}
#define GAS __attribute__((address_space(1)))
#define LAS __attribute__((address_space(3)))
typedef unsigned short bf16;
typedef unsigned v4u __attribute__((ext_vector_type(4)));
typedef float f32x4 __attribute__((ext_vector_type(4)));
typedef short bf16x8 __attribute__((ext_vector_type(8)));
typedef GAS unsigned gu32;
typedef GAS unsigned long long gu64;
#define RLX_AGENT __ATOMIC_RELAXED, __HIP_MEMORY_SCOPE_AGENT
#define LDS_WAIT() asm volatile("s_waitcnt lgkmcnt(0)" ::: "memory")
#define VM_WAIT() asm volatile("s_waitcnt vmcnt(0)" ::: "memory")
__device__ __forceinline__ unsigned long long rt() { return __builtin_amdgcn_s_memrealtime(); }
__device__ __forceinline__ unsigned f2bf(float f) { unsigned u = __builtin_bit_cast(unsigned, f); return (u + 0x7fffu + ((u >> 16) & 1u)) >> 16; }
__device__ __forceinline__ unsigned pk2(float lo, float hi) { return pg8::cvt_pk_bf16(lo, hi); }

#define XB_TMO      128
#define XB_XCNT(j)  (256  + 64 * (j))
#define XB_XSUB(j)  (1280 + 64 * (j))
#define XB_XGEN(j)  (2304 + 64 * (j))
#define XB_TOP      3328
#define XB_TOPGEN   3392
#define XCD_BAR_WORDS 3456
#define XB_SPIN_CAP (1u << 18)

__device__ __forceinline__ unsigned xb_ld(unsigned* p)              { return __hip_atomic_load(p, __ATOMIC_RELAXED, __HIP_MEMORY_SCOPE_AGENT); }
__device__ __forceinline__ unsigned xb_add(unsigned* p, unsigned v) { return __hip_atomic_fetch_add(p, v, __ATOMIC_RELAXED, __HIP_MEMORY_SCOPE_AGENT); }
__device__ __forceinline__ unsigned xb_xcc_id() { return (unsigned)__builtin_amdgcn_s_getreg((3 << 11) | 20) & 0xFu; }
#define XB_SPIN(cond, bar) do { unsigned _sp = 0; while (cond) { __builtin_amdgcn_s_sleep(1); \
    if ((++_sp & 255u) == 0u) { if (xb_ld(&(bar)[XB_TMO])) break; if (_sp > XB_SPIN_CAP) { atomicAdd(&(bar)[XB_TMO], 1u); break; } } } } while (0)

struct XcdBarrier {
    unsigned* bar; unsigned x;
    volatile LAS unsigned* st;
};

__device__ __forceinline__ XcdBarrier xcd_barrier_post(unsigned* bar, volatile LAS unsigned* st) {
    XcdBarrier b; b.bar = bar; b.x = xb_xcc_id(); b.st = st;
    if (threadIdx.x == 0) (void)xb_add(&bar[XB_XCNT(b.x)], 1u);
    return b;
}
__device__ __forceinline__ void xcd_barrier_complete(unsigned* bar, unsigned x, unsigned& nloc, unsigned& nx) {
    const unsigned G = gridDim.x * gridDim.y * gridDim.z;
    unsigned sum, cnt, mine, sp = 0u;
    for (;;) {
        sum = 0u; cnt = 0u; mine = 0u;
#pragma unroll
        for (unsigned j = 0; j < 16; ++j) { const unsigned c = xb_ld(&bar[XB_XCNT(j)]); sum += c; cnt += (c > 0u) ? 1u : 0u; mine = (j == x) ? c : mine; }
        if (sum == G) break;
        __builtin_amdgcn_s_sleep(1);
        if ((++sp & 255u) == 0u) { if (xb_ld(&bar[XB_TMO])) break; if (sp > XB_SPIN_CAP) { atomicAdd(&bar[XB_TMO], 1u); break; } }
    }
    nloc = mine > 0u ? mine : 1u; nx = cnt > 0u ? cnt : 1u;
}

__device__ __forceinline__ void xcd_barrier(const XcdBarrier& b) {
    asm volatile("s_waitcnt vmcnt(0)" ::: "memory");
    __syncthreads();
    if (threadIdx.x == 0) {
        unsigned* bar = b.bar;
        __builtin_amdgcn_s_waitcnt(0);
        unsigned nloc = b.st[0], nx = b.st[1];
        if (nloc == 0u) { xcd_barrier_complete(bar, b.x, nloc, nx); b.st[0] = nloc; b.st[1] = nx; }
        const unsigned old = xb_add(&bar[XB_XSUB(b.x)], 1u);
        const unsigned gen = old / nloc;
        if (old + 1u == (gen + 1u) * nloc) {
            __builtin_amdgcn_fence(__ATOMIC_RELEASE, "agent");
            asm volatile("s_waitcnt vmcnt(0)" ::: "memory");
            const unsigned og = xb_add(&bar[XB_TOP], 1u);
            const unsigned tg = og / nx;
            if (og + 1u == (tg + 1u) * nx) xb_add(&bar[XB_TOPGEN], 1u);
            else XB_SPIN(xb_ld(&bar[XB_TOPGEN]) == tg, bar);
            __builtin_amdgcn_fence(__ATOMIC_ACQUIRE, "agent");
            xb_add(&bar[XB_XGEN(b.x)], 1u);
            asm volatile("s_waitcnt vmcnt(0)" ::: "memory");
        } else {
            XB_SPIN(xb_ld(&bar[XB_XGEN(b.x)]) == gen, bar);
            __builtin_amdgcn_fence(__ATOMIC_ACQUIRE, "agent");
            asm volatile("s_waitcnt vmcnt(0)" ::: "memory");
        }
    }
    __syncthreads();
}

constexpr int NB = 16, SEQ = 4096, DM = 1024, MT = NB * SEQ;
constexpr int DINP = 1792;
constexpr int C_CQ = 0, C_CKV = 256, C_KR = 384, C_QN = 416, C_KVC = 928, C_KVS = 1184, C_KVW = 1440, C_GATE = 1696, DIN = 1720;
constexpr int DFF = 2816, NGU = 2 * DFF;
constexpr int NCMP = 255;
constexpr float EPS = 1e-6f;
constexpr float LOG2E = 1.4426950408889634f;
constexpr float C2Q = 0.10206207261596575f * 1.4426950408889634f;
constexpr float C2N = 0.125f * 1.4426950408889634f;

constexpr int NWAVES = 8, NTHR = 512;
constexpr int NPHASE = 8;
#ifndef MK_N_LAUNCHES
#define MK_N_LAUNCHES 1
#endif
constexpr int N_LAUNCHES = MK_N_LAUNCHES;

constexpr size_t MiB = 1u << 20;
constexpr size_t WS_CTL = 0, CTL_ZERO_BYTES = 1 * MiB;
constexpr size_t WS_WIN = 2 * MiB, WS_WUQ = 6 * MiB, WS_WUKV = 7 * MiB, WS_WOUT = 8 * MiB, WS_WGU = 10 * MiB, WS_WDN = 21 * MiB;
constexpr size_t WS_ROPE = 27 * MiB, WS_BIAS = 27 * MiB + 512 * 1024, WS_BIAS1 = WS_BIAS + 8192;
constexpr size_t WS_RSTDX = 28 * MiB, WS_SSQKV = 29 * MiB, WS_SSATT = 31 * MiB, WS_SSH = 35 * MiB;
constexpr size_t WS_KCMP = 39 * MiB, WS_VCMP = 40 * MiB, WS_KPE = 41 * MiB, WS_OVT = 45 * MiB, WS_W1C = 46 * MiB, WS_W2T = 47 * MiB;
constexpr size_t WS_XB = 64 * MiB, WS_U = 192 * MiB, WS_QM = 420 * MiB, WS_KVM = 516 * MiB, WS_ATT = 644 * MiB, WS_H = 772 * MiB, WS_END = 900 * MiB;
constexpr size_t WS_HID = 64 * MiB;
static_assert(WS_U + (size_t)MT * DINP * 2 <= WS_QM && WS_HID + (size_t)MT * DFF * 2 <= WS_QM && WS_QM + (size_t)MT * 768 * 2 <= WS_KVM && WS_KVM + (size_t)MT * 1024 * 2 <= WS_ATT, "ws map");
constexpr int CW_TMO = 0, CW_BAR = 4096;

constexpr int LDS_BYTES = 163840;
constexpr int MISC_OFF = LDS_BYTES - 256;


typedef unsigned u32x4 __attribute__((ext_vector_type(4))); using pg8::Unit; using pg8::cvt_pk_bf16; using pg8::HALF; using pg8::BM;
typedef float f32x2v __attribute__((ext_vector_type(2)));
__device__ __forceinline__ float bf2f(unsigned short b) { return __builtin_bit_cast(float, (unsigned)b << 16); }
__device__ __forceinline__ float bflo(unsigned w) { return __builtin_bit_cast(float, w << 16); }
__device__ __forceinline__ float bfhi(unsigned w) { return __builtin_bit_cast(float, w & 0xffff0000u); }
__device__ __forceinline__ float sq4(const f32x4 v) { return (v[0] * v[0] + v[1] * v[1]) + (v[2] * v[2] + v[3] * v[3]); }

struct EpiInProj {
    static constexpr bool PERM = true, AFTER_DRAIN = false, MIDK = false;
    pg8::bf16_t* U; const float* rstd; float* ssq;
    __device__ __forceinline__ void operator()(const f32x4 (&acc)[2][2][4][2], const Unit& u, int wr, int wc, int fr, int fq) const {
        const int row0 = u.pm * BM + wr * 64 + fr, col0 = u.pn * BM + wc * 32 + 8 * fq;
#pragma unroll
        for (int ai = 0; ai < 2; ++ai)
#pragma unroll
            for (int m = 0; m < 4; ++m) {
                const int row = row0 + ai * HALF + m * 16; const float r = rstd[row];
                pg8::bf16_t* rowp = U + (size_t)row * DINP + col0; float s0 = 0.f, s1 = 0.f;
#pragma unroll
                for (int bj = 0; bj < 2; ++bj) { const f32x4 v0 = acc[ai][bj][m][0] * r, v1 = acc[ai][bj][m][1] * r;
                    u32x4 w; w.x = cvt_pk_bf16(v0[0], v0[1]); w.y = cvt_pk_bf16(v0[2], v0[3]); w.z = cvt_pk_bf16(v1[0], v1[1]); w.w = cvt_pk_bf16(v1[2], v1[3]);
                    *(u32x4*)(rowp + bj * HALF) = w;
                    const float s = sq4(v0) + sq4(v1); if (bj == 0) s0 = s; else s1 = s; }
                if (u.pn < 2) {
                    float s = (u.pn == 0) ? (s0 + s1) : s0;
                    s += __shfl_xor(s, 16); s += __shfl_xor(s, 32);
                    if (fq == 0) ssq[(size_t)row * 8 + (u.pn == 0 ? 0 : 4) + wc] = s;
                }
            }
    }
};
struct EpiQup {
    static constexpr bool PERM = true, AFTER_DRAIN = false, MIDK = false;
    pg8::bf16_t* Q; const float* ssq; const f32x2v* rope;
    __device__ __forceinline__ void operator()(const f32x4 (&acc)[2][2][4][2], const Unit& u, int wr, int wc, int fr, int fq) const {
        const int row0 = u.pm * BM + wr * 64 + fr, col0 = u.pn * BM + wc * 32 + 8 * fq;
#pragma unroll
        for (int ai = 0; ai < 2; ++ai)
#pragma unroll
            for (int m = 0; m < 4; ++m) {
                const int row = row0 + ai * HALF + m * 16; const int pos = row & (SEQ - 1);
                const f32x4 pp = *(const f32x4*)(ssq + (size_t)row * 8);
                const float r = __builtin_amdgcn_rsqf(((pp[0] + pp[1]) + (pp[2] + pp[3])) * (1.0f / 256.0f) + EPS) * C2Q;
#pragma unroll
                for (int bj = 0; bj < 2; ++bj) { const int c = col0 + bj * HALF; const int d = c % 96;
                    f32x4 v0 = acc[ai][bj][m][0] * r, v1 = acc[ai][bj][m][1] * r;
                    if (d >= 64) { const int i0 = (d - 64) >> 1; const f32x2v* rp = rope + pos * 16 + i0;
                        const f32x2v a = rp[0], b = rp[1], e = rp[2], f = rp[3];
                        f32x4 w0, w1;
                        w0[0] = v0[0] * a.x - v0[1] * a.y; w0[1] = v0[0] * a.y + v0[1] * a.x;
                        w0[2] = v0[2] * b.x - v0[3] * b.y; w0[3] = v0[2] * b.y + v0[3] * b.x;
                        w1[0] = v1[0] * e.x - v1[1] * e.y; w1[1] = v1[0] * e.y + v1[1] * e.x;
                        w1[2] = v1[2] * f.x - v1[3] * f.y; w1[3] = v1[2] * f.y + v1[3] * f.x;
                        v0 = w0; v1 = w1; }
                    u32x4 w; w.x = cvt_pk_bf16(v0[0], v0[1]); w.y = cvt_pk_bf16(v0[2], v0[3]); w.z = cvt_pk_bf16(v1[0], v1[1]); w.w = cvt_pk_bf16(v1[2], v1[3]);
                    *(u32x4*)(Q + (size_t)row * 768 + c) = w; }
                asm volatile("" ::: "memory");
            }
    }
};
struct EpiKVup {
    static constexpr bool PERM = true, AFTER_DRAIN = false, MIDK = false;
    pg8::bf16_t* KV; const float* ssq;
    __device__ __forceinline__ void operator()(const f32x4 (&acc)[2][2][4][2], const Unit& u, int wr, int wc, int fr, int fq) const {
        const int row0 = u.pm * BM + wr * 64 + fr, col0 = u.pn * BM + wc * 32 + 8 * fq;
#pragma unroll
        for (int ai = 0; ai < 2; ++ai)
#pragma unroll
            for (int m = 0; m < 4; ++m) {
                const int row = row0 + ai * HALF + m * 16;
                const f32x4 pp = *(const f32x4*)(ssq + (size_t)row * 8 + 4);
                const float r = __builtin_amdgcn_rsqf(((pp[0] + pp[1]) + (pp[2] + pp[3])) * (1.0f / 128.0f) + EPS);
#pragma unroll
                for (int bj = 0; bj < 2; ++bj) { const f32x4 v0 = acc[ai][bj][m][0] * r, v1 = acc[ai][bj][m][1] * r;
                    u32x4 w; w.x = cvt_pk_bf16(v0[0], v0[1]); w.y = cvt_pk_bf16(v0[2], v0[3]); w.z = cvt_pk_bf16(v1[0], v1[1]); w.w = cvt_pk_bf16(v1[2], v1[3]);
                    *(u32x4*)(KV + (size_t)row * 1024 + col0 + bj * HALF) = w; }
                if (m & 1) asm volatile("" ::: "memory");
            }
    }
};
constexpr int OUT_TAB_OFF = 131072;
struct OutOrder : pg8::StaticOrder {
    const float* ssatt; LAS float* tab;
    __device__ __forceinline__ void a_ready(const Unit& u) const {
        const int tid = threadIdx.x, row = tid >> 1, which = tid & 1;
        const f32x4* pp = (const f32x4*)(ssatt + (size_t)(u.pm * BM + row) * 16 + which * 8); const f32x4 a = pp[0], b = pp[1];
        const float r = __builtin_amdgcn_rsqf((((a[0] + a[1]) + (a[2] + a[3])) + ((b[0] + b[1]) + (b[2] + b[3]))) * (1.0f / 512.0f) + EPS);
        const float o = __shfl_xor(r, 1);
        if (which == 0) { LAS float* t = tab + (u.ui & 1) * 512 + row * 2; t[0] = r / o; t[1] = o; }
    }
};
struct EpiOut {
    static constexpr bool PERM = true, AFTER_DRAIN = false, MIDK = true;
    const pg8::bf16_t* xb; pg8::bf16_t* H; float* ssh; const LAS float* tab;
    __device__ __forceinline__ void midk(f32x4 (&acc)[2][2][4][2], const Unit& u, int wr, int fr) const {
        const LAS float* t = tab + (u.ui & 1) * 512 + (wr * 64 + fr) * 2;
#pragma unroll
        for (int ai = 0; ai < 2; ++ai)
#pragma unroll
            for (int m = 0; m < 4; ++m) { const float ratio = t[(ai * HALF + m * 16) * 2];
#pragma unroll
                for (int bj = 0; bj < 2; ++bj) { acc[ai][bj][m][0] *= ratio; acc[ai][bj][m][1] *= ratio; } }
    }
    __device__ __forceinline__ void operator()(const f32x4 (&acc)[2][2][4][2], const Unit& u, int wr, int wc, int fr, int fq) const {
        const int row0 = u.pm * BM + wr * 64 + fr, col0 = u.pn * BM + wc * 32 + 8 * fq;
        const LAS float* t = tab + (u.ui & 1) * 512 + (wr * 64 + fr) * 2 + 1;
#pragma unroll
        for (int ai = 0; ai < 2; ++ai)
#pragma unroll
            for (int m = 0; m < 4; ++m) {
                const int row = row0 + ai * HALF + m * 16; const float r = t[(ai * HALF + m * 16) * 2];
                float s = 0.f;
#pragma unroll
                for (int bj = 0; bj < 2; ++bj) { const size_t off = (size_t)row * DM + col0 + bj * HALF;
                    const u32x4 xw = *(const u32x4*)(xb + off);
                    f32x4 x0, x1; x0[0] = bflo(xw.x); x0[1] = bfhi(xw.x); x0[2] = bflo(xw.y); x0[3] = bfhi(xw.y); x1[0] = bflo(xw.z); x1[1] = bfhi(xw.z); x1[2] = bflo(xw.w); x1[3] = bfhi(xw.w);
                    const f32x4 v0 = x0 + acc[ai][bj][m][0] * r, v1 = x1 + acc[ai][bj][m][1] * r;
                    u32x4 w; w.x = cvt_pk_bf16(v0[0], v0[1]); w.y = cvt_pk_bf16(v0[2], v0[3]); w.z = cvt_pk_bf16(v1[0], v1[1]); w.w = cvt_pk_bf16(v1[2], v1[3]);
                    *(u32x4*)(H + off) = w; s += sq4(v0) + sq4(v1); }
                s += __shfl_xor(s, 16); s += __shfl_xor(s, 32);
                if (fq == 0) ssh[(size_t)row * 16 + u.pn * 4 + wc] = s;
                if (m & 1) asm volatile("" ::: "memory");
            }
    }
};
struct GUOrder : pg8::StaticOrder {
    const float* ssh; LAS float* tab;
    __device__ __forceinline__ void a_ready(const Unit& u) const {
        const int tid = threadIdx.x, row = tid >> 1, which = tid & 1;
        const f32x4* pp = (const f32x4*)(ssh + (size_t)(u.pm * BM + row) * 16 + which * 8); const f32x4 a = pp[0], b = pp[1];
        float s = ((a[0] + a[1]) + (a[2] + a[3])) + ((b[0] + b[1]) + (b[2] + b[3]));
        s += __shfl_xor(s, 1);
        if (which == 0) tab[(u.ui & 1) * 256 + row] = __builtin_amdgcn_rsqf(s * (1.0f / 1024.0f) + EPS);
    }
};
struct EpiGU {
    static constexpr bool PERM = true, AFTER_DRAIN = false, MIDK = false;
    pg8::bf16_t* HID; const LAS float* tab;
    __device__ __forceinline__ void operator()(const f32x4 (&acc)[2][2][4][2], const Unit& u, int wr, int wc, int fr, int fq) const {
        const int row0 = u.pm * BM + wr * 64 + fr, col0 = u.pn * HALF + wc * 32 + 8 * fq;
        const LAS float* t = tab + (u.ui & 1) * 256 + wr * 64 + fr;
#pragma unroll
        for (int ai = 0; ai < 2; ++ai)
#pragma unroll
            for (int m = 0; m < 4; ++m) {
                const int row = row0 + ai * HALF + m * 16; const float r = t[ai * HALF + m * 16];
                float o[8];
#pragma unroll
                for (int n = 0; n < 2; ++n)
#pragma unroll
                    for (int e = 0; e < 4; ++e) { const float g = acc[ai][0][m][n][e] * r, up = acc[ai][1][m][n][e] * r;
                        const float sg = g * __builtin_amdgcn_rcpf(1.0f + __builtin_amdgcn_exp2f(-g * LOG2E)); o[n * 4 + e] = sg * up; }
                u32x4 w; w.x = cvt_pk_bf16(o[0], o[1]); w.y = cvt_pk_bf16(o[2], o[3]); w.z = cvt_pk_bf16(o[4], o[5]); w.w = cvt_pk_bf16(o[6], o[7]);
                __builtin_nontemporal_store(w, (u32x4*)(HID + (size_t)row * DFF + col0));
            }
    }
};
struct EpiDown {
    static constexpr bool PERM = true, AFTER_DRAIN = false, MIDK = false;
    const pg8::bf16_t* H; pg8::bf16_t* H2; float* ss2;
    __device__ __forceinline__ void operator()(const f32x4 (&acc)[2][2][4][2], const Unit& u, int wr, int wc, int fr, int fq) const {
        const int row0 = u.pm * BM + wr * 64 + fr, col0 = u.pn * BM + wc * 32 + 8 * fq;
#pragma unroll
        for (int ai = 0; ai < 2; ++ai)
#pragma unroll
            for (int m = 0; m < 4; ++m) {
                const int row = row0 + ai * HALF + m * 16; float s = 0.f;
#pragma unroll
                for (int bj = 0; bj < 2; ++bj) { const size_t off = (size_t)row * DM + col0 + bj * HALF;
                    const u32x4 hw = *(const u32x4*)(H + off);
                    f32x4 h0, h1; h0[0] = bflo(hw.x); h0[1] = bfhi(hw.x); h0[2] = bflo(hw.y); h0[3] = bfhi(hw.y); h1[0] = bflo(hw.z); h1[1] = bfhi(hw.z); h1[2] = bflo(hw.w); h1[3] = bfhi(hw.w);
                    h0 += acc[ai][bj][m][0]; h1 += acc[ai][bj][m][1];
                    u32x4 w; w.x = cvt_pk_bf16(h0[0], h0[1]); w.y = cvt_pk_bf16(h0[2], h0[3]); w.z = cvt_pk_bf16(h1[0], h1[1]); w.w = cvt_pk_bf16(h1[2], h1[3]);
                    *(u32x4*)(H2 + off) = w; s += sq4(h0) + sq4(h1); }
                s += __shfl_xor(s, 16); s += __shfl_xor(s, 32);
                if (fq == 0) ss2[(size_t)row * 16 + u.pn * 4 + wc] = s;
                if (m & 1) asm volatile("" ::: "memory");
            }
    }
};

struct Args { const float* in[22]; float* out; unsigned char* ws; int ph_lo, ph_hi, li, pad; };
enum { I_X = 0, I_GMIX, I_WIN, I_GQ, I_WUQ, I_GKV, I_WUKV, I_POSK, I_W1K, I_W2K, I_POSV, I_W1V, I_W2V, I_T5, I_GOM, I_GON, I_WOUT, I_GFFN, I_WG, I_WU, I_WD, I_GFIN };

__device__ __forceinline__ float wave_sum(float v) {
#pragma unroll
    for (int o = 1; o < 64; o <<= 1) v += __shfl_xor(v, o);
    return v;
}
typedef __bf16 bf16x2_t __attribute__((ext_vector_type(2)));
__device__ __forceinline__ float dot2(unsigned a, unsigned b, float c) { return __builtin_amdgcn_fdot2_f32_bf16(__builtin_bit_cast(bf16x2_t, a), __builtin_bit_cast(bf16x2_t, b), c, false); }

template <class F> __device__ __forceinline__ void tr_item(F f, bf16* WT, int ldk, int nblk, LAS float* scr, int item, int lane) {
    const int kb = item / nblk, nb = item % nblk, k0 = 64 * kb, n0 = 32 * nb;
#pragma unroll 8
    for (int i = 0; i < 32; ++i) { const int kk = 2 * i + (lane >> 5); scr[kk * 33 + (lane & 31)] = f(k0 + kk, n0 + (lane & 31)); }
    LDS_WAIT(); asm volatile("" ::: "memory");
    const int c = lane & 7;
#pragma unroll
    for (int j = 0; j < 4; ++j) { const int n = (lane >> 3) + 8 * j; const LAS float* s = scr + (8 * c) * 33 + n;
        v4u o; o.x = pk2(s[0 * 33], s[1 * 33]); o.y = pk2(s[2 * 33], s[3 * 33]); o.z = pk2(s[4 * 33], s[5 * 33]); o.w = pk2(s[6 * 33], s[7 * 33]);
        *(GAS v4u*)(WT + (size_t)(n0 + n) * ldk + k0 + 8 * c) = o; }
    LDS_WAIT(); asm volatile("" ::: "memory");
}
__device__ __forceinline__ int t5_bucket(int n) {
    if (n < 16) return n;
    int b = 16; b += n >= 19; b += n >= 21; b += n >= 24; b += n >= 27; b += n >= 31; b += n >= 35; b += n >= 40; b += n >= 46; b += n >= 52; b += n >= 59; b += n >= 67; b += n >= 77; b += n >= 87; b += n >= 99; b += n >= 113;
    return b;
}
__device__ __forceinline__ float gelu_tanh(float x) {
    const float y = 0.7978845608028654f * (x + 0.044715f * x * x * x);
    const float e = __builtin_amdgcn_exp2f(2.0f * LOG2E * y);
    const float th = 1.0f - 2.0f * __builtin_amdgcn_rcpf(e + 1.0f);
    return 0.5f * x * (1.0f + th);
}

struct Ptrs {
    const float* in[22]; float* out; unsigned char* ws;
    bf16 *Win, *Wuq, *Wukv, *Wout, *Wgu, *Wdn; f32x2v* rope; float *bias, *bias1, *rstdx, *ssqkv, *ssatt, *ssh;
    bf16 *kcmp, *vcmp, *kpe, *ovt, *W1c, *W2t, *XB, *U, *QM, *KVM, *ATT, *H, *HID;
};

__device__ __forceinline__ void p0_prologue(const Ptrs& P, LAS unsigned char* lds, int wg, int G, int wave, int lane, int tid) {
    LAS float* scr = (LAS float*)(lds + wave * 16384);
    const int gw = wg * NWAVES + wave, NGW = G * NWAVES;
    constexpr int I_IN = (1024 / 64) * (DINP / 32), I_UQ = (256 / 64) * (768 / 32), I_UKV = (256 / 64) * (1024 / 32), I_OUT = (1024 / 64) * (1024 / 32), I_GU = (1024 / 64) * (NGU / 32), I_DN = (DFF / 64) * (1024 / 32);
    constexpr int I_W1C = 2 * (1024 / 64) * (256 / 32), I_W2T = 2 * (128 / 64) * (64 / 32);
    constexpr int NITEMS = I_IN + I_UQ + I_UKV + I_OUT + I_GU + I_DN + I_W1C + I_W2T;
    for (int it = gw; it < NITEMS; it += NGW) {
        int r = it;
        if (r < I_IN) { const float* W = P.in[I_WIN]; const float* g = P.in[I_GMIX];
            tr_item([=](int k, int n) -> float { if (n >= DIN) return 0.f; const float s = (n >= C_QN && n < C_KVC) ? C2N : 1.0f; return W[(size_t)k * DIN + n] * g[k] * s; }, P.Win, 1024, DINP / 32, scr, r, lane); continue; } r -= I_IN;
        if (r < I_UQ) { const float* W = P.in[I_WUQ]; const float* g = P.in[I_GQ];
            tr_item([=](int k, int n) -> float { const int h = n / 96, d = n % 96; int src = n; if (d >= 64) { const int e = d - 64; src = h * 96 + 64 + (e & 1) * 16 + (e >> 1); } return W[(size_t)k * 768 + src] * g[k]; }, P.Wuq, 256, 768 / 32, scr, r, lane); continue; } r -= I_UQ;
        if (r < I_UKV) { const float* W = P.in[I_WUKV]; const float* g = P.in[I_GKV];
            tr_item([=](int k, int n) -> float { return k < 128 ? W[(size_t)k * 1024 + n] * g[k] : 0.f; }, P.Wukv, 256, 1024 / 32, scr, r, lane); continue; } r -= I_UKV;
        if (r < I_OUT) { const float* W = P.in[I_WOUT]; const float* g1 = P.in[I_GOM]; const float* g2 = P.in[I_GON];
            tr_item([=](int k, int n) -> float { return W[(size_t)k * 1024 + n] * (k < 512 ? g1[k] : g2[k - 512]); }, P.Wout, 1024, 1024 / 32, scr, r, lane); continue; } r -= I_OUT;
        if (r < I_GU) { const float* g = P.in[I_GFFN]; const bool up = ((r % (NGU / 32)) & 4) != 0;
            if (!up) { const float* W = P.in[I_WG]; tr_item([=](int k, int n) -> float { return W[(size_t)k * DFF + (n >> 8) * 128 + (n & 127)] * g[k]; }, P.Wgu, 1024, NGU / 32, scr, r, lane); }
            else { const float* W = P.in[I_WU]; tr_item([=](int k, int n) -> float { return W[(size_t)k * DFF + (n >> 8) * 128 + (n & 127)] * g[k]; }, P.Wgu, 1024, NGU / 32, scr, r, lane); }
            continue; } r -= I_GU;
        if (r < I_DN) { const float* W = P.in[I_WD];
            tr_item([=](int k, int n) -> float { return W[(size_t)k * 1024 + n]; }, P.Wdn, DFF, 1024 / 32, scr, r, lane); continue; } r -= I_DN;
        if (r < I_W1C) { const int kv = r >= I_W1C / 2; if (kv) r -= I_W1C / 2;
            if (!kv) { const float* W = P.in[I_W1K]; tr_item([=](int k, int n) -> float { return W[(size_t)(k + ((n >> 7) << 10)) * 128 + (n & 127)]; }, P.W1c, 1024, 256 / 32, scr, r, lane); }
            else { const float* W = P.in[I_W1V]; tr_item([=](int k, int n) -> float { return W[(size_t)(k + ((n >> 7) << 10)) * 128 + (n & 127)]; }, P.W1c + 256 * 1024, 1024, 256 / 32, scr, r, lane); }
            continue; } r -= I_W1C;
        { const int kv = r >= I_W2T / 2; if (kv) r -= I_W2T / 2;
            if (!kv) { const float* W = P.in[I_W2K]; tr_item([=](int k, int n) -> float { return W[(size_t)k * 64 + n]; }, P.W2t, 128, 64 / 32, scr, r, lane); }
            else { const float* W = P.in[I_W2V]; tr_item([=](int k, int n) -> float { return W[(size_t)k * 64 + n]; }, P.W2t + 64 * 128, 128, 64 / 32, scr, r, lane); } }
    }
    const int gt = wg * NTHR + tid, NGT = G * NTHR;
    for (int e = gt; e < SEQ * 16; e += NGT) { const int pos = e >> 4, i = e & 15;
        const float inv = __builtin_amdgcn_exp2f(-(float)i * (13.287712379549449f / 16.0f));
        const float ang = (float)pos * inv;
        double rev = (double)ang * 0.15915494309189535; rev -= __builtin_floor(rev);
        const float fr = (float)rev;
        P.rope[e] = (f32x2v){__builtin_amdgcn_cosf(fr), __builtin_amdgcn_sinf(fr)}; }
    for (int e = gt; e < 8 * 128; e += NGT) { const int h = e >> 7, d = e & 127; P.bias[e] = P.in[I_T5][t5_bucket(d) * 8 + h] * LOG2E; }
    for (int e = gt; e < 256 * 64; e += NGT) { const int i = e >> 6, j = e & 63; float w = 0.f; if (j == (i >> 2)) w += ((i & 3) == 3) ? 1.f : 2.f; if ((i & 3) == 3 && j == (i >> 2) + 1) w += 1.f;
        P.ovt[e] = (bf16)(__float_as_uint(w) >> 16); }
    for (int o = gw; o < 256; o += NGW) { const int kv = o >> 7, j = o & 127; const float* pos = P.in[kv ? I_POSV : I_POSK]; const float* w1 = P.in[kv ? I_W1V : I_W1K];
        float s = 0.f; for (int k = lane; k < 2048; k += 64) s += pos[k] * w1[(size_t)k * 128 + j];
        s = wave_sum(s); if (lane == 0) P.bias1[o] = s; }
    for (int m0 = gw * 4; m0 < MT; m0 += NGW * 4) {
        f32x4 v[4][4];
#pragma unroll
        for (int q = 0; q < 4; ++q) { const GAS f32x4* xr = (const GAS f32x4*)(P.in[I_X] + (size_t)(m0 + q) * DM) + lane;
#pragma unroll
            for (int j = 0; j < 4; ++j) v[q][j] = __builtin_nontemporal_load(xr + 64 * j); }
#pragma unroll
        for (int q = 0; q < 4; ++q) { float s = 0.f;
#pragma unroll
            for (int j = 0; j < 4; ++j) s += sq4(v[q][j]);
            s = wave_sum(s);
            if (lane == 0) P.rstdx[m0 + q] = __builtin_amdgcn_rsqf(s * (1.0f / DM) + EPS);
            GAS unsigned long long* o8 = (GAS unsigned long long*)(P.XB + (size_t)(m0 + q) * DM) + lane;
#pragma unroll
            for (int j = 0; j < 4; ++j) o8[64 * j] = (unsigned long long)pk2(v[q][j][0], v[q][j][1]) | ((unsigned long long)pk2(v[q][j][2], v[q][j][3]) << 32); }
    }
}

__device__ __forceinline__ void p2_kpe(const Ptrs& P, int wg, int G, int tid) {
    const int gt = wg * NTHR + tid, NGT = G * NTHR;
    for (int e = gt; e < MT * 16; e += NGT) { const int row = e >> 4, i = e & 15; const int pos = row & (SEQ - 1);
        const float x1 = bf2f(P.U[(size_t)row * DINP + C_KR + i]), x2 = bf2f(P.U[(size_t)row * DINP + C_KR + 16 + i]);
        const f32x2v cs = P.rope[pos * 16 + i];
        *(unsigned*)(P.kpe + (size_t)row * 32 + 2 * i) = pk2(x1 * cs.x - x2 * cs.y, x1 * cs.y + x2 * cs.x); }
}
__device__ __forceinline__ void p7_final(const Ptrs& P, int wg, int G, int wave, int lane) {
    const int gw = wg * NWAVES + wave, NGW = G * NWAVES;
    const GAS f32x4* gp = (const GAS f32x4*)P.in[I_GFIN] + 2 * lane; f32x4 gg[4][2];
#pragma unroll
    for (int j = 0; j < 2; ++j) { gg[j][0] = gp[128 * j]; gg[j][1] = gp[128 * j + 1]; }
    for (int m0 = gw * 4; m0 < MT; m0 += NGW * 4) {
        u32x4 w0[4], w1[4]; float pv[4];
#pragma unroll
        for (int q = 0; q < 4; ++q) { const GAS u32x4* hr = (const GAS u32x4*)(P.ATT + (size_t)(m0 + q) * DM) + lane;
            w0[q] = hr[0]; w1[q] = hr[64]; pv[q] = (lane < 16) ? P.ssatt[(size_t)(m0 + q) * 16 + lane] : 0.f; }
#pragma unroll
        for (int q = 0; q < 4; ++q) {
            const float r = __builtin_amdgcn_rsqf(wave_sum(pv[q]) * (1.0f / DM) + EPS);
            GAS f32x4* o = (GAS f32x4*)(P.out + (size_t)(m0 + q) * DM) + 2 * lane;
            { const u32x4 w = w0[q]; f32x4 a, b; a[0] = bflo(w.x); a[1] = bfhi(w.x); a[2] = bflo(w.y); a[3] = bfhi(w.y); b[0] = bflo(w.z); b[1] = bfhi(w.z); b[2] = bflo(w.w); b[3] = bfhi(w.w);
              o[0] = a * r * gg[0][0]; o[1] = b * r * gg[0][1]; }
            { const u32x4 w = w1[q]; f32x4 a, b; a[0] = bflo(w.x); a[1] = bfhi(w.x); a[2] = bflo(w.y); a[3] = bfhi(w.y); b[0] = bflo(w.z); b[1] = bfhi(w.z); b[2] = bflo(w.w); b[3] = bfhi(w.w);
              o[128] = a * r * gg[1][0]; o[129] = b * r * gg[1][1]; } }
    }
}

struct CmpOrder {
    int G, c; const bf16* U; const bf16* W1c;
    __device__ __forceinline__ bool next(int i, Unit& u) const { const int un = c + i * G; if (un >= 64) return false; u.pm = un; u.pn = 0; u.ui = i; return true; }
    __device__ __forceinline__ void a_ready(const Unit&) const {}
    __device__ __forceinline__ void done(const Unit&) const {}
    __device__ __forceinline__ const char* a_base(const pg8::Gemm&, const Unit& u, size_t) const { const int bh = u.pm >> 1, kv = u.pm & 1;
        return (const char*)(U + (size_t)(bh >> 1) * SEQ * DINP + C_KVC + kv * 128 + (bh & 1) * 64); }
    __device__ __forceinline__ const char* b_base(const pg8::Gemm&, const Unit& u, size_t) const { return (const char*)(W1c + (size_t)(u.pm & 1) * 256 * 1024); }
};
struct EpiCmp {
    static constexpr bool PERM = true, AFTER_DRAIN = true, MIDK = false;
    const float* bias1; const bf16* W2t; bf16* kcmp; bf16* vcmp;
    __device__ __forceinline__ void operator()(const f32x4 (&)[2][2][4][2], const Unit&, int, int, int, int) const {}
    __device__ __forceinline__ void fused(f32x4 (&acc)[2][2][4][2], const Unit& u, int wr, int wc, int fr, int fq, LAS unsigned char* lds, int wid, int lane) const {
        typedef short bf16x8_t __attribute__((ext_vector_type(8))); typedef float f32x16_t __attribute__((ext_vector_type(16)));
        const int bh = u.pm >> 1, kv = u.pm & 1; const int col = wc * 32 + 8 * fq;
        LAS float* OB = (LAS float*)lds;
#pragma unroll
        for (int ai = 0; ai < 2; ++ai)
#pragma unroll
            for (int m = 0; m < 4; ++m) { const int r = ai * HALF + wr * 64 + m * 16 + fr;
                *(LAS f32x4*)(OB + r * 132 + col) = acc[ai][1][m][0]; *(LAS f32x4*)(OB + r * 132 + col + 4) = acc[ai][1][m][1]; }
        const f32x4 bs0 = *(const f32x4*)(bias1 + kv * 128 + col), bs1 = *(const f32x4*)(bias1 + kv * 128 + col + 4);
        asm volatile("s_waitcnt lgkmcnt(0)" ::: "memory"); __builtin_amdgcn_s_barrier(); asm volatile("" ::: "memory");
#pragma unroll
        for (int ai = 0; ai < 2; ++ai)
#pragma unroll
            for (int m = 0; m < 4; ++m) { const int r = ai * HALF + wr * 64 + m * 16 + fr, r1 = r < 255 ? r + 1 : 255;
                const f32x4 b0 = *(const LAS f32x4*)(OB + r1 * 132 + col), b1 = *(const LAS f32x4*)(OB + r1 * 132 + col + 4);
                f32x4 h0 = acc[ai][0][m][0] + b0 + bs0, h1 = acc[ai][0][m][1] + b1 + bs1;
#pragma unroll
                for (int e = 0; e < 4; ++e) { h0[e] = gelu_tanh(h0[e]); h1[e] = gelu_tanh(h1[e]); }
                acc[ai][0][m][0] = h0; acc[ai][0][m][1] = h1; }
        asm volatile("s_waitcnt lgkmcnt(0)" ::: "memory"); __builtin_amdgcn_s_barrier(); asm volatile("" ::: "memory");
        LAS bf16* GB = (LAS bf16*)lds;
#pragma unroll
        for (int ai = 0; ai < 2; ++ai)
#pragma unroll
            for (int m = 0; m < 4; ++m) { const int r = ai * HALF + wr * 64 + m * 16 + fr; const f32x4 h0 = acc[ai][0][m][0], h1 = acc[ai][0][m][1];
                u32x4 w; w.x = pk2(h0[0], h0[1]); w.y = pk2(h0[2], h0[3]); w.z = pk2(h1[0], h1[1]); w.w = pk2(h1[2], h1[3]);
                *(LAS u32x4*)(GB + r * 136 + col) = w; }
        asm volatile("s_waitcnt lgkmcnt(0)" ::: "memory"); __builtin_amdgcn_s_barrier(); asm volatile("" ::: "memory");
        const int r32 = lane & 31, hi = lane >> 5, c = wid * 32 + r32;
        f32x16_t o[2]; o[0] = f32x16_t{}; o[1] = f32x16_t{};
        const bf16* w2 = W2t + (size_t)kv * 64 * 128;
#pragma unroll
        for (int s = 0; s < 8; ++s) { const bf16x8_t gb = *(const LAS bf16x8_t*)(GB + c * 136 + 16 * s + 8 * hi);
#pragma unroll
            for (int dt = 0; dt < 2; ++dt) { const bf16x8_t wa = *(const bf16x8_t*)(w2 + (size_t)(32 * dt + r32) * 128 + 16 * s + 8 * hi);
                o[dt] = __builtin_amdgcn_mfma_f32_32x32x16_bf16(wa, gb, o[dt], 0, 0, 0); } }
        if (c < NCMP) { bf16* op = (kv ? vcmp : kcmp) + ((size_t)bh * 256 + c) * 64 + 4 * hi;
#pragma unroll
            for (int dt = 0; dt < 2; ++dt)
#pragma unroll
                for (int k = 0; k < 4; ++k) *(unsigned long long*)(op + 32 * dt + 8 * k) = (unsigned long long)pk2(o[dt][4 * k], o[dt][4 * k + 1]) | ((unsigned long long)pk2(o[dt][4 * k + 2], o[dt][4 * k + 3]) << 32); }
        asm volatile("s_waitcnt lgkmcnt(0)" ::: "memory"); __builtin_amdgcn_s_barrier();
    }
};

namespace att {
typedef short bf16x8 __attribute__((ext_vector_type(8)));
typedef short s16x4 __attribute__((ext_vector_type(4)));
typedef float f32x16 __attribute__((ext_vector_type(16)));
typedef __attribute__((address_space(3))) const char* lds_cptr;
constexpr float THR = 8.0f;
constexpr float NEG_INF = -__builtin_inff();
__device__ __forceinline__ int crow(int r, int hi) { return (r & 3) + 8 * (r >> 2) + 4 * hi; }
__device__ __forceinline__ float swap_max(float x) { auto rr = __builtin_amdgcn_permlane32_swap(__float_as_uint(x), __float_as_uint(x), false, false); return fmaxf(__uint_as_float(rr[0]), __uint_as_float(rr[1])); }
__device__ __forceinline__ float swap_sum(float x) { auto rr = __builtin_amdgcn_permlane32_swap(__float_as_uint(x), __float_as_uint(x), false, false); return __uint_as_float(rr[0]) + __uint_as_float(rr[1]); }
__device__ __forceinline__ float partner32(float x, int hi) { auto rr = __builtin_amdgcn_permlane32_swap(__float_as_uint(x), __float_as_uint(x), false, false); return __uint_as_float(hi ? rr[0] : rr[1]); }
__device__ __forceinline__ unsigned partner32u(unsigned x, int hi) { auto rr = __builtin_amdgcn_permlane32_swap(x, x, false, false); return hi ? rr[0] : rr[1]; }
__device__ __forceinline__ void dma16(const void* g, LAS unsigned char* l) { unsigned keep; const unsigned dst = (unsigned)__builtin_amdgcn_readfirstlane((int)(unsigned)(uintptr_t)l);
    asm volatile("s_mov_b32 %0, m0\n\ts_mov_b32 m0, %2\n\ts_nop 0\n\tglobal_load_lds_dwordx4 %1, off\n\ts_mov_b32 m0, %0" : "=&s"(keep) : "v"(g), "s"(dst) : "memory"); }
template <int N> __device__ __forceinline__ void wait_bar() { if (N == 3) asm volatile("s_waitcnt vmcnt(3) lgkmcnt(0)\n\ts_barrier" ::: "memory"); else if (N == 2) asm volatile("s_waitcnt vmcnt(2) lgkmcnt(0)\n\ts_barrier" ::: "memory"); else asm volatile("s_waitcnt vmcnt(0) lgkmcnt(0)\n\ts_barrier" ::: "memory"); }

struct SrcMLA {
    static constexpr int DK = 96, NDMA = 3, NV = 1;
    const bf16* kn; const bf16* kp; const bf16* v;
    __device__ __forceinline__ void init(const bf16* KVM, const bf16* KPE, size_t rowb, int h, int wid, int lane) {
        kn = KVM + (rowb + lane) * 1024 + h * 128 + 8 * wid;
        kp = KPE + (rowb + lane) * 32 + 8 * (wid & 3);
        v = KVM + (rowb + 16 * (wid & 3) + (lane >> 2)) * 1024 + h * 128 + 64 + (wid >> 2) * 32 + (lane & 3) * 8; }
    static constexpr int NKD = 2;
    __device__ __forceinline__ void issueK(int tile, LAS unsigned char* ks, int wid) const {
        dma16(kn + (size_t)tile * 64 * 1024, ks + wid * 1024);
        dma16(kp + (size_t)tile * 64 * 32, ks + (8 + (wid & 3)) * 1024); }
    __device__ __forceinline__ void issueV(int tile, LAS unsigned char* vs, int wid) const { dma16(v + (size_t)tile * 64 * 1024, vs + wid * 1024); }
    __device__ __forceinline__ void issue(int tile, LAS unsigned char* ks, LAS unsigned char* vs, int wid) const { issueK(tile, ks, wid); issueV(tile, vs, wid); }
};
struct SrcRows {
    static constexpr int DK = 64, NDMA = 2, NV = 1;
    const bf16* k; const bf16* v; size_t pitch;
    __device__ __forceinline__ void init(const bf16* K0, const bf16* V0, size_t pitch_, int wid, int lane) {
        pitch = pitch_; k = K0 + (size_t)lane * pitch + 8 * wid; v = V0 + (size_t)(16 * (wid & 3) + (lane >> 2)) * pitch + (wid >> 2) * 32 + (lane & 3) * 8; }
    static constexpr int NKD = 1;
    __device__ __forceinline__ void issueK(int tile, LAS unsigned char* ks, int wid) const { dma16(k + (size_t)tile * 64 * pitch, ks + wid * 1024); }
    __device__ __forceinline__ void issueV(int tile, LAS unsigned char* vs, int wid) const { dma16(v + (size_t)tile * 64 * pitch, vs + wid * 1024); }
    __device__ __forceinline__ void issue(int tile, LAS unsigned char* ks, LAS unsigned char* vs, int wid) const { issueK(tile, ks, wid); issueV(tile, vs, wid); }
};

struct SrcCmp {
    static constexpr int DK = 64, NDMA = 3, NV = 2;
    const bf16* k; const bf16* v; const bf16* ov;
    __device__ __forceinline__ void init(const bf16* K0, const bf16* V0, const bf16* OV, int wid, int lane) {
        k = K0 + (size_t)lane * 64 + 8 * wid; const size_t vo = (size_t)(16 * (wid & 3) + (lane >> 2)) * 64 + (wid >> 2) * 32 + (lane & 3) * 8; v = V0 + vo; ov = OV + vo; }
    __device__ __forceinline__ void issue(int tile, LAS unsigned char* ks, LAS unsigned char* vs, int wid) const {
        dma16(k + (size_t)tile * 4096, ks + wid * 1024);
        dma16(v + (size_t)tile * 4096, vs + wid * 1024);
        dma16(ov + (size_t)tile * 4096, vs + 8192 + wid * 1024); }
};

template <int NV> struct RowT { float m, l; f32x16 o[2 * NV]; };
typedef RowT<1> Row;
template <int NV> __device__ __forceinline__ void row_reset(RowT<NV>& R) { R.m = -1e30f; R.l = 0.f;
#pragma unroll
    for (int i = 0; i < 2 * NV; ++i) R.o[i] = f32x16{}; }

template <int DK> __device__ __forceinline__ void qk_tile(f32x16& p0, f32x16& p1, LAS unsigned char* kslot, const bf16x8 (&qr)[DK / 16], int r32, int hi) {
    const LAS unsigned char* kb = kslot + hi * 1024 + r32 * 16;
    p0 = f32x16{}; p1 = f32x16{};
#pragma unroll
    for (int d0 = 0; d0 < DK / 16; ++d0) {
        const bf16x8 b0 = *(const LAS bf16x8*)(kb + d0 * 2048), b1 = *(const LAS bf16x8*)(kb + d0 * 2048 + 512);
        p0 = __builtin_amdgcn_mfma_f32_32x32x16_bf16(b0, qr[d0], p0, 0, 0, 0);
        p1 = __builtin_amdgcn_mfma_f32_32x32x16_bf16(b1, qr[d0], p1, 0, 0, 0); }
}
template <int NV> __device__ __forceinline__ void softmax_tile(f32x16& p0, f32x16& p1, RowT<NV>& R) {
    float a = fmaxf(fmaxf(p0[0], p0[1]), fmaxf(p1[0], p1[1]));
#pragma unroll
    for (int r = 2; r < 16; r += 2) a = fmaxf(a, fmaxf(fmaxf(p0[r], p0[r + 1]), fmaxf(p1[r], p1[r + 1])));
    const float mt = swap_max(a);
    if (__any(mt > R.m + THR)) { const float mn = fmaxf(R.m, mt), f = __builtin_amdgcn_exp2f(R.m - mn); R.m = mn; R.l *= f;
#pragma unroll
        for (int i = 0; i < 2 * NV; ++i) R.o[i] *= f; }
    const float m = R.m; float s = 0.f;
#pragma unroll
    for (int r = 0; r < 16; ++r) { p0[r] = __builtin_amdgcn_exp2f(p0[r] - m); p1[r] = __builtin_amdgcn_exp2f(p1[r] - m); s += p0[r] + p1[r]; }
    R.l += s;
}
template <int NV> __device__ __forceinline__ void pv_tile(const f32x16& p0, const f32x16& p1, RowT<NV>& R, LAS unsigned char* vslot, int lane, int hi) {
    bf16x8 pa[4];
#pragma unroll
    for (int k = 0; k < 4; ++k) { const f32x16& P = (k < 2) ? p0 : p1; const int b = (k & 1) * 8;
        u32x4 w; w.x = pk2(P[b], P[b + 1]); w.y = pk2(P[b + 2], P[b + 3]); w.z = pk2(P[b + 4], P[b + 5]); w.w = pk2(P[b + 6], P[b + 7]); pa[k] = __builtin_bit_cast(bf16x8, w); }
    const int vb = (int)(unsigned)(uintptr_t)vslot + ((lane >> 4) & 1) * 32 + (lane & 3) * 8 + (4 * hi + ((lane & 15) >> 2)) * 64;
#pragma unroll
    for (int d0 = 0; d0 < 2 * NV; ++d0) { s16x4 lo[4], hh[4];
#pragma unroll
        for (int ks = 0; ks < 4; ++ks) {
            asm volatile("ds_read_b64_tr_b16 %0,%1 offset:%c2" : "=&v"(lo[ks]) : "v"(vb), "i"(d0 * 4096 + ks * 1024) : "memory");
            asm volatile("ds_read_b64_tr_b16 %0,%1 offset:%c2" : "=&v"(hh[ks]) : "v"(vb), "i"(d0 * 4096 + ks * 1024 + 512) : "memory"); }
        asm volatile("s_waitcnt lgkmcnt(0)" ::: "memory"); __builtin_amdgcn_sched_barrier(0);
#pragma unroll
        for (int ks = 0; ks < 4; ++ks) { const bf16x8 vf = (bf16x8){lo[ks][0], lo[ks][1], lo[ks][2], lo[ks][3], hh[ks][0], hh[ks][1], hh[ks][2], hh[ks][3]};
            R.o[d0] = __builtin_amdgcn_mfma_f32_32x32x16_bf16(vf, pa[ks], R.o[d0], 0, 0, 0); } }
}

template <class RowPtr>
__device__ __forceinline__ void store_rows(LAS unsigned char* stg, const f32x16& o0, const f32x16& o1, float scale, float& ss, int lane, const RowPtr& rowptr) {
    const int r32 = lane & 31, hi = lane >> 5;
    LAS unsigned char* wp = stg + r32 * 144 + 8 * hi;
#pragma unroll
    for (int d0 = 0; d0 < 2; ++d0)
#pragma unroll
        for (int k = 0; k < 4; ++k) { const f32x16& o = d0 ? o1 : o0;
            const float v0 = o[4 * k] * scale, v1 = o[4 * k + 1] * scale, v2 = o[4 * k + 2] * scale, v3 = o[4 * k + 3] * scale;
            ss += (v0 * v0 + v1 * v1) + (v2 * v2 + v3 * v3);
            *(LAS unsigned long long*)(wp + 64 * d0 + 16 * k) = (unsigned long long)pk2(v0, v1) | ((unsigned long long)pk2(v2, v3) << 32); }
    asm volatile("s_waitcnt lgkmcnt(0)" ::: "memory");
#pragma unroll
    for (int i = 0; i < 4; ++i) { const int row = i * 8 + (lane >> 3), ch = lane & 7;
        const u32x4 v = *(const LAS u32x4*)(stg + row * 144 + ch * 16);
        __builtin_nontemporal_store(v, (u32x4*)(rowptr(row) + ch * 8)); }
}

template <class Src, class Fix, class Skip>
__device__ __forceinline__ void run_tiles(LAS unsigned char* ring, const Src& src, int kt0, int kt1, const bf16x8 (&qr)[Src::DK / 16], RowT<Src::NV>& R, const Fix& fix, const Skip& skip, int wid, int lane) {
    constexpr int KB = Src::DK * 128, SLOT = KB + 8192 * Src::NV;
    const int r32 = lane & 31, hi = lane >> 5; const int nt = kt1 - kt0;
    if (nt <= 0) return;
    src.issue(kt0, ring, ring + KB, wid);
    if (nt > 1) src.issue(kt0 + 1, ring + SLOT, ring + SLOT + KB, wid);
    int s_cur = 0, s_nn = 2 * SLOT;
    for (int i = 0; i < nt; ++i) {
        if (i + 1 < nt) wait_bar<Src::NDMA>(); else wait_bar<0>();
        if (i + 2 < nt) src.issue(kt0 + i + 2, ring + s_nn, ring + s_nn + KB, wid);
        const int tile = kt0 + i;
        if (!skip(tile)) {
            f32x16 p0, p1;
            qk_tile<Src::DK>(p0, p1, ring + s_cur, qr, r32, hi);
            fix(p0, p1, tile);
            softmax_tile(p0, p1, R);
            pv_tile(p0, p1, R, ring + s_cur + KB, lane, hi);
        }
        s_cur = (s_cur == 2 * SLOT) ? 0 : s_cur + SLOT; s_nn = (s_nn == 2 * SLOT) ? 0 : s_nn + SLOT;
    }
    asm volatile("s_waitcnt lgkmcnt(0)\n\ts_barrier" ::: "memory");
}
}


namespace att {
template <int N> __device__ __forceinline__ void wait_bar_n() {
    static_assert(N == 0 || N == 3 || N == 4 || N == 5 || N == 6 || N == 8, "wait_bar_n: add the count");
    if (N == 8) asm volatile("s_waitcnt vmcnt(8) lgkmcnt(0)\n\ts_barrier" ::: "memory"); else if (N == 6) asm volatile("s_waitcnt vmcnt(6) lgkmcnt(0)\n\ts_barrier" ::: "memory");
    else if (N == 5) asm volatile("s_waitcnt vmcnt(5) lgkmcnt(0)\n\ts_barrier" ::: "memory"); else if (N == 4) asm volatile("s_waitcnt vmcnt(4) lgkmcnt(0)\n\ts_barrier" ::: "memory");
    else if (N == 3) asm volatile("s_waitcnt vmcnt(3) lgkmcnt(0)\n\ts_barrier" ::: "memory"); else asm volatile("s_waitcnt vmcnt(0) lgkmcnt(0)\n\ts_barrier" ::: "memory"); }
typedef short v4i16_t __attribute__((ext_vector_type(4)));
typedef float f32x2_t __attribute__((ext_vector_type(2)));
__device__ __forceinline__ s16x4 vtr(const LAS unsigned char* p) { return __builtin_bit_cast(s16x4, __builtin_amdgcn_ds_read_tr16_b64_v4i16((LAS v4i16_t*)p)); }
__device__ __forceinline__ unsigned cvtpk(float lo, float hi) { f32x2_t v = {lo, hi}; bf16x2_t b = __builtin_convertvector(v, bf16x2_t); return __builtin_bit_cast(unsigned, b); }
#define SBAR() __builtin_amdgcn_sched_barrier(0)
#define PIN(x) asm volatile("" : "+v"(x))
#define MX3(a, b, c) __builtin_fmaxf(__builtin_fmaxf((a), (b)), (c))

template <class Src, class Fix>
__device__ __forceinline__ void run_pipe(LAS unsigned char* ring, const Src& src, int kt0, int kt1, const bf16x8 (&qr)[Src::DK / 16], Row& R, const Fix& fix, float bfar, int near_from, int wid, int lane) {
    constexpr int DK = Src::DK, NKS = DK / 16, NK = 2 * NKS, KB = DK * 128, VB = 8192, NKD = Src::NKD, NDMA = NKD + 1;
    const int NT = kt1 - kt0;
    constexpr bool ALT = false;
    if (wid >= 4) __builtin_amdgcn_s_setprio(1);
    const int r32 = lane & 31, hi = lane >> 5;
    LAS unsigned char* kring = ring; LAS unsigned char* vring = ring + 4 * KB;
    const LAS unsigned char* kp0 = kring + hi * 1024 + r32 * 16;
    const LAS unsigned char* vp0 = vring + ((lane >> 4) & 1) * 32 + (lane & 3) * 8 + (4 * hi + ((lane & 15) >> 2)) * 64;
#define TILE(tt) (kt0 + ((tt) < NT ? (tt) : NT - 1))
    src.issueK(TILE(0), kring, wid); src.issueV(TILE(0), vring, wid); src.issueK(TILE(1), kring + KB, wid); src.issueK(TILE(2), kring + 2 * KB, wid);
    src.issueK(TILE(3), kring + 3 * KB, wid); src.issueV(TILE(1), vring + VB, wid);
    bf16x8 kf[NK];
    f32x16 A0, A1, B0, B1, cin;
    float m = 0.f, l = 0.f, csh = 0.f; f32x16 o0 = f32x16{}, o1 = f32x16{};
    wait_bar_n<3 * NKD + 2>();
#define KLOAD(kslot) do { _Pragma("unroll") for (int d0 = 0; d0 < NKS; ++d0) { kf[2 * d0] = *(const LAS bf16x8*)(kp0 + (kslot) + d0 * 2048); kf[2 * d0 + 1] = *(const LAS bf16x8*)(kp0 + (kslot) + d0 * 2048 + 512); } } while (0)
#define ROWMAX(C0, C1, out) do { float a_ = MX3(C0[0], C0[1], C1[0]), b_ = MX3(C0[2], C0[3], C1[1]); a_ = MX3(a_, C1[2], C1[3]); \
        _Pragma("unroll") for (int r = 4; r < 16; r += 4) { a_ = MX3(a_, C0[r], C0[r + 1]); b_ = MX3(b_, C0[r + 2], C0[r + 3]); a_ = MX3(a_, C1[r], C1[r + 1]); b_ = MX3(b_, C1[r + 2], C1[r + 3]); } \
        out = swap_max(__builtin_fmaxf(a_, b_)); } while (0)
    KLOAD(0);
    A0 = f32x16{}; A1 = f32x16{};
#pragma unroll
    for (int d0 = 0; d0 < NKS; ++d0) { A0 = __builtin_amdgcn_mfma_f32_32x32x16_bf16(kf[2 * d0], qr[d0], A0, 0, 0, 0); A1 = __builtin_amdgcn_mfma_f32_32x32x16_bf16(kf[2 * d0 + 1], qr[d0], A1, 0, 0, 0); }
    fix(A0, A1, kt0);
    { float rm; ROWMAX(A0, A1, rm);
      const float sh0 = (kt0 < near_from) ? bfar : 0.f;
      const float dl = (rm > NEG_INF) ? rm + sh0 : 0.f; m = dl; const float c0 = sh0 - dl;
#pragma unroll
      for (int r = 0; r < 16; ++r) { A0[r] = __builtin_amdgcn_exp2f(A0[r] + c0); A1[r] = __builtin_amdgcn_exp2f(A1[r] + c0); }
      csh = (kt0 + 1 < near_from) ? bfar : 0.f;
#pragma unroll
      for (int r = 0; r < 16; ++r) cin[r] = csh - m;
      asm volatile("" : "+v"(cin)); }
    float fpend = 1.0f; bool resc = false;
    wait_bar_n<2 * NKD + 1>();
    src.issueK(TILE(4), kring, wid); src.issueV(TILE(2), vring + 2 * VB, wid);
    KLOAD(KB);
    wait_bar_n<2 * NDMA>();
    int kcur = KB, knext = 2 * KB, vprev = 0, vnext = 3 * VB;
    u32x4 pw0, pw1, pw2, pw3; s16x4 vlo[8], vhi[8];
#define PKW(P, b) cvtpk(P[b], P[(b) + 1])
#define VRD(i) do { vlo[i] = vtr(vp_ + (((i) >> 2) * 4096 + ((i) & 3) * 1024)); vhi[i] = vtr(vp_ + (((i) >> 2) * 4096 + ((i) & 3) * 1024 + 512)); } while (0)
#define VFR(i) (bf16x8){vlo[i][0], vlo[i][1], vlo[i][2], vlo[i][3], vhi[i][0], vhi[i][1], vhi[i][2], vhi[i][3]}
#define PAF(k) __builtin_bit_cast(bf16x8, pw##k)
#define QKM(i, C, first) C = __builtin_amdgcn_mfma_f32_32x32x16_bf16(kf[i], qr[(i) >> 1], (first) ? cin : C, 0, 0, 0)
#define GAPA(MF, a0_, a1_, a2_, a3_, W0, W1, PW) do { MF; sacc += a0_; sacc += a1_; sacc += a2_; sacc += a3_; PIN(sacc); W0; W1; PIN(PW); SBAR(); } while (0)
#define GAPB(MF, X, b) do { MF; X[b] = __builtin_amdgcn_exp2f(X[b]); X[(b) + 1] = __builtin_amdgcn_exp2f(X[(b) + 1]); X[(b) + 2] = __builtin_amdgcn_exp2f(X[(b) + 2]); X[(b) + 3] = __builtin_amdgcn_exp2f(X[(b) + 3]); PIN(X); SBAR(); } while (0)
#define PHASE_A(C0, C1, P0, P1) do { SBAR(); const LAS unsigned char* vp_ = vp0 + vprev; \
        VRD(0); SBAR(); float sacc = P0[0] + P0[1]; \
        GAPA(QKM(0, C0, true), P0[2], P0[3], P0[4], P0[5], pw0[0] = PKW(P0, 0), pw0[1] = PKW(P0, 2), pw0); \
        GAPA(QKM(1, C1, true), P0[6], P0[7], P0[8], P0[9], pw0[2] = PKW(P0, 4), pw0[3] = PKW(P0, 6), pw0); \
        VRD(1); SBAR(); GAPA(QKM(2, C0, false), P0[10], P0[11], P0[12], P0[13], pw1[0] = PKW(P0, 8), pw1[1] = PKW(P0, 10), pw1); \
        GAPA(QKM(3, C1, false), P0[14], P0[15], P1[0], P1[1], pw1[2] = PKW(P0, 12), pw1[3] = PKW(P0, 14), pw1); \
        VRD(2); SBAR(); GAPA(QKM(4, C0, false), P1[2], P1[3], P1[4], P1[5], pw2[0] = PKW(P1, 0), pw2[1] = PKW(P1, 2), pw2); \
        GAPA(QKM(5, C1, false), P1[6], P1[7], P1[8], P1[9], pw2[2] = PKW(P1, 4), pw2[3] = PKW(P1, 6), pw2); \
        VRD(3); SBAR(); GAPA(QKM(6, C0, false), P1[10], P1[11], P1[12], P1[13], pw3[0] = PKW(P1, 8), pw3[1] = PKW(P1, 10), pw3); \
        GAPA(QKM(7, C1, false), P1[14], P1[15], 0.f, 0.f, pw3[2] = PKW(P1, 12), pw3[3] = PKW(P1, 14), pw3); \
        if (NK > 8) { _Pragma("unroll") for (int i_ = 8; i_ < NK; i_ += 2) { QKM(i_, C0, false); QKM(i_ + 1, C1, false); } SBAR(); } \
        l += sacc; } while (0)
#define KRD(j) do { kf[2 * (j)] = *(const LAS bf16x8*)(kp0 + knext + (j) * 2048); kf[2 * (j) + 1] = *(const LAS bf16x8*)(kp0 + knext + (j) * 2048 + 512); SBAR(); } while (0)
#define PHASE_B(C0, C1) do { SBAR(); const LAS unsigned char* vp_ = vp0 + vprev; \
        VRD(4); SBAR(); GAPB(o0 = __builtin_amdgcn_mfma_f32_32x32x16_bf16(VFR(0), PAF(0), o0, 0, 0, 0), C0, 0); \
        VRD(5); SBAR(); GAPB(o0 = __builtin_amdgcn_mfma_f32_32x32x16_bf16(VFR(1), PAF(1), o0, 0, 0, 0), C0, 4); \
        VRD(6); SBAR(); KRD(0); GAPB(o0 = __builtin_amdgcn_mfma_f32_32x32x16_bf16(VFR(2), PAF(2), o0, 0, 0, 0), C0, 8); \
        VRD(7); SBAR(); KRD(1); GAPB(o0 = __builtin_amdgcn_mfma_f32_32x32x16_bf16(VFR(3), PAF(3), o0, 0, 0, 0), C0, 12); \
        KRD(2); GAPB(o1 = __builtin_amdgcn_mfma_f32_32x32x16_bf16(VFR(4), PAF(0), o1, 0, 0, 0), C1, 0); \
        KRD(3); GAPB(o1 = __builtin_amdgcn_mfma_f32_32x32x16_bf16(VFR(5), PAF(1), o1, 0, 0, 0), C1, 4); \
        if (NKS > 4) { KRD(4); } GAPB(o1 = __builtin_amdgcn_mfma_f32_32x32x16_bf16(VFR(6), PAF(2), o1, 0, 0, 0), C1, 8); \
        if (NKS > 5) { KRD(5); } GAPB(o1 = __builtin_amdgcn_mfma_f32_32x32x16_bf16(VFR(7), PAF(3), o1, 0, 0, 0), C1, 12); \
        } while (0)
#define DECIDE(C0, C1, tt) do { \
        fix(C0, C1, kt0 + (tt)); \
        float rm_; ROWMAX(C0, C1, rm_); resc = false; \
        const bool up_ = (rm_ > THR) || (l == 0.f && rm_ < -THR && rm_ > NEG_INF); \
        const float nsh_ = (kt0 + (tt) + 1 < near_from) ? bfar : 0.f; \
        if (__any(up_)) { const float dl_ = up_ ? rm_ : __builtin_fmaxf(rm_, 0.f); m += dl_; fpend = __builtin_amdgcn_exp2f(-dl_); l *= fpend; resc = true; \
            _Pragma("unroll") for (int r = 0; r < 16; ++r) { C0[r] -= dl_; C1[r] -= dl_; } \
            csh = nsh_; _Pragma("unroll") for (int r = 0; r < 16; ++r) cin[r] = csh - m; asm volatile("" : "+v"(cin)); } \
        else if (nsh_ != csh) { csh = nsh_; _Pragma("unroll") for (int r = 0; r < 16; ++r) cin[r] = csh - m; asm volatile("" : "+v"(cin)); } } while (0)
#define STEP(C0, C1, P0, P1, tt) do { \
        if (ALT && wid >= 4) asm volatile("s_barrier" ::: "memory"); \
        PHASE_A(C0, C1, P0, P1); \
        src.issueK(TILE((tt) + 4), kring + kcur, wid); src.issueV(TILE((tt) + 2), vring + vnext, wid); \
        DECIDE(C0, C1, tt); \
        PHASE_B(C0, C1); \
        if (ALT && wid < 4) asm volatile("s_waitcnt lgkmcnt(0)\n\ts_barrier" ::: "memory"); \
        wait_bar_n<2 * NDMA>();                                          \
        if (resc) { o0 *= fpend; o1 *= fpend; } \
        kcur = knext; knext = (knext == 3 * KB) ? 0 : knext + KB; \
        vprev = (vprev == 3 * VB) ? 0 : vprev + VB; vnext = (vnext == 3 * VB) ? 0 : vnext + VB; } while (0)
    int t = 1;
    for (; t + 1 < NT; t += 2) { STEP(B0, B1, A0, A1, t); STEP(A0, A1, B0, B1, t + 1); }
    if (t < NT) { STEP(B0, B1, A0, A1, t); A0 = B0; A1 = B1; }
    { float sacc = 0.f;
#pragma unroll
      for (int r = 0; r < 16; ++r) sacc += A0[r] + A1[r];
      l += sacc;
      pw0 = (u32x4){PKW(A0, 0), PKW(A0, 2), PKW(A0, 4), PKW(A0, 6)}; pw1 = (u32x4){PKW(A0, 8), PKW(A0, 10), PKW(A0, 12), PKW(A0, 14)};
      pw2 = (u32x4){PKW(A1, 0), PKW(A1, 2), PKW(A1, 4), PKW(A1, 6)}; pw3 = (u32x4){PKW(A1, 8), PKW(A1, 10), PKW(A1, 12), PKW(A1, 14)};
      const LAS unsigned char* vp_ = vp0 + vprev;
#pragma unroll
      for (int i = 0; i < 8; ++i) VRD(i);
      o0 = __builtin_amdgcn_mfma_f32_32x32x16_bf16(VFR(0), PAF(0), o0, 0, 0, 0); o1 = __builtin_amdgcn_mfma_f32_32x32x16_bf16(VFR(4), PAF(0), o1, 0, 0, 0);
      o0 = __builtin_amdgcn_mfma_f32_32x32x16_bf16(VFR(1), PAF(1), o0, 0, 0, 0); o1 = __builtin_amdgcn_mfma_f32_32x32x16_bf16(VFR(5), PAF(1), o1, 0, 0, 0);
      o0 = __builtin_amdgcn_mfma_f32_32x32x16_bf16(VFR(2), PAF(2), o0, 0, 0, 0); o1 = __builtin_amdgcn_mfma_f32_32x32x16_bf16(VFR(6), PAF(2), o1, 0, 0, 0);
      o0 = __builtin_amdgcn_mfma_f32_32x32x16_bf16(VFR(3), PAF(3), o0, 0, 0, 0); o1 = __builtin_amdgcn_mfma_f32_32x32x16_bf16(VFR(7), PAF(3), o1, 0, 0, 0); }
    wait_bar_n<0>();
    R.m = m; R.l = l; R.o[0] = o0; R.o[1] = o1;
    __builtin_amdgcn_s_setprio(0);
#undef TILE
#undef KLOAD
#undef ROWMAX
#undef DECIDE
#undef PKW
#undef VRD
#undef VFR
#undef PAF
#undef QKM
#undef GAPA
#undef GAPB
#undef PHASE_A
#undef KRD
#undef PHASE_B
#undef STEP
}
#undef SBAR
#undef PIN
#undef MX3
}
constexpr int MLA_STG_OFF = 98304;
__device__ __forceinline__ void p3_mla(const Ptrs& P, LAS unsigned char* lds, int vcu, int G, int tid, int wid) {
    using namespace att;
    for (int L = vcu; L < 2048; L += G) {
        int lane_u = tid & 63; asm volatile("" : "+v"(lane_u));
        const int lane = lane_u, r32 = lane & 31, hi = lane >> 5;
        int bh, qb;
        if (G == 256) { const int i = L >> 8, s8 = vcu & 7; bh = (vcu >> 3) + 32 * (i >> 1); qb = (i & 1) ? 15 - s8 : s8; }
        else { bh = L >> 4; qb = L & 15; }
        const int b = bh >> 3, h = bh & 7; const size_t rowb = (size_t)b * SEQ;
        const int q0 = qb * 256 + wid * 32, t = q0 + r32; const size_t row = rowb + t;
        bf16x8 qr[6];
#pragma unroll
        for (int d0 = 0; d0 < 6; ++d0) qr[d0] = *(const bf16x8*)(P.QM + row * 768 + h * 96 + d0 * 16 + hi * 8);
        SrcMLA src; src.init(P.KVM, P.kpe, rowb, h, wid, lane);
        Row R; row_reset(R);
        auto fix = [&](f32x16& p0, f32x16& p1, int tile) {
            if (tile * 64 + 63 > q0) {
                const int kb = tile * 64 + 4 * hi;
#pragma unroll
                for (int r = 0; r < 16; ++r) { const int kv = kb + (r & 3) + 8 * (r >> 2); if (kv > t) p0[r] = NEG_INF; if (kv + 32 > t) p1[r] = NEG_INF; } } };
        run_pipe(lds, src, 0, 4 * qb + 4, qr, R, fix, 0.f, 0x7fffffff, wid, lane);
        const float inv = 1.0f / swap_sum(R.l); float ss = 0.f;
        { bf16* const ob = P.ATT + (rowb + q0) * 1024 + h * 64;
          store_rows(lds + MLA_STG_OFF + wid * 4608, R.o[0], R.o[1], inv, ss, lane, [&](int r) -> bf16* { return ob + (size_t)r * 1024; }); }
        ss = swap_sum(ss);
        if (hi == 0) P.ssatt[row * 16 + h] = ss;
    }
}

constexpr int NSA_LB_OFF = 81920;
constexpr int NSA_OUT_OFF = 86016;
__device__ __forceinline__ float dpp_xor1(float x) { return __builtin_bit_cast(float, __builtin_amdgcn_update_dpp(0, __builtin_bit_cast(int, x), 0xB1, 0xF, 0xF, false)); }
__device__ __forceinline__ float dpp_xor2(float x) { return __builtin_bit_cast(float, __builtin_amdgcn_update_dpp(0, __builtin_bit_cast(int, x), 0x4E, 0xF, 0xF, false)); }
__device__ __forceinline__ unsigned dpp_xor1u(unsigned x) { return (unsigned)__builtin_amdgcn_update_dpp(0, (int)x, 0xB1, 0xF, 0xF, false); }
__device__ __forceinline__ unsigned dpp_xor2u(unsigned x) { return (unsigned)__builtin_amdgcn_update_dpp(0, (int)x, 0x4E, 0xF, 0xF, false); }
template <int STEP, int YOFF> __device__ __forceinline__ void add_bias(att::f32x16& p, const LAS float* lb, int D) {
#pragma unroll
    for (int r = 0; r < 16; ++r) { int d = D - STEP * ((r & 3) + 8 * (r >> 2) + YOFF); d = d < 0 ? 0 : (d > 127 ? 127 : d); p[r] += lb[d]; }
}
__device__ __forceinline__ void p3_nsa(const Ptrs& P, LAS unsigned char* lds, int vcu, int G, int tid, int wid) {
    using namespace att;
    LAS float* LB = (LAS float*)(lds + NSA_LB_OFF);
    for (int e = tid; e < 1024; e += NTHR) LB[e] = P.bias[e];
    __syncthreads();
    for (int L = vcu; L < 2048; L += G) {
        int bhk, c;
        if (G == 256) { const int i = L >> 8, sub = vcu & 7; bhk = vcu >> 3; const int base = 16 * (i >> 1); c = (i & 1) ? base + 15 - sub : base + sub; }
        else { bhk = L >> 6; c = L & 63; }
        int lane_u = tid & 63; asm volatile("" : "+v"(lane_u));
        const int lane = lane_u, r32 = lane & 31, hi = lane >> 5, ql = r32 >> 2, g = r32 & 3;
        const int b = bhk >> 1, hk = bhk & 1, hq = hk * 4 + g; const size_t rowb = (size_t)b * SEQ;
        const int t = c * 64 + wid * 8 + ql; const size_t row = rowb + t;
        const LAS float* lb = LB + hq * 128; const float b31 = lb[127];
        bf16x8 qr[4];
#pragma unroll
        for (int d0 = 0; d0 < 4; ++d0) qr[d0] = *(const bf16x8*)(P.U + row * DINP + C_QN + hq * 64 + d0 * 16 + hi * 8);
        float gate[3];
#pragma unroll
        for (int br = 0; br < 3; ++br) { const float x = bf2f(P.U[row * DINP + C_GATE + hq * 3 + br]); gate[br] = __builtin_amdgcn_rcpf(1.0f + __builtin_amdgcn_exp2f(-x * LOG2E)); }
        LAS float* outp = (LAS float*)(lds + NSA_OUT_OFF) + wid * 2048 + lane;
        unsigned mlo, mhi;
        {
            const int nv = t >= 31 ? ((t - 31) >> 4) + 1 : 0;
            int ln = lane_u; asm volatile("" : "+v"(ln));
            SrcCmp src; src.init(P.kcmp + (size_t)bhk * 256 * 64, P.vcmp + (size_t)bhk * 256 * 64, P.ovt, wid, ln);
            RowT<2> R; row_reset(R);
            auto fix = [&](f32x16& p0, f32x16& p1, int tile) {
                const int D = t - 31 - 16 * (64 * tile + 4 * hi);
                add_bias<16, 0>(p0, lb, D); add_bias<16, 32>(p1, lb, D);
                const int ib = 64 * tile + 4 * hi;
#pragma unroll
                for (int r = 0; r < 16; ++r) { const int i = ib + (r & 3) + 8 * (r >> 2); if (i >= nv) p0[r] = NEG_INF; if (i + 32 >= nv) p1[r] = NEG_INF; } };
            auto skip = [&](int) -> bool { return false; };
            run_tiles(lds, src, 0, (4 * c + 3 + 63) >> 6, qr, R, fix, skip, wid, lane);
            const float lt = swap_sum(R.l); const float inv = lt > 0.f ? 1.0f / lt : 0.f;
            { const float f = gate[0] * inv;
#pragma unroll
              for (int i = 0; i < 16; ++i) { outp[64 * i] = R.o[0][i] * f; outp[64 * (16 + i)] = R.o[1][i] * f; } }
            mlo = 0u; mhi = 0u;
            if (c <= 15) { const unsigned long long mk = (2ull << c) - 1ull; mlo = (unsigned)mk; mhi = (unsigned)(mk >> 32); }
            else {
                float cand[8];
#pragma unroll
                for (int rr = 0; rr < 8; ++rr) {
                    float v00 = R.o[2][rr] * inv, v01 = R.o[2][8 + rr] * inv, v10 = R.o[3][rr] * inv, v11 = R.o[3][8 + rr] * inv;
                    v00 += dpp_xor1(v00); v00 += dpp_xor2(v00); v01 += dpp_xor1(v01); v01 += dpp_xor2(v01); v10 += dpp_xor1(v10); v10 += dpp_xor2(v10); v11 += dpp_xor1(v11); v11 += dpp_xor2(v11);
                    cand[rr] = (g & 2) ? ((g & 1) ? v11 : v10) : ((g & 1) ? v01 : v00); }
                unsigned key[8];
#pragma unroll
                for (int rr = 0; rr < 8; ++rr) { const int j = 32 * (g >> 1) + (rr & 3) + 8 * (2 * (g & 1) + (rr >> 2)) + 4 * hi;
                    const bool ok = j >= 1 && j <= c - 2; key[rr] = ok ? ((__float_as_uint(fmaxf(cand[rr], 0.f)) & ~63u) | (unsigned)(63 - j)) : 0u; }
                unsigned long long mk = 1ull | (1ull << c) | (1ull << (c - 1));
                for (int round = 0; round < 13; ++round) {
                    unsigned best = key[0];
#pragma unroll
                    for (int rr = 1; rr < 8; ++rr) best = best > key[rr] ? best : key[rr];
                    { const unsigned o1 = dpp_xor1u(best); best = best > o1 ? best : o1; const unsigned o2 = dpp_xor2u(best); best = best > o2 ? best : o2;
                      auto rr2 = __builtin_amdgcn_permlane32_swap(best, best, false, false); best = rr2[0] > rr2[1] ? rr2[0] : rr2[1]; }
                    if (best != 0u) mk |= 1ull << (63u - (best & 63u));
#pragma unroll
                    for (int rr = 0; rr < 8; ++rr) key[rr] = (key[rr] == best) ? 0u : key[rr];
                }
                mlo = (unsigned)mk; mhi = (unsigned)(mk >> 32);
            }
        }
        {
            int ln = lane_u; asm volatile("" : "+v"(ln));
            SrcRows src; src.init(P.U + rowb * DINP + C_KVS + hk * 64, P.U + rowb * DINP + C_KVS + 128 + hk * 64, DINP, wid, ln);
            Row R; row_reset(R);
            auto fix = [&](f32x16& p0, f32x16& p1, int tile) {
                if (tile >= c - 2) { const int D = t - 64 * tile - 4 * hi; add_bias<1, 0>(p0, lb, D); asm volatile("" ::: "memory"); add_bias<1, 32>(p1, lb, D); }
                const bool sel = ((tile < 32 ? (mlo >> tile) : (mhi >> (tile - 32))) & 1u) != 0u;
                if (tile == c) { const int kb = tile * 64 + 4 * hi;
#pragma unroll
                    for (int r = 0; r < 16; ++r) { const int kv = kb + (r & 3) + 8 * (r >> 2); if (kv > t || !sel) p0[r] = NEG_INF; if (kv + 32 > t || !sel) p1[r] = NEG_INF; } }
                else if (!sel) {
#pragma unroll
                    for (int r = 0; r < 16; ++r) { p0[r] = NEG_INF; p1[r] = NEG_INF; } } };
            run_pipe(lds, src, 0, c + 1, qr, R, fix, b31, c - 2, wid, lane);
            const float f = gate[1] / swap_sum(R.l);
#pragma unroll
            for (int i = 0; i < 16; ++i) { outp[64 * i] += R.o[0][i] * f; outp[64 * (16 + i)] += R.o[1][i] * f; }
        }
        f32x16 out[2];
        {
            int ln = lane_u; asm volatile("" : "+v"(ln));
            SrcRows src; src.init(P.U + rowb * DINP + C_KVW + hk * 64, P.U + rowb * DINP + C_KVW + 128 + hk * 64, DINP, wid, ln);
            Row R; row_reset(R);
            auto fix = [&](f32x16& p0, f32x16& p1, int tile) {
                if (tile >= c - 2) { const int D = t - 64 * tile - 4 * hi; add_bias<1, 0>(p0, lb, D); asm volatile("" ::: "memory"); add_bias<1, 32>(p1, lb, D); }
                if (tile == c || tile == c - 8) { const int kb = tile * 64 + 4 * hi;
#pragma unroll
                    for (int r = 0; r < 16; ++r) { const int kv = kb + (r & 3) + 8 * (r >> 2); const int d0_ = t - kv, d1_ = d0_ - 32;
                        if (d0_ < 0 || d0_ >= 512) p0[r] = NEG_INF; if (d1_ < 0 || d1_ >= 512) p1[r] = NEG_INF; } } };
            run_pipe(lds, src, c >= 8 ? c - 8 : 0, c + 1, qr, R, fix, b31, c - 2, wid, lane);
            const float f = gate[2] / swap_sum(R.l);
#pragma unroll
            for (int i = 0; i < 16; ++i) { out[0][i] = outp[64 * i] + R.o[0][i] * f; out[1][i] = outp[64 * (16 + i)] + R.o[1][i] * f; }
        }
        { float ss = 0.f; bf16* const ob = P.ATT + (rowb + c * 64 + wid * 8) * 1024 + 512 + hk * 256;
            store_rows(lds + NSA_OUT_OFF + wid * 8192, out[0], out[1], 1.0f, ss, lane, [&](int r) -> bf16* { return ob + (size_t)(r >> 2) * 1024 + (r & 3) * 64; });
            ss = swap_sum(ss);
            if (hi == 0) P.ssatt[row * 16 + 8 + hq] = ss; }
    }
}

__global__ void __launch_bounds__(NTHR, 2) mega_fwd(Args args) {
    extern __shared__ __attribute__((aligned(16))) unsigned char lds_raw[];
    LAS unsigned char* lds = (LAS unsigned char*)lds_raw;
    volatile LAS unsigned* MISC = (volatile LAS unsigned*)(lds + MISC_OFF);
    const int tid0 = threadIdx.x;
#define LAUNDER_TID() int tid = tid0; asm volatile("" : "+v"(tid)); const int lane = tid & 63, wave = __builtin_amdgcn_readfirstlane(tid >> 6); (void)lane; (void)wave
    const int G = gridDim.x, wg = blockIdx.x;
    const int vcu = (G % 8 == 0) ? (wg % 8) * (G / 8) + wg / 8 : wg;
    unsigned char* ws = args.ws;
    Ptrs P;
#pragma unroll
    for (int i = 0; i < 22; ++i) P.in[i] = args.in[i];
    P.out = args.out; P.ws = ws;
    P.Win = (bf16*)(ws + WS_WIN); P.Wuq = (bf16*)(ws + WS_WUQ); P.Wukv = (bf16*)(ws + WS_WUKV); P.Wout = (bf16*)(ws + WS_WOUT); P.Wgu = (bf16*)(ws + WS_WGU); P.Wdn = (bf16*)(ws + WS_WDN);
    P.rope = (f32x2v*)(ws + WS_ROPE); P.bias = (float*)(ws + WS_BIAS); P.bias1 = (float*)(ws + WS_BIAS1); P.rstdx = (float*)(ws + WS_RSTDX);
    P.ssqkv = (float*)(ws + WS_SSQKV); P.ssatt = (float*)(ws + WS_SSATT); P.ssh = (float*)(ws + WS_SSH);
    P.kcmp = (bf16*)(ws + WS_KCMP); P.vcmp = (bf16*)(ws + WS_VCMP); P.kpe = (bf16*)(ws + WS_KPE); P.ovt = (bf16*)(ws + WS_OVT); P.W1c = (bf16*)(ws + WS_W1C); P.W2t = (bf16*)(ws + WS_W2T);
    P.XB = (bf16*)(ws + WS_XB); P.U = (bf16*)(ws + WS_U); P.QM = (bf16*)(ws + WS_QM); P.KVM = (bf16*)(ws + WS_KVM); P.ATT = (bf16*)(ws + WS_ATT); P.H = (bf16*)(ws + WS_H); P.HID = (bf16*)(ws + WS_HID);
    gu32* ctl = (gu32*)(ws + WS_CTL);

    if (tid0 < 64) MISC[tid0] = 0u;
    __syncthreads();
    XcdBarrier bar; bar.bar = (unsigned*)(ctl + CW_BAR); bar.x = 0; bar.st = nullptr;
    if (N_LAUNCHES == 1) bar = xcd_barrier_post((unsigned*)(ctl + CW_BAR), MISC + 8);
#define GRID_BAR() do { if (N_LAUNCHES == 1) xcd_barrier(bar); } while (0)
    const int lo = args.ph_lo, hi = args.ph_hi;
#ifndef PHASE_MASK
#define PHASE_MASK 0xff
#endif
#define IN(k) (((PHASE_MASK >> (k)) & 1) && lo <= (k) && (k) < hi)
#define BOTH(k) (IN(k) && IN((k) + 1))
#ifndef REPEAT_MASK
#define REPEAT_MASK 0
#endif
#define REP(k) for (int rep_ = 0; rep_ < (((REPEAT_MASK >> (k)) & 1) ? 2 : 1); ++rep_)

    if (IN(0)) { REP(0) { LAUNDER_TID(); p0_prologue(P, lds, wg, G, wave, lane, tid); } if (BOTH(0)) GRID_BAR(); }

    if (IN(1)) {
        REP(1) {
        pg8::Gemm g{P.XB, P.Win, MT, DINP, 1024, 1024, 1024, 0}; pg8::StaticOrder S; S.init(MT, DINP, G, wg);
        EpiInProj E{P.U, P.rstdx, P.ssqkv};
        pg8::gemm_phase<EpiInProj, pg8::StaticOrder, true, true>(lds, g, S, E); }
        if (BOTH(1)) GRID_BAR();
    }

    if (IN(2)) {
        REP(2) {
        { LAUNDER_TID(); p2_kpe(P, wg, G, tid); }
        { pg8::Gemm g{P.U, P.W1c, 64 * 256, 256, 1024, 16 * DINP, 1024, DINP * 2}; CmpOrder S{G, wg, P.U, P.W1c};
          EpiCmp E{P.bias1, P.W2t, P.kcmp, P.vcmp};
          pg8::gemm_phase<EpiCmp, CmpOrder, false, true>(lds, g, S, E); }
        { const int gq = G > 64 ? G - 64 : G, cq = G > 64 ? wg - 64 : wg;
          if (cq >= 0) { pg8::Gemm g{P.U + C_CQ, P.Wuq, MT, 768, 256, DINP, 256, 0}; pg8::StaticOrder S; S.init(MT, 768, gq, cq);
            EpiQup E{P.QM, P.ssqkv, P.rope};
            pg8::gemm_phase<EpiQup, pg8::StaticOrder, true, true>(lds, g, S, E); } }
        { pg8::Gemm g{P.U + C_CKV, P.Wukv, MT, 1024, 128, DINP, 256, 0}; pg8::StaticOrder S; S.init(MT, 1024, G, wg);
          EpiKVup E{P.KVM, P.ssqkv};
          pg8::gemm_phase<EpiKVup, pg8::StaticOrder, true, true>(lds, g, S, E); }
        }
        if (BOTH(2)) GRID_BAR();
    }

    if (IN(3)) {
        REP(3) {
        REP(8) { LAUNDER_TID(); p3_mla(P, lds, vcu, G, tid, wave); }
        REP(9) { LAUNDER_TID(); p3_nsa(P, lds, vcu, G, tid, wave); }
        }
        if (BOTH(3)) GRID_BAR();
    }

    if (IN(4)) {
        REP(4) {
        { pg8::Gemm g{P.ATT, P.Wout, MT, 1024, 1024, 1024, 1024, 0}; OutOrder S; S.init(MT, 1024, G, wg); S.ssatt = P.ssatt; S.tab = (LAS float*)(lds + OUT_TAB_OFF);
          EpiOut E{P.XB, P.H, P.ssh, (const LAS float*)(lds + OUT_TAB_OFF)};
          pg8::gemm_phase<EpiOut, OutOrder, true, true>(lds, g, S, E); }
        }
        if (BOTH(4)) GRID_BAR();
    }

    if (IN(5)) {
        REP(5) {
        pg8::Gemm g{P.H, P.Wgu, MT, NGU, 1024, 1024, 1024, 0}; GUOrder S; S.init(MT, NGU, G, wg); S.ssh = P.ssh; S.tab = (LAS float*)(lds + OUT_TAB_OFF);
        EpiGU E{P.HID, (const LAS float*)(lds + OUT_TAB_OFF)};
        pg8::gemm_phase<EpiGU, GUOrder, true, true>(lds, g, S, E); }
        if (BOTH(5)) GRID_BAR();
    }

    if (IN(6)) {
        REP(6) {
        pg8::Gemm g{P.HID, P.Wdn, MT, 1024, DFF, DFF, DFF, 0}; pg8::StaticOrder S; S.init(MT, 1024, G, wg);
        EpiDown E{P.H, P.ATT, P.ssatt};
        pg8::gemm_phase<EpiDown, pg8::StaticOrder, true, true>(lds, g, S, E); }
        if (BOTH(6)) GRID_BAR();
    }

    if (IN(7)) { LAUNDER_TID(); p7_final(P, wg, G, wave, lane); }
#undef IN
#undef BOTH
#undef GRID_BAR
}

extern "C" void kernel_launch(void* const* d_in, const int* in_sizes, int n_in, void* d_out, int out_size, void* d_ws, size_t ws_size, hipStream_t stream) {
    static int grid = 0;
    if (grid == 0) {
        if (n_in != 22 || in_sizes[0] != MT * DM || out_size != MT * DM || ws_size < WS_END) { fprintf(stderr, "kernel_launch: unexpected shapes (n_in %d, in0 %d, out %d, ws %zu); nothing launched\n", n_in, n_in > 0 ? in_sizes[0] : -1, out_size, ws_size); grid = -1; return; }
        int dev = 0, cus = 0, per_cu = 0;
        if (hipGetDevice(&dev) != hipSuccess || hipDeviceGetAttribute(&cus, hipDeviceAttributeMultiprocessorCount, dev) != hipSuccess) { fprintf(stderr, "kernel_launch: device query failed\n"); grid = -1; return; }
        if (hipFuncSetAttribute((const void*)mega_fwd, hipFuncAttributeMaxDynamicSharedMemorySize, LDS_BYTES) != hipSuccess) { fprintf(stderr, "kernel_launch: hipFuncSetAttribute failed\n"); grid = -1; return; }
        if (hipOccupancyMaxActiveBlocksPerMultiprocessor(&per_cu, (const void*)mega_fwd, NTHR, LDS_BYTES) != hipSuccess || per_cu < 1)
            fprintf(stderr, "kernel_launch: note: occupancy query reports %d workgroups per CU\n", per_cu);
        (void)hipGetLastError();
        grid = cus;
    }
    if (grid < 0) return;
    if (hipMemsetAsync((char*)d_ws + WS_CTL, 0, CTL_ZERO_BYTES, stream) != hipSuccess) { fprintf(stderr, "kernel_launch: memset failed\n"); return; }
    Args a{};
    for (int i = 0; i < 22; ++i) a.in[i] = (const float*)d_in[i];
    a.out = (float*)d_out; a.ws = (unsigned char*)d_ws;
    for (int li = 0; li < N_LAUNCHES; ++li) {
        a.ph_lo = (N_LAUNCHES == 1) ? 0 : li; a.ph_hi = (N_LAUNCHES == 1) ? NPHASE : li + 1; a.li = li; a.pad = 0;
        hipLaunchKernelGGL(mega_fwd, dim3(grid), dim3(NTHR), LDS_BYTES, stream, a);
        const hipError_t le = hipPeekAtLastError();
        if (le != hipSuccess) { fprintf(stderr, "kernel_launch: launch %d failed: %s\n", li, hipGetErrorName(le)); break; }
    }
}
```

```cpp
#include <hip/hip_runtime.h>
#include <cstdio>
#include <cstdint>
namespace pg8 {
#define PG8_LAS __attribute__((address_space(3)))
typedef unsigned short bf16_t;
typedef short bf16x8 __attribute__((ext_vector_type(8)));
typedef float f32x4 __attribute__((ext_vector_type(4)));
typedef unsigned u32x4 __attribute__((ext_vector_type(4)));
constexpr int BM = 256, BK = 64, HALF = 128, HTB = HALF * BK * 2  , STAGE_BYTES = 8 * HTB, NXCD = 8, WGM = 8;

__host__ __device__ __forceinline__ int lds_byte(int r, int c) { const int st = (r >> 4) * 2 + (c >> 5), rr = r & 15, cc = c & 31, ob = rr * 64 + cc * 2; return st * 1024 + (ob ^ (((ob >> 9) & 1) << 5)); }
__host__ __device__ __forceinline__ void stage_rc(int b, int& R, int& C) { const int st = b / 1024, sb = b % 1024, swz = sb ^ (((sb >> 9) & 1) << 5); R = (st >> 1) * 16 + swz / 64; C = (st & 1) * 32 + (swz % 64) / 2; }
__host__ __device__ __forceinline__ int perm32(int rho) { const int n = rho >> 4, i = rho & 15; return 8 * (i >> 2) + 4 * n + (i & 3); }

struct Unit { int pm, pn, ui; };
struct Gemm { const bf16_t* A; const bf16_t* Bt; int M, N, K, lda, ldb, kstepA; };

struct StaticOrder {
    int nM, nN, nwg, G, c;
    __host__ __device__ void init(int M, int N, int G_, int c_) { nM = M / BM; nN = N / BM; nwg = nM * nN; G = G_; c = c_; }
    __host__ __device__ bool next(int i, Unit& u) const {
        const long L = (long)i * G + c; if (L >= nwg) return false;
        int wgid = (int)L; { const int q = nwg / NXCD, r = nwg % NXCD, xcd = wgid % NXCD, off = wgid / NXCD; wgid = (xcd < r ? xcd * (q + 1) : r * (q + 1) + (xcd - r) * q) + off; }
        const int nig = WGM * nN, gid = wgid / nig, fm = gid * WGM, gsz = (nM - fm) < WGM ? (nM - fm) : WGM;
        u.pm = fm + ((wgid % nig) % gsz); u.pn = (wgid % nig) / gsz; u.ui = i; return true;
    }
    __device__ __forceinline__ void a_ready(const Unit&) const {}
    __device__ __forceinline__ void done(const Unit&) const {}
    __device__ __forceinline__ const char* a_base(const Gemm& g, const Unit& u, size_t tstepA) const { return (const char*)g.A + (size_t)u.pm * tstepA; }
    __device__ __forceinline__ const char* b_base(const Gemm& g, const Unit& u, size_t tstepB) const { return (const char*)g.Bt + (size_t)u.pn * tstepB; }
};

__device__ __forceinline__ unsigned cvt_pk_bf16(float lo, float hi) { unsigned r; asm volatile("v_cvt_pk_bf16_f32 %0, %1, %2" : "=v"(r) : "v"(lo), "v"(hi)); return r; }
typedef float f32x2 __attribute__((ext_vector_type(2)));
typedef int i32x8 __attribute__((ext_vector_type(8)));
typedef int i32x4 __attribute__((ext_vector_type(4)));
__device__ __forceinline__ i32x8 cat8(bf16x8 lo, bf16x8 hi) { const i32x4 a = __builtin_bit_cast(i32x4, lo), b = __builtin_bit_cast(i32x4, hi); return __builtin_shufflevector(a, b, 0, 1, 2, 3, 4, 5, 6, 7); }
__device__ __forceinline__ unsigned cvt_pk4_fp8(float a, float b, float c, float d) { int w = 0; w = __builtin_amdgcn_cvt_pk_fp8_f32(a, b, w, false); w = __builtin_amdgcn_cvt_pk_fp8_f32(c, d, w, true); return (unsigned)w; }
__device__ __forceinline__ void glds16(const char* sbase, unsigned voff, unsigned dst) { unsigned keep;
    asm volatile("s_mov_b32 %0, m0\n\ts_mov_b32 m0, %3\n\ts_nop 0\n\tglobal_load_lds_dwordx4 %1, %2\n\ts_mov_b32 m0, %0" : "=&s"(keep) : "v"(voff), "s"(sbase), "s"(dst) : "memory"); }
template <class Epi, class Sched, bool ALIGN_EPI = false, bool SP2 = false, bool FP8 = false>
__device__ __forceinline__ void gemm_phase(PG8_LAS unsigned char* lds, const Gemm g, const Sched& S, const Epi& E) {
    int tid_ = threadIdx.x; asm volatile("" : "+v"(tid_));
    const int tid = tid_, wid = __builtin_amdgcn_readfirstlane(tid >> 6), lane = tid & 63, wr = wid >> 2, wc = wid & 3, fr = lane & 15, fq = lane >> 4;
    const int K = g.K, nt = K / BK;
    unsigned voffA, voffB;
    { int R, C; stage_rc(tid * 16, R, C); const int Rb = Epi::PERM ? ((R & ~31) + perm32(R & 31)) : R;
      voffA = (unsigned)(R * g.lda + C) * 2u; voffB = (unsigned)(Rb * g.ldb + C) * 2u; }
    const size_t qstepA = (size_t)64 * g.lda * 2, qstepB = (size_t)64 * g.ldb * 2;
    const size_t kstepA = g.kstepA ? (size_t)g.kstepA : (size_t)(BK * 2), kstepB = (size_t)(BK * 2);
    const size_t hstepA = (size_t)HALF * g.lda * 2, hstepB = (size_t)HALF * g.ldb * 2;
    const size_t tstepA = 2 * hstepA, tstepB = 2 * hstepB;
    const unsigned ldsb = (unsigned)(uintptr_t)lds + (unsigned)wid * 1024u;
    const int aoff = lds_byte(wr * 64 + fr, fq * 8), boff = lds_byte(wc * 32 + fr, fq * 8);
#define PG8_SA(b, h) (((b) * 2 + (h)) * HTB)
#define PG8_SB(b, h) ((4 + (b) * 2 + (h)) * HTB)
#define qvoffA qstepA
#define qvoffB qstepB
#define PG8_STAGE(bufoff, gbase, voff) do { glds16((const char*)(gbase), voff, ldsb + (unsigned)(bufoff)); glds16((const char*)(gbase) + q##voff, voff, ldsb + (unsigned)(bufoff) + 8192u); } while (0)
#define PG8_LDA(dst, b, h) do { _Pragma("unroll") for (int m = 0; m < 4; ++m) _Pragma("unroll") for (int k = 0; k < 2; ++k) dst[m][k] = *(const PG8_LAS bf16x8*)(lds + PG8_SA(b, h) + aoff + m * 2048 + k * 1024); } while (0)
#define PG8_LDB(dst, b, h) do { _Pragma("unroll") for (int n = 0; n < 2; ++n) _Pragma("unroll") for (int k = 0; k < 2; ++k) dst[n][k] = *(const PG8_LAS bf16x8*)(lds + PG8_SB(b, h) + boff + n * 2048 + k * 1024); } while (0)
#define PG8_MMA(ai, bj, At, Bt) do { __builtin_amdgcn_s_setprio(1); _Pragma("unroll") for (int m = 0; m < 4; ++m) _Pragma("unroll") for (int n = 0; n < 2; ++n) { \
        if constexpr (FP8) acc[ai][bj][m][n] = __builtin_amdgcn_mfma_scale_f32_16x16x128_f8f6f4(cat8(Bt[n][0], Bt[n][1]), cat8(At[m][0], At[m][1]), acc[ai][bj][m][n], 0, 0, 0, 0, 0, 0); \
        else { _Pragma("unroll") for (int k = 0; k < 2; ++k) acc[ai][bj][m][n] = __builtin_amdgcn_mfma_f32_16x16x32_bf16(Bt[n][k], At[m][k], acc[ai][bj][m][n], 0, 0, 0); } } __builtin_amdgcn_s_setprio(0); } while (0)
#define PG8_WAIT_V(n) asm volatile("s_waitcnt vmcnt(" #n ")" ::: "memory")
#define PG8_WAIT_L(n) asm volatile("s_waitcnt lgkmcnt(" #n ")" ::: "memory")
#define PG8_BAR __builtin_amdgcn_s_barrier()
#define PG8_SCHED __builtin_amdgcn_sched_barrier(0)
    Unit cur, nxt; int ui = 0;
    if (!S.next(0, cur)) return;
    f32x4 acc[2][2][4][2];
#pragma unroll
    for (int a = 0; a < 2; ++a)
#pragma unroll
        for (int b = 0; b < 2; ++b)
#pragma unroll
            for (int m = 0; m < 4; ++m)
#pragma unroll
                for (int n = 0; n < 2; ++n) acc[a][b][m][n] = (f32x4){0.f, 0.f, 0.f, 0.f};
    bf16x8 At[4][2], B0[2][2], B1[2][2];
    const char* cA = S.a_base(g, cur, tstepA); const char* cB = S.b_base(g, cur, tstepB);
    S.a_ready(cur);
    if constexpr (SP2) {
        PG8_STAGE(PG8_SB(0, 0), cB, voffB); PG8_STAGE(PG8_SB(0, 1), cB + hstepB, voffB); PG8_STAGE(PG8_SA(0, 0), cA, voffA); PG8_STAGE(PG8_SA(0, 1), cA + hstepA, voffA);
        if (wr == 1) PG8_BAR;
        PG8_WAIT_V(2); PG8_BAR;
        PG8_STAGE(PG8_SB(1, 0), cB + kstepB, voffB); PG8_STAGE(PG8_SA(1, 0), cA + kstepA, voffA); PG8_STAGE(PG8_SB(1, 1), cB + hstepB + kstepB, voffB);
        PG8_WAIT_V(6); PG8_BAR;
    } else {
        PG8_STAGE(PG8_SB(0, 0), cB, voffB); PG8_STAGE(PG8_SA(0, 0), cA, voffA); PG8_STAGE(PG8_SB(0, 1), cB + hstepB, voffB); PG8_STAGE(PG8_SA(0, 1), cA + hstepA, voffA);
        if (wr == 1) PG8_BAR;
        PG8_WAIT_V(4); PG8_BAR;
        PG8_STAGE(PG8_SB(1, 0), cB + kstepB, voffB); PG8_STAGE(PG8_SA(1, 0), cA + kstepA, voffA); PG8_STAGE(PG8_SB(1, 1), cB + hstepB + kstepB, voffB);
        PG8_WAIT_V(6); PG8_BAR;
    }
    for (;;) {
        const bool has_next = S.next(ui + 1, nxt);
        const char* nA = has_next ? S.a_base(g, nxt, tstepA) : cA; const char* nB = has_next ? S.b_base(g, nxt, tstepB) : cB;
        for (int t = 0; t < nt; t += 2) {
            if constexpr (Epi::MIDK) { if (t == (nt >> 1)) E.midk(acc, cur, wr, fr); }
            const bool last = (t == nt - 2);
            const char* a1 = cA + (size_t)(t + 1) * kstepA;
            const char* a2 = last ? nA : cA + (size_t)(t + 2) * kstepA; const char* b2 = last ? nB : cB + (size_t)(t + 2) * kstepB;
            const char* a3 = a2 + kstepA; const char* b3 = b2 + kstepB;
            if (last && has_next) S.a_ready(nxt);
            if constexpr (SP2) {
            PG8_LDB(B0, 0, 0); PG8_LDB(B1, 0, 1); PG8_SCHED; PG8_LDA(At, 0, 0); PG8_STAGE(PG8_SA(1, 1), a1 + hstepA, voffA);
            PG8_WAIT_V(8); PG8_WAIT_L(0); PG8_BAR; PG8_MMA(0, 0, At, B0); PG8_MMA(0, 1, At, B1); PG8_BAR; PG8_SCHED;
            PG8_LDA(At, 0, 1); PG8_STAGE(PG8_SB(0, 0), b2, voffB); PG8_STAGE(PG8_SB(0, 1), b2 + hstepB, voffB); PG8_STAGE(PG8_SA(0, 0), a2, voffA);
            PG8_WAIT_V(8); PG8_WAIT_L(0); PG8_BAR; PG8_MMA(1, 0, At, B0); PG8_MMA(1, 1, At, B1); PG8_BAR; PG8_SCHED;
            PG8_LDB(B0, 1, 0); PG8_LDB(B1, 1, 1); PG8_SCHED; PG8_LDA(At, 1, 0); PG8_STAGE(PG8_SA(0, 1), a2 + hstepA, voffA);
            PG8_WAIT_V(8); PG8_WAIT_L(0); PG8_BAR; PG8_MMA(0, 0, At, B0); PG8_MMA(0, 1, At, B1); PG8_BAR; PG8_SCHED;
            PG8_LDA(At, 1, 1); PG8_STAGE(PG8_SB(1, 0), b3, voffB); PG8_STAGE(PG8_SB(1, 1), b3 + hstepB, voffB); PG8_STAGE(PG8_SA(1, 0), a3, voffA);
            PG8_WAIT_V(8); PG8_WAIT_L(0); PG8_BAR; PG8_MMA(1, 0, At, B0); PG8_MMA(1, 1, At, B1); PG8_BAR; PG8_SCHED;
            } else {
            PG8_LDB(B0, 0, 0); PG8_SCHED; PG8_LDA(At, 0, 0); PG8_STAGE(PG8_SA(1, 1), a1 + hstepA, voffA);
            PG8_WAIT_L(8); PG8_BAR; PG8_WAIT_L(0); PG8_MMA(0, 0, At, B0); PG8_BAR; PG8_SCHED;
            PG8_LDB(B1, 0, 1); PG8_STAGE(PG8_SB(0, 0), b2, voffB);
            PG8_BAR; PG8_WAIT_L(0); PG8_MMA(0, 1, At, B1); PG8_BAR;
            PG8_LDA(At, 0, 1); PG8_STAGE(PG8_SA(0, 0), a2, voffA);
            PG8_BAR; PG8_WAIT_L(0); PG8_MMA(1, 0, At, B0); PG8_BAR; PG8_SCHED;
            PG8_STAGE(PG8_SB(0, 1), b2 + hstepB, voffB);
            PG8_WAIT_V(6); PG8_BAR; PG8_MMA(1, 1, At, B1); PG8_BAR;
            PG8_LDB(B0, 1, 0); PG8_SCHED; PG8_LDA(At, 1, 0); PG8_STAGE(PG8_SA(0, 1), a2 + hstepA, voffA);
            PG8_WAIT_L(8); PG8_BAR; PG8_WAIT_L(0); PG8_MMA(0, 0, At, B0); PG8_BAR; PG8_SCHED;
            PG8_LDB(B1, 1, 1); PG8_STAGE(PG8_SB(1, 0), b3, voffB);
            PG8_BAR; PG8_WAIT_L(0); PG8_MMA(0, 1, At, B1); PG8_BAR;
            PG8_LDA(At, 1, 1); PG8_STAGE(PG8_SA(1, 0), a3, voffA);
            PG8_BAR; PG8_WAIT_L(0); PG8_MMA(1, 0, At, B0); PG8_BAR; PG8_SCHED;
            PG8_STAGE(PG8_SB(1, 1), b3 + hstepB, voffB);
            PG8_WAIT_V(6); PG8_BAR; PG8_MMA(1, 1, At, B1); PG8_BAR;
            }
        }
        if constexpr (ALIGN_EPI) { if (wr == 0) PG8_BAR; }
        if constexpr (!Epi::AFTER_DRAIN) { E(acc, cur, wr, wc, fr, fq); S.done(cur); }
        if (!has_next) break;
#pragma unroll
        for (int a = 0; a < 2; ++a)
#pragma unroll
            for (int b = 0; b < 2; ++b)
#pragma unroll
                for (int m = 0; m < 4; ++m)
#pragma unroll
                    for (int n = 0; n < 2; ++n) acc[a][b][m][n] = (f32x4){0.f, 0.f, 0.f, 0.f};
        cur = nxt; cA = nA; cB = nB; ++ui;
        if constexpr (ALIGN_EPI) { if (wr == 1) PG8_BAR; }
    }
    PG8_WAIT_V(0);
    if constexpr (!ALIGN_EPI) { if (wr == 0) PG8_BAR; }
    PG8_BAR;
    if constexpr (Epi::AFTER_DRAIN) { E.fused(acc, cur, wr, wc, fr, fq, lds, wid, lane); S.done(cur); }
#undef PG8_SA
#undef PG8_SB
#undef PG8_STAGE
#undef qvoffA
#undef qvoffB
#undef PG8_LDA
#undef PG8_LDB
#undef PG8_MMA
#undef PG8_WAIT_V
#undef PG8_WAIT_L
#undef PG8_BAR
#undef PG8_SCHED
}
}
#define GAS __attribute__((address_space(1)))
#define LAS __attribute__((address_space(3)))
typedef unsigned short bf16;
typedef unsigned v4u __attribute__((ext_vector_type(4)));
typedef float f32x4 __attribute__((ext_vector_type(4)));
typedef short bf16x8 __attribute__((ext_vector_type(8)));
typedef GAS unsigned gu32;
typedef GAS unsigned long long gu64;
#define RLX_AGENT __ATOMIC_RELAXED, __HIP_MEMORY_SCOPE_AGENT
#define LDS_WAIT() asm volatile("s_waitcnt lgkmcnt(0)" ::: "memory")
#define VM_WAIT() asm volatile("s_waitcnt vmcnt(0)" ::: "memory")
__device__ __forceinline__ unsigned long long rt() { return __builtin_amdgcn_s_memrealtime(); }
__device__ __forceinline__ unsigned f2bf(float f) { unsigned u = __builtin_bit_cast(unsigned, f); return (u + 0x7fffu + ((u >> 16) & 1u)) >> 16; }
__device__ __forceinline__ unsigned pk2(float lo, float hi) { return pg8::cvt_pk_bf16(lo, hi); }

#define XB_TMO      128
#define XB_XCNT(j)  (256  + 64 * (j))
#define XB_XSUB(j)  (1280 + 64 * (j))
#define XB_XGEN(j)  (2304 + 64 * (j))
#define XB_TOP      3328
#define XB_TOPGEN   3392
#define XCD_BAR_WORDS 3456
#define XB_SPIN_CAP (1u << 18)

__device__ __forceinline__ unsigned xb_ld(unsigned* p)              { return __hip_atomic_load(p, __ATOMIC_RELAXED, __HIP_MEMORY_SCOPE_AGENT); }
__device__ __forceinline__ unsigned xb_add(unsigned* p, unsigned v) { return __hip_atomic_fetch_add(p, v, __ATOMIC_RELAXED, __HIP_MEMORY_SCOPE_AGENT); }
__device__ __forceinline__ unsigned xb_xcc_id() { return (unsigned)__builtin_amdgcn_s_getreg((3 << 11) | 20) & 0xFu; }
#define XB_SPIN(cond, bar) do { unsigned _sp = 0; while (cond) { __builtin_amdgcn_s_sleep(1); \
    if ((++_sp & 255u) == 0u) { if (xb_ld(&(bar)[XB_TMO])) break; if (_sp > XB_SPIN_CAP) { atomicAdd(&(bar)[XB_TMO], 1u); break; } } } } while (0)

struct XcdBarrier {
    unsigned* bar; unsigned x;
    volatile LAS unsigned* st;
};

__device__ __forceinline__ XcdBarrier xcd_barrier_post(unsigned* bar, volatile LAS unsigned* st) {
    XcdBarrier b; b.bar = bar; b.x = xb_xcc_id(); b.st = st;
    if (threadIdx.x == 0) (void)xb_add(&bar[XB_XCNT(b.x)], 1u);
    return b;
}
__device__ __forceinline__ void xcd_barrier_complete(unsigned* bar, unsigned x, unsigned& nloc, unsigned& nx) {
    const unsigned G = gridDim.x * gridDim.y * gridDim.z;
    unsigned sum, cnt, mine, sp = 0u;
    for (;;) {
        sum = 0u; cnt = 0u; mine = 0u;
#pragma unroll
        for (unsigned j = 0; j < 16; ++j) { const unsigned c = xb_ld(&bar[XB_XCNT(j)]); sum += c; cnt += (c > 0u) ? 1u : 0u; mine = (j == x) ? c : mine; }
        if (sum == G) break;
        __builtin_amdgcn_s_sleep(1);
        if ((++sp & 255u) == 0u) { if (xb_ld(&bar[XB_TMO])) break; if (sp > XB_SPIN_CAP) { atomicAdd(&bar[XB_TMO], 1u); break; } }
    }
    nloc = mine > 0u ? mine : 1u; nx = cnt > 0u ? cnt : 1u;
}

__device__ __forceinline__ void xcd_barrier(const XcdBarrier& b) {
    asm volatile("s_waitcnt vmcnt(0)" ::: "memory");
    __syncthreads();
    if (threadIdx.x == 0) {
        unsigned* bar = b.bar;
        __builtin_amdgcn_s_waitcnt(0);
        unsigned nloc = b.st[0], nx = b.st[1];
        if (nloc == 0u) { xcd_barrier_complete(bar, b.x, nloc, nx); b.st[0] = nloc; b.st[1] = nx; }
        const unsigned old = xb_add(&bar[XB_XSUB(b.x)], 1u);
        const unsigned gen = old / nloc;
        if (old + 1u == (gen + 1u) * nloc) {
            __builtin_amdgcn_fence(__ATOMIC_RELEASE, "agent");
            asm volatile("s_waitcnt vmcnt(0)" ::: "memory");
            const unsigned og = xb_add(&bar[XB_TOP], 1u);
            const unsigned tg = og / nx;
            if (og + 1u == (tg + 1u) * nx) xb_add(&bar[XB_TOPGEN], 1u);
            else XB_SPIN(xb_ld(&bar[XB_TOPGEN]) == tg, bar);
            __builtin_amdgcn_fence(__ATOMIC_ACQUIRE, "agent");
            xb_add(&bar[XB_XGEN(b.x)], 1u);
            asm volatile("s_waitcnt vmcnt(0)" ::: "memory");
        } else {
            XB_SPIN(xb_ld(&bar[XB_XGEN(b.x)]) == gen, bar);
            __builtin_amdgcn_fence(__ATOMIC_ACQUIRE, "agent");
            asm volatile("s_waitcnt vmcnt(0)" ::: "memory");
        }
    }
    __syncthreads();
}

constexpr int NB = 16, SEQ = 4096, DM = 1024, MT = NB * SEQ;
constexpr int DINP = 1792;
constexpr int C_CQ = 0, C_CKV = 256, C_KR = 384, C_QN = 416, C_KVC = 928, C_KVS = 1184, C_KVW = 1440, C_GATE = 1696, DIN = 1720;
constexpr int DFF = 2816, NGU = 2 * DFF;
constexpr int NCMP = 255;
constexpr float EPS = 1e-6f;
constexpr float LOG2E = 1.4426950408889634f;
constexpr float C2Q = 0.10206207261596575f * 1.4426950408889634f;
constexpr float C2N = 0.125f * 1.4426950408889634f;

constexpr int NWAVES = 8, NTHR = 512;
constexpr int NPHASE = 8;
#ifndef MK_N_LAUNCHES
#define MK_N_LAUNCHES 1
#endif
constexpr int N_LAUNCHES = MK_N_LAUNCHES;

constexpr size_t MiB = 1u << 20;
constexpr size_t WS_CTL = 0, CTL_ZERO_BYTES = 1 * MiB;
constexpr size_t WS_WIN = 2 * MiB, WS_WUQ = 6 * MiB, WS_WUKV = 7 * MiB, WS_WOUT = 8 * MiB, WS_WGU = 10 * MiB, WS_WDN = 21 * MiB;
constexpr size_t WS_ROPE = 27 * MiB, WS_BIAS = 27 * MiB + 512 * 1024, WS_BIAS1 = WS_BIAS + 8192;
constexpr size_t WS_RSTDX = 28 * MiB, WS_SSQKV = 29 * MiB, WS_SSATT = 31 * MiB, WS_SSH = 35 * MiB;
constexpr size_t WS_KCMP = 39 * MiB, WS_VCMP = 40 * MiB, WS_KPE = 41 * MiB, WS_OVT = 45 * MiB, WS_W1C = 46 * MiB, WS_W2T = 47 * MiB;
constexpr size_t WS_XB = 64 * MiB, WS_U = 192 * MiB, WS_QM = 420 * MiB, WS_KVM = 516 * MiB, WS_ATT = 644 * MiB, WS_H = 772 * MiB, WS_END = 900 * MiB;
constexpr size_t WS_HID = 64 * MiB;
static_assert(WS_U + (size_t)MT * DINP * 2 <= WS_QM && WS_HID + (size_t)MT * DFF * 2 <= WS_QM && WS_QM + (size_t)MT * 768 * 2 <= WS_KVM && WS_KVM + (size_t)MT * 1024 * 2 <= WS_ATT, "ws map");
constexpr int CW_TMO = 0, CW_BAR = 4096;

constexpr int LDS_BYTES = 163840;
constexpr int MISC_OFF = LDS_BYTES - 256;


typedef unsigned u32x4 __attribute__((ext_vector_type(4))); using pg8::Unit; using pg8::cvt_pk_bf16; using pg8::HALF; using pg8::BM;
typedef float f32x2v __attribute__((ext_vector_type(2)));
typedef unsigned u32x2 __attribute__((ext_vector_type(2)));
__device__ __forceinline__ float bf2f(unsigned short b) { return __builtin_bit_cast(float, (unsigned)b << 16); }
__device__ __forceinline__ float bflo(unsigned w) { return __builtin_bit_cast(float, w << 16); }
__device__ __forceinline__ float bfhi(unsigned w) { return __builtin_bit_cast(float, w & 0xffff0000u); }
__device__ __forceinline__ float sq4(const f32x4 v) { return (v[0] * v[0] + v[1] * v[1]) + (v[2] * v[2] + v[3] * v[3]); }

struct EpiInProj {
    static constexpr bool PERM = true, AFTER_DRAIN = false, MIDK = false;
    pg8::bf16_t* U; const float* rstd; float* ssq;
    __device__ __forceinline__ void operator()(const f32x4 (&acc)[2][2][4][2], const Unit& u, int wr, int wc, int fr, int fq) const {
        const int row0 = u.pm * BM + wr * 64 + fr, col0 = u.pn * BM + wc * 32 + 8 * fq;
#pragma unroll
        for (int ai = 0; ai < 2; ++ai)
#pragma unroll
            for (int m = 0; m < 4; ++m) {
                const int row = row0 + ai * HALF + m * 16; const float r = rstd[row];
                pg8::bf16_t* rowp = U + (size_t)row * DINP + col0; float s0 = 0.f, s1 = 0.f;
#pragma unroll
                for (int bj = 0; bj < 2; ++bj) { const f32x4 v0 = acc[ai][bj][m][0] * r, v1 = acc[ai][bj][m][1] * r;
                    u32x4 w; w.x = cvt_pk_bf16(v0[0], v0[1]); w.y = cvt_pk_bf16(v0[2], v0[3]); w.z = cvt_pk_bf16(v1[0], v1[1]); w.w = cvt_pk_bf16(v1[2], v1[3]);
                    *(u32x4*)(rowp + bj * HALF) = w;
                    const float s = sq4(v0) + sq4(v1); if (bj == 0) s0 = s; else s1 = s; }
                if (u.pn < 2) {
                    float s = (u.pn == 0) ? (s0 + s1) : s0;
                    s += __shfl_xor(s, 16); s += __shfl_xor(s, 32);
                    if (fq == 0) ssq[(size_t)row * 8 + (u.pn == 0 ? 0 : 4) + wc] = s;
                }
            }
    }
};
struct EpiQup {
    static constexpr bool PERM = true, AFTER_DRAIN = false, MIDK = false;
    pg8::bf16_t* Q; const float* ssq; const f32x2v* rope;
    __device__ __forceinline__ void operator()(const f32x4 (&acc)[2][2][4][2], const Unit& u, int wr, int wc, int fr, int fq) const {
        const int row0 = u.pm * BM + wr * 64 + fr, col0 = u.pn * BM + wc * 32 + 8 * fq;
#pragma unroll
        for (int ai = 0; ai < 2; ++ai)
#pragma unroll
            for (int m = 0; m < 4; ++m) {
                const int row = row0 + ai * HALF + m * 16; const int pos = row & (SEQ - 1);
                const f32x4 pp = *(const f32x4*)(ssq + (size_t)row * 8);
                const float r = __builtin_amdgcn_rsqf(((pp[0] + pp[1]) + (pp[2] + pp[3])) * (1.0f / 256.0f) + EPS) * C2Q;
#pragma unroll
                for (int bj = 0; bj < 2; ++bj) { const int c = col0 + bj * HALF; const int d = c % 96;
                    f32x4 v0 = acc[ai][bj][m][0] * r, v1 = acc[ai][bj][m][1] * r;
                    if (d >= 64) { const int i0 = (d - 64) >> 1; const f32x2v* rp = rope + pos * 16 + i0;
                        const f32x2v a = rp[0], b = rp[1], e = rp[2], f = rp[3];
                        f32x4 w0, w1;
                        w0[0] = v0[0] * a.x - v0[1] * a.y; w0[1] = v0[0] * a.y + v0[1] * a.x;
                        w0[2] = v0[2] * b.x - v0[3] * b.y; w0[3] = v0[2] * b.y + v0[3] * b.x;
                        w1[0] = v1[0] * e.x - v1[1] * e.y; w1[1] = v1[0] * e.y + v1[1] * e.x;
                        w1[2] = v1[2] * f.x - v1[3] * f.y; w1[3] = v1[2] * f.y + v1[3] * f.x;
                        v0 = w0; v1 = w1; }
                    u32x4 w; w.x = cvt_pk_bf16(v0[0], v0[1]); w.y = cvt_pk_bf16(v0[2], v0[3]); w.z = cvt_pk_bf16(v1[0], v1[1]); w.w = cvt_pk_bf16(v1[2], v1[3]);
                    *(u32x4*)(Q + (size_t)row * 768 + c) = w; }
                asm volatile("" ::: "memory");
            }
    }
};
struct EpiKVup {
    static constexpr bool PERM = true, AFTER_DRAIN = false, MIDK = false;
    pg8::bf16_t* KV; const float* ssq;
    __device__ __forceinline__ void operator()(const f32x4 (&acc)[2][2][4][2], const Unit& u, int wr, int wc, int fr, int fq) const {
        const int row0 = u.pm * BM + wr * 64 + fr, col0 = u.pn * BM + wc * 32 + 8 * fq;
#pragma unroll
        for (int ai = 0; ai < 2; ++ai)
#pragma unroll
            for (int m = 0; m < 4; ++m) {
                const int row = row0 + ai * HALF + m * 16;
                const f32x4 pp = *(const f32x4*)(ssq + (size_t)row * 8 + 4);
                const float r = __builtin_amdgcn_rsqf(((pp[0] + pp[1]) + (pp[2] + pp[3])) * (1.0f / 128.0f) + EPS);
#pragma unroll
                for (int bj = 0; bj < 2; ++bj) { const f32x4 v0 = acc[ai][bj][m][0] * r, v1 = acc[ai][bj][m][1] * r;
                    u32x4 w; w.x = cvt_pk_bf16(v0[0], v0[1]); w.y = cvt_pk_bf16(v0[2], v0[3]); w.z = cvt_pk_bf16(v1[0], v1[1]); w.w = cvt_pk_bf16(v1[2], v1[3]);
                    *(u32x4*)(KV + (size_t)row * 1024 + col0 + bj * HALF) = w; }
                if (m & 1) asm volatile("" ::: "memory");
            }
    }
};
constexpr int OUT_TAB_OFF = 131072;
struct OutOrder : pg8::StaticOrder {
    const float* ssatt; LAS float* tab;
    __device__ __forceinline__ void a_ready(const Unit& u) const {
        const int tid = threadIdx.x, row = tid >> 1, which = tid & 1;
        const f32x4* pp = (const f32x4*)(ssatt + (size_t)(u.pm * BM + row) * 16 + which * 8); const f32x4 a = pp[0], b = pp[1];
        const float r = __builtin_amdgcn_rsqf((((a[0] + a[1]) + (a[2] + a[3])) + ((b[0] + b[1]) + (b[2] + b[3]))) * (1.0f / 512.0f) + EPS);
        const float o = __shfl_xor(r, 1);
        if (which == 0) { LAS float* t = tab + (u.ui & 1) * 512 + row * 2; t[0] = r / o; t[1] = o; }
    }
};
struct EpiOut {
    static constexpr bool PERM = true, AFTER_DRAIN = false, MIDK = true;
    const pg8::bf16_t* xb; pg8::bf16_t* H; float* ssh; const LAS float* tab;
    __device__ __forceinline__ void midk(f32x4 (&acc)[2][2][4][2], const Unit& u, int wr, int fr) const {
        const LAS float* t = tab + (u.ui & 1) * 512 + (wr * 64 + fr) * 2;
#pragma unroll
        for (int ai = 0; ai < 2; ++ai)
#pragma unroll
            for (int m = 0; m < 4; ++m) { const float ratio = t[(ai * HALF + m * 16) * 2];
#pragma unroll
                for (int bj = 0; bj < 2; ++bj) { acc[ai][bj][m][0] *= ratio; acc[ai][bj][m][1] *= ratio; } }
    }
    __device__ __forceinline__ void operator()(const f32x4 (&acc)[2][2][4][2], const Unit& u, int wr, int wc, int fr, int fq) const {
        const int row0 = u.pm * BM + wr * 64 + fr, col0 = u.pn * BM + wc * 32 + 8 * fq;
        const LAS float* t = tab + (u.ui & 1) * 512 + (wr * 64 + fr) * 2 + 1;
#pragma unroll
        for (int ai = 0; ai < 2; ++ai)
#pragma unroll
            for (int m = 0; m < 4; ++m) {
                const int row = row0 + ai * HALF + m * 16; const float r = t[(ai * HALF + m * 16) * 2];
                float s = 0.f;
#pragma unroll
                for (int bj = 0; bj < 2; ++bj) { const size_t off = (size_t)row * DM + col0 + bj * HALF;
                    const u32x4 xw = *(const u32x4*)(xb + off);
                    f32x4 x0, x1; x0[0] = bflo(xw.x); x0[1] = bfhi(xw.x); x0[2] = bflo(xw.y); x0[3] = bfhi(xw.y); x1[0] = bflo(xw.z); x1[1] = bfhi(xw.z); x1[2] = bflo(xw.w); x1[3] = bfhi(xw.w);
                    const f32x4 v0 = x0 + acc[ai][bj][m][0] * r, v1 = x1 + acc[ai][bj][m][1] * r;
                    u32x4 w; w.x = cvt_pk_bf16(v0[0], v0[1]); w.y = cvt_pk_bf16(v0[2], v0[3]); w.z = cvt_pk_bf16(v1[0], v1[1]); w.w = cvt_pk_bf16(v1[2], v1[3]);
                    *(u32x4*)(H + off) = w; s += sq4(v0) + sq4(v1); }
                s += __shfl_xor(s, 16); s += __shfl_xor(s, 32);
                if (fq == 0) ssh[(size_t)row * 16 + u.pn * 4 + wc] = s;
                if (m & 1) asm volatile("" ::: "memory");
            }
    }
};
struct GUOrder : pg8::StaticOrder {
    const float* ssh; LAS float* tab;
    __device__ __forceinline__ void a_ready(const Unit& u) const {
        const int tid = threadIdx.x, row = tid >> 1, which = tid & 1;
        const f32x4* pp = (const f32x4*)(ssh + (size_t)(u.pm * BM + row) * 16 + which * 8); const f32x4 a = pp[0], b = pp[1];
        float s = ((a[0] + a[1]) + (a[2] + a[3])) + ((b[0] + b[1]) + (b[2] + b[3]));
        s += __shfl_xor(s, 1);
        if (which == 0) tab[(u.ui & 1) * 256 + row] = __builtin_amdgcn_rsqf(s * (1.0f / 1024.0f) + EPS);
    }
};
struct EpiGU {
    static constexpr bool PERM = true, AFTER_DRAIN = false, MIDK = false;
    unsigned char* HID; const LAS float* tab;
    __device__ __forceinline__ void operator()(const f32x4 (&acc)[2][2][4][2], const Unit& u, int wr, int wc, int fr, int fq) const {
        const int row0 = u.pm * BM + wr * 64 + fr, col0 = u.pn * HALF + wc * 32 + 8 * fq;
        const LAS float* t = tab + (u.ui & 1) * 256 + wr * 64 + fr;
#pragma unroll
        for (int ai = 0; ai < 2; ++ai)
#pragma unroll
            for (int m = 0; m < 4; ++m) {
                const int row = row0 + ai * HALF + m * 16; const float r = t[ai * HALF + m * 16];
                float o[8];
#pragma unroll
                for (int n = 0; n < 2; ++n)
#pragma unroll
                    for (int e = 0; e < 4; ++e) { const float g = acc[ai][0][m][n][e] * r, up = acc[ai][1][m][n][e] * (r * 8.0f);
                        const float sg = g * __builtin_amdgcn_rcpf(1.0f + __builtin_amdgcn_exp2f(-g * LOG2E)); o[n * 4 + e] = __builtin_amdgcn_fmed3f(sg * up, -448.0f, 448.0f); }
                u32x2 w; w.x = pg8::cvt_pk4_fp8(o[0], o[1], o[2], o[3]); w.y = pg8::cvt_pk4_fp8(o[4], o[5], o[6], o[7]);
                __builtin_nontemporal_store(w, (u32x2*)(HID + (size_t)row * DFF + col0));
            }
    }
};
struct EpiDown {
    static constexpr bool PERM = true, AFTER_DRAIN = false, MIDK = false;
    const pg8::bf16_t* H; pg8::bf16_t* H2; float* ss2;
    __device__ __forceinline__ void operator()(const f32x4 (&acc)[2][2][4][2], const Unit& u, int wr, int wc, int fr, int fq) const {
        const int row0 = u.pm * BM + wr * 64 + fr, col0 = u.pn * BM + wc * 32 + 8 * fq;
#pragma unroll
        for (int ai = 0; ai < 2; ++ai)
#pragma unroll
            for (int m = 0; m < 4; ++m) {
                const int row = row0 + ai * HALF + m * 16; float s = 0.f;
#pragma unroll
                for (int bj = 0; bj < 2; ++bj) { const size_t off = (size_t)row * DM + col0 + bj * HALF;
                    const u32x4 hw = *(const u32x4*)(H + off);
                    f32x4 h0, h1; h0[0] = bflo(hw.x); h0[1] = bfhi(hw.x); h0[2] = bflo(hw.y); h0[3] = bfhi(hw.y); h1[0] = bflo(hw.z); h1[1] = bfhi(hw.z); h1[2] = bflo(hw.w); h1[3] = bfhi(hw.w);
                    h0 += acc[ai][bj][m][0] * (1.0f / 1024.0f); h1 += acc[ai][bj][m][1] * (1.0f / 1024.0f);
                    u32x4 w; w.x = cvt_pk_bf16(h0[0], h0[1]); w.y = cvt_pk_bf16(h0[2], h0[3]); w.z = cvt_pk_bf16(h1[0], h1[1]); w.w = cvt_pk_bf16(h1[2], h1[3]);
                    *(u32x4*)(H2 + off) = w; s += sq4(h0) + sq4(h1); }
                s += __shfl_xor(s, 16); s += __shfl_xor(s, 32);
                if (fq == 0) ss2[(size_t)row * 16 + u.pn * 4 + wc] = s;
                if (m & 1) asm volatile("" ::: "memory");
            }
    }
};

struct Args { const float* in[22]; float* out; unsigned char* ws; int ph_lo, ph_hi, li, pad; };
enum { I_X = 0, I_GMIX, I_WIN, I_GQ, I_WUQ, I_GKV, I_WUKV, I_POSK, I_W1K, I_W2K, I_POSV, I_W1V, I_W2V, I_T5, I_GOM, I_GON, I_WOUT, I_GFFN, I_WG, I_WU, I_WD, I_GFIN };

__device__ __forceinline__ float wave_sum(float v) {
#pragma unroll
    for (int o = 1; o < 64; o <<= 1) v += __shfl_xor(v, o);
    return v;
}
typedef __bf16 bf16x2_t __attribute__((ext_vector_type(2)));
__device__ __forceinline__ float dot2(unsigned a, unsigned b, float c) { return __builtin_amdgcn_fdot2_f32_bf16(__builtin_bit_cast(bf16x2_t, a), __builtin_bit_cast(bf16x2_t, b), c, false); }

template <class F> __device__ __forceinline__ void tr_item(F f, bf16* WT, int ldk, int nblk, LAS float* scr, int item, int lane) {
    const int kb = item / nblk, nb = item % nblk, k0 = 64 * kb, n0 = 32 * nb;
#pragma unroll 8
    for (int i = 0; i < 32; ++i) { const int kk = 2 * i + (lane >> 5); scr[kk * 33 + (lane & 31)] = f(k0 + kk, n0 + (lane & 31)); }
    LDS_WAIT(); asm volatile("" ::: "memory");
    const int c = lane & 7;
#pragma unroll
    for (int j = 0; j < 4; ++j) { const int n = (lane >> 3) + 8 * j; const LAS float* s = scr + (8 * c) * 33 + n;
        v4u o; o.x = pk2(s[0 * 33], s[1 * 33]); o.y = pk2(s[2 * 33], s[3 * 33]); o.z = pk2(s[4 * 33], s[5 * 33]); o.w = pk2(s[6 * 33], s[7 * 33]);
        *(GAS v4u*)(WT + (size_t)(n0 + n) * ldk + k0 + 8 * c) = o; }
    LDS_WAIT(); asm volatile("" ::: "memory");
}
template <class F> __device__ __forceinline__ void tr_item8(F f, unsigned char* WT, int ldk, int nblk, LAS float* scr, int item, int lane) {
    const int kb = item / nblk, nb = item % nblk, k0 = 64 * kb, n0 = 32 * nb;
#pragma unroll 8
    for (int i = 0; i < 32; ++i) { const int kk = 2 * i + (lane >> 5); scr[kk * 33 + (lane & 31)] = f(k0 + kk, n0 + (lane & 31)); }
    LDS_WAIT(); asm volatile("" ::: "memory");
    const int c = lane & 7;
#pragma unroll
    for (int j = 0; j < 4; ++j) { const int n = (lane >> 3) + 8 * j; const LAS float* s = scr + (8 * c) * 33 + n;
        u32x2 o; o.x = pg8::cvt_pk4_fp8(s[0 * 33], s[1 * 33], s[2 * 33], s[3 * 33]); o.y = pg8::cvt_pk4_fp8(s[4 * 33], s[5 * 33], s[6 * 33], s[7 * 33]);
        *(GAS u32x2*)(WT + (size_t)(n0 + n) * ldk + k0 + 8 * c) = o; }
    LDS_WAIT(); asm volatile("" ::: "memory");
}
__device__ __forceinline__ int t5_bucket(int n) {
    if (n < 16) return n;
    int b = 16; b += n >= 19; b += n >= 21; b += n >= 24; b += n >= 27; b += n >= 31; b += n >= 35; b += n >= 40; b += n >= 46; b += n >= 52; b += n >= 59; b += n >= 67; b += n >= 77; b += n >= 87; b += n >= 99; b += n >= 113;
    return b;
}
__device__ __forceinline__ float gelu_tanh(float x) {
    const float y = 0.7978845608028654f * (x + 0.044715f * x * x * x);
    const float e = __builtin_amdgcn_exp2f(2.0f * LOG2E * y);
    const float th = 1.0f - 2.0f * __builtin_amdgcn_rcpf(e + 1.0f);
    return 0.5f * x * (1.0f + th);
}

struct Ptrs {
    const float* in[22]; float* out; unsigned char* ws;
    bf16 *Win, *Wuq, *Wukv, *Wout, *Wgu, *Wdn; f32x2v* rope; float *bias, *bias1, *rstdx, *ssqkv, *ssatt, *ssh;
    bf16 *kcmp, *vcmp, *kpe, *ovt, *W1c, *W2t, *XB, *U, *QM, *KVM, *ATT, *H, *HID;
};

__device__ __forceinline__ void p0_prologue(const Ptrs& P, LAS unsigned char* lds, int wg, int G, int wave, int lane, int tid) {
    LAS float* scr = (LAS float*)(lds + wave * 16384);
    const int gw = wg * NWAVES + wave, NGW = G * NWAVES;
    constexpr int I_IN = (1024 / 64) * (DINP / 32), I_UQ = (256 / 64) * (768 / 32), I_UKV = (256 / 64) * (1024 / 32), I_OUT = (1024 / 64) * (1024 / 32), I_GU = (1024 / 64) * (NGU / 32), I_DN = (DFF / 64) * (1024 / 32);
    constexpr int I_W1C = 2 * (1024 / 64) * (256 / 32), I_W2T = 2 * (128 / 64) * (64 / 32);
    constexpr int NITEMS = I_IN + I_UQ + I_UKV + I_OUT + I_GU + I_DN + I_W1C + I_W2T;
    for (int it = gw; it < NITEMS; it += NGW) {
        int r = it;
        if (r < I_IN) { const float* W = P.in[I_WIN]; const float* g = P.in[I_GMIX];
            tr_item([=](int k, int n) -> float { if (n >= DIN) return 0.f; const float s = (n >= C_QN && n < C_KVC) ? C2N : 1.0f; return W[(size_t)k * DIN + n] * g[k] * s; }, P.Win, 1024, DINP / 32, scr, r, lane); continue; } r -= I_IN;
        if (r < I_UQ) { const float* W = P.in[I_WUQ]; const float* g = P.in[I_GQ];
            tr_item([=](int k, int n) -> float { const int h = n / 96, d = n % 96; int src = n; if (d >= 64) { const int e = d - 64; src = h * 96 + 64 + (e & 1) * 16 + (e >> 1); } return W[(size_t)k * 768 + src] * g[k]; }, P.Wuq, 256, 768 / 32, scr, r, lane); continue; } r -= I_UQ;
        if (r < I_UKV) { const float* W = P.in[I_WUKV]; const float* g = P.in[I_GKV];
            tr_item([=](int k, int n) -> float { return k < 128 ? W[(size_t)k * 1024 + n] * g[k] : 0.f; }, P.Wukv, 256, 1024 / 32, scr, r, lane); continue; } r -= I_UKV;
        if (r < I_OUT) { const float* W = P.in[I_WOUT]; const float* g1 = P.in[I_GOM]; const float* g2 = P.in[I_GON];
            tr_item([=](int k, int n) -> float { return W[(size_t)k * 1024 + n] * (k < 512 ? g1[k] : g2[k - 512]); }, P.Wout, 1024, 1024 / 32, scr, r, lane); continue; } r -= I_OUT;
        if (r < I_GU) { const float* g = P.in[I_GFFN]; const bool up = ((r % (NGU / 32)) & 4) != 0;
            if (!up) { const float* W = P.in[I_WG]; tr_item([=](int k, int n) -> float { return W[(size_t)k * DFF + (n >> 8) * 128 + (n & 127)] * g[k]; }, P.Wgu, 1024, NGU / 32, scr, r, lane); }
            else { const float* W = P.in[I_WU]; tr_item([=](int k, int n) -> float { return W[(size_t)k * DFF + (n >> 8) * 128 + (n & 127)] * g[k]; }, P.Wgu, 1024, NGU / 32, scr, r, lane); }
            continue; } r -= I_GU;
        if (r < I_DN) { const float* W = P.in[I_WD];
            tr_item8([=](int k, int n) -> float { return W[(size_t)k * 1024 + n] * 128.0f; }, (unsigned char*)P.Wdn, DFF, 1024 / 32, scr, r, lane); continue; } r -= I_DN;
        if (r < I_W1C) { const int kv = r >= I_W1C / 2; if (kv) r -= I_W1C / 2;
            if (!kv) { const float* W = P.in[I_W1K]; tr_item([=](int k, int n) -> float { return W[(size_t)(k + ((n >> 7) << 10)) * 128 + (n & 127)]; }, P.W1c, 1024, 256 / 32, scr, r, lane); }
            else { const float* W = P.in[I_W1V]; tr_item([=](int k, int n) -> float { return W[(size_t)(k + ((n >> 7) << 10)) * 128 + (n & 127)]; }, P.W1c + 256 * 1024, 1024, 256 / 32, scr, r, lane); }
            continue; } r -= I_W1C;
        { const int kv = r >= I_W2T / 2; if (kv) r -= I_W2T / 2;
            if (!kv) { const float* W = P.in[I_W2K]; tr_item([=](int k, int n) -> float { return W[(size_t)k * 64 + n]; }, P.W2t, 128, 64 / 32, scr, r, lane); }
            else { const float* W = P.in[I_W2V]; tr_item([=](int k, int n) -> float { return W[(size_t)k * 64 + n]; }, P.W2t + 64 * 128, 128, 64 / 32, scr, r, lane); } }
    }
    const int gt = wg * NTHR + tid, NGT = G * NTHR;
    for (int e = gt; e < SEQ * 16; e += NGT) { const int pos = e >> 4, i = e & 15;
        const float inv = __builtin_amdgcn_exp2f(-(float)i * (13.287712379549449f / 16.0f));
        const float ang = (float)pos * inv;
        double rev = (double)ang * 0.15915494309189535; rev -= __builtin_floor(rev);
        const float fr = (float)rev;
        P.rope[e] = (f32x2v){__builtin_amdgcn_cosf(fr), __builtin_amdgcn_sinf(fr)}; }
    for (int e = gt; e < 8 * 128; e += NGT) { const int h = e >> 7, d = e & 127; P.bias[e] = P.in[I_T5][t5_bucket(d) * 8 + h] * LOG2E; }
    for (int e = gt; e < 256 * 64; e += NGT) { const int i = e >> 6, j = e & 63; float w = 0.f; if (j == (i >> 2)) w += ((i & 3) == 3) ? 1.f : 2.f; if ((i & 3) == 3 && j == (i >> 2) + 1) w += 1.f;
        P.ovt[e] = (bf16)(__float_as_uint(w) >> 16); }
    for (int o = gw; o < 256; o += NGW) { const int kv = o >> 7, j = o & 127; const float* pos = P.in[kv ? I_POSV : I_POSK]; const float* w1 = P.in[kv ? I_W1V : I_W1K];
        float s = 0.f; for (int k = lane; k < 2048; k += 64) s += pos[k] * w1[(size_t)k * 128 + j];
        s = wave_sum(s); if (lane == 0) P.bias1[o] = s; }
    for (int m0 = gw * 4; m0 < MT; m0 += NGW * 4) {
        f32x4 v[4][4];
#pragma unroll
        for (int q = 0; q < 4; ++q) { const GAS f32x4* xr = (const GAS f32x4*)(P.in[I_X] + (size_t)(m0 + q) * DM) + lane;
#pragma unroll
            for (int j = 0; j < 4; ++j) v[q][j] = __builtin_nontemporal_load(xr + 64 * j); }
#pragma unroll
        for (int q = 0; q < 4; ++q) { float s = 0.f;
#pragma unroll
            for (int j = 0; j < 4; ++j) s += sq4(v[q][j]);
            s = wave_sum(s);
            if (lane == 0) P.rstdx[m0 + q] = __builtin_amdgcn_rsqf(s * (1.0f / DM) + EPS);
            GAS unsigned long long* o8 = (GAS unsigned long long*)(P.XB + (size_t)(m0 + q) * DM) + lane;
#pragma unroll
            for (int j = 0; j < 4; ++j) o8[64 * j] = (unsigned long long)pk2(v[q][j][0], v[q][j][1]) | ((unsigned long long)pk2(v[q][j][2], v[q][j][3]) << 32); }
    }
}

__device__ __forceinline__ void p2_kpe(const Ptrs& P, int wg, int G, int tid) {
    const int gt = wg * NTHR + tid, NGT = G * NTHR;
    for (int e = gt; e < MT * 16; e += NGT) { const int row = e >> 4, i = e & 15; const int pos = row & (SEQ - 1);
        const float x1 = bf2f(P.U[(size_t)row * DINP + C_KR + i]), x2 = bf2f(P.U[(size_t)row * DINP + C_KR + 16 + i]);
        const f32x2v cs = P.rope[pos * 16 + i];
        *(unsigned*)(P.kpe + (size_t)row * 32 + 2 * i) = pk2(x1 * cs.x - x2 * cs.y, x1 * cs.y + x2 * cs.x); }
}
__device__ __forceinline__ void p7_final(const Ptrs& P, int wg, int G, int wave, int lane) {
    const int gw = wg * NWAVES + wave, NGW = G * NWAVES;
    const GAS f32x4* gp = (const GAS f32x4*)P.in[I_GFIN] + 2 * lane; f32x4 gg[4][2];
#pragma unroll
    for (int j = 0; j < 2; ++j) { gg[j][0] = gp[128 * j]; gg[j][1] = gp[128 * j + 1]; }
    for (int m0 = gw * 4; m0 < MT; m0 += NGW * 4) {
        u32x4 w0[4], w1[4]; float pv[4];
#pragma unroll
        for (int q = 0; q < 4; ++q) { const GAS u32x4* hr = (const GAS u32x4*)(P.ATT + (size_t)(m0 + q) * DM) + lane;
            w0[q] = hr[0]; w1[q] = hr[64]; pv[q] = (lane < 16) ? P.ssatt[(size_t)(m0 + q) * 16 + lane] : 0.f; }
#pragma unroll
        for (int q = 0; q < 4; ++q) {
            const float r = __builtin_amdgcn_rsqf(wave_sum(pv[q]) * (1.0f / DM) + EPS);
            GAS f32x4* o = (GAS f32x4*)(P.out + (size_t)(m0 + q) * DM) + 2 * lane;
            { const u32x4 w = w0[q]; f32x4 a, b; a[0] = bflo(w.x); a[1] = bfhi(w.x); a[2] = bflo(w.y); a[3] = bfhi(w.y); b[0] = bflo(w.z); b[1] = bfhi(w.z); b[2] = bflo(w.w); b[3] = bfhi(w.w);
              o[0] = a * r * gg[0][0]; o[1] = b * r * gg[0][1]; }
            { const u32x4 w = w1[q]; f32x4 a, b; a[0] = bflo(w.x); a[1] = bfhi(w.x); a[2] = bflo(w.y); a[3] = bfhi(w.y); b[0] = bflo(w.z); b[1] = bfhi(w.z); b[2] = bflo(w.w); b[3] = bfhi(w.w);
              o[128] = a * r * gg[1][0]; o[129] = b * r * gg[1][1]; } }
    }
}

struct CmpOrder {
    int G, c; const bf16* U; const bf16* W1c;
    __device__ __forceinline__ bool next(int i, Unit& u) const { const int un = c + i * G; if (un >= 64) return false; u.pm = un; u.pn = 0; u.ui = i; return true; }
    __device__ __forceinline__ void a_ready(const Unit&) const {}
    __device__ __forceinline__ void done(const Unit&) const {}
    __device__ __forceinline__ const char* a_base(const pg8::Gemm&, const Unit& u, size_t) const { const int bh = u.pm >> 1, kv = u.pm & 1;
        return (const char*)(U + (size_t)(bh >> 1) * SEQ * DINP + C_KVC + kv * 128 + (bh & 1) * 64); }
    __device__ __forceinline__ const char* b_base(const pg8::Gemm&, const Unit& u, size_t) const { return (const char*)(W1c + (size_t)(u.pm & 1) * 256 * 1024); }
};
struct EpiCmp {
    static constexpr bool PERM = true, AFTER_DRAIN = true, MIDK = false;
    const float* bias1; const bf16* W2t; bf16* kcmp; bf16* vcmp;
    __device__ __forceinline__ void operator()(const f32x4 (&)[2][2][4][2], const Unit&, int, int, int, int) const {}
    __device__ __forceinline__ void fused(f32x4 (&acc)[2][2][4][2], const Unit& u, int wr, int wc, int fr, int fq, LAS unsigned char* lds, int wid, int lane) const {
        typedef short bf16x8_t __attribute__((ext_vector_type(8))); typedef float f32x16_t __attribute__((ext_vector_type(16)));
        const int bh = u.pm >> 1, kv = u.pm & 1; const int col = wc * 32 + 8 * fq;
        LAS float* OB = (LAS float*)lds;
#pragma unroll
        for (int ai = 0; ai < 2; ++ai)
#pragma unroll
            for (int m = 0; m < 4; ++m) { const int r = ai * HALF + wr * 64 + m * 16 + fr;
                *(LAS f32x4*)(OB + r * 132 + col) = acc[ai][1][m][0]; *(LAS f32x4*)(OB + r * 132 + col + 4) = acc[ai][1][m][1]; }
        const f32x4 bs0 = *(const f32x4*)(bias1 + kv * 128 + col), bs1 = *(const f32x4*)(bias1 + kv * 128 + col + 4);
        asm volatile("s_waitcnt lgkmcnt(0)" ::: "memory"); __builtin_amdgcn_s_barrier(); asm volatile("" ::: "memory");
#pragma unroll
        for (int ai = 0; ai < 2; ++ai)
#pragma unroll
            for (int m = 0; m < 4; ++m) { const int r = ai * HALF + wr * 64 + m * 16 + fr, r1 = r < 255 ? r + 1 : 255;
                const f32x4 b0 = *(const LAS f32x4*)(OB + r1 * 132 + col), b1 = *(const LAS f32x4*)(OB + r1 * 132 + col + 4);
                f32x4 h0 = acc[ai][0][m][0] + b0 + bs0, h1 = acc[ai][0][m][1] + b1 + bs1;
#pragma unroll
                for (int e = 0; e < 4; ++e) { h0[e] = gelu_tanh(h0[e]); h1[e] = gelu_tanh(h1[e]); }
                acc[ai][0][m][0] = h0; acc[ai][0][m][1] = h1; }
        asm volatile("s_waitcnt lgkmcnt(0)" ::: "memory"); __builtin_amdgcn_s_barrier(); asm volatile("" ::: "memory");
        LAS bf16* GB = (LAS bf16*)lds;
#pragma unroll
        for (int ai = 0; ai < 2; ++ai)
#pragma unroll
            for (int m = 0; m < 4; ++m) { const int r = ai * HALF + wr * 64 + m * 16 + fr; const f32x4 h0 = acc[ai][0][m][0], h1 = acc[ai][0][m][1];
                u32x4 w; w.x = pk2(h0[0], h0[1]); w.y = pk2(h0[2], h0[3]); w.z = pk2(h1[0], h1[1]); w.w = pk2(h1[2], h1[3]);
                *(LAS u32x4*)(GB + r * 136 + col) = w; }
        asm volatile("s_waitcnt lgkmcnt(0)" ::: "memory"); __builtin_amdgcn_s_barrier(); asm volatile("" ::: "memory");
        const int r32 = lane & 31, hi = lane >> 5, c = wid * 32 + r32;
        f32x16_t o[2]; o[0] = f32x16_t{}; o[1] = f32x16_t{};
        const bf16* w2 = W2t + (size_t)kv * 64 * 128;
#pragma unroll
        for (int s = 0; s < 8; ++s) { const bf16x8_t gb = *(const LAS bf16x8_t*)(GB + c * 136 + 16 * s + 8 * hi);
#pragma unroll
            for (int dt = 0; dt < 2; ++dt) { const bf16x8_t wa = *(const bf16x8_t*)(w2 + (size_t)(32 * dt + r32) * 128 + 16 * s + 8 * hi);
                o[dt] = __builtin_amdgcn_mfma_f32_32x32x16_bf16(wa, gb, o[dt], 0, 0, 0); } }
        if (c < NCMP) { bf16* op = (kv ? vcmp : kcmp) + ((size_t)bh * 256 + c) * 64 + 4 * hi;
#pragma unroll
            for (int dt = 0; dt < 2; ++dt)
#pragma unroll
                for (int k = 0; k < 4; ++k) *(unsigned long long*)(op + 32 * dt + 8 * k) = (unsigned long long)pk2(o[dt][4 * k], o[dt][4 * k + 1]) | ((unsigned long long)pk2(o[dt][4 * k + 2], o[dt][4 * k + 3]) << 32); }
        asm volatile("s_waitcnt lgkmcnt(0)" ::: "memory"); __builtin_amdgcn_s_barrier();
    }
};

namespace att {
typedef short bf16x8 __attribute__((ext_vector_type(8)));
typedef short s16x4 __attribute__((ext_vector_type(4)));
typedef float f32x16 __attribute__((ext_vector_type(16)));
typedef __attribute__((address_space(3))) const char* lds_cptr;
constexpr float THR = 8.0f;
constexpr float NEG_INF = -__builtin_inff();
__device__ __forceinline__ int crow(int r, int hi) { return (r & 3) + 8 * (r >> 2) + 4 * hi; }
__device__ __forceinline__ float swap_max(float x) { auto rr = __builtin_amdgcn_permlane32_swap(__float_as_uint(x), __float_as_uint(x), false, false); return fmaxf(__uint_as_float(rr[0]), __uint_as_float(rr[1])); }
__device__ __forceinline__ float swap_sum(float x) { auto rr = __builtin_amdgcn_permlane32_swap(__float_as_uint(x), __float_as_uint(x), false, false); return __uint_as_float(rr[0]) + __uint_as_float(rr[1]); }
__device__ __forceinline__ float partner32(float x, int hi) { auto rr = __builtin_amdgcn_permlane32_swap(__float_as_uint(x), __float_as_uint(x), false, false); return __uint_as_float(hi ? rr[0] : rr[1]); }
__device__ __forceinline__ unsigned partner32u(unsigned x, int hi) { auto rr = __builtin_amdgcn_permlane32_swap(x, x, false, false); return hi ? rr[0] : rr[1]; }
__device__ __forceinline__ void dma16(const void* g, LAS unsigned char* l) { unsigned keep; const unsigned dst = (unsigned)__builtin_amdgcn_readfirstlane((int)(unsigned)(uintptr_t)l);
    asm volatile("s_mov_b32 %0, m0\n\ts_mov_b32 m0, %2\n\ts_nop 0\n\tglobal_load_lds_dwordx4 %1, off\n\ts_mov_b32 m0, %0" : "=&s"(keep) : "v"(g), "s"(dst) : "memory"); }
template <int N> __device__ __forceinline__ void wait_bar() { if (N == 3) asm volatile("s_waitcnt vmcnt(3) lgkmcnt(0)\n\ts_barrier" ::: "memory"); else if (N == 2) asm volatile("s_waitcnt vmcnt(2) lgkmcnt(0)\n\ts_barrier" ::: "memory"); else asm volatile("s_waitcnt vmcnt(0) lgkmcnt(0)\n\ts_barrier" ::: "memory"); }

struct SrcMLA {
    static constexpr int DK = 96, NDMA = 3, NV = 1;
    const bf16* kn; const bf16* kp; const bf16* v;
    __device__ __forceinline__ void init(const bf16* KVM, const bf16* KPE, size_t rowb, int h, int wid, int lane) {
        kn = KVM + (rowb + lane) * 1024 + h * 128 + 8 * wid;
        kp = KPE + (rowb + lane) * 32 + 8 * (wid & 3);
        v = KVM + (rowb + 16 * (wid & 3) + (lane >> 2)) * 1024 + h * 128 + 64 + (wid >> 2) * 32 + (lane & 3) * 8; }
    static constexpr int NKD = 2;
    __device__ __forceinline__ void issueK(int tile, LAS unsigned char* ks, int wid) const {
        dma16(kn + (size_t)tile * 64 * 1024, ks + wid * 1024);
        dma16(kp + (size_t)tile * 64 * 32, ks + (8 + (wid & 3)) * 1024); }
    __device__ __forceinline__ void issueV(int tile, LAS unsigned char* vs, int wid) const { dma16(v + (size_t)tile * 64 * 1024, vs + wid * 1024); }
    __device__ __forceinline__ void issue(int tile, LAS unsigned char* ks, LAS unsigned char* vs, int wid) const { issueK(tile, ks, wid); issueV(tile, vs, wid); }
};
struct SrcRows {
    static constexpr int DK = 64, NDMA = 2, NV = 1;
    const bf16* k; const bf16* v; size_t pitch;
    __device__ __forceinline__ void init(const bf16* K0, const bf16* V0, size_t pitch_, int wid, int lane) {
        pitch = pitch_; k = K0 + (size_t)lane * pitch + 8 * wid; v = V0 + (size_t)(16 * (wid & 3) + (lane >> 2)) * pitch + (wid >> 2) * 32 + (lane & 3) * 8; }
    static constexpr int NKD = 1;
    __device__ __forceinline__ void issueK(int tile, LAS unsigned char* ks, int wid) const { dma16(k + (size_t)tile * 64 * pitch, ks + wid * 1024); }
    __device__ __forceinline__ void issueV(int tile, LAS unsigned char* vs, int wid) const { dma16(v + (size_t)tile * 64 * pitch, vs + wid * 1024); }
    __device__ __forceinline__ void issue(int tile, LAS unsigned char* ks, LAS unsigned char* vs, int wid) const { issueK(tile, ks, wid); issueV(tile, vs, wid); }
};

struct SrcCmp {
    static constexpr int DK = 64, NDMA = 3, NV = 2;
    const bf16* k; const bf16* v; const bf16* ov;
    __device__ __forceinline__ void init(const bf16* K0, const bf16* V0, const bf16* OV, int wid, int lane) {
        k = K0 + (size_t)lane * 64 + 8 * wid; const size_t vo = (size_t)(16 * (wid & 3) + (lane >> 2)) * 64 + (wid >> 2) * 32 + (lane & 3) * 8; v = V0 + vo; ov = OV + vo; }
    __device__ __forceinline__ void issue(int tile, LAS unsigned char* ks, LAS unsigned char* vs, int wid) const {
        dma16(k + (size_t)tile * 4096, ks + wid * 1024);
        dma16(v + (size_t)tile * 4096, vs + wid * 1024);
        dma16(ov + (size_t)tile * 4096, vs + 8192 + wid * 1024); }
};

template <int NV> struct RowT { float m, l; f32x16 o[2 * NV]; };
typedef RowT<1> Row;
template <int NV> __device__ __forceinline__ void row_reset(RowT<NV>& R) { R.m = -1e30f; R.l = 0.f;
#pragma unroll
    for (int i = 0; i < 2 * NV; ++i) R.o[i] = f32x16{}; }

template <int DK> __device__ __forceinline__ void qk_tile(f32x16& p0, f32x16& p1, LAS unsigned char* kslot, const bf16x8 (&qr)[DK / 16], int r32, int hi) {
    const LAS unsigned char* kb = kslot + hi * 1024 + r32 * 16;
    p0 = f32x16{}; p1 = f32x16{};
#pragma unroll
    for (int d0 = 0; d0 < DK / 16; ++d0) {
        const bf16x8 b0 = *(const LAS bf16x8*)(kb + d0 * 2048), b1 = *(const LAS bf16x8*)(kb + d0 * 2048 + 512);
        p0 = __builtin_amdgcn_mfma_f32_32x32x16_bf16(b0, qr[d0], p0, 0, 0, 0);
        p1 = __builtin_amdgcn_mfma_f32_32x32x16_bf16(b1, qr[d0], p1, 0, 0, 0); }
}
template <int NV> __device__ __forceinline__ void softmax_tile(f32x16& p0, f32x16& p1, RowT<NV>& R) {
    float a = fmaxf(fmaxf(p0[0], p0[1]), fmaxf(p1[0], p1[1]));
#pragma unroll
    for (int r = 2; r < 16; r += 2) a = fmaxf(a, fmaxf(fmaxf(p0[r], p0[r + 1]), fmaxf(p1[r], p1[r + 1])));
    const float mt = swap_max(a);
    if (__any(mt > R.m + THR)) { const float mn = fmaxf(R.m, mt), f = __builtin_amdgcn_exp2f(R.m - mn); R.m = mn; R.l *= f;
#pragma unroll
        for (int i = 0; i < 2 * NV; ++i) R.o[i] *= f; }
    const float m = R.m; float s = 0.f;
#pragma unroll
    for (int r = 0; r < 16; ++r) { p0[r] = __builtin_amdgcn_exp2f(p0[r] - m); p1[r] = __builtin_amdgcn_exp2f(p1[r] - m); s += p0[r] + p1[r]; }
    R.l += s;
}
template <int NV> __device__ __forceinline__ void pv_tile(const f32x16& p0, const f32x16& p1, RowT<NV>& R, LAS unsigned char* vslot, int lane, int hi) {
    bf16x8 pa[4];
#pragma unroll
    for (int k = 0; k < 4; ++k) { const f32x16& P = (k < 2) ? p0 : p1; const int b = (k & 1) * 8;
        u32x4 w; w.x = pk2(P[b], P[b + 1]); w.y = pk2(P[b + 2], P[b + 3]); w.z = pk2(P[b + 4], P[b + 5]); w.w = pk2(P[b + 6], P[b + 7]); pa[k] = __builtin_bit_cast(bf16x8, w); }
    const int vb = (int)(unsigned)(uintptr_t)vslot + ((lane >> 4) & 1) * 32 + (lane & 3) * 8 + (4 * hi + ((lane & 15) >> 2)) * 64;
#pragma unroll
    for (int d0 = 0; d0 < 2 * NV; ++d0) { s16x4 lo[4], hh[4];
#pragma unroll
        for (int ks = 0; ks < 4; ++ks) {
            asm volatile("ds_read_b64_tr_b16 %0,%1 offset:%c2" : "=&v"(lo[ks]) : "v"(vb), "i"(d0 * 4096 + ks * 1024) : "memory");
            asm volatile("ds_read_b64_tr_b16 %0,%1 offset:%c2" : "=&v"(hh[ks]) : "v"(vb), "i"(d0 * 4096 + ks * 1024 + 512) : "memory"); }
        asm volatile("s_waitcnt lgkmcnt(0)" ::: "memory"); __builtin_amdgcn_sched_barrier(0);
#pragma unroll
        for (int ks = 0; ks < 4; ++ks) { const bf16x8 vf = (bf16x8){lo[ks][0], lo[ks][1], lo[ks][2], lo[ks][3], hh[ks][0], hh[ks][1], hh[ks][2], hh[ks][3]};
            R.o[d0] = __builtin_amdgcn_mfma_f32_32x32x16_bf16(vf, pa[ks], R.o[d0], 0, 0, 0); } }
}

template <class RowPtr>
__device__ __forceinline__ void store_rows(LAS unsigned char* stg, const f32x16& o0, const f32x16& o1, float scale, float& ss, int lane, const RowPtr& rowptr) {
    const int r32 = lane & 31, hi = lane >> 5;
    LAS unsigned char* wp = stg + r32 * 144 + 8 * hi;
#pragma unroll
    for (int d0 = 0; d0 < 2; ++d0)
#pragma unroll
        for (int k = 0; k < 4; ++k) { const f32x16& o = d0 ? o1 : o0;
            const float v0 = o[4 * k] * scale, v1 = o[4 * k + 1] * scale, v2 = o[4 * k + 2] * scale, v3 = o[4 * k + 3] * scale;
            ss += (v0 * v0 + v1 * v1) + (v2 * v2 + v3 * v3);
            *(LAS unsigned long long*)(wp + 64 * d0 + 16 * k) = (unsigned long long)pk2(v0, v1) | ((unsigned long long)pk2(v2, v3) << 32); }
    asm volatile("s_waitcnt lgkmcnt(0)" ::: "memory");
#pragma unroll
    for (int i = 0; i < 4; ++i) { const int row = i * 8 + (lane >> 3), ch = lane & 7;
        const u32x4 v = *(const LAS u32x4*)(stg + row * 144 + ch * 16);
        __builtin_nontemporal_store(v, (u32x4*)(rowptr(row) + ch * 8)); }
}

template <class Src, class Fix, class Skip>
__device__ __forceinline__ void run_tiles(LAS unsigned char* ring, const Src& src, int kt0, int kt1, const bf16x8 (&qr)[Src::DK / 16], RowT<Src::NV>& R, const Fix& fix, const Skip& skip, int wid, int lane) {
    constexpr int KB = Src::DK * 128, SLOT = KB + 8192 * Src::NV;
    const int r32 = lane & 31, hi = lane >> 5; const int nt = kt1 - kt0;
    if (nt <= 0) return;
    src.issue(kt0, ring, ring + KB, wid);
    if (nt > 1) src.issue(kt0 + 1, ring + SLOT, ring + SLOT + KB, wid);
    int s_cur = 0, s_nn = 2 * SLOT;
    for (int i = 0; i < nt; ++i) {
        if (i + 1 < nt) wait_bar<Src::NDMA>(); else wait_bar<0>();
        if (i + 2 < nt) src.issue(kt0 + i + 2, ring + s_nn, ring + s_nn + KB, wid);
        const int tile = kt0 + i;
        if (!skip(tile)) {
            f32x16 p0, p1;
            qk_tile<Src::DK>(p0, p1, ring + s_cur, qr, r32, hi);
            fix(p0, p1, tile);
            softmax_tile(p0, p1, R);
            pv_tile(p0, p1, R, ring + s_cur + KB, lane, hi);
        }
        s_cur = (s_cur == 2 * SLOT) ? 0 : s_cur + SLOT; s_nn = (s_nn == 2 * SLOT) ? 0 : s_nn + SLOT;
    }
    asm volatile("s_waitcnt lgkmcnt(0)\n\ts_barrier" ::: "memory");
}
}


namespace att {
template <int N> __device__ __forceinline__ void wait_bar_n() {
    static_assert(N == 0 || N == 3 || N == 4 || N == 5 || N == 6 || N == 8, "wait_bar_n: add the count");
    if (N == 8) asm volatile("s_waitcnt vmcnt(8) lgkmcnt(0)\n\ts_barrier" ::: "memory"); else if (N == 6) asm volatile("s_waitcnt vmcnt(6) lgkmcnt(0)\n\ts_barrier" ::: "memory");
    else if (N == 5) asm volatile("s_waitcnt vmcnt(5) lgkmcnt(0)\n\ts_barrier" ::: "memory"); else if (N == 4) asm volatile("s_waitcnt vmcnt(4) lgkmcnt(0)\n\ts_barrier" ::: "memory");
    else if (N == 3) asm volatile("s_waitcnt vmcnt(3) lgkmcnt(0)\n\ts_barrier" ::: "memory"); else asm volatile("s_waitcnt vmcnt(0) lgkmcnt(0)\n\ts_barrier" ::: "memory"); }
typedef short v4i16_t __attribute__((ext_vector_type(4)));
typedef float f32x2_t __attribute__((ext_vector_type(2)));
__device__ __forceinline__ s16x4 vtr(const LAS unsigned char* p) { return __builtin_bit_cast(s16x4, __builtin_amdgcn_ds_read_tr16_b64_v4i16((LAS v4i16_t*)p)); }
__device__ __forceinline__ unsigned cvtpk(float lo, float hi) { f32x2_t v = {lo, hi}; bf16x2_t b = __builtin_convertvector(v, bf16x2_t); return __builtin_bit_cast(unsigned, b); }
#define SBAR() __builtin_amdgcn_sched_barrier(0)
#define PIN(x) asm volatile("" : "+v"(x))
#define MX3(a, b, c) __builtin_fmaxf(__builtin_fmaxf((a), (b)), (c))

template <class Src, class Fix>
__device__ __forceinline__ void run_pipe(LAS unsigned char* ring, const Src& src, int kt0, int kt1, const bf16x8 (&qr)[Src::DK / 16], Row& R, const Fix& fix, float bfar, int near_from, int wid, int lane) {
    constexpr int DK = Src::DK, NKS = DK / 16, NK = 2 * NKS, KB = DK * 128, VB = 8192, NKD = Src::NKD, NDMA = NKD + 1;
    const int NT = kt1 - kt0;
    constexpr bool ALT = false;
    if (wid >= 4) __builtin_amdgcn_s_setprio(1);
    const int r32 = lane & 31, hi = lane >> 5;
    LAS unsigned char* kring = ring; LAS unsigned char* vring = ring + 4 * KB;
    const LAS unsigned char* kp0 = kring + hi * 1024 + r32 * 16;
    const LAS unsigned char* vp0 = vring + ((lane >> 4) & 1) * 32 + (lane & 3) * 8 + (4 * hi + ((lane & 15) >> 2)) * 64;
#define TILE(tt) (kt0 + ((tt) < NT ? (tt) : NT - 1))
    src.issueK(TILE(0), kring, wid); src.issueV(TILE(0), vring, wid); src.issueK(TILE(1), kring + KB, wid); src.issueK(TILE(2), kring + 2 * KB, wid);
    src.issueK(TILE(3), kring + 3 * KB, wid); src.issueV(TILE(1), vring + VB, wid);
    bf16x8 kf[NK];
    f32x16 A0, A1, B0, B1, cin;
    float m = 0.f, l = 0.f, csh = 0.f; f32x16 o0 = f32x16{}, o1 = f32x16{};
    wait_bar_n<3 * NKD + 2>();
#define KLOAD(kslot) do { _Pragma("unroll") for (int d0 = 0; d0 < NKS; ++d0) { kf[2 * d0] = *(const LAS bf16x8*)(kp0 + (kslot) + d0 * 2048); kf[2 * d0 + 1] = *(const LAS bf16x8*)(kp0 + (kslot) + d0 * 2048 + 512); } } while (0)
#define ROWMAX(C0, C1, out) do { float a_ = MX3(C0[0], C0[1], C1[0]), b_ = MX3(C0[2], C0[3], C1[1]); a_ = MX3(a_, C1[2], C1[3]); \
        _Pragma("unroll") for (int r = 4; r < 16; r += 4) { a_ = MX3(a_, C0[r], C0[r + 1]); b_ = MX3(b_, C0[r + 2], C0[r + 3]); a_ = MX3(a_, C1[r], C1[r + 1]); b_ = MX3(b_, C1[r + 2], C1[r + 3]); } \
        out = swap_max(__builtin_fmaxf(a_, b_)); } while (0)
    KLOAD(0);
    A0 = f32x16{}; A1 = f32x16{};
#pragma unroll
    for (int d0 = 0; d0 < NKS; ++d0) { A0 = __builtin_amdgcn_mfma_f32_32x32x16_bf16(kf[2 * d0], qr[d0], A0, 0, 0, 0); A1 = __builtin_amdgcn_mfma_f32_32x32x16_bf16(kf[2 * d0 + 1], qr[d0], A1, 0, 0, 0); }
    fix(A0, A1, kt0);
    { float rm; ROWMAX(A0, A1, rm);
      const float sh0 = (kt0 < near_from) ? bfar : 0.f;
      const float dl = (rm > NEG_INF) ? rm + sh0 : 0.f; m = dl; const float c0 = sh0 - dl;
#pragma unroll
      for (int r = 0; r < 16; ++r) { A0[r] = __builtin_amdgcn_exp2f(A0[r] + c0); A1[r] = __builtin_amdgcn_exp2f(A1[r] + c0); }
      csh = (kt0 + 1 < near_from) ? bfar : 0.f;
#pragma unroll
      for (int r = 0; r < 16; ++r) cin[r] = csh - m;
      asm volatile("" : "+v"(cin)); }
    float fpend = 1.0f; bool resc = false;
    wait_bar_n<2 * NKD + 1>();
    src.issueK(TILE(4), kring, wid); src.issueV(TILE(2), vring + 2 * VB, wid);
    KLOAD(KB);
    wait_bar_n<2 * NDMA>();
    int kcur = KB, knext = 2 * KB, vprev = 0, vnext = 3 * VB;
    u32x4 pw0, pw1, pw2, pw3; s16x4 vlo[8], vhi[8];
#define PKW(P, b) cvtpk(P[b], P[(b) + 1])
#define VRD(i) do { vlo[i] = vtr(vp_ + (((i) >> 2) * 4096 + ((i) & 3) * 1024)); vhi[i] = vtr(vp_ + (((i) >> 2) * 4096 + ((i) & 3) * 1024 + 512)); } while (0)
#define VFR(i) (bf16x8){vlo[i][0], vlo[i][1], vlo[i][2], vlo[i][3], vhi[i][0], vhi[i][1], vhi[i][2], vhi[i][3]}
#define PAF(k) __builtin_bit_cast(bf16x8, pw##k)
#define QKM(i, C, first) C = __builtin_amdgcn_mfma_f32_32x32x16_bf16(kf[i], qr[(i) >> 1], (first) ? cin : C, 0, 0, 0)
#define GAPA(MF, a0_, a1_, a2_, a3_, W0, W1, PW) do { MF; sacc += a0_; sacc += a1_; sacc += a2_; sacc += a3_; PIN(sacc); W0; W1; PIN(PW); SBAR(); } while (0)
#define GAPB(MF, X, b) do { MF; X[b] = __builtin_amdgcn_exp2f(X[b]); X[(b) + 1] = __builtin_amdgcn_exp2f(X[(b) + 1]); X[(b) + 2] = __builtin_amdgcn_exp2f(X[(b) + 2]); X[(b) + 3] = __builtin_amdgcn_exp2f(X[(b) + 3]); PIN(X); SBAR(); } while (0)
#define PHASE_A(C0, C1, P0, P1) do { SBAR(); const LAS unsigned char* vp_ = vp0 + vprev; \
        VRD(0); SBAR(); float sacc = P0[0] + P0[1]; \
        GAPA(QKM(0, C0, true), P0[2], P0[3], P0[4], P0[5], pw0[0] = PKW(P0, 0), pw0[1] = PKW(P0, 2), pw0); \
        GAPA(QKM(1, C1, true), P0[6], P0[7], P0[8], P0[9], pw0[2] = PKW(P0, 4), pw0[3] = PKW(P0, 6), pw0); \
        VRD(1); SBAR(); GAPA(QKM(2, C0, false), P0[10], P0[11], P0[12], P0[13], pw1[0] = PKW(P0, 8), pw1[1] = PKW(P0, 10), pw1); \
        GAPA(QKM(3, C1, false), P0[14], P0[15], P1[0], P1[1], pw1[2] = PKW(P0, 12), pw1[3] = PKW(P0, 14), pw1); \
        VRD(2); SBAR(); GAPA(QKM(4, C0, false), P1[2], P1[3], P1[4], P1[5], pw2[0] = PKW(P1, 0), pw2[1] = PKW(P1, 2), pw2); \
        GAPA(QKM(5, C1, false), P1[6], P1[7], P1[8], P1[9], pw2[2] = PKW(P1, 4), pw2[3] = PKW(P1, 6), pw2); \
        VRD(3); SBAR(); GAPA(QKM(6, C0, false), P1[10], P1[11], P1[12], P1[13], pw3[0] = PKW(P1, 8), pw3[1] = PKW(P1, 10), pw3); \
        GAPA(QKM(7, C1, false), P1[14], P1[15], 0.f, 0.f, pw3[2] = PKW(P1, 12), pw3[3] = PKW(P1, 14), pw3); \
        if (NK > 8) { _Pragma("unroll") for (int i_ = 8; i_ < NK; i_ += 2) { QKM(i_, C0, false); QKM(i_ + 1, C1, false); } SBAR(); } \
        l += sacc; } while (0)
#define KRD(j) do { kf[2 * (j)] = *(const LAS bf16x8*)(kp0 + knext + (j) * 2048); kf[2 * (j) + 1] = *(const LAS bf16x8*)(kp0 + knext + (j) * 2048 + 512); SBAR(); } while (0)
#define PHASE_B(C0, C1) do { SBAR(); const LAS unsigned char* vp_ = vp0 + vprev; \
        VRD(4); SBAR(); GAPB(o0 = __builtin_amdgcn_mfma_f32_32x32x16_bf16(VFR(0), PAF(0), o0, 0, 0, 0), C0, 0); \
        VRD(5); SBAR(); GAPB(o0 = __builtin_amdgcn_mfma_f32_32x32x16_bf16(VFR(1), PAF(1), o0, 0, 0, 0), C0, 4); \
        VRD(6); SBAR(); KRD(0); GAPB(o0 = __builtin_amdgcn_mfma_f32_32x32x16_bf16(VFR(2), PAF(2), o0, 0, 0, 0), C0, 8); \
        VRD(7); SBAR(); KRD(1); GAPB(o0 = __builtin_amdgcn_mfma_f32_32x32x16_bf16(VFR(3), PAF(3), o0, 0, 0, 0), C0, 12); \
        KRD(2); GAPB(o1 = __builtin_amdgcn_mfma_f32_32x32x16_bf16(VFR(4), PAF(0), o1, 0, 0, 0), C1, 0); \
        KRD(3); GAPB(o1 = __builtin_amdgcn_mfma_f32_32x32x16_bf16(VFR(5), PAF(1), o1, 0, 0, 0), C1, 4); \
        if (NKS > 4) { KRD(4); } GAPB(o1 = __builtin_amdgcn_mfma_f32_32x32x16_bf16(VFR(6), PAF(2), o1, 0, 0, 0), C1, 8); \
        if (NKS > 5) { KRD(5); } GAPB(o1 = __builtin_amdgcn_mfma_f32_32x32x16_bf16(VFR(7), PAF(3), o1, 0, 0, 0), C1, 12); \
        } while (0)
#define DECIDE(C0, C1, tt) do { \
        fix(C0, C1, kt0 + (tt)); \
        float rm_; ROWMAX(C0, C1, rm_); resc = false; \
        const bool up_ = (rm_ > THR) || (l == 0.f && rm_ < -THR && rm_ > NEG_INF); \
        const float nsh_ = (kt0 + (tt) + 1 < near_from) ? bfar : 0.f; \
        if (__any(up_)) { const float dl_ = up_ ? rm_ : __builtin_fmaxf(rm_, 0.f); m += dl_; fpend = __builtin_amdgcn_exp2f(-dl_); l *= fpend; resc = true; \
            _Pragma("unroll") for (int r = 0; r < 16; ++r) { C0[r] -= dl_; C1[r] -= dl_; } \
            csh = nsh_; _Pragma("unroll") for (int r = 0; r < 16; ++r) cin[r] = csh - m; asm volatile("" : "+v"(cin)); } \
        else if (nsh_ != csh) { csh = nsh_; _Pragma("unroll") for (int r = 0; r < 16; ++r) cin[r] = csh - m; asm volatile("" : "+v"(cin)); } } while (0)
#define STEP(C0, C1, P0, P1, tt) do { \
        if (ALT && wid >= 4) asm volatile("s_barrier" ::: "memory"); \
        PHASE_A(C0, C1, P0, P1); \
        src.issueK(TILE((tt) + 4), kring + kcur, wid); src.issueV(TILE((tt) + 2), vring + vnext, wid); \
        DECIDE(C0, C1, tt); \
        PHASE_B(C0, C1); \
        if (ALT && wid < 4) asm volatile("s_waitcnt lgkmcnt(0)\n\ts_barrier" ::: "memory"); \
        wait_bar_n<2 * NDMA>();                                          \
        if (resc) { o0 *= fpend; o1 *= fpend; } \
        kcur = knext; knext = (knext == 3 * KB) ? 0 : knext + KB; \
        vprev = (vprev == 3 * VB) ? 0 : vprev + VB; vnext = (vnext == 3 * VB) ? 0 : vnext + VB; } while (0)
    int t = 1;
    for (; t + 1 < NT; t += 2) { STEP(B0, B1, A0, A1, t); STEP(A0, A1, B0, B1, t + 1); }
    if (t < NT) { STEP(B0, B1, A0, A1, t); A0 = B0; A1 = B1; }
    { float sacc = 0.f;
#pragma unroll
      for (int r = 0; r < 16; ++r) sacc += A0[r] + A1[r];
      l += sacc;
      pw0 = (u32x4){PKW(A0, 0), PKW(A0, 2), PKW(A0, 4), PKW(A0, 6)}; pw1 = (u32x4){PKW(A0, 8), PKW(A0, 10), PKW(A0, 12), PKW(A0, 14)};
      pw2 = (u32x4){PKW(A1, 0), PKW(A1, 2), PKW(A1, 4), PKW(A1, 6)}; pw3 = (u32x4){PKW(A1, 8), PKW(A1, 10), PKW(A1, 12), PKW(A1, 14)};
      const LAS unsigned char* vp_ = vp0 + vprev;
#pragma unroll
      for (int i = 0; i < 8; ++i) VRD(i);
      o0 = __builtin_amdgcn_mfma_f32_32x32x16_bf16(VFR(0), PAF(0), o0, 0, 0, 0); o1 = __builtin_amdgcn_mfma_f32_32x32x16_bf16(VFR(4), PAF(0), o1, 0, 0, 0);
      o0 = __builtin_amdgcn_mfma_f32_32x32x16_bf16(VFR(1), PAF(1), o0, 0, 0, 0); o1 = __builtin_amdgcn_mfma_f32_32x32x16_bf16(VFR(5), PAF(1), o1, 0, 0, 0);
      o0 = __builtin_amdgcn_mfma_f32_32x32x16_bf16(VFR(2), PAF(2), o0, 0, 0, 0); o1 = __builtin_amdgcn_mfma_f32_32x32x16_bf16(VFR(6), PAF(2), o1, 0, 0, 0);
      o0 = __builtin_amdgcn_mfma_f32_32x32x16_bf16(VFR(3), PAF(3), o0, 0, 0, 0); o1 = __builtin_amdgcn_mfma_f32_32x32x16_bf16(VFR(7), PAF(3), o1, 0, 0, 0); }
    wait_bar_n<0>();
    R.m = m; R.l = l; R.o[0] = o0; R.o[1] = o1;
    __builtin_amdgcn_s_setprio(0);
#undef TILE
#undef KLOAD
#undef ROWMAX
#undef DECIDE
#undef PKW
#undef VRD
#undef VFR
#undef PAF
#undef QKM
#undef GAPA
#undef GAPB
#undef PHASE_A
#undef KRD
#undef PHASE_B
#undef STEP
}
#undef SBAR
#undef PIN
#undef MX3
}
constexpr int MLA_STG_OFF = 98304;
__device__ __forceinline__ void p3_mla(const Ptrs& P, LAS unsigned char* lds, int vcu, int G, int tid, int wid) {
    using namespace att;
    for (int L = vcu; L < 2048; L += G) {
        int lane_u = tid & 63; asm volatile("" : "+v"(lane_u));
        const int lane = lane_u, r32 = lane & 31, hi = lane >> 5;
        int bh, qb;
        if (G == 256) { const int i = L >> 8, s8 = vcu & 7; bh = (vcu >> 3) + 32 * (i >> 1); qb = (i & 1) ? 15 - s8 : s8; }
        else { bh = L >> 4; qb = L & 15; }
        const int b = bh >> 3, h = bh & 7; const size_t rowb = (size_t)b * SEQ;
        const int q0 = qb * 256 + wid * 32, t = q0 + r32; const size_t row = rowb + t;
        bf16x8 qr[6];
#pragma unroll
        for (int d0 = 0; d0 < 6; ++d0) qr[d0] = *(const bf16x8*)(P.QM + row * 768 + h * 96 + d0 * 16 + hi * 8);
        SrcMLA src; src.init(P.KVM, P.kpe, rowb, h, wid, lane);
        Row R; row_reset(R);
        auto fix = [&](f32x16& p0, f32x16& p1, int tile) {
            if (tile * 64 + 63 > q0) {
                const int kb = tile * 64 + 4 * hi;
#pragma unroll
                for (int r = 0; r < 16; ++r) { const int kv = kb + (r & 3) + 8 * (r >> 2); if (kv > t) p0[r] = NEG_INF; if (kv + 32 > t) p1[r] = NEG_INF; } } };
        run_pipe(lds, src, 0, 4 * qb + 4, qr, R, fix, 0.f, 0x7fffffff, wid, lane);
        const float inv = 1.0f / swap_sum(R.l); float ss = 0.f;
        { bf16* const ob = P.ATT + (rowb + q0) * 1024 + h * 64;
          store_rows(lds + MLA_STG_OFF + wid * 4608, R.o[0], R.o[1], inv, ss, lane, [&](int r) -> bf16* { return ob + (size_t)r * 1024; }); }
        ss = swap_sum(ss);
        if (hi == 0) P.ssatt[row * 16 + h] = ss;
    }
}

constexpr int NSA_LB_OFF = 81920;
constexpr int NSA_OUT_OFF = 86016;
__device__ __forceinline__ float dpp_xor1(float x) { return __builtin_bit_cast(float, __builtin_amdgcn_update_dpp(0, __builtin_bit_cast(int, x), 0xB1, 0xF, 0xF, false)); }
__device__ __forceinline__ float dpp_xor2(float x) { return __builtin_bit_cast(float, __builtin_amdgcn_update_dpp(0, __builtin_bit_cast(int, x), 0x4E, 0xF, 0xF, false)); }
__device__ __forceinline__ unsigned dpp_xor1u(unsigned x) { return (unsigned)__builtin_amdgcn_update_dpp(0, (int)x, 0xB1, 0xF, 0xF, false); }
__device__ __forceinline__ unsigned dpp_xor2u(unsigned x) { return (unsigned)__builtin_amdgcn_update_dpp(0, (int)x, 0x4E, 0xF, 0xF, false); }
template <int STEP, int YOFF> __device__ __forceinline__ void add_bias(att::f32x16& p, const LAS float* lb, int D) {
#pragma unroll
    for (int r = 0; r < 16; ++r) { int d = D - STEP * ((r & 3) + 8 * (r >> 2) + YOFF); d = d < 0 ? 0 : (d > 127 ? 127 : d); p[r] += lb[d]; }
}
__device__ __forceinline__ void p3_nsa(const Ptrs& P, LAS unsigned char* lds, int vcu, int G, int tid, int wid) {
    using namespace att;
    LAS float* LB = (LAS float*)(lds + NSA_LB_OFF);
    for (int e = tid; e < 1024; e += NTHR) LB[e] = P.bias[e];
    __syncthreads();
    for (int L = vcu; L < 2048; L += G) {
        int bhk, c;
        if (G == 256) { const int i = L >> 8, sub = vcu & 7; bhk = vcu >> 3; const int base = 16 * (i >> 1); c = (i & 1) ? base + 15 - sub : base + sub; }
        else { bhk = L >> 6; c = L & 63; }
        int lane_u = tid & 63; asm volatile("" : "+v"(lane_u));
        const int lane = lane_u, r32 = lane & 31, hi = lane >> 5, ql = r32 >> 2, g = r32 & 3;
        const int b = bhk >> 1, hk = bhk & 1, hq = hk * 4 + g; const size_t rowb = (size_t)b * SEQ;
        const int t = c * 64 + wid * 8 + ql; const size_t row = rowb + t;
        const LAS float* lb = LB + hq * 128; const float b31 = lb[127];
        bf16x8 qr[4];
#pragma unroll
        for (int d0 = 0; d0 < 4; ++d0) qr[d0] = *(const bf16x8*)(P.U + row * DINP + C_QN + hq * 64 + d0 * 16 + hi * 8);
        float gate[3];
#pragma unroll
        for (int br = 0; br < 3; ++br) { const float x = bf2f(P.U[row * DINP + C_GATE + hq * 3 + br]); gate[br] = __builtin_amdgcn_rcpf(1.0f + __builtin_amdgcn_exp2f(-x * LOG2E)); }
        LAS float* outp = (LAS float*)(lds + NSA_OUT_OFF) + wid * 2048 + lane;
        unsigned mlo, mhi;
        {
            const int nv = t >= 31 ? ((t - 31) >> 4) + 1 : 0;
            int ln = lane_u; asm volatile("" : "+v"(ln));
            SrcCmp src; src.init(P.kcmp + (size_t)bhk * 256 * 64, P.vcmp + (size_t)bhk * 256 * 64, P.ovt, wid, ln);
            RowT<2> R; row_reset(R);
            auto fix = [&](f32x16& p0, f32x16& p1, int tile) {
                const int D = t - 31 - 16 * (64 * tile + 4 * hi);
                add_bias<16, 0>(p0, lb, D); add_bias<16, 32>(p1, lb, D);
                const int ib = 64 * tile + 4 * hi;
#pragma unroll
                for (int r = 0; r < 16; ++r) { const int i = ib + (r & 3) + 8 * (r >> 2); if (i >= nv) p0[r] = NEG_INF; if (i + 32 >= nv) p1[r] = NEG_INF; } };
            auto skip = [&](int) -> bool { return false; };
            run_tiles(lds, src, 0, (4 * c + 3 + 63) >> 6, qr, R, fix, skip, wid, lane);
            const float lt = swap_sum(R.l); const float inv = lt > 0.f ? 1.0f / lt : 0.f;
            { const float f = gate[0] * inv;
#pragma unroll
              for (int i = 0; i < 16; ++i) { outp[64 * i] = R.o[0][i] * f; outp[64 * (16 + i)] = R.o[1][i] * f; } }
            mlo = 0u; mhi = 0u;
            if (c <= 15) { const unsigned long long mk = (2ull << c) - 1ull; mlo = (unsigned)mk; mhi = (unsigned)(mk >> 32); }
            else {
                float cand[8];
#pragma unroll
                for (int rr = 0; rr < 8; ++rr) {
                    float v00 = R.o[2][rr] * inv, v01 = R.o[2][8 + rr] * inv, v10 = R.o[3][rr] * inv, v11 = R.o[3][8 + rr] * inv;
                    v00 += dpp_xor1(v00); v00 += dpp_xor2(v00); v01 += dpp_xor1(v01); v01 += dpp_xor2(v01); v10 += dpp_xor1(v10); v10 += dpp_xor2(v10); v11 += dpp_xor1(v11); v11 += dpp_xor2(v11);
                    cand[rr] = (g & 2) ? ((g & 1) ? v11 : v10) : ((g & 1) ? v01 : v00); }
                unsigned key[8];
#pragma unroll
                for (int rr = 0; rr < 8; ++rr) { const int j = 32 * (g >> 1) + (rr & 3) + 8 * (2 * (g & 1) + (rr >> 2)) + 4 * hi;
                    const bool ok = j >= 1 && j <= c - 2; key[rr] = ok ? ((__float_as_uint(fmaxf(cand[rr], 0.f)) & ~63u) | (unsigned)(63 - j)) : 0u; }
                unsigned long long mk = 1ull | (1ull << c) | (1ull << (c - 1));
                for (int round = 0; round < 13; ++round) {
                    unsigned best = key[0];
#pragma unroll
                    for (int rr = 1; rr < 8; ++rr) best = best > key[rr] ? best : key[rr];
                    { const unsigned o1 = dpp_xor1u(best); best = best > o1 ? best : o1; const unsigned o2 = dpp_xor2u(best); best = best > o2 ? best : o2;
                      auto rr2 = __builtin_amdgcn_permlane32_swap(best, best, false, false); best = rr2[0] > rr2[1] ? rr2[0] : rr2[1]; }
                    if (best != 0u) mk |= 1ull << (63u - (best & 63u));
#pragma unroll
                    for (int rr = 0; rr < 8; ++rr) key[rr] = (key[rr] == best) ? 0u : key[rr];
                }
                mlo = (unsigned)mk; mhi = (unsigned)(mk >> 32);
            }
        }
        {
            int ln = lane_u; asm volatile("" : "+v"(ln));
            SrcRows src; src.init(P.U + rowb * DINP + C_KVS + hk * 64, P.U + rowb * DINP + C_KVS + 128 + hk * 64, DINP, wid, ln);
            Row R; row_reset(R);
            auto fix = [&](f32x16& p0, f32x16& p1, int tile) {
                if (tile >= c - 2) { const int D = t - 64 * tile - 4 * hi; add_bias<1, 0>(p0, lb, D); asm volatile("" ::: "memory"); add_bias<1, 32>(p1, lb, D); }
                const bool sel = ((tile < 32 ? (mlo >> tile) : (mhi >> (tile - 32))) & 1u) != 0u;
                if (tile == c) { const int kb = tile * 64 + 4 * hi;
#pragma unroll
                    for (int r = 0; r < 16; ++r) { const int kv = kb + (r & 3) + 8 * (r >> 2); if (kv > t || !sel) p0[r] = NEG_INF; if (kv + 32 > t || !sel) p1[r] = NEG_INF; } }
                else if (!sel) {
#pragma unroll
                    for (int r = 0; r < 16; ++r) { p0[r] = NEG_INF; p1[r] = NEG_INF; } } };
            run_pipe(lds, src, 0, c + 1, qr, R, fix, b31, c - 2, wid, lane);
            const float f = gate[1] / swap_sum(R.l);
#pragma unroll
            for (int i = 0; i < 16; ++i) { outp[64 * i] += R.o[0][i] * f; outp[64 * (16 + i)] += R.o[1][i] * f; }
        }
        f32x16 out[2];
        {
            int ln = lane_u; asm volatile("" : "+v"(ln));
            SrcRows src; src.init(P.U + rowb * DINP + C_KVW + hk * 64, P.U + rowb * DINP + C_KVW + 128 + hk * 64, DINP, wid, ln);
            Row R; row_reset(R);
            auto fix = [&](f32x16& p0, f32x16& p1, int tile) {
                if (tile >= c - 2) { const int D = t - 64 * tile - 4 * hi; add_bias<1, 0>(p0, lb, D); asm volatile("" ::: "memory"); add_bias<1, 32>(p1, lb, D); }
                if (tile == c || tile == c - 8) { const int kb = tile * 64 + 4 * hi;
#pragma unroll
                    for (int r = 0; r < 16; ++r) { const int kv = kb + (r & 3) + 8 * (r >> 2); const int d0_ = t - kv, d1_ = d0_ - 32;
                        if (d0_ < 0 || d0_ >= 512) p0[r] = NEG_INF; if (d1_ < 0 || d1_ >= 512) p1[r] = NEG_INF; } } };
            run_pipe(lds, src, c >= 8 ? c - 8 : 0, c + 1, qr, R, fix, b31, c - 2, wid, lane);
            const float f = gate[2] / swap_sum(R.l);
#pragma unroll
            for (int i = 0; i < 16; ++i) { out[0][i] = outp[64 * i] + R.o[0][i] * f; out[1][i] = outp[64 * (16 + i)] + R.o[1][i] * f; }
        }
        { float ss = 0.f; bf16* const ob = P.ATT + (rowb + c * 64 + wid * 8) * 1024 + 512 + hk * 256;
            store_rows(lds + NSA_OUT_OFF + wid * 8192, out[0], out[1], 1.0f, ss, lane, [&](int r) -> bf16* { return ob + (size_t)(r >> 2) * 1024 + (r & 3) * 64; });
            ss = swap_sum(ss);
            if (hi == 0) P.ssatt[row * 16 + 8 + hq] = ss; }
    }
}

__global__ void __launch_bounds__(NTHR, 2) mega_fwd(Args args) {
    extern __shared__ __attribute__((aligned(16))) unsigned char lds_raw[];
    LAS unsigned char* lds = (LAS unsigned char*)lds_raw;
    volatile LAS unsigned* MISC = (volatile LAS unsigned*)(lds + MISC_OFF);
    const int tid0 = threadIdx.x;
#define LAUNDER_TID() int tid = tid0; asm volatile("" : "+v"(tid)); const int lane = tid & 63, wave = __builtin_amdgcn_readfirstlane(tid >> 6); (void)lane; (void)wave
    const int G = gridDim.x, wg = blockIdx.x;
    const int vcu = (G % 8 == 0) ? (wg % 8) * (G / 8) + wg / 8 : wg;
    unsigned char* ws = args.ws;
    Ptrs P;
#pragma unroll
    for (int i = 0; i < 22; ++i) P.in[i] = args.in[i];
    P.out = args.out; P.ws = ws;
    P.Win = (bf16*)(ws + WS_WIN); P.Wuq = (bf16*)(ws + WS_WUQ); P.Wukv = (bf16*)(ws + WS_WUKV); P.Wout = (bf16*)(ws + WS_WOUT); P.Wgu = (bf16*)(ws + WS_WGU); P.Wdn = (bf16*)(ws + WS_WDN);
    P.rope = (f32x2v*)(ws + WS_ROPE); P.bias = (float*)(ws + WS_BIAS); P.bias1 = (float*)(ws + WS_BIAS1); P.rstdx = (float*)(ws + WS_RSTDX);
    P.ssqkv = (float*)(ws + WS_SSQKV); P.ssatt = (float*)(ws + WS_SSATT); P.ssh = (float*)(ws + WS_SSH);
    P.kcmp = (bf16*)(ws + WS_KCMP); P.vcmp = (bf16*)(ws + WS_VCMP); P.kpe = (bf16*)(ws + WS_KPE); P.ovt = (bf16*)(ws + WS_OVT); P.W1c = (bf16*)(ws + WS_W1C); P.W2t = (bf16*)(ws + WS_W2T);
    P.XB = (bf16*)(ws + WS_XB); P.U = (bf16*)(ws + WS_U); P.QM = (bf16*)(ws + WS_QM); P.KVM = (bf16*)(ws + WS_KVM); P.ATT = (bf16*)(ws + WS_ATT); P.H = (bf16*)(ws + WS_H); P.HID = (bf16*)(ws + WS_HID);
    gu32* ctl = (gu32*)(ws + WS_CTL);

    if (tid0 < 64) MISC[tid0] = 0u;
    __syncthreads();
    XcdBarrier bar; bar.bar = (unsigned*)(ctl + CW_BAR); bar.x = 0; bar.st = nullptr;
    if (N_LAUNCHES == 1) bar = xcd_barrier_post((unsigned*)(ctl + CW_BAR), MISC + 8);
#define GRID_BAR() do { if (N_LAUNCHES == 1) xcd_barrier(bar); } while (0)
    const int lo = args.ph_lo, hi = args.ph_hi;
#ifndef PHASE_MASK
#define PHASE_MASK 0xff
#endif
#define IN(k) (((PHASE_MASK >> (k)) & 1) && lo <= (k) && (k) < hi)
#define BOTH(k) (IN(k) && IN((k) + 1))
#ifndef REPEAT_MASK
#define REPEAT_MASK 0
#endif
#define REP(k) for (int rep_ = 0; rep_ < (((REPEAT_MASK >> (k)) & 1) ? 2 : 1); ++rep_)

    if (IN(0)) { REP(0) { LAUNDER_TID(); p0_prologue(P, lds, wg, G, wave, lane, tid); } if (BOTH(0)) GRID_BAR(); }

    if (IN(1)) {
        REP(1) {
        pg8::Gemm g{P.XB, P.Win, MT, DINP, 1024, 1024, 1024, 0}; pg8::StaticOrder S; S.init(MT, DINP, G, wg);
        EpiInProj E{P.U, P.rstdx, P.ssqkv};
        pg8::gemm_phase<EpiInProj, pg8::StaticOrder, true, true>(lds, g, S, E); }
        if (BOTH(1)) GRID_BAR();
    }

    if (IN(2)) {
        REP(2) {
        { LAUNDER_TID(); p2_kpe(P, wg, G, tid); }
        { pg8::Gemm g{P.U, P.W1c, 64 * 256, 256, 1024, 16 * DINP, 1024, DINP * 2}; CmpOrder S{G, wg, P.U, P.W1c};
          EpiCmp E{P.bias1, P.W2t, P.kcmp, P.vcmp};
          pg8::gemm_phase<EpiCmp, CmpOrder, false, true>(lds, g, S, E); }
        { const int gq = G > 64 ? G - 64 : G, cq = G > 64 ? wg - 64 : wg;
          if (cq >= 0) { pg8::Gemm g{P.U + C_CQ, P.Wuq, MT, 768, 256, DINP, 256, 0}; pg8::StaticOrder S; S.init(MT, 768, gq, cq);
            EpiQup E{P.QM, P.ssqkv, P.rope};
            pg8::gemm_phase<EpiQup, pg8::StaticOrder, true, true>(lds, g, S, E); } }
        { pg8::Gemm g{P.U + C_CKV, P.Wukv, MT, 1024, 128, DINP, 256, 0}; pg8::StaticOrder S; S.init(MT, 1024, G, wg);
          EpiKVup E{P.KVM, P.ssqkv};
          pg8::gemm_phase<EpiKVup, pg8::StaticOrder, true, true>(lds, g, S, E); }
        }
        if (BOTH(2)) GRID_BAR();
    }

    if (IN(3)) {
        REP(3) {
        REP(8) { LAUNDER_TID(); p3_mla(P, lds, vcu, G, tid, wave); }
        REP(9) { LAUNDER_TID(); p3_nsa(P, lds, vcu, G, tid, wave); }
        }
        if (BOTH(3)) GRID_BAR();
    }

    if (IN(4)) {
        REP(4) {
        { pg8::Gemm g{P.ATT, P.Wout, MT, 1024, 1024, 1024, 1024, 0}; OutOrder S; S.init(MT, 1024, G, wg); S.ssatt = P.ssatt; S.tab = (LAS float*)(lds + OUT_TAB_OFF);
          EpiOut E{P.XB, P.H, P.ssh, (const LAS float*)(lds + OUT_TAB_OFF)};
          pg8::gemm_phase<EpiOut, OutOrder, true, true>(lds, g, S, E); }
        }
        if (BOTH(4)) GRID_BAR();
    }

    if (IN(5)) {
        REP(5) {
        pg8::Gemm g{P.H, P.Wgu, MT, NGU, 1024, 1024, 1024, 0}; GUOrder S; S.init(MT, NGU, G, wg); S.ssh = P.ssh; S.tab = (LAS float*)(lds + OUT_TAB_OFF);
        EpiGU E{(unsigned char*)P.HID, (const LAS float*)(lds + OUT_TAB_OFF)};
        pg8::gemm_phase<EpiGU, GUOrder, true, true>(lds, g, S, E); }
        if (BOTH(5)) GRID_BAR();
    }

    if (IN(6)) {
        REP(6) {
        pg8::Gemm g{P.HID, P.Wdn, MT, 1024, DFF / 2, DFF / 2, DFF / 2, 0}; pg8::StaticOrder S; S.init(MT, 1024, G, wg);
        EpiDown E{P.H, P.ATT, P.ssatt};
        pg8::gemm_phase<EpiDown, pg8::StaticOrder, true, true, true>(lds, g, S, E); }
        if (BOTH(6)) GRID_BAR();
    }

    if (IN(7)) { LAUNDER_TID(); p7_final(P, wg, G, wave, lane); }
#undef IN
#undef BOTH
#undef GRID_BAR
}

extern "C" void kernel_launch(void* const* d_in, const int* in_sizes, int n_in, void* d_out, int out_size, void* d_ws, size_t ws_size, hipStream_t stream) {
    static int grid = 0;
    if (grid == 0) {
        if (n_in != 22 || in_sizes[0] != MT * DM || out_size != MT * DM || ws_size < WS_END) { fprintf(stderr, "kernel_launch: unexpected shapes (n_in %d, in0 %d, out %d, ws %zu); nothing launched\n", n_in, n_in > 0 ? in_sizes[0] : -1, out_size, ws_size); grid = -1; return; }
        int dev = 0, cus = 0, per_cu = 0;
        if (hipGetDevice(&dev) != hipSuccess || hipDeviceGetAttribute(&cus, hipDeviceAttributeMultiprocessorCount, dev) != hipSuccess) { fprintf(stderr, "kernel_launch: device query failed\n"); grid = -1; return; }
        if (hipFuncSetAttribute((const void*)mega_fwd, hipFuncAttributeMaxDynamicSharedMemorySize, LDS_BYTES) != hipSuccess) { fprintf(stderr, "kernel_launch: hipFuncSetAttribute failed\n"); grid = -1; return; }
        if (hipOccupancyMaxActiveBlocksPerMultiprocessor(&per_cu, (const void*)mega_fwd, NTHR, LDS_BYTES) != hipSuccess || per_cu < 1)
            fprintf(stderr, "kernel_launch: note: occupancy query reports %d workgroups per CU\n", per_cu);
        (void)hipGetLastError();
        grid = cus;
    }
    if (grid < 0) return;
    if (hipMemsetAsync((char*)d_ws + WS_CTL, 0, CTL_ZERO_BYTES, stream) != hipSuccess) { fprintf(stderr, "kernel_launch: memset failed\n"); return; }
    Args a{};
    for (int i = 0; i < 22; ++i) a.in[i] = (const float*)d_in[i];
    a.out = (float*)d_out; a.ws = (unsigned char*)d_ws;
    for (int li = 0; li < N_LAUNCHES; ++li) {
        a.ph_lo = (N_LAUNCHES == 1) ? 0 : li; a.ph_hi = (N_LAUNCHES == 1) ? NPHASE : li + 1; a.li = li; a.pad = 0;
        hipLaunchKernelGGL(mega_fwd, dim3(grid), dim3(NTHR), LDS_BYTES, stream, a);
        const hipError_t le = hipPeekAtLastError();
        if (le != hipSuccess) { fprintf(stderr, "kernel_launch: launch %d failed: %s\n", li, hipGetErrorName(le)); break; }
    }
}
```

```cpp
#include <hip/hip_runtime.h>
#include <cstdio>
#include <cstdint>
namespace pg8 {
#define PG8_LAS __attribute__((address_space(3)))
typedef unsigned short bf16_t;
typedef short bf16x8 __attribute__((ext_vector_type(8)));
typedef float f32x4 __attribute__((ext_vector_type(4)));
typedef unsigned u32x4 __attribute__((ext_vector_type(4)));
constexpr int BM = 256, BK = 64, HALF = 128, HTB = HALF * BK * 2  , STAGE_BYTES = 8 * HTB, NXCD = 8, WGM = 8;

__host__ __device__ __forceinline__ int lds_byte(int r, int c) { const int st = (r >> 4) * 2 + (c >> 5), rr = r & 15, cc = c & 31, ob = rr * 64 + cc * 2; return st * 1024 + (ob ^ (((ob >> 9) & 1) << 5)); }
__host__ __device__ __forceinline__ void stage_rc(int b, int& R, int& C) { const int st = b / 1024, sb = b % 1024, swz = sb ^ (((sb >> 9) & 1) << 5); R = (st >> 1) * 16 + swz / 64; C = (st & 1) * 32 + (swz % 64) / 2; }
__host__ __device__ __forceinline__ int perm32(int rho) { const int n = rho >> 4, i = rho & 15; return 8 * (i >> 2) + 4 * n + (i & 3); }

struct Unit { int pm, pn, ui; };
struct Gemm { const bf16_t* A; const bf16_t* Bt; int M, N, K, lda, ldb, kstepA; };

struct StaticOrder {
    int nM, nN, nwg, G, c;
    __host__ __device__ void init(int M, int N, int G_, int c_) { nM = M / BM; nN = N / BM; nwg = nM * nN; G = G_; c = c_; }
    __host__ __device__ bool next(int i, Unit& u) const {
        const long L = (long)i * G + c; if (L >= nwg) return false;
        int wgid = (int)L; { const int q = nwg / NXCD, r = nwg % NXCD, xcd = wgid % NXCD, off = wgid / NXCD; wgid = (xcd < r ? xcd * (q + 1) : r * (q + 1) + (xcd - r) * q) + off; }
        const int nig = WGM * nN, gid = wgid / nig, fm = gid * WGM, gsz = (nM - fm) < WGM ? (nM - fm) : WGM;
        u.pm = fm + ((wgid % nig) % gsz); u.pn = (wgid % nig) / gsz; u.ui = i; return true;
    }
    struct Pre {};
    __device__ __forceinline__ Pre a_pre(const Unit&, int) const { return Pre{}; }
    __device__ __forceinline__ void a_post(const Unit&, const Pre&, int) const {}
    __device__ __forceinline__ void done(const Unit&) const {}
    __device__ __forceinline__ const char* a_base(const Gemm& g, const Unit& u, size_t tstepA) const { return (const char*)g.A + (size_t)u.pm * tstepA; }
    __device__ __forceinline__ const char* b_base(const Gemm& g, const Unit& u, size_t tstepB) const { return (const char*)g.Bt + (size_t)u.pn * tstepB; }
};

__device__ __forceinline__ unsigned cvt_pk_bf16(float lo, float hi) { unsigned r; asm volatile("v_cvt_pk_bf16_f32 %0, %1, %2" : "=v"(r) : "v"(lo), "v"(hi)); return r; }
typedef float f32x2 __attribute__((ext_vector_type(2)));
typedef int i32x8 __attribute__((ext_vector_type(8)));
typedef int i32x4 __attribute__((ext_vector_type(4)));
__device__ __forceinline__ i32x8 cat8(bf16x8 lo, bf16x8 hi) { const i32x4 a = __builtin_bit_cast(i32x4, lo), b = __builtin_bit_cast(i32x4, hi); return __builtin_shufflevector(a, b, 0, 1, 2, 3, 4, 5, 6, 7); }
__device__ __forceinline__ unsigned cvt_pk4_fp8(float a, float b, float c, float d) { int w = 0; w = __builtin_amdgcn_cvt_pk_fp8_f32(a, b, w, false); w = __builtin_amdgcn_cvt_pk_fp8_f32(c, d, w, true); return (unsigned)w; }
__device__ __forceinline__ void glds16(const char* sbase, unsigned voff, unsigned dst) { unsigned keep;
    asm volatile("s_mov_b32 %0, m0\n\ts_mov_b32 m0, %3\n\ts_nop 0\n\tglobal_load_lds_dwordx4 %1, %2\n\ts_mov_b32 m0, %0" : "=&s"(keep) : "v"(voff), "s"(sbase), "s"(dst) : "memory"); }
__device__ __forceinline__ int lane_id() { int r; asm volatile("v_mbcnt_lo_u32_b32 %0, -1, 0\n\tv_mbcnt_hi_u32_b32 %0, -1, %0" : "=v"(r)); return r; }
template <class Epi, class Sched, bool ALIGN_EPI = false, bool SP2 = false, bool FP8 = false>
__device__ __forceinline__ void gemm_phase(PG8_LAS unsigned char* lds, const Gemm g, const Sched& S, const Epi& E, const int wv  ) {
    int tid_ = wv * 64 + lane_id(); asm volatile("" : "+v"(tid_));
    const int tid = tid_, wid = __builtin_amdgcn_readfirstlane(tid >> 6), lane = tid & 63, wr = wid >> 2, wc = wid & 3, fr = lane & 15, fq = lane >> 4;
    const int K = g.K, nt = K / BK;
    unsigned voffA, voffB;
    { int R, C; stage_rc(tid * 16, R, C); const int Rb = Epi::PERM ? ((R & ~31) + perm32(R & 31)) : R;
      voffA = (unsigned)(R * g.lda + C) * 2u; voffB = (unsigned)(Rb * g.ldb + C) * 2u; }
    const size_t qstepA = (size_t)64 * g.lda * 2, qstepB = (size_t)64 * g.ldb * 2;
    const size_t kstepA = g.kstepA ? (size_t)g.kstepA : (size_t)(BK * 2), kstepB = (size_t)(BK * 2);
    const size_t hstepA = (size_t)HALF * g.lda * 2, hstepB = (size_t)HALF * g.ldb * 2;
    const size_t tstepA = 2 * hstepA, tstepB = 2 * hstepB;
    const unsigned ldsb = (unsigned)(uintptr_t)lds + (unsigned)wid * 1024u;
    const int aoff = lds_byte(wr * 64 + fr, fq * 8), boff = lds_byte(wc * 32 + fr, fq * 8);
#define PG8_SA(b, h) (((b) * 2 + (h)) * HTB)
#define PG8_SB(b, h) ((4 + (b) * 2 + (h)) * HTB)
#define qvoffA qstepA
#define qvoffB qstepB
#define PG8_STAGE(bufoff, gbase, voff) do { glds16((const char*)(gbase), voff, ldsb + (unsigned)(bufoff)); glds16((const char*)(gbase) + q##voff, voff, ldsb + (unsigned)(bufoff) + 8192u); } while (0)
#define PG8_LDA(dst, b, h) do { _Pragma("unroll") for (int m = 0; m < 4; ++m) _Pragma("unroll") for (int k = 0; k < 2; ++k) dst[m][k] = *(const PG8_LAS bf16x8*)(lds + PG8_SA(b, h) + aoff + m * 2048 + k * 1024); } while (0)
#define PG8_LDB(dst, b, h) do { _Pragma("unroll") for (int n = 0; n < 2; ++n) _Pragma("unroll") for (int k = 0; k < 2; ++k) dst[n][k] = *(const PG8_LAS bf16x8*)(lds + PG8_SB(b, h) + boff + n * 2048 + k * 1024); } while (0)
#define PG8_MMA(ai, bj, At, Bt) do { __builtin_amdgcn_s_setprio(1); _Pragma("unroll") for (int m = 0; m < 4; ++m) _Pragma("unroll") for (int n = 0; n < 2; ++n) { \
        if constexpr (FP8) acc[ai][bj][m][n] = __builtin_amdgcn_mfma_scale_f32_16x16x128_f8f6f4(cat8(Bt[n][0], Bt[n][1]), cat8(At[m][0], At[m][1]), acc[ai][bj][m][n], 0, 0, 0, 0, 0, 0); \
        else { _Pragma("unroll") for (int k = 0; k < 2; ++k) acc[ai][bj][m][n] = __builtin_amdgcn_mfma_f32_16x16x32_bf16(Bt[n][k], At[m][k], acc[ai][bj][m][n], 0, 0, 0); } } __builtin_amdgcn_s_setprio(0); } while (0)
#define PG8_WAIT_V(n) asm volatile("s_waitcnt vmcnt(" #n ")" ::: "memory")
#define PG8_WAIT_L(n) asm volatile("s_waitcnt lgkmcnt(" #n ")" ::: "memory")
#define PG8_BAR __builtin_amdgcn_s_barrier()
#define PG8_SCHED __builtin_amdgcn_sched_barrier(0)
    Unit cur, nxt; int ui = 0;
    if (!S.next(0, cur)) return;
    f32x4 acc[2][2][4][2];
#pragma unroll
    for (int a = 0; a < 2; ++a)
#pragma unroll
        for (int b = 0; b < 2; ++b)
#pragma unroll
            for (int m = 0; m < 4; ++m)
#pragma unroll
                for (int n = 0; n < 2; ++n) acc[a][b][m][n] = (f32x4){0.f, 0.f, 0.f, 0.f};
    bf16x8 At[4][2], B0[2][2], B1[2][2];
    const char* cA = S.a_base(g, cur, tstepA); const char* cB = S.b_base(g, cur, tstepB);
    S.a_post(cur, S.a_pre(cur, tid), tid);
    if constexpr (SP2) {
        PG8_STAGE(PG8_SB(0, 0), cB, voffB); PG8_STAGE(PG8_SB(0, 1), cB + hstepB, voffB); PG8_STAGE(PG8_SA(0, 0), cA, voffA); PG8_STAGE(PG8_SA(0, 1), cA + hstepA, voffA);
        if (wr == 1) PG8_BAR;
        PG8_WAIT_V(2); PG8_BAR;
        PG8_STAGE(PG8_SB(1, 0), cB + kstepB, voffB); PG8_STAGE(PG8_SA(1, 0), cA + kstepA, voffA); PG8_STAGE(PG8_SB(1, 1), cB + hstepB + kstepB, voffB);
        PG8_WAIT_V(6); PG8_BAR;
    } else {
        PG8_STAGE(PG8_SB(0, 0), cB, voffB); PG8_STAGE(PG8_SA(0, 0), cA, voffA); PG8_STAGE(PG8_SB(0, 1), cB + hstepB, voffB); PG8_STAGE(PG8_SA(0, 1), cA + hstepA, voffA);
        if (wr == 1) PG8_BAR;
        PG8_WAIT_V(4); PG8_BAR;
        PG8_STAGE(PG8_SB(1, 0), cB + kstepB, voffB); PG8_STAGE(PG8_SA(1, 0), cA + kstepA, voffA); PG8_STAGE(PG8_SB(1, 1), cB + hstepB + kstepB, voffB);
        PG8_WAIT_V(6); PG8_BAR;
    }
    for (;;) {
        const bool has_next = S.next(ui + 1, nxt);
        const char* nA = has_next ? S.a_base(g, nxt, tstepA) : cA; const char* nB = has_next ? S.b_base(g, nxt, tstepB) : cB;
        for (int t = 0; t < nt; t += 2) {
            if constexpr (Epi::MIDK) { if (t == (nt >> 1)) E.midk(acc, cur, wr, fr); }
            const bool last = (t == nt - 2);
            const char* a1 = cA + (size_t)(t + 1) * kstepA;
            const char* a2 = last ? nA : cA + (size_t)(t + 2) * kstepA; const char* b2 = last ? nB : cB + (size_t)(t + 2) * kstepB;
            const char* a3 = a2 + kstepA; const char* b3 = b2 + kstepB;
            if constexpr (SP2) {
            PG8_LDB(B0, 0, 0); PG8_LDB(B1, 0, 1); PG8_SCHED; PG8_LDA(At, 0, 0); PG8_STAGE(PG8_SA(1, 1), a1 + hstepA, voffA);
            PG8_WAIT_V(8); PG8_WAIT_L(0); PG8_BAR; PG8_MMA(0, 0, At, B0); PG8_MMA(0, 1, At, B1); PG8_BAR; PG8_SCHED;
            PG8_LDA(At, 0, 1); PG8_STAGE(PG8_SB(0, 0), b2, voffB); PG8_STAGE(PG8_SB(0, 1), b2 + hstepB, voffB); PG8_STAGE(PG8_SA(0, 0), a2, voffA);
            PG8_WAIT_V(8); PG8_WAIT_L(0); PG8_BAR; PG8_MMA(1, 0, At, B0); PG8_MMA(1, 1, At, B1); PG8_BAR; PG8_SCHED;
            PG8_LDB(B0, 1, 0); PG8_LDB(B1, 1, 1); PG8_SCHED; PG8_LDA(At, 1, 0); PG8_STAGE(PG8_SA(0, 1), a2 + hstepA, voffA);
            PG8_WAIT_V(8); PG8_WAIT_L(0); PG8_BAR; PG8_MMA(0, 0, At, B0); PG8_MMA(0, 1, At, B1); PG8_BAR; PG8_SCHED;
            PG8_LDA(At, 1, 1); PG8_STAGE(PG8_SB(1, 0), b3, voffB); PG8_STAGE(PG8_SB(1, 1), b3 + hstepB, voffB); PG8_STAGE(PG8_SA(1, 0), a3, voffA);
            PG8_WAIT_V(8); PG8_WAIT_L(0); PG8_BAR; PG8_MMA(1, 0, At, B0); PG8_MMA(1, 1, At, B1); PG8_BAR; PG8_SCHED;
            } else {
            PG8_LDB(B0, 0, 0); PG8_SCHED; PG8_LDA(At, 0, 0); PG8_STAGE(PG8_SA(1, 1), a1 + hstepA, voffA);
            PG8_WAIT_L(8); PG8_BAR; PG8_WAIT_L(0); PG8_MMA(0, 0, At, B0); PG8_BAR; PG8_SCHED;
            PG8_LDB(B1, 0, 1); PG8_STAGE(PG8_SB(0, 0), b2, voffB);
            PG8_BAR; PG8_WAIT_L(0); PG8_MMA(0, 1, At, B1); PG8_BAR;
            PG8_LDA(At, 0, 1); PG8_STAGE(PG8_SA(0, 0), a2, voffA);
            PG8_BAR; PG8_WAIT_L(0); PG8_MMA(1, 0, At, B0); PG8_BAR; PG8_SCHED;
            PG8_STAGE(PG8_SB(0, 1), b2 + hstepB, voffB);
            PG8_WAIT_V(6); PG8_BAR; PG8_MMA(1, 1, At, B1); PG8_BAR;
            PG8_LDB(B0, 1, 0); PG8_SCHED; PG8_LDA(At, 1, 0); PG8_STAGE(PG8_SA(0, 1), a2 + hstepA, voffA);
            PG8_WAIT_L(8); PG8_BAR; PG8_WAIT_L(0); PG8_MMA(0, 0, At, B0); PG8_BAR; PG8_SCHED;
            PG8_LDB(B1, 1, 1); PG8_STAGE(PG8_SB(1, 0), b3, voffB);
            PG8_BAR; PG8_WAIT_L(0); PG8_MMA(0, 1, At, B1); PG8_BAR;
            PG8_LDA(At, 1, 1); PG8_STAGE(PG8_SA(1, 0), a3, voffA);
            PG8_BAR; PG8_WAIT_L(0); PG8_MMA(1, 0, At, B0); PG8_BAR; PG8_SCHED;
            PG8_STAGE(PG8_SB(1, 1), b3 + hstepB, voffB);
            PG8_WAIT_V(6); PG8_BAR; PG8_MMA(1, 1, At, B1); PG8_BAR;
            }
        }
        if constexpr (ALIGN_EPI) { if (wr == 0) PG8_BAR; }
        int tid2 = wv * 64 + lane_id(); asm volatile("" : "+v"(tid2)); const int fr2 = tid2 & 15, fq2 = (tid2 >> 4) & 3;
        const typename Sched::Pre pre = S.a_pre(has_next ? nxt : cur, tid2);
        if constexpr (!Epi::AFTER_DRAIN) { E(acc, cur, wr, wc, fr2, fq2); S.done(cur); }
        if (has_next) S.a_post(nxt, pre, tid2);
        if (!has_next) break;
#pragma unroll
        for (int a = 0; a < 2; ++a)
#pragma unroll
            for (int b = 0; b < 2; ++b)
#pragma unroll
                for (int m = 0; m < 4; ++m)
#pragma unroll
                    for (int n = 0; n < 2; ++n) acc[a][b][m][n] = (f32x4){0.f, 0.f, 0.f, 0.f};
        cur = nxt; cA = nA; cB = nB; ++ui;
        if constexpr (ALIGN_EPI) { if (wr == 1) PG8_BAR; }
    }
    PG8_WAIT_V(0);
    if constexpr (!ALIGN_EPI) { if (wr == 0) PG8_BAR; }
    PG8_BAR;
    if constexpr (Epi::AFTER_DRAIN) { E.fused(acc, cur, wr, wc, fr, fq, lds, wid, lane); S.done(cur); }
#undef PG8_SA
#undef PG8_SB
#undef PG8_STAGE
#undef qvoffA
#undef qvoffB
#undef PG8_LDA
#undef PG8_LDB
#undef PG8_MMA
#undef PG8_WAIT_V
#undef PG8_WAIT_L
#undef PG8_BAR
#undef PG8_SCHED
}
}
#define GAS __attribute__((address_space(1)))
#define LAS __attribute__((address_space(3)))
typedef unsigned short bf16;
typedef unsigned v4u __attribute__((ext_vector_type(4)));
typedef float f32x4 __attribute__((ext_vector_type(4)));
typedef short bf16x8 __attribute__((ext_vector_type(8)));
typedef GAS unsigned gu32;
typedef GAS unsigned long long gu64;
#define RLX_AGENT __ATOMIC_RELAXED, __HIP_MEMORY_SCOPE_AGENT
#define LDS_WAIT() asm volatile("s_waitcnt lgkmcnt(0)" ::: "memory")
#define VM_WAIT() asm volatile("s_waitcnt vmcnt(0)" ::: "memory")
__device__ __forceinline__ unsigned long long rt() { return __builtin_amdgcn_s_memrealtime(); }
__device__ __forceinline__ unsigned f2bf(float f) { unsigned u = __builtin_bit_cast(unsigned, f); return (u + 0x7fffu + ((u >> 16) & 1u)) >> 16; }
__device__ __forceinline__ unsigned pk2(float lo, float hi) { return pg8::cvt_pk_bf16(lo, hi); }

#define XB_TMO      128
#define XB_XCNT(j)  (256  + 64 * (j))
#define XB_XSUB(j)  (1280 + 64 * (j))
#define XB_XGEN(j)  (2304 + 64 * (j))
#define XB_TOP      3328
#define XB_TOPGEN   3392
#define XCD_BAR_WORDS 3456
#define XB_SPIN_CAP (1u << 18)

__device__ __forceinline__ unsigned xb_ld(unsigned* p)              { return __hip_atomic_load(p, __ATOMIC_RELAXED, __HIP_MEMORY_SCOPE_AGENT); }
__device__ __forceinline__ unsigned xb_add(unsigned* p, unsigned v) { return __hip_atomic_fetch_add(p, v, __ATOMIC_RELAXED, __HIP_MEMORY_SCOPE_AGENT); }
__device__ __forceinline__ unsigned xb_xcc_id() { return (unsigned)__builtin_amdgcn_s_getreg((3 << 11) | 20) & 0xFu; }
#define XB_SPIN(cond, bar) do { unsigned _sp = 0; while (cond) { __builtin_amdgcn_s_sleep(1); \
    if ((++_sp & 255u) == 0u) { if (xb_ld(&(bar)[XB_TMO])) break; if (_sp > XB_SPIN_CAP) { atomicAdd(&(bar)[XB_TMO], 1u); break; } } } } while (0)

struct XcdBarrier {
    unsigned* bar; unsigned x; bool lead;
    volatile LAS unsigned* st;
};

__device__ __forceinline__ XcdBarrier xcd_barrier_post(unsigned* bar, volatile LAS unsigned* st) {
    XcdBarrier b; b.bar = bar; b.x = xb_xcc_id(); b.st = st; b.lead = __builtin_amdgcn_readfirstlane((int)threadIdx.x) < 64;
    if (threadIdx.x == 0) (void)xb_add(&bar[XB_XCNT(b.x)], 1u);
    return b;
}
__device__ __forceinline__ void xcd_barrier_complete(unsigned* bar, unsigned x, unsigned& nloc, unsigned& nx) {
    const unsigned G = gridDim.x * gridDim.y * gridDim.z;
    unsigned sum, cnt, mine, sp = 0u;
    for (;;) {
        sum = 0u; cnt = 0u; mine = 0u;
#pragma unroll
        for (unsigned j = 0; j < 16; ++j) { const unsigned c = xb_ld(&bar[XB_XCNT(j)]); sum += c; cnt += (c > 0u) ? 1u : 0u; mine = (j == x) ? c : mine; }
        if (sum == G) break;
        __builtin_amdgcn_s_sleep(1);
        if ((++sp & 255u) == 0u) { if (xb_ld(&bar[XB_TMO])) break; if (sp > XB_SPIN_CAP) { atomicAdd(&bar[XB_TMO], 1u); break; } }
    }
    nloc = mine > 0u ? mine : 1u; nx = cnt > 0u ? cnt : 1u;
}

__device__ __forceinline__ void xcd_barrier(const XcdBarrier& b) {
    asm volatile("s_waitcnt vmcnt(0)" ::: "memory");
    __syncthreads();
    if (b.lead && pg8::lane_id() == 0) {
        unsigned* bar = b.bar;
        __builtin_amdgcn_s_waitcnt(0);
        unsigned nloc = b.st[0], nx = b.st[1];
        if (nloc == 0u) { xcd_barrier_complete(bar, b.x, nloc, nx); b.st[0] = nloc; b.st[1] = nx; }
        const unsigned old = xb_add(&bar[XB_XSUB(b.x)], 1u);
        const unsigned gen = old / nloc;
        if (old + 1u == (gen + 1u) * nloc) {
            __builtin_amdgcn_fence(__ATOMIC_RELEASE, "agent");
            asm volatile("s_waitcnt vmcnt(0)" ::: "memory");
            const unsigned og = xb_add(&bar[XB_TOP], 1u);
            const unsigned tg = og / nx;
            if (og + 1u == (tg + 1u) * nx) xb_add(&bar[XB_TOPGEN], 1u);
            else XB_SPIN(xb_ld(&bar[XB_TOPGEN]) == tg, bar);
            __builtin_amdgcn_fence(__ATOMIC_ACQUIRE, "agent");
            xb_add(&bar[XB_XGEN(b.x)], 1u);
            asm volatile("s_waitcnt vmcnt(0)" ::: "memory");
        } else {
            XB_SPIN(xb_ld(&bar[XB_XGEN(b.x)]) == gen, bar);
            __builtin_amdgcn_fence(__ATOMIC_ACQUIRE, "agent");
            asm volatile("s_waitcnt vmcnt(0)" ::: "memory");
        }
    }
    __syncthreads();
}

constexpr int NB = 16, SEQ = 4096, DM = 1024, MT = NB * SEQ;
constexpr int DINP = 1792;
constexpr int C_CQ = 0, C_CKV = 256, C_KR = 384, C_QN = 416, C_KVC = 928, C_KVS = 1184, C_KVW = 1440, C_GATE = 1696, DIN = 1720;
constexpr int DFF = 2816, NGU = 2 * DFF;
constexpr int NCMP = 255;
constexpr float EPS = 1e-6f;
constexpr float LOG2E = 1.4426950408889634f;
constexpr float C2Q = 0.10206207261596575f * 1.4426950408889634f;
constexpr float C2N = 0.125f * 1.4426950408889634f;

constexpr int NWAVES = 8, NTHR = 512;
constexpr int NPHASE = 8;
#ifndef MK_N_LAUNCHES
#define MK_N_LAUNCHES 1
#endif
constexpr int N_LAUNCHES = MK_N_LAUNCHES;

constexpr size_t MiB = 1u << 20;
constexpr size_t WS_CTL = 0, CTL_ZERO_BYTES = 1 * MiB;
constexpr size_t WS_WIN = 2 * MiB, WS_WUQ = 6 * MiB, WS_WUKV = 7 * MiB, WS_WOUT = 8 * MiB, WS_WGU = 10 * MiB, WS_WDN = 21 * MiB;
constexpr size_t WS_ROPE = 27 * MiB, WS_BIAS = 27 * MiB + 512 * 1024, WS_BIAS1 = WS_BIAS + 8192;
constexpr size_t WS_RSTDX = 28 * MiB, WS_SSQKV = 29 * MiB, WS_SSATT = 31 * MiB, WS_SSH = 35 * MiB;
constexpr size_t WS_KCMP = 39 * MiB, WS_VCMP = 40 * MiB, WS_KPE = 41 * MiB, WS_OVT = 45 * MiB, WS_W1C = 46 * MiB, WS_W2T = 47 * MiB;
constexpr size_t WS_XB = 64 * MiB, WS_U = 192 * MiB, WS_QM = 420 * MiB, WS_KVM = 516 * MiB, WS_ATT = 644 * MiB, WS_H = 772 * MiB, WS_END = 900 * MiB;
constexpr size_t WS_HID = 64 * MiB;
static_assert(WS_U + (size_t)MT * DINP * 2 <= WS_QM && WS_HID + (size_t)MT * DFF * 2 <= WS_QM && WS_QM + (size_t)MT * 768 * 2 <= WS_KVM && WS_KVM + (size_t)MT * 1024 * 2 <= WS_ATT, "ws map");
constexpr int CW_TMO = 0, CW_BAR = 4096;

constexpr int LDS_BYTES = 163840;
constexpr int MISC_OFF = LDS_BYTES - 256;


typedef unsigned u32x4 __attribute__((ext_vector_type(4))); using pg8::Unit; using pg8::cvt_pk_bf16; using pg8::HALF; using pg8::BM;
typedef float f32x2v __attribute__((ext_vector_type(2)));
typedef unsigned u32x2 __attribute__((ext_vector_type(2)));
__device__ __forceinline__ float bf2f(unsigned short b) { return __builtin_bit_cast(float, (unsigned)b << 16); }
__device__ __forceinline__ float bflo(unsigned w) { return __builtin_bit_cast(float, w << 16); }
__device__ __forceinline__ float bfhi(unsigned w) { return __builtin_bit_cast(float, w & 0xffff0000u); }
__device__ __forceinline__ float sq4(const f32x4 v) { return (v[0] * v[0] + v[1] * v[1]) + (v[2] * v[2] + v[3] * v[3]); }

struct EpiInProj {
    static constexpr bool PERM = true, AFTER_DRAIN = false, MIDK = false;
    pg8::bf16_t* U; const float* rstd; float* ssq;
    __device__ __forceinline__ void operator()(const f32x4 (&acc)[2][2][4][2], const Unit& u, int wr, int wc, int fr, int fq) const {
        const int row0 = u.pm * BM + wr * 64 + fr, col0 = u.pn * BM + wc * 32 + 8 * fq;
#pragma unroll
        for (int ai = 0; ai < 2; ++ai)
#pragma unroll
            for (int m = 0; m < 4; ++m) {
                const int row = row0 + ai * HALF + m * 16; const float r = rstd[row];
                pg8::bf16_t* rowp = U + (size_t)row * DINP + col0; float s0 = 0.f, s1 = 0.f;
#pragma unroll
                for (int bj = 0; bj < 2; ++bj) { const f32x4 v0 = acc[ai][bj][m][0] * r, v1 = acc[ai][bj][m][1] * r;
                    u32x4 w; w.x = cvt_pk_bf16(v0[0], v0[1]); w.y = cvt_pk_bf16(v0[2], v0[3]); w.z = cvt_pk_bf16(v1[0], v1[1]); w.w = cvt_pk_bf16(v1[2], v1[3]);
                    *(u32x4*)(rowp + bj * HALF) = w;
                    const float s = sq4(v0) + sq4(v1); if (bj == 0) s0 = s; else s1 = s; }
                if (u.pn < 2) {
                    float s = (u.pn == 0) ? (s0 + s1) : s0;
                    s += __shfl_xor(s, 16); s += __shfl_xor(s, 32);
                    if (fq == 0) ssq[(size_t)row * 8 + (u.pn == 0 ? 0 : 4) + wc] = s;
                }
            }
    }
};
struct EpiQup {
    static constexpr bool PERM = true, AFTER_DRAIN = false, MIDK = false;
    pg8::bf16_t* Q; const float* ssq; const f32x2v* rope;
    __device__ __forceinline__ void operator()(const f32x4 (&acc)[2][2][4][2], const Unit& u, int wr, int wc, int fr, int fq) const {
        const int row0 = u.pm * BM + wr * 64 + fr, col0 = u.pn * BM + wc * 32 + 8 * fq;
#pragma unroll
        for (int ai = 0; ai < 2; ++ai)
#pragma unroll
            for (int m = 0; m < 4; ++m) {
                const int row = row0 + ai * HALF + m * 16; const int pos = row & (SEQ - 1);
                const f32x4 pp = *(const f32x4*)(ssq + (size_t)row * 8);
                const float r = __builtin_amdgcn_rsqf(((pp[0] + pp[1]) + (pp[2] + pp[3])) * (1.0f / 256.0f) + EPS) * C2Q;
#pragma unroll
                for (int bj = 0; bj < 2; ++bj) { const int c = col0 + bj * HALF; const int d = c % 96;
                    f32x4 v0 = acc[ai][bj][m][0] * r, v1 = acc[ai][bj][m][1] * r;
                    if (d >= 64) { const int i0 = (d - 64) >> 1; const f32x2v* rp = rope + pos * 16 + i0;
                        const f32x2v a = rp[0], b = rp[1], e = rp[2], f = rp[3];
                        f32x4 w0, w1;
                        w0[0] = v0[0] * a.x - v0[1] * a.y; w0[1] = v0[0] * a.y + v0[1] * a.x;
                        w0[2] = v0[2] * b.x - v0[3] * b.y; w0[3] = v0[2] * b.y + v0[3] * b.x;
                        w1[0] = v1[0] * e.x - v1[1] * e.y; w1[1] = v1[0] * e.y + v1[1] * e.x;
                        w1[2] = v1[2] * f.x - v1[3] * f.y; w1[3] = v1[2] * f.y + v1[3] * f.x;
                        v0 = w0; v1 = w1; }
                    u32x4 w; w.x = cvt_pk_bf16(v0[0], v0[1]); w.y = cvt_pk_bf16(v0[2], v0[3]); w.z = cvt_pk_bf16(v1[0], v1[1]); w.w = cvt_pk_bf16(v1[2], v1[3]);
                    *(u32x4*)(Q + (size_t)row * 768 + c) = w; }
                asm volatile("" ::: "memory");
            }
    }
};
struct EpiKVup {
    static constexpr bool PERM = true, AFTER_DRAIN = false, MIDK = false;
    pg8::bf16_t* KV; const float* ssq;
    __device__ __forceinline__ void operator()(const f32x4 (&acc)[2][2][4][2], const Unit& u, int wr, int wc, int fr, int fq) const {
        const int row0 = u.pm * BM + wr * 64 + fr, col0 = u.pn * BM + wc * 32 + 8 * fq;
#pragma unroll
        for (int ai = 0; ai < 2; ++ai)
#pragma unroll
            for (int m = 0; m < 4; ++m) {
                const int row = row0 + ai * HALF + m * 16;
                const f32x4 pp = *(const f32x4*)(ssq + (size_t)row * 8 + 4);
                const float r = __builtin_amdgcn_rsqf(((pp[0] + pp[1]) + (pp[2] + pp[3])) * (1.0f / 128.0f) + EPS);
#pragma unroll
                for (int bj = 0; bj < 2; ++bj) { const f32x4 v0 = acc[ai][bj][m][0] * r, v1 = acc[ai][bj][m][1] * r;
                    u32x4 w; w.x = cvt_pk_bf16(v0[0], v0[1]); w.y = cvt_pk_bf16(v0[2], v0[3]); w.z = cvt_pk_bf16(v1[0], v1[1]); w.w = cvt_pk_bf16(v1[2], v1[3]);
                    *(u32x4*)(KV + (size_t)row * 1024 + col0 + bj * HALF) = w; }
                if (m & 1) asm volatile("" ::: "memory");
            }
    }
};
constexpr int OUT_TAB_OFF = 131072;
struct OutOrder : pg8::StaticOrder {
    const float* ssatt; LAS float* tab;
    struct Pre { f32x4 a, b; };
    __device__ __forceinline__ Pre a_pre(const Unit& u, int tid) const {
        const int row = tid >> 1, which = tid & 1;
        const f32x4* pp = (const f32x4*)(ssatt + (size_t)(u.pm * BM + row) * 16 + which * 8); return Pre{pp[0], pp[1]};
    }
    __device__ __forceinline__ void a_post(const Unit& u, const Pre& p, int tid) const {
        const int row = tid >> 1, which = tid & 1; const f32x4 a = p.a, b = p.b;
        const float r = __builtin_amdgcn_rsqf((((a[0] + a[1]) + (a[2] + a[3])) + ((b[0] + b[1]) + (b[2] + b[3]))) * (1.0f / 512.0f) + EPS);
        const float o = __shfl_xor(r, 1);
        if (which == 0) { LAS float* t = tab + (u.ui & 1) * 512 + row * 2; t[0] = r / o; t[1] = o; }
    }
};
struct EpiOut {
    static constexpr bool PERM = true, AFTER_DRAIN = false, MIDK = true;
    const pg8::bf16_t* xb; pg8::bf16_t* H; unsigned char* H8; float* ssh; const LAS float* tab;
    __device__ __forceinline__ void midk(f32x4 (&acc)[2][2][4][2], const Unit& u, int wr, int fr) const {
        const LAS float* t = tab + (u.ui & 1) * 512 + (wr * 64 + fr) * 2;
#pragma unroll
        for (int ai = 0; ai < 2; ++ai)
#pragma unroll
            for (int m = 0; m < 4; ++m) { const float ratio = t[(ai * HALF + m * 16) * 2];
#pragma unroll
                for (int bj = 0; bj < 2; ++bj) { acc[ai][bj][m][0] *= ratio; acc[ai][bj][m][1] *= ratio; } }
    }
    __device__ __forceinline__ void operator()(const f32x4 (&acc)[2][2][4][2], const Unit& u, int wr, int wc, int fr, int fq) const {
        const int row0 = u.pm * BM + wr * 64 + fr, col0 = u.pn * BM + wc * 32 + 8 * fq;
        const LAS float* t = tab + (u.ui & 1) * 512 + (wr * 64 + fr) * 2 + 1;
#pragma unroll
        for (int ai = 0; ai < 2; ++ai)
#pragma unroll
            for (int m = 0; m < 4; ++m) {
                const int row = row0 + ai * HALF + m * 16; const float r = t[(ai * HALF + m * 16) * 2];
                float s = 0.f;
#pragma unroll
                for (int bj = 0; bj < 2; ++bj) { const size_t off = (size_t)row * DM + col0 + bj * HALF;
                    const u32x4 xw = *(const u32x4*)(xb + off);
                    f32x4 x0, x1; x0[0] = bflo(xw.x); x0[1] = bfhi(xw.x); x0[2] = bflo(xw.y); x0[3] = bfhi(xw.y); x1[0] = bflo(xw.z); x1[1] = bfhi(xw.z); x1[2] = bflo(xw.w); x1[3] = bfhi(xw.w);
                    const f32x4 v0 = x0 + acc[ai][bj][m][0] * r, v1 = x1 + acc[ai][bj][m][1] * r;
                    u32x4 w; w.x = cvt_pk_bf16(v0[0], v0[1]); w.y = cvt_pk_bf16(v0[2], v0[3]); w.z = cvt_pk_bf16(v1[0], v1[1]); w.w = cvt_pk_bf16(v1[2], v1[3]);
                    *(u32x4*)(H + off) = w; s += sq4(v0) + sq4(v1);
                    u32x2 w8; w8.x = pg8::cvt_pk4_fp8(v0[0], v0[1], v0[2], v0[3]); w8.y = pg8::cvt_pk4_fp8(v1[0], v1[1], v1[2], v1[3]); *(u32x2*)(H8 + off) = w8; }
                s += __shfl_xor(s, 16); s += __shfl_xor(s, 32);
                if (fq == 0) ssh[(size_t)row * 16 + u.pn * 4 + wc] = s;
                if (m & 1) asm volatile("" ::: "memory");
            }
    }
};
struct GUOrder : pg8::StaticOrder {
    const float* ssh; LAS float* tab;
    struct Pre { f32x4 a, b; };
    __device__ __forceinline__ Pre a_pre(const Unit& u, int tid) const {
        const int row = tid >> 1, which = tid & 1;
        const f32x4* pp = (const f32x4*)(ssh + (size_t)(u.pm * BM + row) * 16 + which * 8); return Pre{pp[0], pp[1]};
    }
    __device__ __forceinline__ void a_post(const Unit& u, const Pre& p, int tid) const {
        const int row = tid >> 1, which = tid & 1; const f32x4 a = p.a, b = p.b;
        float s = ((a[0] + a[1]) + (a[2] + a[3])) + ((b[0] + b[1]) + (b[2] + b[3]));
        s += __shfl_xor(s, 1);
        if (which == 0) tab[(u.ui & 1) * 256 + row] = __builtin_amdgcn_rsqf(s * (1.0f / 1024.0f) + EPS) * (1.0f / 128.0f);
    }
};
struct EpiGU {
    static constexpr bool PERM = true, AFTER_DRAIN = false, MIDK = false;
    unsigned char* HID; const LAS float* tab;
    __device__ __forceinline__ void operator()(const f32x4 (&acc)[2][2][4][2], const Unit& u, int wr, int wc, int fr, int fq) const {
        const int row0 = u.pm * BM + wr * 64 + fr, col0 = u.pn * HALF + wc * 32 + 8 * fq;
        const LAS float* t = tab + (u.ui & 1) * 256 + wr * 64 + fr;
#pragma unroll
        for (int ai = 0; ai < 2; ++ai)
#pragma unroll
            for (int m = 0; m < 4; ++m) {
                const int row = row0 + ai * HALF + m * 16; const float r = t[ai * HALF + m * 16];
                float o[8];
#pragma unroll
                for (int n = 0; n < 2; ++n)
#pragma unroll
                    for (int e = 0; e < 4; ++e) { const float g = acc[ai][0][m][n][e] * r, up = acc[ai][1][m][n][e] * r;
                        const float sg = g * __builtin_amdgcn_rcpf(1.0f + __builtin_amdgcn_exp2f(-g * LOG2E)); o[n * 4 + e] = __builtin_amdgcn_fmed3f(sg * up, -448.0f, 448.0f); }
                u32x2 w; w.x = pg8::cvt_pk4_fp8(o[0], o[1], o[2], o[3]); w.y = pg8::cvt_pk4_fp8(o[4], o[5], o[6], o[7]);
                __builtin_nontemporal_store(w, (u32x2*)(HID + (size_t)row * DFF + col0));
            }
    }
};
struct EpiDown {
    static constexpr bool PERM = true, AFTER_DRAIN = false, MIDK = false;
    const pg8::bf16_t* H; pg8::bf16_t* H2; float* ss2;
    __device__ __forceinline__ void operator()(const f32x4 (&acc)[2][2][4][2], const Unit& u, int wr, int wc, int fr, int fq) const {
        const int row0 = u.pm * BM + wr * 64 + fr, col0 = u.pn * BM + wc * 32 + 8 * fq;
#pragma unroll
        for (int ai = 0; ai < 2; ++ai)
#pragma unroll
            for (int m = 0; m < 4; ++m) {
                const int row = row0 + ai * HALF + m * 16; float s = 0.f;
#pragma unroll
                for (int bj = 0; bj < 2; ++bj) { const size_t off = (size_t)row * DM + col0 + bj * HALF;
                    const u32x4 hw = *(const u32x4*)(H + off);
                    f32x4 h0, h1; h0[0] = bflo(hw.x); h0[1] = bfhi(hw.x); h0[2] = bflo(hw.y); h0[3] = bfhi(hw.y); h1[0] = bflo(hw.z); h1[1] = bfhi(hw.z); h1[2] = bflo(hw.w); h1[3] = bfhi(hw.w);
                    h0 += acc[ai][bj][m][0] * (1.0f / 128.0f); h1 += acc[ai][bj][m][1] * (1.0f / 128.0f);
                    u32x4 w; w.x = cvt_pk_bf16(h0[0], h0[1]); w.y = cvt_pk_bf16(h0[2], h0[3]); w.z = cvt_pk_bf16(h1[0], h1[1]); w.w = cvt_pk_bf16(h1[2], h1[3]);
                    *(u32x4*)(H2 + off) = w; s += sq4(h0) + sq4(h1); }
                s += __shfl_xor(s, 16); s += __shfl_xor(s, 32);
                if (fq == 0) ss2[(size_t)row * 16 + u.pn * 4 + wc] = s;
                if (m & 1) asm volatile("" ::: "memory");
            }
    }
};

struct Args { const float* in[22]; float* out; unsigned char* ws; int ph_lo, ph_hi, li, pad; };
enum { I_X = 0, I_GMIX, I_WIN, I_GQ, I_WUQ, I_GKV, I_WUKV, I_POSK, I_W1K, I_W2K, I_POSV, I_W1V, I_W2V, I_T5, I_GOM, I_GON, I_WOUT, I_GFFN, I_WG, I_WU, I_WD, I_GFIN };

__device__ __forceinline__ float wave_sum(float v) {
#pragma unroll
    for (int o = 1; o < 64; o <<= 1) v += __shfl_xor(v, o);
    return v;
}
typedef __bf16 bf16x2_t __attribute__((ext_vector_type(2)));
__device__ __forceinline__ float dot2(unsigned a, unsigned b, float c) { return __builtin_amdgcn_fdot2_f32_bf16(__builtin_bit_cast(bf16x2_t, a), __builtin_bit_cast(bf16x2_t, b), c, false); }

template <class F> __device__ __forceinline__ void tr_item(F f, bf16* WT, int ldk, int nblk, LAS float* scr, int item, int lane) {
    const int kb = item / nblk, nb = item % nblk, k0 = 64 * kb, n0 = 32 * nb;
#pragma unroll 8
    for (int i = 0; i < 32; ++i) { const int kk = 2 * i + (lane >> 5); scr[kk * 33 + (lane & 31)] = f(k0 + kk, n0 + (lane & 31)); }
    LDS_WAIT(); asm volatile("" ::: "memory");
    const int c = lane & 7;
#pragma unroll
    for (int j = 0; j < 4; ++j) { const int n = (lane >> 3) + 8 * j; const LAS float* s = scr + (8 * c) * 33 + n;
        v4u o; o.x = pk2(s[0 * 33], s[1 * 33]); o.y = pk2(s[2 * 33], s[3 * 33]); o.z = pk2(s[4 * 33], s[5 * 33]); o.w = pk2(s[6 * 33], s[7 * 33]);
        *(GAS v4u*)(WT + (size_t)(n0 + n) * ldk + k0 + 8 * c) = o; }
    LDS_WAIT(); asm volatile("" ::: "memory");
}
template <class F> __device__ __forceinline__ void tr_item8(F f, unsigned char* WT, int ldk, int nblk, LAS float* scr, int item, int lane) {
    const int kb = item / nblk, nb = item % nblk, k0 = 64 * kb, n0 = 32 * nb;
#pragma unroll 8
    for (int i = 0; i < 32; ++i) { const int kk = 2 * i + (lane >> 5); scr[kk * 33 + (lane & 31)] = f(k0 + kk, n0 + (lane & 31)); }
    LDS_WAIT(); asm volatile("" ::: "memory");
    const int c = lane & 7;
#pragma unroll
    for (int j = 0; j < 4; ++j) { const int n = (lane >> 3) + 8 * j; const LAS float* s = scr + (8 * c) * 33 + n;
        u32x2 o; o.x = pg8::cvt_pk4_fp8(s[0 * 33], s[1 * 33], s[2 * 33], s[3 * 33]); o.y = pg8::cvt_pk4_fp8(s[4 * 33], s[5 * 33], s[6 * 33], s[7 * 33]);
        *(GAS u32x2*)(WT + (size_t)(n0 + n) * ldk + k0 + 8 * c) = o; }
    LDS_WAIT(); asm volatile("" ::: "memory");
}
__device__ __forceinline__ int t5_bucket(int n) {
    if (n < 16) return n;
    int b = 16; b += n >= 19; b += n >= 21; b += n >= 24; b += n >= 27; b += n >= 31; b += n >= 35; b += n >= 40; b += n >= 46; b += n >= 52; b += n >= 59; b += n >= 67; b += n >= 77; b += n >= 87; b += n >= 99; b += n >= 113;
    return b;
}
__device__ __forceinline__ float gelu_tanh(float x) {
    const float y = 0.7978845608028654f * (x + 0.044715f * x * x * x);
    const float e = __builtin_amdgcn_exp2f(2.0f * LOG2E * y);
    const float th = 1.0f - 2.0f * __builtin_amdgcn_rcpf(e + 1.0f);
    return 0.5f * x * (1.0f + th);
}

struct Ptrs {
    const float* in[22]; float* out; unsigned char* ws;
    bf16 *Win, *Wuq, *Wukv, *Wout, *Wgu, *Wdn; f32x2v* rope; float *bias, *bias1, *rstdx, *ssqkv, *ssatt, *ssh;
    bf16 *kcmp, *vcmp, *kpe, *ovt, *W1c, *W2t, *XB, *U, *QM, *KVM, *ATT, *H, *HID;
};

__device__ __forceinline__ void p0_prologue(const Ptrs& P, LAS unsigned char* lds, int wg, int G, int wave, int lane, int tid) {
    LAS float* scr = (LAS float*)(lds + wave * 16384);
    const int gw = wg * NWAVES + wave, NGW = G * NWAVES;
    constexpr int I_IN = (1024 / 64) * (DINP / 32), I_UQ = (256 / 64) * (768 / 32), I_UKV = (256 / 64) * (1024 / 32), I_OUT = (1024 / 64) * (1024 / 32), I_GU = (1024 / 64) * (NGU / 32), I_DN = (DFF / 64) * (1024 / 32);
    constexpr int I_W1C = 2 * (1024 / 64) * (256 / 32), I_W2T = 2 * (128 / 64) * (64 / 32);
    constexpr int NITEMS = I_IN + I_UQ + I_UKV + I_OUT + I_GU + I_DN + I_W1C + I_W2T;
    for (int it = gw; it < NITEMS; it += NGW) {
        int r = it;
        if (r < I_IN) { const float* W = P.in[I_WIN]; const float* g = P.in[I_GMIX];
            tr_item([=](int k, int n) -> float { if (n >= DIN) return 0.f; const float s = (n >= C_QN && n < C_KVC) ? C2N : 1.0f; return W[(size_t)k * DIN + n] * g[k] * s; }, P.Win, 1024, DINP / 32, scr, r, lane); continue; } r -= I_IN;
        if (r < I_UQ) { const float* W = P.in[I_WUQ]; const float* g = P.in[I_GQ];
            tr_item([=](int k, int n) -> float { const int h = n / 96, d = n % 96; int src = n; if (d >= 64) { const int e = d - 64; src = h * 96 + 64 + (e & 1) * 16 + (e >> 1); } return W[(size_t)k * 768 + src] * g[k]; }, P.Wuq, 256, 768 / 32, scr, r, lane); continue; } r -= I_UQ;
        if (r < I_UKV) { const float* W = P.in[I_WUKV]; const float* g = P.in[I_GKV];
            tr_item([=](int k, int n) -> float { return k < 128 ? W[(size_t)k * 1024 + n] * g[k] : 0.f; }, P.Wukv, 256, 1024 / 32, scr, r, lane); continue; } r -= I_UKV;
        if (r < I_OUT) { const float* W = P.in[I_WOUT]; const float* g1 = P.in[I_GOM]; const float* g2 = P.in[I_GON];
            tr_item([=](int k, int n) -> float { return W[(size_t)k * 1024 + n] * (k < 512 ? g1[k] : g2[k - 512]); }, P.Wout, 1024, 1024 / 32, scr, r, lane); continue; } r -= I_OUT;
        if (r < I_GU) { const float* g = P.in[I_GFFN]; const bool up = ((r % (NGU / 32)) & 4) != 0;
            if (!up) { const float* W = P.in[I_WG]; tr_item8([=](int k, int n) -> float { return W[(size_t)k * DFF + (n >> 8) * 128 + (n & 127)] * (g[k] * 128.0f); }, (unsigned char*)P.Wgu, 1024, NGU / 32, scr, r, lane); }
            else { const float* W = P.in[I_WU]; tr_item8([=](int k, int n) -> float { return W[(size_t)k * DFF + (n >> 8) * 128 + (n & 127)] * (g[k] * 128.0f); }, (unsigned char*)P.Wgu, 1024, NGU / 32, scr, r, lane); }
            continue; } r -= I_GU;
        if (r < I_DN) { const float* W = P.in[I_WD];
            tr_item8([=](int k, int n) -> float { return W[(size_t)k * 1024 + n] * 128.0f; }, (unsigned char*)P.Wdn, DFF, 1024 / 32, scr, r, lane); continue; } r -= I_DN;
        if (r < I_W1C) { const int kv = r >= I_W1C / 2; if (kv) r -= I_W1C / 2;
            if (!kv) { const float* W = P.in[I_W1K]; tr_item([=](int k, int n) -> float { return W[(size_t)(k + ((n >> 7) << 10)) * 128 + (n & 127)]; }, P.W1c, 1024, 256 / 32, scr, r, lane); }
            else { const float* W = P.in[I_W1V]; tr_item([=](int k, int n) -> float { return W[(size_t)(k + ((n >> 7) << 10)) * 128 + (n & 127)]; }, P.W1c + 256 * 1024, 1024, 256 / 32, scr, r, lane); }
            continue; } r -= I_W1C;
        { const int kv = r >= I_W2T / 2; if (kv) r -= I_W2T / 2;
            if (!kv) { const float* W = P.in[I_W2K]; tr_item([=](int k, int n) -> float { return W[(size_t)k * 64 + n]; }, P.W2t, 128, 64 / 32, scr, r, lane); }
            else { const float* W = P.in[I_W2V]; tr_item([=](int k, int n) -> float { return W[(size_t)k * 64 + n]; }, P.W2t + 64 * 128, 128, 64 / 32, scr, r, lane); } }
    }
    const int gt = wg * NTHR + tid, NGT = G * NTHR;
    for (int e = gt; e < SEQ * 16; e += NGT) { const int pos = e >> 4, i = e & 15;
        const float inv = __builtin_amdgcn_exp2f(-(float)i * (13.287712379549449f / 16.0f));
        const float ang = (float)pos * inv;
        double rev = (double)ang * 0.15915494309189535; rev -= __builtin_floor(rev);
        const float fr = (float)rev;
        P.rope[e] = (f32x2v){__builtin_amdgcn_cosf(fr), __builtin_amdgcn_sinf(fr)}; }
    for (int e = gt; e < 8 * 128; e += NGT) { const int h = e >> 7, d = e & 127; P.bias[e] = P.in[I_T5][t5_bucket(d) * 8 + h] * LOG2E; }
    for (int e = gt; e < 256 * 64; e += NGT) { const int i = e >> 6, j = e & 63; float w = 0.f; if (j == (i >> 2)) w += ((i & 3) == 3) ? 1.f : 2.f; if ((i & 3) == 3 && j == (i >> 2) + 1) w += 1.f;
        P.ovt[e] = (bf16)(__float_as_uint(w) >> 16); }
    for (int o = gw; o < 256; o += NGW) { const int kv = o >> 7, j = o & 127; const float* pos = P.in[kv ? I_POSV : I_POSK]; const float* w1 = P.in[kv ? I_W1V : I_W1K];
        float s = 0.f; for (int k = lane; k < 2048; k += 64) s += pos[k] * w1[(size_t)k * 128 + j];
        s = wave_sum(s); if (lane == 0) P.bias1[o] = s; }
    for (int m0 = gw * 4; m0 < MT; m0 += NGW * 4) {
        f32x4 v[4][4];
#pragma unroll
        for (int q = 0; q < 4; ++q) { const GAS f32x4* xr = (const GAS f32x4*)(P.in[I_X] + (size_t)(m0 + q) * DM) + lane;
#pragma unroll
            for (int j = 0; j < 4; ++j) v[q][j] = __builtin_nontemporal_load(xr + 64 * j); }
#pragma unroll
        for (int q = 0; q < 4; ++q) { float s = 0.f;
#pragma unroll
            for (int j = 0; j < 4; ++j) s += sq4(v[q][j]);
            s = wave_sum(s);
            if (lane == 0) P.rstdx[m0 + q] = __builtin_amdgcn_rsqf(s * (1.0f / DM) + EPS);
            GAS unsigned long long* o8 = (GAS unsigned long long*)(P.XB + (size_t)(m0 + q) * DM) + lane;
#pragma unroll
            for (int j = 0; j < 4; ++j) o8[64 * j] = (unsigned long long)pk2(v[q][j][0], v[q][j][1]) | ((unsigned long long)pk2(v[q][j][2], v[q][j][3]) << 32); }
    }
}

__device__ __forceinline__ void p2_kpe(const Ptrs& P, int wg, int G, int tid) {
    const int gt = wg * NTHR + tid, NGT = G * NTHR;
    for (int e = gt; e < MT * 16; e += NGT) { const int row = e >> 4, i = e & 15; const int pos = row & (SEQ - 1);
        const float x1 = bf2f(P.U[(size_t)row * DINP + C_KR + i]), x2 = bf2f(P.U[(size_t)row * DINP + C_KR + 16 + i]);
        const f32x2v cs = P.rope[pos * 16 + i];
        *(unsigned*)(P.kpe + (size_t)row * 32 + 2 * i) = pk2(x1 * cs.x - x2 * cs.y, x1 * cs.y + x2 * cs.x); }
}
__device__ __forceinline__ void p7_final(const Ptrs& P, int wg, int G, int wave, int lane) {
    const int gw = wg * NWAVES + wave, NGW = G * NWAVES;
    const GAS f32x4* gp = (const GAS f32x4*)P.in[I_GFIN] + 2 * lane; f32x4 gg[4][2];
#pragma unroll
    for (int j = 0; j < 2; ++j) { gg[j][0] = gp[128 * j]; gg[j][1] = gp[128 * j + 1]; }
    for (int m0 = gw * 4; m0 < MT; m0 += NGW * 4) {
        u32x4 w0[4], w1[4]; float pv[4];
#pragma unroll
        for (int q = 0; q < 4; ++q) { const GAS u32x4* hr = (const GAS u32x4*)(P.ATT + (size_t)(m0 + q) * DM) + lane;
            w0[q] = hr[0]; w1[q] = hr[64]; pv[q] = (lane < 16) ? P.ssatt[(size_t)(m0 + q) * 16 + lane] : 0.f; }
#pragma unroll
        for (int q = 0; q < 4; ++q) {
            const float r = __builtin_amdgcn_rsqf(wave_sum(pv[q]) * (1.0f / DM) + EPS);
            GAS f32x4* o = (GAS f32x4*)(P.out + (size_t)(m0 + q) * DM) + 2 * lane;
            { const u32x4 w = w0[q]; f32x4 a, b; a[0] = bflo(w.x); a[1] = bfhi(w.x); a[2] = bflo(w.y); a[3] = bfhi(w.y); b[0] = bflo(w.z); b[1] = bfhi(w.z); b[2] = bflo(w.w); b[3] = bfhi(w.w);
              o[0] = a * r * gg[0][0]; o[1] = b * r * gg[0][1]; }
            { const u32x4 w = w1[q]; f32x4 a, b; a[0] = bflo(w.x); a[1] = bfhi(w.x); a[2] = bflo(w.y); a[3] = bfhi(w.y); b[0] = bflo(w.z); b[1] = bfhi(w.z); b[2] = bflo(w.w); b[3] = bfhi(w.w);
              o[128] = a * r * gg[1][0]; o[129] = b * r * gg[1][1]; } }
    }
}

struct CmpOrder {
    int G, c; const bf16* U; const bf16* W1c;
    __device__ __forceinline__ bool next(int i, Unit& u) const { const int un = c + i * G; if (un >= 64) return false; u.pm = un; u.pn = 0; u.ui = i; return true; }
    struct Pre {};
    __device__ __forceinline__ Pre a_pre(const Unit&, int) const { return Pre{}; }
    __device__ __forceinline__ void a_post(const Unit&, const Pre&, int) const {}
    __device__ __forceinline__ void done(const Unit&) const {}
    __device__ __forceinline__ const char* a_base(const pg8::Gemm&, const Unit& u, size_t) const { const int bh = u.pm >> 1, kv = u.pm & 1;
        return (const char*)(U + (size_t)(bh >> 1) * SEQ * DINP + C_KVC + kv * 128 + (bh & 1) * 64); }
    __device__ __forceinline__ const char* b_base(const pg8::Gemm&, const Unit& u, size_t) const { return (const char*)(W1c + (size_t)(u.pm & 1) * 256 * 1024); }
};
struct EpiCmp {
    static constexpr bool PERM = true, AFTER_DRAIN = true, MIDK = false;
    const float* bias1; const bf16* W2t; bf16* kcmp; bf16* vcmp;
    __device__ __forceinline__ void operator()(const f32x4 (&)[2][2][4][2], const Unit&, int, int, int, int) const {}
    __device__ __forceinline__ void fused(f32x4 (&acc)[2][2][4][2], const Unit& u, int wr, int wc, int fr, int fq, LAS unsigned char* lds, int wid, int lane) const {
        typedef short bf16x8_t __attribute__((ext_vector_type(8))); typedef float f32x16_t __attribute__((ext_vector_type(16)));
        const int bh = u.pm >> 1, kv = u.pm & 1; const int col = wc * 32 + 8 * fq;
        LAS float* OB = (LAS float*)lds;
#pragma unroll
        for (int ai = 0; ai < 2; ++ai)
#pragma unroll
            for (int m = 0; m < 4; ++m) { const int r = ai * HALF + wr * 64 + m * 16 + fr;
                *(LAS f32x4*)(OB + r * 132 + col) = acc[ai][1][m][0]; *(LAS f32x4*)(OB + r * 132 + col + 4) = acc[ai][1][m][1]; }
        const f32x4 bs0 = *(const f32x4*)(bias1 + kv * 128 + col), bs1 = *(const f32x4*)(bias1 + kv * 128 + col + 4);
        asm volatile("s_waitcnt lgkmcnt(0)" ::: "memory"); __builtin_amdgcn_s_barrier(); asm volatile("" ::: "memory");
#pragma unroll
        for (int ai = 0; ai < 2; ++ai)
#pragma unroll
            for (int m = 0; m < 4; ++m) { const int r = ai * HALF + wr * 64 + m * 16 + fr, r1 = r < 255 ? r + 1 : 255;
                const f32x4 b0 = *(const LAS f32x4*)(OB + r1 * 132 + col), b1 = *(const LAS f32x4*)(OB + r1 * 132 + col + 4);
                f32x4 h0 = acc[ai][0][m][0] + b0 + bs0, h1 = acc[ai][0][m][1] + b1 + bs1;
#pragma unroll
                for (int e = 0; e < 4; ++e) { h0[e] = gelu_tanh(h0[e]); h1[e] = gelu_tanh(h1[e]); }
                acc[ai][0][m][0] = h0; acc[ai][0][m][1] = h1; }
        asm volatile("s_waitcnt lgkmcnt(0)" ::: "memory"); __builtin_amdgcn_s_barrier(); asm volatile("" ::: "memory");
        LAS bf16* GB = (LAS bf16*)lds;
#pragma unroll
        for (int ai = 0; ai < 2; ++ai)
#pragma unroll
            for (int m = 0; m < 4; ++m) { const int r = ai * HALF + wr * 64 + m * 16 + fr; const f32x4 h0 = acc[ai][0][m][0], h1 = acc[ai][0][m][1];
                u32x4 w; w.x = pk2(h0[0], h0[1]); w.y = pk2(h0[2], h0[3]); w.z = pk2(h1[0], h1[1]); w.w = pk2(h1[2], h1[3]);
                *(LAS u32x4*)(GB + r * 136 + col) = w; }
        asm volatile("s_waitcnt lgkmcnt(0)" ::: "memory"); __builtin_amdgcn_s_barrier(); asm volatile("" ::: "memory");
        const int r32 = lane & 31, hi = lane >> 5, c = wid * 32 + r32;
        f32x16_t o[2]; o[0] = f32x16_t{}; o[1] = f32x16_t{};
        const bf16* w2 = W2t + (size_t)kv * 64 * 128;
#pragma unroll
        for (int s = 0; s < 8; ++s) { const bf16x8_t gb = *(const LAS bf16x8_t*)(GB + c * 136 + 16 * s + 8 * hi);
#pragma unroll
            for (int dt = 0; dt < 2; ++dt) { const bf16x8_t wa = *(const bf16x8_t*)(w2 + (size_t)(32 * dt + r32) * 128 + 16 * s + 8 * hi);
                o[dt] = __builtin_amdgcn_mfma_f32_32x32x16_bf16(wa, gb, o[dt], 0, 0, 0); } }
        if (c < NCMP) { bf16* op = (kv ? vcmp : kcmp) + ((size_t)bh * 256 + c) * 64 + 4 * hi;
#pragma unroll
            for (int dt = 0; dt < 2; ++dt)
#pragma unroll
                for (int k = 0; k < 4; ++k) *(unsigned long long*)(op + 32 * dt + 8 * k) = (unsigned long long)pk2(o[dt][4 * k], o[dt][4 * k + 1]) | ((unsigned long long)pk2(o[dt][4 * k + 2], o[dt][4 * k + 3]) << 32); }
        asm volatile("s_waitcnt lgkmcnt(0)" ::: "memory"); __builtin_amdgcn_s_barrier();
    }
};

namespace att {
typedef short bf16x8 __attribute__((ext_vector_type(8)));
typedef short s16x4 __attribute__((ext_vector_type(4)));
typedef float f32x16 __attribute__((ext_vector_type(16)));
typedef __attribute__((address_space(3))) const char* lds_cptr;
constexpr float THR = 8.0f;
constexpr float NEG_INF = -__builtin_inff();
__device__ __forceinline__ int crow(int r, int hi) { return (r & 3) + 8 * (r >> 2) + 4 * hi; }
__device__ __forceinline__ float swap_max(float x) { auto rr = __builtin_amdgcn_permlane32_swap(__float_as_uint(x), __float_as_uint(x), false, false); return fmaxf(__uint_as_float(rr[0]), __uint_as_float(rr[1])); }
__device__ __forceinline__ float swap_sum(float x) { auto rr = __builtin_amdgcn_permlane32_swap(__float_as_uint(x), __float_as_uint(x), false, false); return __uint_as_float(rr[0]) + __uint_as_float(rr[1]); }
__device__ __forceinline__ float partner32(float x, int hi) { auto rr = __builtin_amdgcn_permlane32_swap(__float_as_uint(x), __float_as_uint(x), false, false); return __uint_as_float(hi ? rr[0] : rr[1]); }
__device__ __forceinline__ unsigned partner32u(unsigned x, int hi) { auto rr = __builtin_amdgcn_permlane32_swap(x, x, false, false); return hi ? rr[0] : rr[1]; }
__device__ __forceinline__ void dma16(const void* g, LAS unsigned char* l) { unsigned keep; const unsigned dst = (unsigned)__builtin_amdgcn_readfirstlane((int)(unsigned)(uintptr_t)l);
    asm volatile("s_mov_b32 %0, m0\n\ts_mov_b32 m0, %2\n\ts_nop 0\n\tglobal_load_lds_dwordx4 %1, off\n\ts_mov_b32 m0, %0" : "=&s"(keep) : "v"(g), "s"(dst) : "memory"); }
template <int N> __device__ __forceinline__ void wait_bar() { if (N == 3) asm volatile("s_waitcnt vmcnt(3) lgkmcnt(0)\n\ts_barrier" ::: "memory"); else if (N == 2) asm volatile("s_waitcnt vmcnt(2) lgkmcnt(0)\n\ts_barrier" ::: "memory"); else asm volatile("s_waitcnt vmcnt(0) lgkmcnt(0)\n\ts_barrier" ::: "memory"); }

struct SrcMLA {
    static constexpr int DK = 96, NDMA = 3, NV = 1;
    const bf16* kn; const bf16* kp; const bf16* v;
    __device__ __forceinline__ void init(const bf16* KVM, const bf16* KPE, size_t rowb, int h, int wid, int lane) {
        kn = KVM + (rowb + lane) * 1024 + h * 128 + 8 * wid;
        kp = KPE + (rowb + lane) * 32 + 8 * (wid & 3);
        v = KVM + (rowb + 16 * (wid & 3) + (lane >> 2)) * 1024 + h * 128 + 64 + (wid >> 2) * 32 + (lane & 3) * 8; }
    static constexpr int NKD = 2;
    __device__ __forceinline__ void issueK(int tile, LAS unsigned char* ks, int wid) const {
        dma16(kn + (size_t)tile * 64 * 1024, ks + wid * 1024);
        dma16(kp + (size_t)tile * 64 * 32, ks + (8 + (wid & 3)) * 1024); }
    __device__ __forceinline__ void issueV(int tile, LAS unsigned char* vs, int wid) const { dma16(v + (size_t)tile * 64 * 1024, vs + wid * 1024); }
    __device__ __forceinline__ void issue(int tile, LAS unsigned char* ks, LAS unsigned char* vs, int wid) const { issueK(tile, ks, wid); issueV(tile, vs, wid); }
};
struct SrcRows {
    static constexpr int DK = 64, NDMA = 2, NV = 1;
    const bf16* k; const bf16* v; size_t pitch;
    __device__ __forceinline__ void init(const bf16* K0, const bf16* V0, size_t pitch_, int wid, int lane) {
        pitch = pitch_; k = K0 + (size_t)lane * pitch + 8 * wid; v = V0 + (size_t)(16 * (wid & 3) + (lane >> 2)) * pitch + (wid >> 2) * 32 + (lane & 3) * 8; }
    static constexpr int NKD = 1;
    __device__ __forceinline__ void issueK(int tile, LAS unsigned char* ks, int wid) const { dma16(k + (size_t)tile * 64 * pitch, ks + wid * 1024); }
    __device__ __forceinline__ void issueV(int tile, LAS unsigned char* vs, int wid) const { dma16(v + (size_t)tile * 64 * pitch, vs + wid * 1024); }
    __device__ __forceinline__ void issue(int tile, LAS unsigned char* ks, LAS unsigned char* vs, int wid) const { issueK(tile, ks, wid); issueV(tile, vs, wid); }
};

struct SrcCmp {
    static constexpr int DK = 64, NDMA = 3, NV = 2;
    const bf16* k; const bf16* v; const bf16* ov;
    __device__ __forceinline__ void init(const bf16* K0, const bf16* V0, const bf16* OV, int wid, int lane) {
        k = K0 + (size_t)lane * 64 + 8 * wid; const size_t vo = (size_t)(16 * (wid & 3) + (lane >> 2)) * 64 + (wid >> 2) * 32 + (lane & 3) * 8; v = V0 + vo; ov = OV + vo; }
    __device__ __forceinline__ void issue(int tile, LAS unsigned char* ks, LAS unsigned char* vs, int wid) const {
        dma16(k + (size_t)tile * 4096, ks + wid * 1024);
        dma16(v + (size_t)tile * 4096, vs + wid * 1024);
        dma16(ov + (size_t)tile * 4096, vs + 8192 + wid * 1024); }
};

template <int NV> struct RowT { float m, l; f32x16 o[2 * NV]; };
typedef RowT<1> Row;
template <int NV> __device__ __forceinline__ void row_reset(RowT<NV>& R) { R.m = -1e30f; R.l = 0.f;
#pragma unroll
    for (int i = 0; i < 2 * NV; ++i) R.o[i] = f32x16{}; }

template <int DK> __device__ __forceinline__ void qk_tile(f32x16& p0, f32x16& p1, LAS unsigned char* kslot, const bf16x8 (&qr)[DK / 16], int r32, int hi) {
    const LAS unsigned char* kb = kslot + hi * 1024 + r32 * 16;
    p0 = f32x16{}; p1 = f32x16{};
#pragma unroll
    for (int d0 = 0; d0 < DK / 16; ++d0) {
        const bf16x8 b0 = *(const LAS bf16x8*)(kb + d0 * 2048), b1 = *(const LAS bf16x8*)(kb + d0 * 2048 + 512);
        p0 = __builtin_amdgcn_mfma_f32_32x32x16_bf16(b0, qr[d0], p0, 0, 0, 0);
        p1 = __builtin_amdgcn_mfma_f32_32x32x16_bf16(b1, qr[d0], p1, 0, 0, 0); }
}
template <int NV> __device__ __forceinline__ void softmax_tile(f32x16& p0, f32x16& p1, RowT<NV>& R) {
    float a = fmaxf(fmaxf(p0[0], p0[1]), fmaxf(p1[0], p1[1]));
#pragma unroll
    for (int r = 2; r < 16; r += 2) a = fmaxf(a, fmaxf(fmaxf(p0[r], p0[r + 1]), fmaxf(p1[r], p1[r + 1])));
    const float mt = swap_max(a);
    if (__any(mt > R.m + THR)) { const float mn = fmaxf(R.m, mt), f = __builtin_amdgcn_exp2f(R.m - mn); R.m = mn; R.l *= f;
#pragma unroll
        for (int i = 0; i < 2 * NV; ++i) R.o[i] *= f; }
    const float m = R.m; float s = 0.f;
#pragma unroll
    for (int r = 0; r < 16; ++r) { p0[r] = __builtin_amdgcn_exp2f(p0[r] - m); p1[r] = __builtin_amdgcn_exp2f(p1[r] - m); s += p0[r] + p1[r]; }
    R.l += s;
}
template <int NV> __device__ __forceinline__ void pv_tile(const f32x16& p0, const f32x16& p1, RowT<NV>& R, LAS unsigned char* vslot, int lane, int hi) {
    bf16x8 pa[4];
#pragma unroll
    for (int k = 0; k < 4; ++k) { const f32x16& P = (k < 2) ? p0 : p1; const int b = (k & 1) * 8;
        u32x4 w; w.x = pk2(P[b], P[b + 1]); w.y = pk2(P[b + 2], P[b + 3]); w.z = pk2(P[b + 4], P[b + 5]); w.w = pk2(P[b + 6], P[b + 7]); pa[k] = __builtin_bit_cast(bf16x8, w); }
    const int vb = (int)(unsigned)(uintptr_t)vslot + ((lane >> 4) & 1) * 32 + (lane & 3) * 8 + (4 * hi + ((lane & 15) >> 2)) * 64;
#pragma unroll
    for (int d0 = 0; d0 < 2 * NV; ++d0) { s16x4 lo[4], hh[4];
#pragma unroll
        for (int ks = 0; ks < 4; ++ks) {
            asm volatile("ds_read_b64_tr_b16 %0,%1 offset:%c2" : "=&v"(lo[ks]) : "v"(vb), "i"(d0 * 4096 + ks * 1024) : "memory");
            asm volatile("ds_read_b64_tr_b16 %0,%1 offset:%c2" : "=&v"(hh[ks]) : "v"(vb), "i"(d0 * 4096 + ks * 1024 + 512) : "memory"); }
        asm volatile("s_waitcnt lgkmcnt(0)" ::: "memory"); __builtin_amdgcn_sched_barrier(0);
#pragma unroll
        for (int ks = 0; ks < 4; ++ks) { const bf16x8 vf = (bf16x8){lo[ks][0], lo[ks][1], lo[ks][2], lo[ks][3], hh[ks][0], hh[ks][1], hh[ks][2], hh[ks][3]};
            R.o[d0] = __builtin_amdgcn_mfma_f32_32x32x16_bf16(vf, pa[ks], R.o[d0], 0, 0, 0); } }
}

template <class RowPtr>
__device__ __forceinline__ void store_rows(LAS unsigned char* stg, const f32x16& o0, const f32x16& o1, float scale, float& ss, int lane, const RowPtr& rowptr) {
    const int r32 = lane & 31, hi = lane >> 5;
    LAS unsigned char* wp = stg + r32 * 144 + 8 * hi;
#pragma unroll
    for (int d0 = 0; d0 < 2; ++d0)
#pragma unroll
        for (int k = 0; k < 4; ++k) { const f32x16& o = d0 ? o1 : o0;
            const float v0 = o[4 * k] * scale, v1 = o[4 * k + 1] * scale, v2 = o[4 * k + 2] * scale, v3 = o[4 * k + 3] * scale;
            ss += (v0 * v0 + v1 * v1) + (v2 * v2 + v3 * v3);
            *(LAS unsigned long long*)(wp + 64 * d0 + 16 * k) = (unsigned long long)pk2(v0, v1) | ((unsigned long long)pk2(v2, v3) << 32); }
    asm volatile("s_waitcnt lgkmcnt(0)" ::: "memory");
#pragma unroll
    for (int i = 0; i < 4; ++i) { const int row = i * 8 + (lane >> 3), ch = lane & 7;
        const u32x4 v = *(const LAS u32x4*)(stg + row * 144 + ch * 16);
        __builtin_nontemporal_store(v, (u32x4*)(rowptr(row) + ch * 8)); }
}

template <class Src, class Fix, class Skip>
__device__ __forceinline__ void run_tiles(LAS unsigned char* ring, const Src& src, int kt0, int kt1, const bf16x8 (&qr)[Src::DK / 16], RowT<Src::NV>& R, const Fix& fix, const Skip& skip, int wid, int lane) {
    constexpr int KB = Src::DK * 128, SLOT = KB + 8192 * Src::NV;
    const int r32 = lane & 31, hi = lane >> 5; const int nt = kt1 - kt0;
    if (nt <= 0) return;
    src.issue(kt0, ring, ring + KB, wid);
    if (nt > 1) src.issue(kt0 + 1, ring + SLOT, ring + SLOT + KB, wid);
    int s_cur = 0, s_nn = 2 * SLOT;
    for (int i = 0; i < nt; ++i) {
        if (i + 1 < nt) wait_bar<Src::NDMA>(); else wait_bar<0>();
        if (i + 2 < nt) src.issue(kt0 + i + 2, ring + s_nn, ring + s_nn + KB, wid);
        const int tile = kt0 + i;
        if (!skip(tile)) {
            f32x16 p0, p1;
            qk_tile<Src::DK>(p0, p1, ring + s_cur, qr, r32, hi);
            fix(p0, p1, tile);
            softmax_tile(p0, p1, R);
            pv_tile(p0, p1, R, ring + s_cur + KB, lane, hi);
        }
        s_cur = (s_cur == 2 * SLOT) ? 0 : s_cur + SLOT; s_nn = (s_nn == 2 * SLOT) ? 0 : s_nn + SLOT;
    }
    asm volatile("s_waitcnt lgkmcnt(0)\n\ts_barrier" ::: "memory");
}
}


namespace att {
template <int N> __device__ __forceinline__ void wait_bar_n() {
    static_assert(N == 0 || N == 3 || N == 4 || N == 5 || N == 6 || N == 8, "wait_bar_n: add the count");
    if (N == 8) asm volatile("s_waitcnt vmcnt(8) lgkmcnt(0)\n\ts_barrier" ::: "memory"); else if (N == 6) asm volatile("s_waitcnt vmcnt(6) lgkmcnt(0)\n\ts_barrier" ::: "memory");
    else if (N == 5) asm volatile("s_waitcnt vmcnt(5) lgkmcnt(0)\n\ts_barrier" ::: "memory"); else if (N == 4) asm volatile("s_waitcnt vmcnt(4) lgkmcnt(0)\n\ts_barrier" ::: "memory");
    else if (N == 3) asm volatile("s_waitcnt vmcnt(3) lgkmcnt(0)\n\ts_barrier" ::: "memory"); else asm volatile("s_waitcnt vmcnt(0) lgkmcnt(0)\n\ts_barrier" ::: "memory"); }
typedef short v4i16_t __attribute__((ext_vector_type(4)));
typedef float f32x2_t __attribute__((ext_vector_type(2)));
__device__ __forceinline__ s16x4 vtr(const LAS unsigned char* p) { return __builtin_bit_cast(s16x4, __builtin_amdgcn_ds_read_tr16_b64_v4i16((LAS v4i16_t*)p)); }
__device__ __forceinline__ unsigned cvtpk(float lo, float hi) { f32x2_t v = {lo, hi}; bf16x2_t b = __builtin_convertvector(v, bf16x2_t); return __builtin_bit_cast(unsigned, b); }
#define SBAR() __builtin_amdgcn_sched_barrier(0)
#define PIN(x) asm volatile("" : "+v"(x))
#define MX3(a, b, c) __builtin_fmaxf(__builtin_fmaxf((a), (b)), (c))

template <class Src, class Fix>
__device__ __forceinline__ void run_pipe(LAS unsigned char* ring, const Src& src, int kt0, int kt1, const bf16x8 (&qr)[Src::DK / 16], Row& R, const Fix& fix, float bfar, int near_from, int wid, int lane) {
    constexpr int DK = Src::DK, NKS = DK / 16, NK = 2 * NKS, KB = DK * 128, VB = 8192, NKD = Src::NKD, NDMA = NKD + 1;
    const int NT = kt1 - kt0;
    constexpr bool ALT = false;
    if (wid >= 4) __builtin_amdgcn_s_setprio(1);
    const int r32 = lane & 31, hi = lane >> 5;
    LAS unsigned char* kring = ring; LAS unsigned char* vring = ring + 4 * KB;
    const LAS unsigned char* kp0 = kring + hi * 1024 + r32 * 16;
    const LAS unsigned char* vp0 = vring + ((lane >> 4) & 1) * 32 + (lane & 3) * 8 + (4 * hi + ((lane & 15) >> 2)) * 64;
#define TILE(tt) (kt0 + ((tt) < NT ? (tt) : NT - 1))
    src.issueK(TILE(0), kring, wid); src.issueV(TILE(0), vring, wid); src.issueK(TILE(1), kring + KB, wid); src.issueK(TILE(2), kring + 2 * KB, wid);
    src.issueK(TILE(3), kring + 3 * KB, wid); src.issueV(TILE(1), vring + VB, wid);
    bf16x8 kf[NK];
    f32x16 A0, A1, B0, B1, cin;
    float m = 0.f, l = 0.f, csh = 0.f; f32x16 o0 = f32x16{}, o1 = f32x16{};
    wait_bar_n<3 * NKD + 2>();
#define KLOAD(kslot) do { _Pragma("unroll") for (int d0 = 0; d0 < NKS; ++d0) { kf[2 * d0] = *(const LAS bf16x8*)(kp0 + (kslot) + d0 * 2048); kf[2 * d0 + 1] = *(const LAS bf16x8*)(kp0 + (kslot) + d0 * 2048 + 512); } } while (0)
#define ROWMAX(C0, C1, out) do { float a_ = MX3(C0[0], C0[1], C1[0]), b_ = MX3(C0[2], C0[3], C1[1]); a_ = MX3(a_, C1[2], C1[3]); \
        _Pragma("unroll") for (int r = 4; r < 16; r += 4) { a_ = MX3(a_, C0[r], C0[r + 1]); b_ = MX3(b_, C0[r + 2], C0[r + 3]); a_ = MX3(a_, C1[r], C1[r + 1]); b_ = MX3(b_, C1[r + 2], C1[r + 3]); } \
        out = swap_max(__builtin_fmaxf(a_, b_)); } while (0)
    KLOAD(0);
    A0 = f32x16{}; A1 = f32x16{};
#pragma unroll
    for (int d0 = 0; d0 < NKS; ++d0) { A0 = __builtin_amdgcn_mfma_f32_32x32x16_bf16(kf[2 * d0], qr[d0], A0, 0, 0, 0); A1 = __builtin_amdgcn_mfma_f32_32x32x16_bf16(kf[2 * d0 + 1], qr[d0], A1, 0, 0, 0); }
    fix(A0, A1, kt0);
    { float rm; ROWMAX(A0, A1, rm);
      const float sh0 = (kt0 < near_from) ? bfar : 0.f;
      const float dl = (rm > NEG_INF) ? rm + sh0 : 0.f; m = dl; const float c0 = sh0 - dl;
#pragma unroll
      for (int r = 0; r < 16; ++r) { A0[r] = __builtin_amdgcn_exp2f(A0[r] + c0); A1[r] = __builtin_amdgcn_exp2f(A1[r] + c0); }
      csh = (kt0 + 1 < near_from) ? bfar : 0.f;
#pragma unroll
      for (int r = 0; r < 16; ++r) cin[r] = csh - m;
      asm volatile("" : "+v"(cin)); }
    float fpend = 1.0f; bool resc = false;
    wait_bar_n<2 * NKD + 1>();
    src.issueK(TILE(4), kring, wid); src.issueV(TILE(2), vring + 2 * VB, wid);
    KLOAD(KB);
    wait_bar_n<2 * NDMA>();
    int kcur = KB, knext = 2 * KB, vprev = 0, vnext = 3 * VB;
    u32x4 pw0, pw1, pw2, pw3; s16x4 vlo[8], vhi[8];
#define PKW(P, b) cvtpk(P[b], P[(b) + 1])
#define VRD(i) do { vlo[i] = vtr(vp_ + (((i) >> 2) * 4096 + ((i) & 3) * 1024)); vhi[i] = vtr(vp_ + (((i) >> 2) * 4096 + ((i) & 3) * 1024 + 512)); } while (0)
#define VFR(i) (bf16x8){vlo[i][0], vlo[i][1], vlo[i][2], vlo[i][3], vhi[i][0], vhi[i][1], vhi[i][2], vhi[i][3]}
#define PAF(k) __builtin_bit_cast(bf16x8, pw##k)
#define QKM(i, C, first) C = __builtin_amdgcn_mfma_f32_32x32x16_bf16(kf[i], qr[(i) >> 1], (first) ? cin : C, 0, 0, 0)
#define GAPA(MF, a0_, a1_, a2_, a3_, W0, W1, PW) do { MF; sacc += a0_; sacc += a1_; sacc += a2_; sacc += a3_; PIN(sacc); W0; W1; PIN(PW); SBAR(); } while (0)
#define GAPB(MF, X, b) do { MF; X[b] = __builtin_amdgcn_exp2f(X[b]); X[(b) + 1] = __builtin_amdgcn_exp2f(X[(b) + 1]); X[(b) + 2] = __builtin_amdgcn_exp2f(X[(b) + 2]); X[(b) + 3] = __builtin_amdgcn_exp2f(X[(b) + 3]); PIN(X); SBAR(); } while (0)
#define PHASE_A(C0, C1, P0, P1) do { SBAR(); const LAS unsigned char* vp_ = vp0 + vprev; \
        VRD(0); SBAR(); float sacc = P0[0] + P0[1]; \
        GAPA(QKM(0, C0, true), P0[2], P0[3], P0[4], P0[5], pw0[0] = PKW(P0, 0), pw0[1] = PKW(P0, 2), pw0); \
        GAPA(QKM(1, C1, true), P0[6], P0[7], P0[8], P0[9], pw0[2] = PKW(P0, 4), pw0[3] = PKW(P0, 6), pw0); \
        VRD(1); SBAR(); GAPA(QKM(2, C0, false), P0[10], P0[11], P0[12], P0[13], pw1[0] = PKW(P0, 8), pw1[1] = PKW(P0, 10), pw1); \
        GAPA(QKM(3, C1, false), P0[14], P0[15], P1[0], P1[1], pw1[2] = PKW(P0, 12), pw1[3] = PKW(P0, 14), pw1); \
        VRD(2); SBAR(); GAPA(QKM(4, C0, false), P1[2], P1[3], P1[4], P1[5], pw2[0] = PKW(P1, 0), pw2[1] = PKW(P1, 2), pw2); \
        GAPA(QKM(5, C1, false), P1[6], P1[7], P1[8], P1[9], pw2[2] = PKW(P1, 4), pw2[3] = PKW(P1, 6), pw2); \
        VRD(3); SBAR(); GAPA(QKM(6, C0, false), P1[10], P1[11], P1[12], P1[13], pw3[0] = PKW(P1, 8), pw3[1] = PKW(P1, 10), pw3); \
        GAPA(QKM(7, C1, false), P1[14], P1[15], 0.f, 0.f, pw3[2] = PKW(P1, 12), pw3[3] = PKW(P1, 14), pw3); \
        if (NK > 8) { _Pragma("unroll") for (int i_ = 8; i_ < NK; i_ += 2) { QKM(i_, C0, false); QKM(i_ + 1, C1, false); } SBAR(); } \
        l += sacc; } while (0)
#define KRD(j) do { kf[2 * (j)] = *(const LAS bf16x8*)(kp0 + knext + (j) * 2048); kf[2 * (j) + 1] = *(const LAS bf16x8*)(kp0 + knext + (j) * 2048 + 512); SBAR(); } while (0)
#define PHASE_B(C0, C1) do { SBAR(); const LAS unsigned char* vp_ = vp0 + vprev; \
        VRD(4); SBAR(); GAPB(o0 = __builtin_amdgcn_mfma_f32_32x32x16_bf16(VFR(0), PAF(0), o0, 0, 0, 0), C0, 0); \
        VRD(5); SBAR(); GAPB(o0 = __builtin_amdgcn_mfma_f32_32x32x16_bf16(VFR(1), PAF(1), o0, 0, 0, 0), C0, 4); \
        VRD(6); SBAR(); KRD(0); GAPB(o0 = __builtin_amdgcn_mfma_f32_32x32x16_bf16(VFR(2), PAF(2), o0, 0, 0, 0), C0, 8); \
        VRD(7); SBAR(); KRD(1); GAPB(o0 = __builtin_amdgcn_mfma_f32_32x32x16_bf16(VFR(3), PAF(3), o0, 0, 0, 0), C0, 12); \
        KRD(2); GAPB(o1 = __builtin_amdgcn_mfma_f32_32x32x16_bf16(VFR(4), PAF(0), o1, 0, 0, 0), C1, 0); \
        KRD(3); GAPB(o1 = __builtin_amdgcn_mfma_f32_32x32x16_bf16(VFR(5), PAF(1), o1, 0, 0, 0), C1, 4); \
        if (NKS > 4) { KRD(4); } GAPB(o1 = __builtin_amdgcn_mfma_f32_32x32x16_bf16(VFR(6), PAF(2), o1, 0, 0, 0), C1, 8); \
        if (NKS > 5) { KRD(5); } GAPB(o1 = __builtin_amdgcn_mfma_f32_32x32x16_bf16(VFR(7), PAF(3), o1, 0, 0, 0), C1, 12); \
        } while (0)
#define DECIDE(C0, C1, tt) do { \
        fix(C0, C1, kt0 + (tt)); \
        float rm_; ROWMAX(C0, C1, rm_); resc = false; \
        const bool up_ = (rm_ > THR) || (l == 0.f && rm_ < -THR && rm_ > NEG_INF); \
        const float nsh_ = (kt0 + (tt) + 1 < near_from) ? bfar : 0.f; \
        if (__any(up_)) { const float dl_ = up_ ? rm_ : __builtin_fmaxf(rm_, 0.f); m += dl_; fpend = __builtin_amdgcn_exp2f(-dl_); l *= fpend; resc = true; \
            _Pragma("unroll") for (int r = 0; r < 16; ++r) { C0[r] -= dl_; C1[r] -= dl_; } \
            csh = nsh_; _Pragma("unroll") for (int r = 0; r < 16; ++r) cin[r] = csh - m; asm volatile("" : "+v"(cin)); } \
        else if (nsh_ != csh) { csh = nsh_; _Pragma("unroll") for (int r = 0; r < 16; ++r) cin[r] = csh - m; asm volatile("" : "+v"(cin)); } } while (0)
#define STEP(C0, C1, P0, P1, tt) do { \
        if (ALT && wid >= 4) asm volatile("s_barrier" ::: "memory"); \
        PHASE_A(C0, C1, P0, P1); \
        src.issueK(TILE((tt) + 4), kring + kcur, wid); src.issueV(TILE((tt) + 2), vring + vnext, wid); \
        DECIDE(C0, C1, tt); \
        PHASE_B(C0, C1); \
        if (ALT && wid < 4) asm volatile("s_waitcnt lgkmcnt(0)\n\ts_barrier" ::: "memory"); \
        wait_bar_n<2 * NDMA>();                                          \
        if (resc) { o0 *= fpend; o1 *= fpend; } \
        kcur = knext; knext = (knext == 3 * KB) ? 0 : knext + KB; \
        vprev = (vprev == 3 * VB) ? 0 : vprev + VB; vnext = (vnext == 3 * VB) ? 0 : vnext + VB; } while (0)
    int t = 1;
    for (; t + 1 < NT; t += 2) { STEP(B0, B1, A0, A1, t); STEP(A0, A1, B0, B1, t + 1); }
    if (t < NT) { STEP(B0, B1, A0, A1, t); A0 = B0; A1 = B1; }
    { float sacc = 0.f;
#pragma unroll
      for (int r = 0; r < 16; ++r) sacc += A0[r] + A1[r];
      l += sacc;
      pw0 = (u32x4){PKW(A0, 0), PKW(A0, 2), PKW(A0, 4), PKW(A0, 6)}; pw1 = (u32x4){PKW(A0, 8), PKW(A0, 10), PKW(A0, 12), PKW(A0, 14)};
      pw2 = (u32x4){PKW(A1, 0), PKW(A1, 2), PKW(A1, 4), PKW(A1, 6)}; pw3 = (u32x4){PKW(A1, 8), PKW(A1, 10), PKW(A1, 12), PKW(A1, 14)};
      const LAS unsigned char* vp_ = vp0 + vprev;
#pragma unroll
      for (int i = 0; i < 8; ++i) VRD(i);
      o0 = __builtin_amdgcn_mfma_f32_32x32x16_bf16(VFR(0), PAF(0), o0, 0, 0, 0); o1 = __builtin_amdgcn_mfma_f32_32x32x16_bf16(VFR(4), PAF(0), o1, 0, 0, 0);
      o0 = __builtin_amdgcn_mfma_f32_32x32x16_bf16(VFR(1), PAF(1), o0, 0, 0, 0); o1 = __builtin_amdgcn_mfma_f32_32x32x16_bf16(VFR(5), PAF(1), o1, 0, 0, 0);
      o0 = __builtin_amdgcn_mfma_f32_32x32x16_bf16(VFR(2), PAF(2), o0, 0, 0, 0); o1 = __builtin_amdgcn_mfma_f32_32x32x16_bf16(VFR(6), PAF(2), o1, 0, 0, 0);
      o0 = __builtin_amdgcn_mfma_f32_32x32x16_bf16(VFR(3), PAF(3), o0, 0, 0, 0); o1 = __builtin_amdgcn_mfma_f32_32x32x16_bf16(VFR(7), PAF(3), o1, 0, 0, 0); }
    wait_bar_n<0>();
    R.m = m; R.l = l; R.o[0] = o0; R.o[1] = o1;
    __builtin_amdgcn_s_setprio(0);
#undef TILE
#undef KLOAD
#undef ROWMAX
#undef DECIDE
#undef PKW
#undef VRD
#undef VFR
#undef PAF
#undef QKM
#undef GAPA
#undef GAPB
#undef PHASE_A
#undef KRD
#undef PHASE_B
#undef STEP
}
#undef SBAR
#undef PIN
#undef MX3
}
constexpr int MLA_STG_OFF = 98304;
__device__ __forceinline__ void p3_mla(const Ptrs& P, LAS unsigned char* lds, int vcu, int G, int tid, int wid) {
    using namespace att;
    for (int L = vcu; L < 2048; L += G) {
        int lane_u = tid & 63; asm volatile("" : "+v"(lane_u));
        const int lane = lane_u, r32 = lane & 31, hi = lane >> 5;
        int bh, qb;
        if (G == 256) { const int i = L >> 8, s8 = vcu & 7; bh = (vcu >> 3) + 32 * (i >> 1); qb = (i & 1) ? 15 - s8 : s8; }
        else { bh = L >> 4; qb = L & 15; }
        const int b = bh >> 3, h = bh & 7; const size_t rowb = (size_t)b * SEQ;
        const int q0 = qb * 256 + wid * 32, t = q0 + r32; const size_t row = rowb + t;
        bf16x8 qr[6];
#pragma unroll
        for (int d0 = 0; d0 < 6; ++d0) qr[d0] = *(const bf16x8*)(P.QM + row * 768 + h * 96 + d0 * 16 + hi * 8);
        SrcMLA src; src.init(P.KVM, P.kpe, rowb, h, wid, lane);
        Row R; row_reset(R);
        auto fix = [&](f32x16& p0, f32x16& p1, int tile) {
            if (tile * 64 + 63 > q0) {
                const int kb = tile * 64 + 4 * hi;
#pragma unroll
                for (int r = 0; r < 16; ++r) { const int kv = kb + (r & 3) + 8 * (r >> 2); if (kv > t) p0[r] = NEG_INF; if (kv + 32 > t) p1[r] = NEG_INF; } } };
        run_pipe(lds, src, 0, 4 * qb + 4, qr, R, fix, 0.f, 0x7fffffff, wid, lane);
        const float inv = 1.0f / swap_sum(R.l); float ss = 0.f;
        { bf16* const ob = P.ATT + (rowb + q0) * 1024 + h * 64;
          store_rows(lds + MLA_STG_OFF + wid * 4608, R.o[0], R.o[1], inv, ss, lane, [&](int r) -> bf16* { return ob + (size_t)r * 1024; }); }
        ss = swap_sum(ss);
        if (hi == 0) P.ssatt[row * 16 + h] = ss;
    }
}

constexpr int NSA_LB_OFF = 81920;
constexpr int NSA_OUT_OFF = 86016;
__device__ __forceinline__ float dpp_xor1(float x) { return __builtin_bit_cast(float, __builtin_amdgcn_update_dpp(0, __builtin_bit_cast(int, x), 0xB1, 0xF, 0xF, false)); }
__device__ __forceinline__ float dpp_xor2(float x) { return __builtin_bit_cast(float, __builtin_amdgcn_update_dpp(0, __builtin_bit_cast(int, x), 0x4E, 0xF, 0xF, false)); }
__device__ __forceinline__ unsigned dpp_xor1u(unsigned x) { return (unsigned)__builtin_amdgcn_update_dpp(0, (int)x, 0xB1, 0xF, 0xF, false); }
__device__ __forceinline__ unsigned dpp_xor2u(unsigned x) { return (unsigned)__builtin_amdgcn_update_dpp(0, (int)x, 0x4E, 0xF, 0xF, false); }
template <int STEP, int YOFF> __device__ __forceinline__ void add_bias(att::f32x16& p, const LAS float* lb, int D) {
#pragma unroll
    for (int r = 0; r < 16; ++r) { int d = D - STEP * ((r & 3) + 8 * (r >> 2) + YOFF); d = d < 0 ? 0 : (d > 127 ? 127 : d); p[r] += lb[d]; }
}
__device__ __forceinline__ void p3_nsa(const Ptrs& P, LAS unsigned char* lds, int vcu, int G, int tid, int wid) {
    using namespace att;
    LAS float* LB = (LAS float*)(lds + NSA_LB_OFF);
    for (int e = tid; e < 1024; e += NTHR) LB[e] = P.bias[e];
    __syncthreads();
    for (int L = vcu; L < 2048; L += G) {
        int bhk, c;
        if (G == 256) { const int i = L >> 8, sub = vcu & 7; bhk = vcu >> 3; const int base = 16 * (i >> 1); c = (i & 1) ? base + 15 - sub : base + sub; }
        else { bhk = L >> 6; c = L & 63; }
        int lane_u = tid & 63; asm volatile("" : "+v"(lane_u));
        const int lane = lane_u, r32 = lane & 31, hi = lane >> 5, ql = r32 >> 2, g = r32 & 3;
        const int b = bhk >> 1, hk = bhk & 1, hq = hk * 4 + g; const size_t rowb = (size_t)b * SEQ;
        const int t = c * 64 + wid * 8 + ql; const size_t row = rowb + t;
        const LAS float* lb = LB + hq * 128; const float b31 = lb[127];
        bf16x8 qr[4];
#pragma unroll
        for (int d0 = 0; d0 < 4; ++d0) qr[d0] = *(const bf16x8*)(P.U + row * DINP + C_QN + hq * 64 + d0 * 16 + hi * 8);
        float gate[3];
#pragma unroll
        for (int br = 0; br < 3; ++br) { const float x = bf2f(P.U[row * DINP + C_GATE + hq * 3 + br]); gate[br] = __builtin_amdgcn_rcpf(1.0f + __builtin_amdgcn_exp2f(-x * LOG2E)); }
        LAS float* outp = (LAS float*)(lds + NSA_OUT_OFF) + wid * 2048 + lane;
        unsigned mlo, mhi;
        {
            const int nv = t >= 31 ? ((t - 31) >> 4) + 1 : 0;
            int ln = lane_u; asm volatile("" : "+v"(ln));
            SrcCmp src; src.init(P.kcmp + (size_t)bhk * 256 * 64, P.vcmp + (size_t)bhk * 256 * 64, P.ovt, wid, ln);
            RowT<2> R; row_reset(R);
            auto fix = [&](f32x16& p0, f32x16& p1, int tile) {
                const int D = t - 31 - 16 * (64 * tile + 4 * hi);
                add_bias<16, 0>(p0, lb, D); add_bias<16, 32>(p1, lb, D);
                const int ib = 64 * tile + 4 * hi;
#pragma unroll
                for (int r = 0; r < 16; ++r) { const int i = ib + (r & 3) + 8 * (r >> 2); if (i >= nv) p0[r] = NEG_INF; if (i + 32 >= nv) p1[r] = NEG_INF; } };
            auto skip = [&](int) -> bool { return false; };
            run_tiles(lds, src, 0, (4 * c + 3 + 63) >> 6, qr, R, fix, skip, wid, lane);
            const float lt = swap_sum(R.l); const float inv = lt > 0.f ? 1.0f / lt : 0.f;
            { const float f = gate[0] * inv;
#pragma unroll
              for (int i = 0; i < 16; ++i) { outp[64 * i] = R.o[0][i] * f; outp[64 * (16 + i)] = R.o[1][i] * f; } }
            mlo = 0u; mhi = 0u;
            if (c <= 15) { const unsigned long long mk = (2ull << c) - 1ull; mlo = (unsigned)mk; mhi = (unsigned)(mk >> 32); }
            else {
                float cand[8];
#pragma unroll
                for (int rr = 0; rr < 8; ++rr) {
                    float v00 = R.o[2][rr] * inv, v01 = R.o[2][8 + rr] * inv, v10 = R.o[3][rr] * inv, v11 = R.o[3][8 + rr] * inv;
                    v00 += dpp_xor1(v00); v00 += dpp_xor2(v00); v01 += dpp_xor1(v01); v01 += dpp_xor2(v01); v10 += dpp_xor1(v10); v10 += dpp_xor2(v10); v11 += dpp_xor1(v11); v11 += dpp_xor2(v11);
                    cand[rr] = (g & 2) ? ((g & 1) ? v11 : v10) : ((g & 1) ? v01 : v00); }
                unsigned key[8];
#pragma unroll
                for (int rr = 0; rr < 8; ++rr) { const int j = 32 * (g >> 1) + (rr & 3) + 8 * (2 * (g & 1) + (rr >> 2)) + 4 * hi;
                    const bool ok = j >= 1 && j <= c - 2; key[rr] = ok ? ((__float_as_uint(fmaxf(cand[rr], 0.f)) & ~63u) | (unsigned)(63 - j)) : 0u; }
                unsigned long long mk = 1ull | (1ull << c) | (1ull << (c - 1));
                for (int round = 0; round < 13; ++round) {
                    unsigned best = key[0];
#pragma unroll
                    for (int rr = 1; rr < 8; ++rr) best = best > key[rr] ? best : key[rr];
                    { const unsigned o1 = dpp_xor1u(best); best = best > o1 ? best : o1; const unsigned o2 = dpp_xor2u(best); best = best > o2 ? best : o2;
                      auto rr2 = __builtin_amdgcn_permlane32_swap(best, best, false, false); best = rr2[0] > rr2[1] ? rr2[0] : rr2[1]; }
                    if (best != 0u) mk |= 1ull << (63u - (best & 63u));
#pragma unroll
                    for (int rr = 0; rr < 8; ++rr) key[rr] = (key[rr] == best) ? 0u : key[rr];
                }
                mlo = (unsigned)mk; mhi = (unsigned)(mk >> 32);
            }
        }
        {
            int ln = lane_u; asm volatile("" : "+v"(ln));
            SrcRows src; src.init(P.U + rowb * DINP + C_KVS + hk * 64, P.U + rowb * DINP + C_KVS + 128 + hk * 64, DINP, wid, ln);
            Row R; row_reset(R);
            auto fix = [&](f32x16& p0, f32x16& p1, int tile) {
                if (tile >= c - 2) { const int D = t - 64 * tile - 4 * hi; add_bias<1, 0>(p0, lb, D); asm volatile("" ::: "memory"); add_bias<1, 32>(p1, lb, D); }
                const bool sel = ((tile < 32 ? (mlo >> tile) : (mhi >> (tile - 32))) & 1u) != 0u;
                if (tile == c) { const int kb = tile * 64 + 4 * hi;
#pragma unroll
                    for (int r = 0; r < 16; ++r) { const int kv = kb + (r & 3) + 8 * (r >> 2); if (kv > t || !sel) p0[r] = NEG_INF; if (kv + 32 > t || !sel) p1[r] = NEG_INF; } }
                else if (!sel) {
#pragma unroll
                    for (int r = 0; r < 16; ++r) { p0[r] = NEG_INF; p1[r] = NEG_INF; } } };
            run_pipe(lds, src, 0, c + 1, qr, R, fix, b31, c - 2, wid, lane);
            const float f = gate[1] / swap_sum(R.l);
#pragma unroll
            for (int i = 0; i < 16; ++i) { outp[64 * i] += R.o[0][i] * f; outp[64 * (16 + i)] += R.o[1][i] * f; }
        }
        f32x16 out[2];
        {
            int ln = lane_u; asm volatile("" : "+v"(ln));
            SrcRows src; src.init(P.U + rowb * DINP + C_KVW + hk * 64, P.U + rowb * DINP + C_KVW + 128 + hk * 64, DINP, wid, ln);
            Row R; row_reset(R);
            auto fix = [&](f32x16& p0, f32x16& p1, int tile) {
                if (tile >= c - 2) { const int D = t - 64 * tile - 4 * hi; add_bias<1, 0>(p0, lb, D); asm volatile("" ::: "memory"); add_bias<1, 32>(p1, lb, D); }
                if (tile == c || tile == c - 8) { const int kb = tile * 64 + 4 * hi;
#pragma unroll
                    for (int r = 0; r < 16; ++r) { const int kv = kb + (r & 3) + 8 * (r >> 2); const int d0_ = t - kv, d1_ = d0_ - 32;
                        if (d0_ < 0 || d0_ >= 512) p0[r] = NEG_INF; if (d1_ < 0 || d1_ >= 512) p1[r] = NEG_INF; } } };
            run_pipe(lds, src, c >= 8 ? c - 8 : 0, c + 1, qr, R, fix, b31, c - 2, wid, lane);
            const float f = gate[2] / swap_sum(R.l);
#pragma unroll
            for (int i = 0; i < 16; ++i) { out[0][i] = outp[64 * i] + R.o[0][i] * f; out[1][i] = outp[64 * (16 + i)] + R.o[1][i] * f; }
        }
        { float ss = 0.f; bf16* const ob = P.ATT + (rowb + c * 64 + wid * 8) * 1024 + 512 + hk * 256;
            store_rows(lds + NSA_OUT_OFF + wid * 8192, out[0], out[1], 1.0f, ss, lane, [&](int r) -> bf16* { return ob + (size_t)(r >> 2) * 1024 + (r & 3) * 64; });
            ss = swap_sum(ss);
            if (hi == 0) P.ssatt[row * 16 + 8 + hq] = ss; }
    }
}

__global__ void __launch_bounds__(NTHR, 2) mega_fwd(Args args) {
    extern __shared__ __attribute__((aligned(16))) unsigned char lds_raw[];
    LAS unsigned char* lds = (LAS unsigned char*)lds_raw;
    volatile LAS unsigned* MISC = (volatile LAS unsigned*)(lds + MISC_OFF);
    const int wv0 = __builtin_amdgcn_readfirstlane((int)threadIdx.x >> 6);
#define LAUNDER_TID() int tid = wv0 * 64 + pg8::lane_id(); asm volatile("" : "+v"(tid)); const int lane = tid & 63, wave = __builtin_amdgcn_readfirstlane(tid >> 6); (void)lane; (void)wave
    const int G = gridDim.x, wg = blockIdx.x;
    const int vcu = (G % 8 == 0) ? (wg % 8) * (G / 8) + wg / 8 : wg;
    unsigned char* ws = args.ws;
    Ptrs P;
#pragma unroll
    for (int i = 0; i < 22; ++i) P.in[i] = args.in[i];
    P.out = args.out; P.ws = ws;
    P.Win = (bf16*)(ws + WS_WIN); P.Wuq = (bf16*)(ws + WS_WUQ); P.Wukv = (bf16*)(ws + WS_WUKV); P.Wout = (bf16*)(ws + WS_WOUT); P.Wgu = (bf16*)(ws + WS_WGU); P.Wdn = (bf16*)(ws + WS_WDN);
    P.rope = (f32x2v*)(ws + WS_ROPE); P.bias = (float*)(ws + WS_BIAS); P.bias1 = (float*)(ws + WS_BIAS1); P.rstdx = (float*)(ws + WS_RSTDX);
    P.ssqkv = (float*)(ws + WS_SSQKV); P.ssatt = (float*)(ws + WS_SSATT); P.ssh = (float*)(ws + WS_SSH);
    P.kcmp = (bf16*)(ws + WS_KCMP); P.vcmp = (bf16*)(ws + WS_VCMP); P.kpe = (bf16*)(ws + WS_KPE); P.ovt = (bf16*)(ws + WS_OVT); P.W1c = (bf16*)(ws + WS_W1C); P.W2t = (bf16*)(ws + WS_W2T);
    P.XB = (bf16*)(ws + WS_XB); P.U = (bf16*)(ws + WS_U); P.QM = (bf16*)(ws + WS_QM); P.KVM = (bf16*)(ws + WS_KVM); P.ATT = (bf16*)(ws + WS_ATT); P.H = (bf16*)(ws + WS_H); P.HID = (bf16*)(ws + WS_HID);
    gu32* ctl = (gu32*)(ws + WS_CTL);

    if (wv0 == 0) MISC[pg8::lane_id()] = 0u;
    __syncthreads();
    XcdBarrier bar; bar.bar = (unsigned*)(ctl + CW_BAR); bar.x = 0; bar.st = nullptr; bar.lead = false;
    if (N_LAUNCHES == 1) bar = xcd_barrier_post((unsigned*)(ctl + CW_BAR), MISC + 8);
#define GRID_BAR() do { if (N_LAUNCHES == 1) xcd_barrier(bar); } while (0)
    const int lo = args.ph_lo, hi = args.ph_hi;
#ifndef PHASE_MASK
#define PHASE_MASK 0xff
#endif
#define IN(k) (((PHASE_MASK >> (k)) & 1) && lo <= (k) && (k) < hi)
#define BOTH(k) (IN(k) && IN((k) + 1))
#ifndef REPEAT_MASK
#define REPEAT_MASK 0
#endif
#define REP(k) for (int rep_ = 0; rep_ < (((REPEAT_MASK >> (k)) & 1) ? 2 : 1); ++rep_)

    if (IN(0)) { REP(0) { LAUNDER_TID(); p0_prologue(P, lds, wg, G, wave, lane, tid); } if (BOTH(0)) GRID_BAR(); }

    if (IN(1)) {
        REP(1) {
        pg8::Gemm g{P.XB, P.Win, MT, DINP, 1024, 1024, 1024, 0}; pg8::StaticOrder S; S.init(MT, DINP, G, wg);
        EpiInProj E{P.U, P.rstdx, P.ssqkv};
        pg8::gemm_phase<EpiInProj, pg8::StaticOrder, true, true>(lds, g, S, E, wv0); }
        if (BOTH(1)) GRID_BAR();
    }

    if (IN(2)) {
        REP(2) {
        { LAUNDER_TID(); p2_kpe(P, wg, G, tid); }
        { pg8::Gemm g{P.U, P.W1c, 64 * 256, 256, 1024, 16 * DINP, 1024, DINP * 2}; CmpOrder S{G, wg, P.U, P.W1c};
          EpiCmp E{P.bias1, P.W2t, P.kcmp, P.vcmp};
          pg8::gemm_phase<EpiCmp, CmpOrder, false, true>(lds, g, S, E, wv0); }
        { const int gq = G > 64 ? G - 64 : G, cq = G > 64 ? wg - 64 : wg;
          if (cq >= 0) { pg8::Gemm g{P.U + C_CQ, P.Wuq, MT, 768, 256, DINP, 256, 0}; pg8::StaticOrder S; S.init(MT, 768, gq, cq);
            EpiQup E{P.QM, P.ssqkv, P.rope};
            pg8::gemm_phase<EpiQup, pg8::StaticOrder, true, true>(lds, g, S, E, wv0); } }
        { pg8::Gemm g{P.U + C_CKV, P.Wukv, MT, 1024, 128, DINP, 256, 0}; pg8::StaticOrder S; S.init(MT, 1024, G, wg);
          EpiKVup E{P.KVM, P.ssqkv};
          pg8::gemm_phase<EpiKVup, pg8::StaticOrder, true, true>(lds, g, S, E, wv0); }
        }
        if (BOTH(2)) GRID_BAR();
    }

    if (IN(3)) {
        REP(3) {
        REP(8) { LAUNDER_TID(); p3_mla(P, lds, vcu, G, tid, wave); }
        REP(9) { LAUNDER_TID(); p3_nsa(P, lds, vcu, G, tid, wave); }
        }
        if (BOTH(3)) GRID_BAR();
    }

    if (IN(4)) {
        REP(4) {
        { pg8::Gemm g{P.ATT, P.Wout, MT, 1024, 1024, 1024, 1024, 0}; OutOrder S; S.init(MT, 1024, G, wg); S.ssatt = P.ssatt; S.tab = (LAS float*)(lds + OUT_TAB_OFF);
          EpiOut E{P.XB, P.H, (unsigned char*)P.QM, P.ssh, (const LAS float*)(lds + OUT_TAB_OFF)};
          pg8::gemm_phase<EpiOut, OutOrder, true, true>(lds, g, S, E, wv0); }
        }
        if (BOTH(4)) GRID_BAR();
    }

    if (IN(5)) {
        REP(5) {
        pg8::Gemm g{P.QM, P.Wgu, MT, NGU, 512, 512, 512, 0}; GUOrder S; S.init(MT, NGU, G, wg); S.ssh = P.ssh; S.tab = (LAS float*)(lds + OUT_TAB_OFF);
        EpiGU E{(unsigned char*)P.HID, (const LAS float*)(lds + OUT_TAB_OFF)};
        pg8::gemm_phase<EpiGU, GUOrder, true, true, true>(lds, g, S, E, wv0); }
        if (BOTH(5)) GRID_BAR();
    }

    if (IN(6)) {
        REP(6) {
        pg8::Gemm g{P.HID, P.Wdn, MT, 1024, DFF / 2, DFF / 2, DFF / 2, 0}; pg8::StaticOrder S; S.init(MT, 1024, G, wg);
        EpiDown E{P.H, P.ATT, P.ssatt};
        pg8::gemm_phase<EpiDown, pg8::StaticOrder, true, true, true>(lds, g, S, E, wv0); }
        if (BOTH(6)) GRID_BAR();
    }

    if (IN(7)) { LAUNDER_TID(); p7_final(P, wg, G, wave, lane); }
#undef IN
#undef BOTH
#undef GRID_BAR
}

extern "C" void kernel_launch(void* const* d_in, const int* in_sizes, int n_in, void* d_out, int out_size, void* d_ws, size_t ws_size, hipStream_t stream) {
    static int grid = 0;
    if (grid == 0) {
        if (n_in != 22 || in_sizes[0] != MT * DM || out_size != MT * DM || ws_size < WS_END) { fprintf(stderr, "kernel_launch: unexpected shapes (n_in %d, in0 %d, out %d, ws %zu); nothing launched\n", n_in, n_in > 0 ? in_sizes[0] : -1, out_size, ws_size); grid = -1; return; }
        int dev = 0, cus = 0, per_cu = 0;
        if (hipGetDevice(&dev) != hipSuccess || hipDeviceGetAttribute(&cus, hipDeviceAttributeMultiprocessorCount, dev) != hipSuccess) { fprintf(stderr, "kernel_launch: device query failed\n"); grid = -1; return; }
        if (hipFuncSetAttribute((const void*)mega_fwd, hipFuncAttributeMaxDynamicSharedMemorySize, LDS_BYTES) != hipSuccess) { fprintf(stderr, "kernel_launch: hipFuncSetAttribute failed\n"); grid = -1; return; }
        if (hipOccupancyMaxActiveBlocksPerMultiprocessor(&per_cu, (const void*)mega_fwd, NTHR, LDS_BYTES) != hipSuccess || per_cu < 1)
            fprintf(stderr, "kernel_launch: note: occupancy query reports %d workgroups per CU\n", per_cu);
        (void)hipGetLastError();
        grid = cus;
    }
    if (grid < 0) return;
    if (hipMemsetAsync((char*)d_ws + WS_CTL, 0, CTL_ZERO_BYTES, stream) != hipSuccess) { fprintf(stderr, "kernel_launch: memset failed\n"); return; }
    Args a{};
    for (int i = 0; i < 22; ++i) a.in[i] = (const float*)d_in[i];
    a.out = (float*)d_out; a.ws = (unsigned char*)d_ws;
    for (int li = 0; li < N_LAUNCHES; ++li) {
        a.ph_lo = (N_LAUNCHES == 1) ? 0 : li; a.ph_hi = (N_LAUNCHES == 1) ? NPHASE : li + 1; a.li = li; a.pad = 0;
        hipLaunchKernelGGL(mega_fwd, dim3(grid), dim3(NTHR), LDS_BYTES, stream, a);
        const hipError_t le = hipPeekAtLastError();
        if (le != hipSuccess) { fprintf(stderr, "kernel_launch: launch %d failed: %s\n", li, hipGetErrorName(le)); break; }
    }
}
```

```cpp
#include <hip/hip_runtime.h>
#include <cstdio>
#include <cstdint>
namespace pg8 {
#define PG8_LAS __attribute__((address_space(3)))
typedef unsigned short bf16_t;
typedef short bf16x8 __attribute__((ext_vector_type(8)));
typedef float f32x4 __attribute__((ext_vector_type(4)));
typedef unsigned u32x4 __attribute__((ext_vector_type(4)));
constexpr int BM = 256, BK = 64, HALF = 128, HTB = HALF * BK * 2  , STAGE_BYTES = 8 * HTB, NXCD = 8, WGM = 8;

__host__ __device__ __forceinline__ int lds_byte(int r, int c) { const int st = (r >> 4) * 2 + (c >> 5), rr = r & 15, cc = c & 31, ob = rr * 64 + cc * 2; return st * 1024 + (ob ^ (((ob >> 9) & 1) << 5)); }
__host__ __device__ __forceinline__ void stage_rc(int b, int& R, int& C) { const int st = b / 1024, sb = b % 1024, swz = sb ^ (((sb >> 9) & 1) << 5); R = (st >> 1) * 16 + swz / 64; C = (st & 1) * 32 + (swz % 64) / 2; }
__host__ __device__ __forceinline__ int perm32(int rho) { const int n = rho >> 4, i = rho & 15; return 8 * (i >> 2) + 4 * n + (i & 3); }

struct Unit { int pm, pn, ui; };
struct Gemm { const bf16_t* A; const bf16_t* Bt; int M, N, K, lda, ldb, kstepA; };

struct StaticOrder {
    int nM, nN, nwg, G, c;
    __host__ __device__ void init(int M, int N, int G_, int c_) { nM = M / BM; nN = N / BM; nwg = nM * nN; G = G_; c = c_; }
    __host__ __device__ bool next(int i, Unit& u) const {
        const long L = (long)i * G + c; if (L >= nwg) return false;
        int wgid = (int)L; { const int q = nwg / NXCD, r = nwg % NXCD, xcd = wgid % NXCD, off = wgid / NXCD; wgid = (xcd < r ? xcd * (q + 1) : r * (q + 1) + (xcd - r) * q) + off; }
        const int nig = WGM * nN, gid = wgid / nig, fm = gid * WGM, gsz = (nM - fm) < WGM ? (nM - fm) : WGM;
        u.pm = fm + ((wgid % nig) % gsz); u.pn = (wgid % nig) / gsz; u.ui = i; return true;
    }
    struct Pre {};
    __device__ __forceinline__ Pre a_pre(const Unit&, int) const { return Pre{}; }
    __device__ __forceinline__ void a_post(const Unit&, const Pre&, int) const {}
    __device__ __forceinline__ void done(const Unit&) const {}
    __device__ __forceinline__ const char* a_base(const Gemm& g, const Unit& u, size_t tstepA) const { return (const char*)g.A + (size_t)u.pm * tstepA; }
    __device__ __forceinline__ const char* b_base(const Gemm& g, const Unit& u, size_t tstepB) const { return (const char*)g.Bt + (size_t)u.pn * tstepB; }
};

__device__ __forceinline__ unsigned cvt_pk_bf16(float lo, float hi) { unsigned r; asm volatile("v_cvt_pk_bf16_f32 %0, %1, %2" : "=v"(r) : "v"(lo), "v"(hi)); return r; }
typedef float f32x2 __attribute__((ext_vector_type(2)));
typedef int i32x8 __attribute__((ext_vector_type(8)));
typedef int i32x4 __attribute__((ext_vector_type(4)));
__device__ __forceinline__ i32x8 cat8(bf16x8 lo, bf16x8 hi) { const i32x4 a = __builtin_bit_cast(i32x4, lo), b = __builtin_bit_cast(i32x4, hi); return __builtin_shufflevector(a, b, 0, 1, 2, 3, 4, 5, 6, 7); }
__device__ __forceinline__ unsigned cvt_pk4_fp8(float a, float b, float c, float d) { int w = 0; w = __builtin_amdgcn_cvt_pk_fp8_f32(a, b, w, false); w = __builtin_amdgcn_cvt_pk_fp8_f32(c, d, w, true); return (unsigned)w; }
__device__ __forceinline__ void glds16(const char* sbase, unsigned voff, unsigned dst) { unsigned keep;
    asm volatile("s_mov_b32 %0, m0\n\ts_mov_b32 m0, %3\n\ts_nop 0\n\tglobal_load_lds_dwordx4 %1, %2\n\ts_mov_b32 m0, %0" : "=&s"(keep) : "v"(voff), "s"(sbase), "s"(dst) : "memory"); }
__device__ __forceinline__ int lane_id() { int r; asm volatile("v_mbcnt_lo_u32_b32 %0, -1, 0\n\tv_mbcnt_hi_u32_b32 %0, -1, %0" : "=v"(r)); return r; }
template <class Epi, class Sched, bool ALIGN_EPI = false, bool SP2 = false, bool FP8 = false>
__device__ __forceinline__ void gemm_phase(PG8_LAS unsigned char* lds, const Gemm g, const Sched& S, const Epi& E, const int wv  ) {
    int tid_ = wv * 64 + lane_id(); asm volatile("" : "+v"(tid_));
    const int tid = tid_, wid = __builtin_amdgcn_readfirstlane(tid >> 6), lane = tid & 63, wr = wid >> 2, wc = wid & 3, fr = lane & 15, fq = lane >> 4;
    const int K = g.K, nt = K / BK;
    unsigned voffA, voffB;
    { int R, C; stage_rc(tid * 16, R, C); const int Rb = Epi::PERM ? ((R & ~31) + perm32(R & 31)) : R;
      voffA = (unsigned)(R * g.lda + C) * 2u; voffB = (unsigned)(Rb * g.ldb + C) * 2u; }
    const size_t qstepA = (size_t)64 * g.lda * 2, qstepB = (size_t)64 * g.ldb * 2;
    const size_t kstepA = g.kstepA ? (size_t)g.kstepA : (size_t)(BK * 2), kstepB = (size_t)(BK * 2);
    const size_t hstepA = (size_t)HALF * g.lda * 2, hstepB = (size_t)HALF * g.ldb * 2;
    const size_t tstepA = 2 * hstepA, tstepB = 2 * hstepB;
    const unsigned ldsb = (unsigned)(uintptr_t)lds + (unsigned)wid * 1024u;
    const int aoff = lds_byte(wr * 64 + fr, fq * 8), boff = lds_byte(wc * 32 + fr, fq * 8);
#define PG8_SA(b, h) (((b) * 2 + (h)) * HTB)
#define PG8_SB(b, h) ((4 + (b) * 2 + (h)) * HTB)
#define qvoffA qstepA
#define qvoffB qstepB
#define PG8_STAGE(bufoff, gbase, voff) do { glds16((const char*)(gbase), voff, ldsb + (unsigned)(bufoff)); glds16((const char*)(gbase) + q##voff, voff, ldsb + (unsigned)(bufoff) + 8192u); } while (0)
#define PG8_LDA(dst, b, h) do { _Pragma("unroll") for (int m = 0; m < 4; ++m) _Pragma("unroll") for (int k = 0; k < 2; ++k) dst[m][k] = *(const PG8_LAS bf16x8*)(lds + PG8_SA(b, h) + aoff + m * 2048 + k * 1024); } while (0)
#define PG8_LDB(dst, b, h) do { _Pragma("unroll") for (int n = 0; n < 2; ++n) _Pragma("unroll") for (int k = 0; k < 2; ++k) dst[n][k] = *(const PG8_LAS bf16x8*)(lds + PG8_SB(b, h) + boff + n * 2048 + k * 1024); } while (0)
#define PG8_MMA(ai, bj, At, Bt) do { __builtin_amdgcn_s_setprio(1); _Pragma("unroll") for (int m = 0; m < 4; ++m) _Pragma("unroll") for (int n = 0; n < 2; ++n) { \
        if constexpr (FP8) acc[ai][bj][m][n] = __builtin_amdgcn_mfma_scale_f32_16x16x128_f8f6f4(cat8(Bt[n][0], Bt[n][1]), cat8(At[m][0], At[m][1]), acc[ai][bj][m][n], 0, 0, 0, 0, 0, 0); \
        else { _Pragma("unroll") for (int k = 0; k < 2; ++k) acc[ai][bj][m][n] = __builtin_amdgcn_mfma_f32_16x16x32_bf16(Bt[n][k], At[m][k], acc[ai][bj][m][n], 0, 0, 0); } } __builtin_amdgcn_s_setprio(0); } while (0)
#define PG8_WAIT_V(n) asm volatile("s_waitcnt vmcnt(" #n ")" ::: "memory")
#define PG8_WAIT_L(n) asm volatile("s_waitcnt lgkmcnt(" #n ")" ::: "memory")
#define PG8_BAR __builtin_amdgcn_s_barrier()
#define PG8_SCHED __builtin_amdgcn_sched_barrier(0)
    Unit cur, nxt; int ui = 0;
    if (!S.next(0, cur)) return;
    f32x4 acc[2][2][4][2];
#pragma unroll
    for (int a = 0; a < 2; ++a)
#pragma unroll
        for (int b = 0; b < 2; ++b)
#pragma unroll
            for (int m = 0; m < 4; ++m)
#pragma unroll
                for (int n = 0; n < 2; ++n) acc[a][b][m][n] = (f32x4){0.f, 0.f, 0.f, 0.f};
    bf16x8 At[4][2], B0[2][2], B1[2][2];
    const char* cA = S.a_base(g, cur, tstepA); const char* cB = S.b_base(g, cur, tstepB);
    S.a_post(cur, S.a_pre(cur, tid), tid);
    if constexpr (SP2) {
        PG8_STAGE(PG8_SB(0, 0), cB, voffB); PG8_STAGE(PG8_SB(0, 1), cB + hstepB, voffB); PG8_STAGE(PG8_SA(0, 0), cA, voffA); PG8_STAGE(PG8_SA(0, 1), cA + hstepA, voffA);
        if (wr == 1) PG8_BAR;
        PG8_WAIT_V(2); PG8_BAR;
        PG8_STAGE(PG8_SB(1, 0), cB + kstepB, voffB); PG8_STAGE(PG8_SA(1, 0), cA + kstepA, voffA); PG8_STAGE(PG8_SB(1, 1), cB + hstepB + kstepB, voffB);
        PG8_WAIT_V(6); PG8_BAR;
    } else {
        PG8_STAGE(PG8_SB(0, 0), cB, voffB); PG8_STAGE(PG8_SA(0, 0), cA, voffA); PG8_STAGE(PG8_SB(0, 1), cB + hstepB, voffB); PG8_STAGE(PG8_SA(0, 1), cA + hstepA, voffA);
        if (wr == 1) PG8_BAR;
        PG8_WAIT_V(4); PG8_BAR;
        PG8_STAGE(PG8_SB(1, 0), cB + kstepB, voffB); PG8_STAGE(PG8_SA(1, 0), cA + kstepA, voffA); PG8_STAGE(PG8_SB(1, 1), cB + hstepB + kstepB, voffB);
        PG8_WAIT_V(6); PG8_BAR;
    }
    for (;;) {
        const bool has_next = S.next(ui + 1, nxt);
        const char* nA = has_next ? S.a_base(g, nxt, tstepA) : cA; const char* nB = has_next ? S.b_base(g, nxt, tstepB) : cB;
        for (int t = 0; t < nt; t += 2) {
            if constexpr (Epi::MIDK) { if (t == (nt >> 1)) E.midk(acc, cur, wr, fr); }
            const bool last = (t == nt - 2);
            const char* a1 = cA + (size_t)(t + 1) * kstepA;
            const char* a2 = last ? nA : cA + (size_t)(t + 2) * kstepA; const char* b2 = last ? nB : cB + (size_t)(t + 2) * kstepB;
            const char* a3 = a2 + kstepA; const char* b3 = b2 + kstepB;
            if constexpr (SP2) {
            PG8_LDB(B0, 0, 0); PG8_LDB(B1, 0, 1); PG8_SCHED; PG8_LDA(At, 0, 0); PG8_STAGE(PG8_SA(1, 1), a1 + hstepA, voffA);
            PG8_WAIT_V(8); PG8_WAIT_L(0); PG8_BAR; PG8_MMA(0, 0, At, B0); PG8_MMA(0, 1, At, B1); PG8_BAR; PG8_SCHED;
            PG8_LDA(At, 0, 1); PG8_STAGE(PG8_SB(0, 0), b2, voffB); PG8_STAGE(PG8_SB(0, 1), b2 + hstepB, voffB); PG8_STAGE(PG8_SA(0, 0), a2, voffA);
            PG8_WAIT_V(8); PG8_WAIT_L(0); PG8_BAR; PG8_MMA(1, 0, At, B0); PG8_MMA(1, 1, At, B1); PG8_BAR; PG8_SCHED;
            PG8_LDB(B0, 1, 0); PG8_LDB(B1, 1, 1); PG8_SCHED; PG8_LDA(At, 1, 0); PG8_STAGE(PG8_SA(0, 1), a2 + hstepA, voffA);
            PG8_WAIT_V(8); PG8_WAIT_L(0); PG8_BAR; PG8_MMA(0, 0, At, B0); PG8_MMA(0, 1, At, B1); PG8_BAR; PG8_SCHED;
            PG8_LDA(At, 1, 1); PG8_STAGE(PG8_SB(1, 0), b3, voffB); PG8_STAGE(PG8_SB(1, 1), b3 + hstepB, voffB); PG8_STAGE(PG8_SA(1, 0), a3, voffA);
            PG8_WAIT_V(8); PG8_WAIT_L(0); PG8_BAR; PG8_MMA(1, 0, At, B0); PG8_MMA(1, 1, At, B1); PG8_BAR; PG8_SCHED;
            } else {
            PG8_LDB(B0, 0, 0); PG8_SCHED; PG8_LDA(At, 0, 0); PG8_STAGE(PG8_SA(1, 1), a1 + hstepA, voffA);
            PG8_WAIT_L(8); PG8_BAR; PG8_WAIT_L(0); PG8_MMA(0, 0, At, B0); PG8_BAR; PG8_SCHED;
            PG8_LDB(B1, 0, 1); PG8_STAGE(PG8_SB(0, 0), b2, voffB);
            PG8_BAR; PG8_WAIT_L(0); PG8_MMA(0, 1, At, B1); PG8_BAR;
            PG8_LDA(At, 0, 1); PG8_STAGE(PG8_SA(0, 0), a2, voffA);
            PG8_BAR; PG8_WAIT_L(0); PG8_MMA(1, 0, At, B0); PG8_BAR; PG8_SCHED;
            PG8_STAGE(PG8_SB(0, 1), b2 + hstepB, voffB);
            PG8_WAIT_V(6); PG8_BAR; PG8_MMA(1, 1, At, B1); PG8_BAR;
            PG8_LDB(B0, 1, 0); PG8_SCHED; PG8_LDA(At, 1, 0); PG8_STAGE(PG8_SA(0, 1), a2 + hstepA, voffA);
            PG8_WAIT_L(8); PG8_BAR; PG8_WAIT_L(0); PG8_MMA(0, 0, At, B0); PG8_BAR; PG8_SCHED;
            PG8_LDB(B1, 1, 1); PG8_STAGE(PG8_SB(1, 0), b3, voffB);
            PG8_BAR; PG8_WAIT_L(0); PG8_MMA(0, 1, At, B1); PG8_BAR;
            PG8_LDA(At, 1, 1); PG8_STAGE(PG8_SA(1, 0), a3, voffA);
            PG8_BAR; PG8_WAIT_L(0); PG8_MMA(1, 0, At, B0); PG8_BAR; PG8_SCHED;
            PG8_STAGE(PG8_SB(1, 1), b3 + hstepB, voffB);
            PG8_WAIT_V(6); PG8_BAR; PG8_MMA(1, 1, At, B1); PG8_BAR;
            }
        }
        if constexpr (ALIGN_EPI) { if (wr == 0) PG8_BAR; }
        int tid2 = wv * 64 + lane_id(); asm volatile("" : "+v"(tid2)); const int fr2 = tid2 & 15, fq2 = (tid2 >> 4) & 3;
        const typename Sched::Pre pre = S.a_pre(has_next ? nxt : cur, tid2);
        if constexpr (!Epi::AFTER_DRAIN) { E(acc, cur, wr, wc, fr2, fq2); S.done(cur); }
        if (has_next) S.a_post(nxt, pre, tid2);
        if (!has_next) break;
#pragma unroll
        for (int a = 0; a < 2; ++a)
#pragma unroll
            for (int b = 0; b < 2; ++b)
#pragma unroll
                for (int m = 0; m < 4; ++m)
#pragma unroll
                    for (int n = 0; n < 2; ++n) acc[a][b][m][n] = (f32x4){0.f, 0.f, 0.f, 0.f};
        cur = nxt; cA = nA; cB = nB; ++ui;
        if constexpr (ALIGN_EPI) { if (wr == 1) PG8_BAR; }
    }
    PG8_WAIT_V(0);
    if constexpr (!ALIGN_EPI) { if (wr == 0) PG8_BAR; }
    PG8_BAR;
    if constexpr (Epi::AFTER_DRAIN) { E.fused(acc, cur, wr, wc, fr, fq, lds, wid, lane); S.done(cur); }
#undef PG8_SA
#undef PG8_SB
#undef PG8_STAGE
#undef qvoffA
#undef qvoffB
#undef PG8_LDA
#undef PG8_LDB
#undef PG8_MMA
#undef PG8_WAIT_V
#undef PG8_WAIT_L
#undef PG8_BAR
#undef PG8_SCHED
}
}
#define GAS __attribute__((address_space(1)))
#define LAS __attribute__((address_space(3)))
typedef unsigned short bf16;
typedef unsigned v4u __attribute__((ext_vector_type(4)));
typedef float f32x4 __attribute__((ext_vector_type(4)));
typedef short bf16x8 __attribute__((ext_vector_type(8)));
typedef GAS unsigned gu32;
typedef GAS unsigned long long gu64;
#define RLX_AGENT __ATOMIC_RELAXED, __HIP_MEMORY_SCOPE_AGENT
#define LDS_WAIT() asm volatile("s_waitcnt lgkmcnt(0)" ::: "memory")
#define VM_WAIT() asm volatile("s_waitcnt vmcnt(0)" ::: "memory")
__device__ __forceinline__ unsigned long long rt() { return __builtin_amdgcn_s_memrealtime(); }
__device__ __forceinline__ unsigned f2bf(float f) { unsigned u = __builtin_bit_cast(unsigned, f); return (u + 0x7fffu + ((u >> 16) & 1u)) >> 16; }
__device__ __forceinline__ unsigned pk2(float lo, float hi) { return pg8::cvt_pk_bf16(lo, hi); }

#define XB_TMO      128
#define XB_XCNT(j)  (256  + 64 * (j))
#define XB_XSUB(j)  (1280 + 64 * (j))
#define XB_XGEN(j)  (2304 + 64 * (j))
#define XB_TOP      3328
#define XB_TOPGEN   3392
#define XCD_BAR_WORDS 3456
#define XB_SPIN_CAP (1u << 18)

__device__ __forceinline__ unsigned xb_ld(unsigned* p)              { return __hip_atomic_load(p, __ATOMIC_RELAXED, __HIP_MEMORY_SCOPE_AGENT); }
__device__ __forceinline__ unsigned xb_add(unsigned* p, unsigned v) { return __hip_atomic_fetch_add(p, v, __ATOMIC_RELAXED, __HIP_MEMORY_SCOPE_AGENT); }
__device__ __forceinline__ unsigned xb_xcc_id() { return (unsigned)__builtin_amdgcn_s_getreg((3 << 11) | 20) & 0xFu; }
#define XB_SPIN(cond, bar) do { unsigned _sp = 0; while (cond) { __builtin_amdgcn_s_sleep(1); \
    if ((++_sp & 255u) == 0u) { if (xb_ld(&(bar)[XB_TMO])) break; if (_sp > XB_SPIN_CAP) { atomicAdd(&(bar)[XB_TMO], 1u); break; } } } } while (0)

struct XcdBarrier {
    unsigned* bar; unsigned x; bool lead;
    volatile LAS unsigned* st;
};

__device__ __forceinline__ XcdBarrier xcd_barrier_post(unsigned* bar, volatile LAS unsigned* st) {
    XcdBarrier b; b.bar = bar; b.x = xb_xcc_id(); b.st = st; b.lead = __builtin_amdgcn_readfirstlane((int)threadIdx.x) < 64;
    if (threadIdx.x == 0) (void)xb_add(&bar[XB_XCNT(b.x)], 1u);
    return b;
}
__device__ __forceinline__ void xcd_barrier_complete(unsigned* bar, unsigned x, unsigned& nloc, unsigned& nx) {
    const unsigned G = gridDim.x * gridDim.y * gridDim.z;
    unsigned sum, cnt, mine, sp = 0u;
    for (;;) {
        sum = 0u; cnt = 0u; mine = 0u;
#pragma unroll
        for (unsigned j = 0; j < 16; ++j) { const unsigned c = xb_ld(&bar[XB_XCNT(j)]); sum += c; cnt += (c > 0u) ? 1u : 0u; mine = (j == x) ? c : mine; }
        if (sum == G) break;
        __builtin_amdgcn_s_sleep(1);
        if ((++sp & 255u) == 0u) { if (xb_ld(&bar[XB_TMO])) break; if (sp > XB_SPIN_CAP) { atomicAdd(&bar[XB_TMO], 1u); break; } }
    }
    nloc = mine > 0u ? mine : 1u; nx = cnt > 0u ? cnt : 1u;
}

__device__ __forceinline__ void xcd_barrier(const XcdBarrier& b) {
    asm volatile("s_waitcnt vmcnt(0)" ::: "memory");
    __syncthreads();
    if (b.lead && pg8::lane_id() == 0) {
        unsigned* bar = b.bar;
        __builtin_amdgcn_s_waitcnt(0);
        unsigned nloc = b.st[0], nx = b.st[1];
        if (nloc == 0u) { xcd_barrier_complete(bar, b.x, nloc, nx); b.st[0] = nloc; b.st[1] = nx; }
        const unsigned old = xb_add(&bar[XB_XSUB(b.x)], 1u);
        const unsigned gen = old / nloc;
        if (old + 1u == (gen + 1u) * nloc) {
            __builtin_amdgcn_fence(__ATOMIC_RELEASE, "agent");
            asm volatile("s_waitcnt vmcnt(0)" ::: "memory");
            const unsigned og = xb_add(&bar[XB_TOP], 1u);
            const unsigned tg = og / nx;
            if (og + 1u == (tg + 1u) * nx) xb_add(&bar[XB_TOPGEN], 1u);
            else XB_SPIN(xb_ld(&bar[XB_TOPGEN]) == tg, bar);
            __builtin_amdgcn_fence(__ATOMIC_ACQUIRE, "agent");
            xb_add(&bar[XB_XGEN(b.x)], 1u);
            asm volatile("s_waitcnt vmcnt(0)" ::: "memory");
        } else {
            XB_SPIN(xb_ld(&bar[XB_XGEN(b.x)]) == gen, bar);
            __builtin_amdgcn_fence(__ATOMIC_ACQUIRE, "agent");
            asm volatile("s_waitcnt vmcnt(0)" ::: "memory");
        }
    }
    __syncthreads();
}

constexpr int NB = 16, SEQ = 4096, DM = 1024, MT = NB * SEQ;
constexpr int DINP = 1792;
constexpr int C_CQ = 0, C_CKV = 256, C_KR = 384, C_QN = 416, C_KVC = 928, C_KVS = 1184, C_KVW = 1440, C_GATE = 1696, DIN = 1720;
constexpr int DFF = 2816, NGU = 2 * DFF;
constexpr int NCMP = 255;
constexpr float EPS = 1e-6f;
constexpr float LOG2E = 1.4426950408889634f;
constexpr float C2Q = 0.10206207261596575f * 1.4426950408889634f;
constexpr float C2N = 0.125f * 1.4426950408889634f;

constexpr int NWAVES = 8, NTHR = 512;
constexpr int NPHASE = 8;
#ifndef MK_N_LAUNCHES
#define MK_N_LAUNCHES 1
#endif
constexpr int N_LAUNCHES = MK_N_LAUNCHES;

constexpr size_t MiB = 1u << 20;
constexpr size_t WS_CTL = 0, CTL_ZERO_BYTES = 1 * MiB;
constexpr size_t WS_WIN = 2 * MiB, WS_WUQ = 6 * MiB, WS_WUKV = 7 * MiB, WS_WOUT = 8 * MiB, WS_WGU = 10 * MiB, WS_WDN = 21 * MiB;
constexpr size_t WS_ROPE = 27 * MiB, WS_BIAS = 27 * MiB + 512 * 1024, WS_BIAS1 = WS_BIAS + 8192;
constexpr size_t WS_RSTDX = 28 * MiB, WS_SSQKV = 29 * MiB, WS_SSATT = 31 * MiB, WS_SSH = 35 * MiB;
constexpr size_t WS_KCMP = 39 * MiB, WS_VCMP = 40 * MiB, WS_KPE = 41 * MiB, WS_OVT = 45 * MiB, WS_W1C = 46 * MiB, WS_W2T = 47 * MiB;
constexpr size_t WS_XB = 64 * MiB, WS_U = 192 * MiB, WS_QM = 420 * MiB, WS_KVM = 516 * MiB, WS_ATT = 644 * MiB, WS_H = 772 * MiB, WS_END = 900 * MiB;
constexpr size_t WS_HID = 64 * MiB;
static_assert(WS_U + (size_t)MT * DINP * 2 <= WS_QM && WS_HID + (size_t)MT * DFF * 2 <= WS_QM && WS_QM + (size_t)MT * 768 * 2 <= WS_KVM && WS_KVM + (size_t)MT * 1024 * 2 <= WS_ATT, "ws map");
constexpr int CW_TMO = 0, CW_BAR = 4096;

constexpr int LDS_BYTES = 163840;
constexpr int MISC_OFF = LDS_BYTES - 256;


typedef unsigned u32x4 __attribute__((ext_vector_type(4))); using pg8::Unit; using pg8::cvt_pk_bf16; using pg8::HALF; using pg8::BM;
typedef float f32x2v __attribute__((ext_vector_type(2)));
typedef unsigned u32x2 __attribute__((ext_vector_type(2)));
__device__ __forceinline__ float bf2f(unsigned short b) { return __builtin_bit_cast(float, (unsigned)b << 16); }
__device__ __forceinline__ float bflo(unsigned w) { return __builtin_bit_cast(float, w << 16); }
__device__ __forceinline__ float bfhi(unsigned w) { return __builtin_bit_cast(float, w & 0xffff0000u); }
__device__ __forceinline__ float sq4(const f32x4 v) { return (v[0] * v[0] + v[1] * v[1]) + (v[2] * v[2] + v[3] * v[3]); }

struct EpiInProj {
    static constexpr bool PERM = true, AFTER_DRAIN = false, MIDK = false;
    pg8::bf16_t* U; const float* rstd; float* ssq;
    __device__ __forceinline__ void operator()(const f32x4 (&acc)[2][2][4][2], const Unit& u, int wr, int wc, int fr, int fq) const {
        const int row0 = u.pm * BM + wr * 64 + fr, col0 = u.pn * BM + wc * 32 + 8 * fq;
#pragma unroll
        for (int ai = 0; ai < 2; ++ai)
#pragma unroll
            for (int m = 0; m < 4; ++m) {
                const int row = row0 + ai * HALF + m * 16; const float r = rstd[row];
                pg8::bf16_t* rowp = U + (size_t)row * DINP + col0; float s0 = 0.f, s1 = 0.f;
#pragma unroll
                for (int bj = 0; bj < 2; ++bj) { const f32x4 v0 = acc[ai][bj][m][0] * r, v1 = acc[ai][bj][m][1] * r;
                    u32x4 w; w.x = cvt_pk_bf16(v0[0], v0[1]); w.y = cvt_pk_bf16(v0[2], v0[3]); w.z = cvt_pk_bf16(v1[0], v1[1]); w.w = cvt_pk_bf16(v1[2], v1[3]);
                    *(u32x4*)(rowp + bj * HALF) = w;
                    const float s = sq4(v0) + sq4(v1); if (bj == 0) s0 = s; else s1 = s; }
                if (u.pn < 2) {
                    float s = (u.pn == 0) ? (s0 + s1) : s0;
                    s += __shfl_xor(s, 16); s += __shfl_xor(s, 32);
                    if (fq == 0) ssq[(size_t)row * 8 + (u.pn == 0 ? 0 : 4) + wc] = s;
                }
            }
    }
};
struct EpiQup {
    static constexpr bool PERM = true, AFTER_DRAIN = false, MIDK = false;
    pg8::bf16_t* Q; const float* ssq; const f32x2v* rope;
    __device__ __forceinline__ void operator()(const f32x4 (&acc)[2][2][4][2], const Unit& u, int wr, int wc, int fr, int fq) const {
        const int row0 = u.pm * BM + wr * 64 + fr, col0 = u.pn * BM + wc * 32 + 8 * fq;
#pragma unroll
        for (int ai = 0; ai < 2; ++ai)
#pragma unroll
            for (int m = 0; m < 4; ++m) {
                const int row = row0 + ai * HALF + m * 16; const int pos = row & (SEQ - 1);
                const f32x4 pp = *(const f32x4*)(ssq + (size_t)row * 8);
                const float r = __builtin_amdgcn_rsqf(((pp[0] + pp[1]) + (pp[2] + pp[3])) * (1.0f / 256.0f) + EPS) * C2Q;
#pragma unroll
                for (int bj = 0; bj < 2; ++bj) { const int c = col0 + bj * HALF; const int d = c % 96;
                    f32x4 v0 = acc[ai][bj][m][0] * r, v1 = acc[ai][bj][m][1] * r;
                    if (d >= 64) { const int i0 = (d - 64) >> 1; const f32x2v* rp = rope + pos * 16 + i0;
                        const f32x2v a = rp[0], b = rp[1], e = rp[2], f = rp[3];
                        f32x4 w0, w1;
                        w0[0] = v0[0] * a.x - v0[1] * a.y; w0[1] = v0[0] * a.y + v0[1] * a.x;
                        w0[2] = v0[2] * b.x - v0[3] * b.y; w0[3] = v0[2] * b.y + v0[3] * b.x;
                        w1[0] = v1[0] * e.x - v1[1] * e.y; w1[1] = v1[0] * e.y + v1[1] * e.x;
                        w1[2] = v1[2] * f.x - v1[3] * f.y; w1[3] = v1[2] * f.y + v1[3] * f.x;
                        v0 = w0; v1 = w1; }
                    u32x4 w; w.x = cvt_pk_bf16(v0[0], v0[1]); w.y = cvt_pk_bf16(v0[2], v0[3]); w.z = cvt_pk_bf16(v1[0], v1[1]); w.w = cvt_pk_bf16(v1[2], v1[3]);
                    *(u32x4*)(Q + (size_t)row * 768 + c) = w; }
                asm volatile("" ::: "memory");
            }
    }
};
struct EpiKVup {
    static constexpr bool PERM = true, AFTER_DRAIN = false, MIDK = false;
    pg8::bf16_t* KV; const float* ssq;
    __device__ __forceinline__ void operator()(const f32x4 (&acc)[2][2][4][2], const Unit& u, int wr, int wc, int fr, int fq) const {
        const int row0 = u.pm * BM + wr * 64 + fr, col0 = u.pn * BM + wc * 32 + 8 * fq;
#pragma unroll
        for (int ai = 0; ai < 2; ++ai)
#pragma unroll
            for (int m = 0; m < 4; ++m) {
                const int row = row0 + ai * HALF + m * 16;
                const f32x4 pp = *(const f32x4*)(ssq + (size_t)row * 8 + 4);
                const float r = __builtin_amdgcn_rsqf(((pp[0] + pp[1]) + (pp[2] + pp[3])) * (1.0f / 128.0f) + EPS);
#pragma unroll
                for (int bj = 0; bj < 2; ++bj) { const f32x4 v0 = acc[ai][bj][m][0] * r, v1 = acc[ai][bj][m][1] * r;
                    u32x4 w; w.x = cvt_pk_bf16(v0[0], v0[1]); w.y = cvt_pk_bf16(v0[2], v0[3]); w.z = cvt_pk_bf16(v1[0], v1[1]); w.w = cvt_pk_bf16(v1[2], v1[3]);
                    *(u32x4*)(KV + (size_t)row * 1024 + col0 + bj * HALF) = w; }
                if (m & 1) asm volatile("" ::: "memory");
            }
    }
};
constexpr int OUT_TAB_OFF = 131072;
struct OutOrder : pg8::StaticOrder {
    const float* ssatt; LAS float* tab;
    struct Pre { f32x4 a, b; };
    __device__ __forceinline__ Pre a_pre(const Unit& u, int tid) const {
        const int row = tid >> 1, which = tid & 1;
        const f32x4* pp = (const f32x4*)(ssatt + (size_t)(u.pm * BM + row) * 16 + which * 8); return Pre{pp[0], pp[1]};
    }
    __device__ __forceinline__ void a_post(const Unit& u, const Pre& p, int tid) const {
        const int row = tid >> 1, which = tid & 1; const f32x4 a = p.a, b = p.b;
        const float r = __builtin_amdgcn_rsqf((((a[0] + a[1]) + (a[2] + a[3])) + ((b[0] + b[1]) + (b[2] + b[3]))) * (1.0f / 512.0f) + EPS);
        const float o = __shfl_xor(r, 1);
        if (which == 0) { LAS float* t = tab + (u.ui & 1) * 512 + row * 2; t[0] = r / o; t[1] = o; }
    }
};
struct EpiOut {
    static constexpr bool PERM = true, AFTER_DRAIN = false, MIDK = true;
    const pg8::bf16_t* xb; pg8::bf16_t* H; unsigned char* H8; float* ssh; const LAS float* tab;
    __device__ __forceinline__ void midk(f32x4 (&acc)[2][2][4][2], const Unit& u, int wr, int fr) const {
        const LAS float* t = tab + (u.ui & 1) * 512 + (wr * 64 + fr) * 2;
#pragma unroll
        for (int ai = 0; ai < 2; ++ai)
#pragma unroll
            for (int m = 0; m < 4; ++m) { const float ratio = t[(ai * HALF + m * 16) * 2];
#pragma unroll
                for (int bj = 0; bj < 2; ++bj) { acc[ai][bj][m][0] *= ratio; acc[ai][bj][m][1] *= ratio; } }
    }
    __device__ __forceinline__ void operator()(const f32x4 (&acc)[2][2][4][2], const Unit& u, int wr, int wc, int fr, int fq) const {
        const int row0 = u.pm * BM + wr * 64 + fr, col0 = u.pn * BM + wc * 32 + 8 * fq;
        const LAS float* t = tab + (u.ui & 1) * 512 + (wr * 64 + fr) * 2 + 1;
#pragma unroll
        for (int ai = 0; ai < 2; ++ai)
#pragma unroll
            for (int m = 0; m < 4; ++m) {
                const int row = row0 + ai * HALF + m * 16; const float r = t[(ai * HALF + m * 16) * 2];
                float s = 0.f;
#pragma unroll
                for (int bj = 0; bj < 2; ++bj) { const size_t off = (size_t)row * DM + col0 + bj * HALF;
                    const u32x4 xw = *(const u32x4*)(xb + off);
                    f32x4 x0, x1; x0[0] = bflo(xw.x); x0[1] = bfhi(xw.x); x0[2] = bflo(xw.y); x0[3] = bfhi(xw.y); x1[0] = bflo(xw.z); x1[1] = bfhi(xw.z); x1[2] = bflo(xw.w); x1[3] = bfhi(xw.w);
                    const f32x4 v0 = x0 + acc[ai][bj][m][0] * r, v1 = x1 + acc[ai][bj][m][1] * r;
                    u32x4 w; w.x = cvt_pk_bf16(v0[0], v0[1]); w.y = cvt_pk_bf16(v0[2], v0[3]); w.z = cvt_pk_bf16(v1[0], v1[1]); w.w = cvt_pk_bf16(v1[2], v1[3]);
                    *(u32x4*)(H + off) = w; s += sq4(v0) + sq4(v1);
                    u32x2 w8; w8.x = pg8::cvt_pk4_fp8(v0[0], v0[1], v0[2], v0[3]); w8.y = pg8::cvt_pk4_fp8(v1[0], v1[1], v1[2], v1[3]); *(u32x2*)(H8 + off) = w8; }
                s += __shfl_xor(s, 16); s += __shfl_xor(s, 32);
                if (fq == 0) ssh[(size_t)row * 16 + u.pn * 4 + wc] = s;
                if (m & 1) asm volatile("" ::: "memory");
            }
    }
};
struct GUOrder : pg8::StaticOrder {
    const float* ssh; LAS float* tab;
    struct Pre { f32x4 a, b; };
    __device__ __forceinline__ Pre a_pre(const Unit& u, int tid) const {
        const int row = tid >> 1, which = tid & 1;
        const f32x4* pp = (const f32x4*)(ssh + (size_t)(u.pm * BM + row) * 16 + which * 8); return Pre{pp[0], pp[1]};
    }
    __device__ __forceinline__ void a_post(const Unit& u, const Pre& p, int tid) const {
        const int row = tid >> 1, which = tid & 1; const f32x4 a = p.a, b = p.b;
        float s = ((a[0] + a[1]) + (a[2] + a[3])) + ((b[0] + b[1]) + (b[2] + b[3]));
        s += __shfl_xor(s, 1);
        if (which == 0) tab[(u.ui & 1) * 256 + row] = __builtin_amdgcn_rsqf(s * (1.0f / 1024.0f) + EPS) * (1.0f / 128.0f);
    }
};
struct EpiGU {
    static constexpr bool PERM = true, AFTER_DRAIN = false, MIDK = false;
    unsigned char* HID; const LAS float* tab;
    __device__ __forceinline__ void operator()(const f32x4 (&acc)[2][2][4][2], const Unit& u, int wr, int wc, int fr, int fq) const {
        const int row0 = u.pm * BM + wr * 64 + fr, col0 = u.pn * HALF + wc * 32 + 8 * fq;
        const LAS float* t = tab + (u.ui & 1) * 256 + wr * 64 + fr;
#pragma unroll
        for (int ai = 0; ai < 2; ++ai)
#pragma unroll
            for (int m = 0; m < 4; ++m) {
                const int row = row0 + ai * HALF + m * 16; const float r = t[ai * HALF + m * 16];
                float o[8];
#pragma unroll
                for (int n = 0; n < 2; ++n)
#pragma unroll
                    for (int e = 0; e < 4; ++e) { const float g = acc[ai][0][m][n][e] * r, up = acc[ai][1][m][n][e] * r;
                        const float sg = g * __builtin_amdgcn_rcpf(1.0f + __builtin_amdgcn_exp2f(-g * LOG2E)); o[n * 4 + e] = __builtin_amdgcn_fmed3f(sg * up, -448.0f, 448.0f); }
                u32x2 w; w.x = pg8::cvt_pk4_fp8(o[0], o[1], o[2], o[3]); w.y = pg8::cvt_pk4_fp8(o[4], o[5], o[6], o[7]);
                *(u32x2*)(HID + (size_t)row * DFF + col0) = w;
            }
    }
};
struct EpiDown {
    static constexpr bool PERM = true, AFTER_DRAIN = false, MIDK = false;
    const pg8::bf16_t* H; pg8::bf16_t* H2; float* ss2;
    __device__ __forceinline__ void operator()(const f32x4 (&acc)[2][2][4][2], const Unit& u, int wr, int wc, int fr, int fq) const {
        const int row0 = u.pm * BM + wr * 64 + fr, col0 = u.pn * BM + wc * 32 + 8 * fq;
#pragma unroll
        for (int ai = 0; ai < 2; ++ai)
#pragma unroll
            for (int m = 0; m < 4; ++m) {
                const int row = row0 + ai * HALF + m * 16; float s = 0.f;
#pragma unroll
                for (int bj = 0; bj < 2; ++bj) { const size_t off = (size_t)row * DM + col0 + bj * HALF;
                    const u32x4 hw = *(const u32x4*)(H + off);
                    f32x4 h0, h1; h0[0] = bflo(hw.x); h0[1] = bfhi(hw.x); h0[2] = bflo(hw.y); h0[3] = bfhi(hw.y); h1[0] = bflo(hw.z); h1[1] = bfhi(hw.z); h1[2] = bflo(hw.w); h1[3] = bfhi(hw.w);
                    h0 += acc[ai][bj][m][0] * (1.0f / 128.0f); h1 += acc[ai][bj][m][1] * (1.0f / 128.0f);
                    u32x4 w; w.x = cvt_pk_bf16(h0[0], h0[1]); w.y = cvt_pk_bf16(h0[2], h0[3]); w.z = cvt_pk_bf16(h1[0], h1[1]); w.w = cvt_pk_bf16(h1[2], h1[3]);
                    *(u32x4*)(H2 + off) = w; s += sq4(h0) + sq4(h1); }
                s += __shfl_xor(s, 16); s += __shfl_xor(s, 32);
                if (fq == 0) ss2[(size_t)row * 16 + u.pn * 4 + wc] = s;
                if (m & 1) asm volatile("" ::: "memory");
            }
    }
};

struct Args { const float* in[22]; float* out; unsigned char* ws; int ph_lo, ph_hi, li, pad; };
enum { I_X = 0, I_GMIX, I_WIN, I_GQ, I_WUQ, I_GKV, I_WUKV, I_POSK, I_W1K, I_W2K, I_POSV, I_W1V, I_W2V, I_T5, I_GOM, I_GON, I_WOUT, I_GFFN, I_WG, I_WU, I_WD, I_GFIN };

__device__ __forceinline__ float wave_sum(float v) {
#pragma unroll
    for (int o = 1; o < 64; o <<= 1) v += __shfl_xor(v, o);
    return v;
}
typedef __bf16 bf16x2_t __attribute__((ext_vector_type(2)));
__device__ __forceinline__ float dot2(unsigned a, unsigned b, float c) { return __builtin_amdgcn_fdot2_f32_bf16(__builtin_bit_cast(bf16x2_t, a), __builtin_bit_cast(bf16x2_t, b), c, false); }

template <class F> __device__ __forceinline__ void tr_item(F f, bf16* WT, int ldk, int nblk, LAS float* scr, int item, int lane) {
    const int kb = item / nblk, nb = item % nblk, k0 = 64 * kb, n0 = 32 * nb;
#pragma unroll 8
    for (int i = 0; i < 32; ++i) { const int kk = 2 * i + (lane >> 5); scr[kk * 33 + (lane & 31)] = f(k0 + kk, n0 + (lane & 31)); }
    LDS_WAIT(); asm volatile("" ::: "memory");
    const int c = lane & 7;
#pragma unroll
    for (int j = 0; j < 4; ++j) { const int n = (lane >> 3) + 8 * j; const LAS float* s = scr + (8 * c) * 33 + n;
        v4u o; o.x = pk2(s[0 * 33], s[1 * 33]); o.y = pk2(s[2 * 33], s[3 * 33]); o.z = pk2(s[4 * 33], s[5 * 33]); o.w = pk2(s[6 * 33], s[7 * 33]);
        *(GAS v4u*)(WT + (size_t)(n0 + n) * ldk + k0 + 8 * c) = o; }
    LDS_WAIT(); asm volatile("" ::: "memory");
}
template <class F> __device__ __forceinline__ void tr_item8(F f, unsigned char* WT, int ldk, int nblk, LAS float* scr, int item, int lane) {
    const int kb = item / nblk, nb = item % nblk, k0 = 64 * kb, n0 = 32 * nb;
#pragma unroll 8
    for (int i = 0; i < 32; ++i) { const int kk = 2 * i + (lane >> 5); scr[kk * 33 + (lane & 31)] = f(k0 + kk, n0 + (lane & 31)); }
    LDS_WAIT(); asm volatile("" ::: "memory");
    const int c = lane & 7;
#pragma unroll
    for (int j = 0; j < 4; ++j) { const int n = (lane >> 3) + 8 * j; const LAS float* s = scr + (8 * c) * 33 + n;
        u32x2 o; o.x = pg8::cvt_pk4_fp8(s[0 * 33], s[1 * 33], s[2 * 33], s[3 * 33]); o.y = pg8::cvt_pk4_fp8(s[4 * 33], s[5 * 33], s[6 * 33], s[7 * 33]);
        *(GAS u32x2*)(WT + (size_t)(n0 + n) * ldk + k0 + 8 * c) = o; }
    LDS_WAIT(); asm volatile("" ::: "memory");
}
__device__ __forceinline__ int t5_bucket(int n) {
    if (n < 16) return n;
    int b = 16; b += n >= 19; b += n >= 21; b += n >= 24; b += n >= 27; b += n >= 31; b += n >= 35; b += n >= 40; b += n >= 46; b += n >= 52; b += n >= 59; b += n >= 67; b += n >= 77; b += n >= 87; b += n >= 99; b += n >= 113;
    return b;
}
__device__ __forceinline__ float gelu_tanh(float x) {
    const float y = 0.7978845608028654f * (x + 0.044715f * x * x * x);
    const float e = __builtin_amdgcn_exp2f(2.0f * LOG2E * y);
    const float th = 1.0f - 2.0f * __builtin_amdgcn_rcpf(e + 1.0f);
    return 0.5f * x * (1.0f + th);
}

struct Ptrs {
    const float* in[22]; float* out; unsigned char* ws;
    bf16 *Win, *Wuq, *Wukv, *Wout, *Wgu, *Wdn; f32x2v* rope; float *bias, *bias1, *rstdx, *ssqkv, *ssatt, *ssh;
    bf16 *kcmp, *vcmp, *kpe, *ovt, *W1c, *W2t, *XB, *U, *QM, *KVM, *ATT, *H, *HID;
};

__device__ __forceinline__ void p0_prologue(const Ptrs& P, LAS unsigned char* lds, int wg, int G, int wave, int lane, int tid) {
    LAS float* scr = (LAS float*)(lds + wave * 16384);
    const int gw = wg * NWAVES + wave, NGW = G * NWAVES;
    constexpr int I_IN = (1024 / 64) * (DINP / 32), I_UQ = (256 / 64) * (768 / 32), I_UKV = (256 / 64) * (1024 / 32), I_OUT = (1024 / 64) * (1024 / 32), I_GU = (1024 / 64) * (NGU / 32), I_DN = (DFF / 64) * (1024 / 32);
    constexpr int I_W1C = 2 * (1024 / 64) * (256 / 32), I_W2T = 2 * (128 / 64) * (64 / 32);
    constexpr int NITEMS = I_IN + I_UQ + I_UKV + I_OUT + I_GU + I_DN + I_W1C + I_W2T;
    for (int it = gw; it < NITEMS; it += NGW) {
        int r = it;
        if (r < I_IN) { const float* W = P.in[I_WIN]; const float* g = P.in[I_GMIX];
            tr_item([=](int k, int n) -> float { if (n >= DIN) return 0.f; const float s = (n >= C_QN && n < C_KVC) ? C2N : 1.0f; return W[(size_t)k * DIN + n] * g[k] * s; }, P.Win, 1024, DINP / 32, scr, r, lane); continue; } r -= I_IN;
        if (r < I_UQ) { const float* W = P.in[I_WUQ]; const float* g = P.in[I_GQ];
            tr_item([=](int k, int n) -> float { const int h = n / 96, d = n % 96; int src = n; if (d >= 64) { const int e = d - 64; src = h * 96 + 64 + (e & 1) * 16 + (e >> 1); } return W[(size_t)k * 768 + src] * g[k]; }, P.Wuq, 256, 768 / 32, scr, r, lane); continue; } r -= I_UQ;
        if (r < I_UKV) { const float* W = P.in[I_WUKV]; const float* g = P.in[I_GKV];
            tr_item([=](int k, int n) -> float { return k < 128 ? W[(size_t)k * 1024 + n] * g[k] : 0.f; }, P.Wukv, 256, 1024 / 32, scr, r, lane); continue; } r -= I_UKV;
        if (r < I_OUT) { const float* W = P.in[I_WOUT]; const float* g1 = P.in[I_GOM]; const float* g2 = P.in[I_GON];
            tr_item([=](int k, int n) -> float { return W[(size_t)k * 1024 + n] * (k < 512 ? g1[k] : g2[k - 512]); }, P.Wout, 1024, 1024 / 32, scr, r, lane); continue; } r -= I_OUT;
        if (r < I_GU) { const float* g = P.in[I_GFFN]; const bool up = ((r % (NGU / 32)) & 4) != 0;
            if (!up) { const float* W = P.in[I_WG]; tr_item8([=](int k, int n) -> float { return W[(size_t)k * DFF + (n >> 8) * 128 + (n & 127)] * (g[k] * 128.0f); }, (unsigned char*)P.Wgu, 1024, NGU / 32, scr, r, lane); }
            else { const float* W = P.in[I_WU]; tr_item8([=](int k, int n) -> float { return W[(size_t)k * DFF + (n >> 8) * 128 + (n & 127)] * (g[k] * 128.0f); }, (unsigned char*)P.Wgu, 1024, NGU / 32, scr, r, lane); }
            continue; } r -= I_GU;
        if (r < I_DN) { const float* W = P.in[I_WD];
            tr_item8([=](int k, int n) -> float { return W[(size_t)k * 1024 + n] * 128.0f; }, (unsigned char*)P.Wdn, DFF, 1024 / 32, scr, r, lane); continue; } r -= I_DN;
        if (r < I_W1C) { const int kv = r >= I_W1C / 2; if (kv) r -= I_W1C / 2;
            if (!kv) { const float* W = P.in[I_W1K]; tr_item([=](int k, int n) -> float { return W[(size_t)(k + ((n >> 7) << 10)) * 128 + (n & 127)]; }, P.W1c, 1024, 256 / 32, scr, r, lane); }
            else { const float* W = P.in[I_W1V]; tr_item([=](int k, int n) -> float { return W[(size_t)(k + ((n >> 7) << 10)) * 128 + (n & 127)]; }, P.W1c + 256 * 1024, 1024, 256 / 32, scr, r, lane); }
            continue; } r -= I_W1C;
        { const int kv = r >= I_W2T / 2; if (kv) r -= I_W2T / 2;
            if (!kv) { const float* W = P.in[I_W2K]; tr_item([=](int k, int n) -> float { return W[(size_t)k * 64 + n]; }, P.W2t, 128, 64 / 32, scr, r, lane); }
            else { const float* W = P.in[I_W2V]; tr_item([=](int k, int n) -> float { return W[(size_t)k * 64 + n]; }, P.W2t + 64 * 128, 128, 64 / 32, scr, r, lane); } }
    }
    const int gt = wg * NTHR + tid, NGT = G * NTHR;
    for (int e = gt; e < SEQ * 16; e += NGT) { const int pos = e >> 4, i = e & 15;
        const float inv = __builtin_amdgcn_exp2f(-(float)i * (13.287712379549449f / 16.0f));
        const float ang = (float)pos * inv;
        double rev = (double)ang * 0.15915494309189535; rev -= __builtin_floor(rev);
        const float fr = (float)rev;
        P.rope[e] = (f32x2v){__builtin_amdgcn_cosf(fr), __builtin_amdgcn_sinf(fr)}; }
    for (int e = gt; e < 8 * 128; e += NGT) { const int h = e >> 7, d = e & 127; P.bias[e] = P.in[I_T5][t5_bucket(d) * 8 + h] * LOG2E; }
    for (int e = gt; e < 256 * 64; e += NGT) { const int i = e >> 6, j = e & 63; float w = 0.f; if (j == (i >> 2)) w += ((i & 3) == 3) ? 1.f : 2.f; if ((i & 3) == 3 && j == (i >> 2) + 1) w += 1.f;
        P.ovt[e] = (bf16)(__float_as_uint(w) >> 16); }
    for (int o = gw; o < 256; o += NGW) { const int kv = o >> 7, j = o & 127; const float* pos = P.in[kv ? I_POSV : I_POSK]; const float* w1 = P.in[kv ? I_W1V : I_W1K];
        float s = 0.f; for (int k = lane; k < 2048; k += 64) s += pos[k] * w1[(size_t)k * 128 + j];
        s = wave_sum(s); if (lane == 0) P.bias1[o] = s; }
    for (int m0 = gw * 4; m0 < MT; m0 += NGW * 4) {
        f32x4 v[4][4];
#pragma unroll
        for (int q = 0; q < 4; ++q) { const GAS f32x4* xr = (const GAS f32x4*)(P.in[I_X] + (size_t)(m0 + q) * DM) + lane;
#pragma unroll
            for (int j = 0; j < 4; ++j) v[q][j] = __builtin_nontemporal_load(xr + 64 * j); }
#pragma unroll
        for (int q = 0; q < 4; ++q) { float s = 0.f;
#pragma unroll
            for (int j = 0; j < 4; ++j) s += sq4(v[q][j]);
            s = wave_sum(s);
            if (lane == 0) P.rstdx[m0 + q] = __builtin_amdgcn_rsqf(s * (1.0f / DM) + EPS);
            GAS unsigned long long* o8 = (GAS unsigned long long*)(P.XB + (size_t)(m0 + q) * DM) + lane;
#pragma unroll
            for (int j = 0; j < 4; ++j) o8[64 * j] = (unsigned long long)pk2(v[q][j][0], v[q][j][1]) | ((unsigned long long)pk2(v[q][j][2], v[q][j][3]) << 32); }
    }
}

__device__ __forceinline__ void p2_kpe(const Ptrs& P, int wg, int G, int tid) {
    const int gt = wg * NTHR + tid, NGT = G * NTHR;
    for (int e = gt; e < MT * 16; e += NGT) { const int row = e >> 4, i = e & 15; const int pos = row & (SEQ - 1);
        const float x1 = bf2f(P.U[(size_t)row * DINP + C_KR + i]), x2 = bf2f(P.U[(size_t)row * DINP + C_KR + 16 + i]);
        const f32x2v cs = P.rope[pos * 16 + i];
        *(unsigned*)(P.kpe + (size_t)row * 32 + 2 * i) = pk2(x1 * cs.x - x2 * cs.y, x1 * cs.y + x2 * cs.x); }
}
__device__ __forceinline__ void p7_final(const Ptrs& P, int wg, int G, int wave, int lane) {
    const int gw = wg * NWAVES + wave, NGW = G * NWAVES;
    const GAS f32x4* gp = (const GAS f32x4*)P.in[I_GFIN] + 2 * lane; f32x4 gg[4][2];
#pragma unroll
    for (int j = 0; j < 2; ++j) { gg[j][0] = gp[128 * j]; gg[j][1] = gp[128 * j + 1]; }
    for (int m0 = gw * 4; m0 < MT; m0 += NGW * 4) {
        u32x4 w0[4], w1[4]; float pv[4];
#pragma unroll
        for (int q = 0; q < 4; ++q) { const GAS u32x4* hr = (const GAS u32x4*)(P.ATT + (size_t)(m0 + q) * DM) + lane;
            w0[q] = hr[0]; w1[q] = hr[64]; pv[q] = (lane < 16) ? P.ssatt[(size_t)(m0 + q) * 16 + lane] : 0.f; }
#pragma unroll
        for (int q = 0; q < 4; ++q) {
            const float r = __builtin_amdgcn_rsqf(wave_sum(pv[q]) * (1.0f / DM) + EPS);
            GAS f32x4* o = (GAS f32x4*)(P.out + (size_t)(m0 + q) * DM) + 2 * lane;
            { const u32x4 w = w0[q]; f32x4 a, b; a[0] = bflo(w.x); a[1] = bfhi(w.x); a[2] = bflo(w.y); a[3] = bfhi(w.y); b[0] = bflo(w.z); b[1] = bfhi(w.z); b[2] = bflo(w.w); b[3] = bfhi(w.w);
              o[0] = a * r * gg[0][0]; o[1] = b * r * gg[0][1]; }
            { const u32x4 w = w1[q]; f32x4 a, b; a[0] = bflo(w.x); a[1] = bfhi(w.x); a[2] = bflo(w.y); a[3] = bfhi(w.y); b[0] = bflo(w.z); b[1] = bfhi(w.z); b[2] = bflo(w.w); b[3] = bfhi(w.w);
              o[128] = a * r * gg[1][0]; o[129] = b * r * gg[1][1]; } }
    }
}

struct CmpOrder {
    int G, c; const bf16* U; const bf16* W1c;
    __device__ __forceinline__ bool next(int i, Unit& u) const { const int un = c + i * G; if (un >= 64) return false; u.pm = un; u.pn = 0; u.ui = i; return true; }
    struct Pre {};
    __device__ __forceinline__ Pre a_pre(const Unit&, int) const { return Pre{}; }
    __device__ __forceinline__ void a_post(const Unit&, const Pre&, int) const {}
    __device__ __forceinline__ void done(const Unit&) const {}
    __device__ __forceinline__ const char* a_base(const pg8::Gemm&, const Unit& u, size_t) const { const int bh = u.pm >> 1, kv = u.pm & 1;
        return (const char*)(U + (size_t)(bh >> 1) * SEQ * DINP + C_KVC + kv * 128 + (bh & 1) * 64); }
    __device__ __forceinline__ const char* b_base(const pg8::Gemm&, const Unit& u, size_t) const { return (const char*)(W1c + (size_t)(u.pm & 1) * 256 * 1024); }
};
struct EpiCmp {
    static constexpr bool PERM = true, AFTER_DRAIN = true, MIDK = false;
    const float* bias1; const bf16* W2t; bf16* kcmp; bf16* vcmp;
    __device__ __forceinline__ void operator()(const f32x4 (&)[2][2][4][2], const Unit&, int, int, int, int) const {}
    __device__ __forceinline__ void fused(f32x4 (&acc)[2][2][4][2], const Unit& u, int wr, int wc, int fr, int fq, LAS unsigned char* lds, int wid, int lane) const {
        typedef short bf16x8_t __attribute__((ext_vector_type(8))); typedef float f32x16_t __attribute__((ext_vector_type(16)));
        const int bh = u.pm >> 1, kv = u.pm & 1; const int col = wc * 32 + 8 * fq;
        LAS float* OB = (LAS float*)lds;
#pragma unroll
        for (int ai = 0; ai < 2; ++ai)
#pragma unroll
            for (int m = 0; m < 4; ++m) { const int r = ai * HALF + wr * 64 + m * 16 + fr;
                *(LAS f32x4*)(OB + r * 132 + col) = acc[ai][1][m][0]; *(LAS f32x4*)(OB + r * 132 + col + 4) = acc[ai][1][m][1]; }
        const f32x4 bs0 = *(const f32x4*)(bias1 + kv * 128 + col), bs1 = *(const f32x4*)(bias1 + kv * 128 + col + 4);
        asm volatile("s_waitcnt lgkmcnt(0)" ::: "memory"); __builtin_amdgcn_s_barrier(); asm volatile("" ::: "memory");
#pragma unroll
        for (int ai = 0; ai < 2; ++ai)
#pragma unroll
            for (int m = 0; m < 4; ++m) { const int r = ai * HALF + wr * 64 + m * 16 + fr, r1 = r < 255 ? r + 1 : 255;
                const f32x4 b0 = *(const LAS f32x4*)(OB + r1 * 132 + col), b1 = *(const LAS f32x4*)(OB + r1 * 132 + col + 4);
                f32x4 h0 = acc[ai][0][m][0] + b0 + bs0, h1 = acc[ai][0][m][1] + b1 + bs1;
#pragma unroll
                for (int e = 0; e < 4; ++e) { h0[e] = gelu_tanh(h0[e]); h1[e] = gelu_tanh(h1[e]); }
                acc[ai][0][m][0] = h0; acc[ai][0][m][1] = h1; }
        asm volatile("s_waitcnt lgkmcnt(0)" ::: "memory"); __builtin_amdgcn_s_barrier(); asm volatile("" ::: "memory");
        LAS bf16* GB = (LAS bf16*)lds;
#pragma unroll
        for (int ai = 0; ai < 2; ++ai)
#pragma unroll
            for (int m = 0; m < 4; ++m) { const int r = ai * HALF + wr * 64 + m * 16 + fr; const f32x4 h0 = acc[ai][0][m][0], h1 = acc[ai][0][m][1];
                u32x4 w; w.x = pk2(h0[0], h0[1]); w.y = pk2(h0[2], h0[3]); w.z = pk2(h1[0], h1[1]); w.w = pk2(h1[2], h1[3]);
                *(LAS u32x4*)(GB + r * 136 + col) = w; }
        asm volatile("s_waitcnt lgkmcnt(0)" ::: "memory"); __builtin_amdgcn_s_barrier(); asm volatile("" ::: "memory");
        const int r32 = lane & 31, hi = lane >> 5, c = wid * 32 + r32;
        f32x16_t o[2]; o[0] = f32x16_t{}; o[1] = f32x16_t{};
        const bf16* w2 = W2t + (size_t)kv * 64 * 128;
#pragma unroll
        for (int s = 0; s < 8; ++s) { const bf16x8_t gb = *(const LAS bf16x8_t*)(GB + c * 136 + 16 * s + 8 * hi);
#pragma unroll
            for (int dt = 0; dt < 2; ++dt) { const bf16x8_t wa = *(const bf16x8_t*)(w2 + (size_t)(32 * dt + r32) * 128 + 16 * s + 8 * hi);
                o[dt] = __builtin_amdgcn_mfma_f32_32x32x16_bf16(wa, gb, o[dt], 0, 0, 0); } }
        if (c < NCMP) { bf16* op = (kv ? vcmp : kcmp) + ((size_t)bh * 256 + c) * 64 + 4 * hi;
#pragma unroll
            for (int dt = 0; dt < 2; ++dt)
#pragma unroll
                for (int k = 0; k < 4; ++k) *(unsigned long long*)(op + 32 * dt + 8 * k) = (unsigned long long)pk2(o[dt][4 * k], o[dt][4 * k + 1]) | ((unsigned long long)pk2(o[dt][4 * k + 2], o[dt][4 * k + 3]) << 32); }
        asm volatile("s_waitcnt lgkmcnt(0)" ::: "memory"); __builtin_amdgcn_s_barrier();
    }
};

namespace att {
typedef short bf16x8 __attribute__((ext_vector_type(8)));
typedef short s16x4 __attribute__((ext_vector_type(4)));
typedef float f32x16 __attribute__((ext_vector_type(16)));
typedef __attribute__((address_space(3))) const char* lds_cptr;
constexpr float THR = 8.0f;
constexpr float NEG_INF = -__builtin_inff();
__device__ __forceinline__ int crow(int r, int hi) { return (r & 3) + 8 * (r >> 2) + 4 * hi; }
__device__ __forceinline__ float swap_max(float x) { auto rr = __builtin_amdgcn_permlane32_swap(__float_as_uint(x), __float_as_uint(x), false, false); return fmaxf(__uint_as_float(rr[0]), __uint_as_float(rr[1])); }
__device__ __forceinline__ float swap_sum(float x) { auto rr = __builtin_amdgcn_permlane32_swap(__float_as_uint(x), __float_as_uint(x), false, false); return __uint_as_float(rr[0]) + __uint_as_float(rr[1]); }
__device__ __forceinline__ float partner32(float x, int hi) { auto rr = __builtin_amdgcn_permlane32_swap(__float_as_uint(x), __float_as_uint(x), false, false); return __uint_as_float(hi ? rr[0] : rr[1]); }
__device__ __forceinline__ unsigned partner32u(unsigned x, int hi) { auto rr = __builtin_amdgcn_permlane32_swap(x, x, false, false); return hi ? rr[0] : rr[1]; }
__device__ __forceinline__ void dma16(const void* g, LAS unsigned char* l) { unsigned keep; const unsigned dst = (unsigned)__builtin_amdgcn_readfirstlane((int)(unsigned)(uintptr_t)l);
    asm volatile("s_mov_b32 %0, m0\n\ts_mov_b32 m0, %2\n\ts_nop 0\n\tglobal_load_lds_dwordx4 %1, off\n\ts_mov_b32 m0, %0" : "=&s"(keep) : "v"(g), "s"(dst) : "memory"); }
template <int N> __device__ __forceinline__ void wait_bar() { if (N == 3) asm volatile("s_waitcnt vmcnt(3) lgkmcnt(0)\n\ts_barrier" ::: "memory"); else if (N == 2) asm volatile("s_waitcnt vmcnt(2) lgkmcnt(0)\n\ts_barrier" ::: "memory"); else asm volatile("s_waitcnt vmcnt(0) lgkmcnt(0)\n\ts_barrier" ::: "memory"); }

struct SrcMLA {
    static constexpr int DK = 96, NDMA = 3, NV = 1;
    const bf16* kn; const bf16* kp; const bf16* v;
    __device__ __forceinline__ void init(const bf16* KVM, const bf16* KPE, size_t rowb, int h, int wid, int lane) {
        kn = KVM + (rowb + lane) * 1024 + h * 128 + 8 * wid;
        kp = KPE + (rowb + lane) * 32 + 8 * (wid & 3);
        v = KVM + (rowb + 16 * (wid & 3) + (lane >> 2)) * 1024 + h * 128 + 64 + (wid >> 2) * 32 + (lane & 3) * 8; }
    static constexpr int NKD = 2;
    __device__ __forceinline__ void issueK(int tile, LAS unsigned char* ks, int wid) const {
        dma16(kn + (size_t)tile * 64 * 1024, ks + wid * 1024);
        dma16(kp + (size_t)tile * 64 * 32, ks + (8 + (wid & 3)) * 1024); }
    __device__ __forceinline__ void issueV(int tile, LAS unsigned char* vs, int wid) const { dma16(v + (size_t)tile * 64 * 1024, vs + wid * 1024); }
    __device__ __forceinline__ void issue(int tile, LAS unsigned char* ks, LAS unsigned char* vs, int wid) const { issueK(tile, ks, wid); issueV(tile, vs, wid); }
};
struct SrcRows {
    static constexpr int DK = 64, NDMA = 2, NV = 1;
    const bf16* k; const bf16* v; size_t pitch;
    __device__ __forceinline__ void init(const bf16* K0, const bf16* V0, size_t pitch_, int wid, int lane) {
        pitch = pitch_; k = K0 + (size_t)lane * pitch + 8 * wid; v = V0 + (size_t)(16 * (wid & 3) + (lane >> 2)) * pitch + (wid >> 2) * 32 + (lane & 3) * 8; }
    static constexpr int NKD = 1;
    __device__ __forceinline__ void issueK(int tile, LAS unsigned char* ks, int wid) const { dma16(k + (size_t)tile * 64 * pitch, ks + wid * 1024); }
    __device__ __forceinline__ void issueV(int tile, LAS unsigned char* vs, int wid) const { dma16(v + (size_t)tile * 64 * pitch, vs + wid * 1024); }
    __device__ __forceinline__ void issue(int tile, LAS unsigned char* ks, LAS unsigned char* vs, int wid) const { issueK(tile, ks, wid); issueV(tile, vs, wid); }
};

struct SrcCmp {
    static constexpr int DK = 64, NDMA = 3, NV = 2;
    const bf16* k; const bf16* v; const bf16* ov;
    __device__ __forceinline__ void init(const bf16* K0, const bf16* V0, const bf16* OV, int wid, int lane) {
        k = K0 + (size_t)lane * 64 + 8 * wid; const size_t vo = (size_t)(16 * (wid & 3) + (lane >> 2)) * 64 + (wid >> 2) * 32 + (lane & 3) * 8; v = V0 + vo; ov = OV + vo; }
    __device__ __forceinline__ void issue(int tile, LAS unsigned char* ks, LAS unsigned char* vs, int wid) const {
        dma16(k + (size_t)tile * 4096, ks + wid * 1024);
        dma16(v + (size_t)tile * 4096, vs + wid * 1024);
        dma16(ov + (size_t)tile * 4096, vs + 8192 + wid * 1024); }
};

template <int NV> struct RowT { float m, l; f32x16 o[2 * NV]; };
typedef RowT<1> Row;
template <int NV> __device__ __forceinline__ void row_reset(RowT<NV>& R) { R.m = -1e30f; R.l = 0.f;
#pragma unroll
    for (int i = 0; i < 2 * NV; ++i) R.o[i] = f32x16{}; }

template <int DK> __device__ __forceinline__ void qk_tile(f32x16& p0, f32x16& p1, LAS unsigned char* kslot, const bf16x8 (&qr)[DK / 16], int r32, int hi) {
    const LAS unsigned char* kb = kslot + hi * 1024 + r32 * 16;
    p0 = f32x16{}; p1 = f32x16{};
#pragma unroll
    for (int d0 = 0; d0 < DK / 16; ++d0) {
        const bf16x8 b0 = *(const LAS bf16x8*)(kb + d0 * 2048), b1 = *(const LAS bf16x8*)(kb + d0 * 2048 + 512);
        p0 = __builtin_amdgcn_mfma_f32_32x32x16_bf16(b0, qr[d0], p0, 0, 0, 0);
        p1 = __builtin_amdgcn_mfma_f32_32x32x16_bf16(b1, qr[d0], p1, 0, 0, 0); }
}
template <int NV> __device__ __forceinline__ void softmax_tile(f32x16& p0, f32x16& p1, RowT<NV>& R) {
    float a = fmaxf(fmaxf(p0[0], p0[1]), fmaxf(p1[0], p1[1]));
#pragma unroll
    for (int r = 2; r < 16; r += 2) a = fmaxf(a, fmaxf(fmaxf(p0[r], p0[r + 1]), fmaxf(p1[r], p1[r + 1])));
    const float mt = swap_max(a);
    if (__any(mt > R.m + THR)) { const float mn = fmaxf(R.m, mt), f = __builtin_amdgcn_exp2f(R.m - mn); R.m = mn; R.l *= f;
#pragma unroll
        for (int i = 0; i < 2 * NV; ++i) R.o[i] *= f; }
    const float m = R.m; float s = 0.f;
#pragma unroll
    for (int r = 0; r < 16; ++r) { p0[r] = __builtin_amdgcn_exp2f(p0[r] - m); p1[r] = __builtin_amdgcn_exp2f(p1[r] - m); s += p0[r] + p1[r]; }
    R.l += s;
}
template <int NV> __device__ __forceinline__ void pv_tile(const f32x16& p0, const f32x16& p1, RowT<NV>& R, LAS unsigned char* vslot, int lane, int hi) {
    bf16x8 pa[4];
#pragma unroll
    for (int k = 0; k < 4; ++k) { const f32x16& P = (k < 2) ? p0 : p1; const int b = (k & 1) * 8;
        u32x4 w; w.x = pk2(P[b], P[b + 1]); w.y = pk2(P[b + 2], P[b + 3]); w.z = pk2(P[b + 4], P[b + 5]); w.w = pk2(P[b + 6], P[b + 7]); pa[k] = __builtin_bit_cast(bf16x8, w); }
    const int vb = (int)(unsigned)(uintptr_t)vslot + ((lane >> 4) & 1) * 32 + (lane & 3) * 8 + (4 * hi + ((lane & 15) >> 2)) * 64;
#pragma unroll
    for (int d0 = 0; d0 < 2 * NV; ++d0) { s16x4 lo[4], hh[4];
#pragma unroll
        for (int ks = 0; ks < 4; ++ks) {
            asm volatile("ds_read_b64_tr_b16 %0,%1 offset:%c2" : "=&v"(lo[ks]) : "v"(vb), "i"(d0 * 4096 + ks * 1024) : "memory");
            asm volatile("ds_read_b64_tr_b16 %0,%1 offset:%c2" : "=&v"(hh[ks]) : "v"(vb), "i"(d0 * 4096 + ks * 1024 + 512) : "memory"); }
        asm volatile("s_waitcnt lgkmcnt(0)" ::: "memory"); __builtin_amdgcn_sched_barrier(0);
#pragma unroll
        for (int ks = 0; ks < 4; ++ks) { const bf16x8 vf = (bf16x8){lo[ks][0], lo[ks][1], lo[ks][2], lo[ks][3], hh[ks][0], hh[ks][1], hh[ks][2], hh[ks][3]};
            R.o[d0] = __builtin_amdgcn_mfma_f32_32x32x16_bf16(vf, pa[ks], R.o[d0], 0, 0, 0); } }
}

template <class RowPtr>
__device__ __forceinline__ void store_rows(LAS unsigned char* stg, const f32x16& o0, const f32x16& o1, float scale, float& ss, int lane, const RowPtr& rowptr) {
    const int r32 = lane & 31, hi = lane >> 5;
    LAS unsigned char* wp = stg + r32 * 144 + 8 * hi;
#pragma unroll
    for (int d0 = 0; d0 < 2; ++d0)
#pragma unroll
        for (int k = 0; k < 4; ++k) { const f32x16& o = d0 ? o1 : o0;
            const float v0 = o[4 * k] * scale, v1 = o[4 * k + 1] * scale, v2 = o[4 * k + 2] * scale, v3 = o[4 * k + 3] * scale;
            ss += (v0 * v0 + v1 * v1) + (v2 * v2 + v3 * v3);
            *(LAS unsigned long long*)(wp + 64 * d0 + 16 * k) = (unsigned long long)pk2(v0, v1) | ((unsigned long long)pk2(v2, v3) << 32); }
    asm volatile("s_waitcnt lgkmcnt(0)" ::: "memory");
#pragma unroll
    for (int i = 0; i < 4; ++i) { const int row = i * 8 + (lane >> 3), ch = lane & 7;
        const u32x4 v = *(const LAS u32x4*)(stg + row * 144 + ch * 16);
        __builtin_nontemporal_store(v, (u32x4*)(rowptr(row) + ch * 8)); }
}

template <class Src, class Fix, class Skip>
__device__ __forceinline__ void run_tiles(LAS unsigned char* ring, const Src& src, int kt0, int kt1, const bf16x8 (&qr)[Src::DK / 16], RowT<Src::NV>& R, const Fix& fix, const Skip& skip, int wid, int lane) {
    constexpr int KB = Src::DK * 128, SLOT = KB + 8192 * Src::NV;
    const int r32 = lane & 31, hi = lane >> 5; const int nt = kt1 - kt0;
    if (nt <= 0) return;
    src.issue(kt0, ring, ring + KB, wid);
    if (nt > 1) src.issue(kt0 + 1, ring + SLOT, ring + SLOT + KB, wid);
    int s_cur = 0, s_nn = 2 * SLOT;
    for (int i = 0; i < nt; ++i) {
        if (i + 1 < nt) wait_bar<Src::NDMA>(); else wait_bar<0>();
        if (i + 2 < nt) src.issue(kt0 + i + 2, ring + s_nn, ring + s_nn + KB, wid);
        const int tile = kt0 + i;
        if (!skip(tile)) {
            f32x16 p0, p1;
            qk_tile<Src::DK>(p0, p1, ring + s_cur, qr, r32, hi);
            fix(p0, p1, tile);
            softmax_tile(p0, p1, R);
            pv_tile(p0, p1, R, ring + s_cur + KB, lane, hi);
        }
        s_cur = (s_cur == 2 * SLOT) ? 0 : s_cur + SLOT; s_nn = (s_nn == 2 * SLOT) ? 0 : s_nn + SLOT;
    }
    asm volatile("s_waitcnt lgkmcnt(0)\n\ts_barrier" ::: "memory");
}
}


namespace att {
template <int N> __device__ __forceinline__ void wait_bar_n() {
    static_assert(N == 0 || N == 3 || N == 4 || N == 5 || N == 6 || N == 8, "wait_bar_n: add the count");
    if (N == 8) asm volatile("s_waitcnt vmcnt(8) lgkmcnt(0)\n\ts_barrier" ::: "memory"); else if (N == 6) asm volatile("s_waitcnt vmcnt(6) lgkmcnt(0)\n\ts_barrier" ::: "memory");
    else if (N == 5) asm volatile("s_waitcnt vmcnt(5) lgkmcnt(0)\n\ts_barrier" ::: "memory"); else if (N == 4) asm volatile("s_waitcnt vmcnt(4) lgkmcnt(0)\n\ts_barrier" ::: "memory");
    else if (N == 3) asm volatile("s_waitcnt vmcnt(3) lgkmcnt(0)\n\ts_barrier" ::: "memory"); else asm volatile("s_waitcnt vmcnt(0) lgkmcnt(0)\n\ts_barrier" ::: "memory"); }
typedef short v4i16_t __attribute__((ext_vector_type(4)));
typedef float f32x2_t __attribute__((ext_vector_type(2)));
__device__ __forceinline__ s16x4 vtr(const LAS unsigned char* p) { return __builtin_bit_cast(s16x4, __builtin_amdgcn_ds_read_tr16_b64_v4i16((LAS v4i16_t*)p)); }
__device__ __forceinline__ unsigned cvtpk(float lo, float hi) { f32x2_t v = {lo, hi}; bf16x2_t b = __builtin_convertvector(v, bf16x2_t); return __builtin_bit_cast(unsigned, b); }
#define SBAR() __builtin_amdgcn_sched_barrier(0)
#define PIN(x) asm volatile("" : "+v"(x))
#define MX3(a, b, c) __builtin_fmaxf(__builtin_fmaxf((a), (b)), (c))

template <class Src, class Fix>
__device__ __forceinline__ void run_pipe(LAS unsigned char* ring, const Src& src, int kt0, int kt1, const bf16x8 (&qr)[Src::DK / 16], Row& R, const Fix& fix, float bfar, int near_from, int wid, int lane) {
    constexpr int DK = Src::DK, NKS = DK / 16, NK = 2 * NKS, KB = DK * 128, VB = 8192, NKD = Src::NKD, NDMA = NKD + 1;
    const int NT = kt1 - kt0;
    constexpr bool ALT = false;
    if (wid >= 4) __builtin_amdgcn_s_setprio(1);
    const int r32 = lane & 31, hi = lane >> 5;
    LAS unsigned char* kring = ring; LAS unsigned char* vring = ring + 4 * KB;
    const LAS unsigned char* kp0 = kring + hi * 1024 + r32 * 16;
    const LAS unsigned char* vp0 = vring + ((lane >> 4) & 1) * 32 + (lane & 3) * 8 + (4 * hi + ((lane & 15) >> 2)) * 64;
#define TILE(tt) (kt0 + ((tt) < NT ? (tt) : NT - 1))
    src.issueK(TILE(0), kring, wid); src.issueV(TILE(0), vring, wid); src.issueK(TILE(1), kring + KB, wid); src.issueK(TILE(2), kring + 2 * KB, wid);
    src.issueK(TILE(3), kring + 3 * KB, wid); src.issueV(TILE(1), vring + VB, wid);
    bf16x8 kf[NK];
    f32x16 A0, A1, B0, B1, cin;
    float m = 0.f, l = 0.f, csh = 0.f; f32x16 o0 = f32x16{}, o1 = f32x16{};
    wait_bar_n<3 * NKD + 2>();
#define KLOAD(kslot) do { _Pragma("unroll") for (int d0 = 0; d0 < NKS; ++d0) { kf[2 * d0] = *(const LAS bf16x8*)(kp0 + (kslot) + d0 * 2048); kf[2 * d0 + 1] = *(const LAS bf16x8*)(kp0 + (kslot) + d0 * 2048 + 512); } } while (0)
#define ROWMAX(C0, C1, out) do { float a_ = MX3(C0[0], C0[1], C1[0]), b_ = MX3(C0[2], C0[3], C1[1]); a_ = MX3(a_, C1[2], C1[3]); \
        _Pragma("unroll") for (int r = 4; r < 16; r += 4) { a_ = MX3(a_, C0[r], C0[r + 1]); b_ = MX3(b_, C0[r + 2], C0[r + 3]); a_ = MX3(a_, C1[r], C1[r + 1]); b_ = MX3(b_, C1[r + 2], C1[r + 3]); } \
        out = swap_max(__builtin_fmaxf(a_, b_)); } while (0)
    KLOAD(0);
    A0 = f32x16{}; A1 = f32x16{};
#pragma unroll
    for (int d0 = 0; d0 < NKS; ++d0) { A0 = __builtin_amdgcn_mfma_f32_32x32x16_bf16(kf[2 * d0], qr[d0], A0, 0, 0, 0); A1 = __builtin_amdgcn_mfma_f32_32x32x16_bf16(kf[2 * d0 + 1], qr[d0], A1, 0, 0, 0); }
    fix(A0, A1, kt0);
    { float rm; ROWMAX(A0, A1, rm);
      const float sh0 = (kt0 < near_from) ? bfar : 0.f;
      const float dl = (rm > NEG_INF) ? rm + sh0 : 0.f; m = dl; const float c0 = sh0 - dl;
#pragma unroll
      for (int r = 0; r < 16; ++r) { A0[r] = __builtin_amdgcn_exp2f(A0[r] + c0); A1[r] = __builtin_amdgcn_exp2f(A1[r] + c0); }
      csh = (kt0 + 1 < near_from) ? bfar : 0.f;
#pragma unroll
      for (int r = 0; r < 16; ++r) cin[r] = csh - m;
      asm volatile("" : "+v"(cin)); }
    float fpend = 1.0f; bool resc = false;
    wait_bar_n<2 * NKD + 1>();
    src.issueK(TILE(4), kring, wid); src.issueV(TILE(2), vring + 2 * VB, wid);
    KLOAD(KB);
    wait_bar_n<2 * NDMA>();
    int kcur = KB, knext = 2 * KB, vprev = 0, vnext = 3 * VB;
    u32x4 pw0, pw1, pw2, pw3; s16x4 vlo[8], vhi[8];
#define PKW(P, b) cvtpk(P[b], P[(b) + 1])
#define VRD(i) do { vlo[i] = vtr(vp_ + (((i) >> 2) * 4096 + ((i) & 3) * 1024)); vhi[i] = vtr(vp_ + (((i) >> 2) * 4096 + ((i) & 3) * 1024 + 512)); } while (0)
#define VFR(i) (bf16x8){vlo[i][0], vlo[i][1], vlo[i][2], vlo[i][3], vhi[i][0], vhi[i][1], vhi[i][2], vhi[i][3]}
#define PAF(k) __builtin_bit_cast(bf16x8, pw##k)
#define QKM(i, C, first) C = __builtin_amdgcn_mfma_f32_32x32x16_bf16(kf[i], qr[(i) >> 1], (first) ? cin : C, 0, 0, 0)
#define GAPA(MF, a0_, a1_, a2_, a3_, W0, W1, PW) do { MF; sacc += a0_; sacc += a1_; sacc += a2_; sacc += a3_; PIN(sacc); W0; W1; PIN(PW); SBAR(); } while (0)
#define GAPB(MF, X, b) do { MF; X[b] = __builtin_amdgcn_exp2f(X[b]); X[(b) + 1] = __builtin_amdgcn_exp2f(X[(b) + 1]); X[(b) + 2] = __builtin_amdgcn_exp2f(X[(b) + 2]); X[(b) + 3] = __builtin_amdgcn_exp2f(X[(b) + 3]); PIN(X); SBAR(); } while (0)
#define PHASE_A(C0, C1, P0, P1) do { SBAR(); const LAS unsigned char* vp_ = vp0 + vprev; \
        VRD(0); SBAR(); float sacc = P0[0] + P0[1]; \
        GAPA(QKM(0, C0, true), P0[2], P0[3], P0[4], P0[5], pw0[0] = PKW(P0, 0), pw0[1] = PKW(P0, 2), pw0); \
        GAPA(QKM(1, C1, true), P0[6], P0[7], P0[8], P0[9], pw0[2] = PKW(P0, 4), pw0[3] = PKW(P0, 6), pw0); \
        VRD(1); SBAR(); GAPA(QKM(2, C0, false), P0[10], P0[11], P0[12], P0[13], pw1[0] = PKW(P0, 8), pw1[1] = PKW(P0, 10), pw1); \
        GAPA(QKM(3, C1, false), P0[14], P0[15], P1[0], P1[1], pw1[2] = PKW(P0, 12), pw1[3] = PKW(P0, 14), pw1); \
        VRD(2); SBAR(); GAPA(QKM(4, C0, false), P1[2], P1[3], P1[4], P1[5], pw2[0] = PKW(P1, 0), pw2[1] = PKW(P1, 2), pw2); \
        GAPA(QKM(5, C1, false), P1[6], P1[7], P1[8], P1[9], pw2[2] = PKW(P1, 4), pw2[3] = PKW(P1, 6), pw2); \
        VRD(3); SBAR(); GAPA(QKM(6, C0, false), P1[10], P1[11], P1[12], P1[13], pw3[0] = PKW(P1, 8), pw3[1] = PKW(P1, 10), pw3); \
        GAPA(QKM(7, C1, false), P1[14], P1[15], 0.f, 0.f, pw3[2] = PKW(P1, 12), pw3[3] = PKW(P1, 14), pw3); \
        if (NK > 8) { _Pragma("unroll") for (int i_ = 8; i_ < NK; i_ += 2) { QKM(i_, C0, false); QKM(i_ + 1, C1, false); } SBAR(); } \
        l += sacc; } while (0)
#define KRD(j) do { kf[2 * (j)] = *(const LAS bf16x8*)(kp0 + knext + (j) * 2048); kf[2 * (j) + 1] = *(const LAS bf16x8*)(kp0 + knext + (j) * 2048 + 512); SBAR(); } while (0)
#define PHASE_B(C0, C1) do { SBAR(); const LAS unsigned char* vp_ = vp0 + vprev; \
        VRD(4); SBAR(); GAPB(o0 = __builtin_amdgcn_mfma_f32_32x32x16_bf16(VFR(0), PAF(0), o0, 0, 0, 0), C0, 0); \
        VRD(5); SBAR(); GAPB(o0 = __builtin_amdgcn_mfma_f32_32x32x16_bf16(VFR(1), PAF(1), o0, 0, 0, 0), C0, 4); \
        VRD(6); SBAR(); KRD(0); GAPB(o0 = __builtin_amdgcn_mfma_f32_32x32x16_bf16(VFR(2), PAF(2), o0, 0, 0, 0), C0, 8); \
        VRD(7); SBAR(); KRD(1); GAPB(o0 = __builtin_amdgcn_mfma_f32_32x32x16_bf16(VFR(3), PAF(3), o0, 0, 0, 0), C0, 12); \
        KRD(2); GAPB(o1 = __builtin_amdgcn_mfma_f32_32x32x16_bf16(VFR(4), PAF(0), o1, 0, 0, 0), C1, 0); \
        KRD(3); GAPB(o1 = __builtin_amdgcn_mfma_f32_32x32x16_bf16(VFR(5), PAF(1), o1, 0, 0, 0), C1, 4); \
        if (NKS > 4) { KRD(4); } GAPB(o1 = __builtin_amdgcn_mfma_f32_32x32x16_bf16(VFR(6), PAF(2), o1, 0, 0, 0), C1, 8); \
        if (NKS > 5) { KRD(5); } GAPB(o1 = __builtin_amdgcn_mfma_f32_32x32x16_bf16(VFR(7), PAF(3), o1, 0, 0, 0), C1, 12); \
        } while (0)
#define DECIDE(C0, C1, tt) do { \
        fix(C0, C1, kt0 + (tt)); \
        float rm_; ROWMAX(C0, C1, rm_); resc = false; \
        const bool up_ = (rm_ > THR) || (l == 0.f && rm_ < -THR && rm_ > NEG_INF); \
        const float nsh_ = (kt0 + (tt) + 1 < near_from) ? bfar : 0.f; \
        if (__any(up_)) { const float dl_ = up_ ? rm_ : __builtin_fmaxf(rm_, 0.f); m += dl_; fpend = __builtin_amdgcn_exp2f(-dl_); l *= fpend; resc = true; \
            _Pragma("unroll") for (int r = 0; r < 16; ++r) { C0[r] -= dl_; C1[r] -= dl_; } \
            csh = nsh_; _Pragma("unroll") for (int r = 0; r < 16; ++r) cin[r] = csh - m; asm volatile("" : "+v"(cin)); } \
        else if (nsh_ != csh) { csh = nsh_; _Pragma("unroll") for (int r = 0; r < 16; ++r) cin[r] = csh - m; asm volatile("" : "+v"(cin)); } } while (0)
#define STEP(C0, C1, P0, P1, tt) do { \
        if (ALT && wid >= 4) asm volatile("s_barrier" ::: "memory"); \
        PHASE_A(C0, C1, P0, P1); \
        src.issueK(TILE((tt) + 4), kring + kcur, wid); src.issueV(TILE((tt) + 2), vring + vnext, wid); \
        DECIDE(C0, C1, tt); \
        PHASE_B(C0, C1); \
        if (ALT && wid < 4) asm volatile("s_waitcnt lgkmcnt(0)\n\ts_barrier" ::: "memory"); \
        wait_bar_n<2 * NDMA>();                                          \
        if (resc) { o0 *= fpend; o1 *= fpend; } \
        kcur = knext; knext = (knext == 3 * KB) ? 0 : knext + KB; \
        vprev = (vprev == 3 * VB) ? 0 : vprev + VB; vnext = (vnext == 3 * VB) ? 0 : vnext + VB; } while (0)
    int t = 1;
    for (; t + 1 < NT; t += 2) { STEP(B0, B1, A0, A1, t); STEP(A0, A1, B0, B1, t + 1); }
    if (t < NT) { STEP(B0, B1, A0, A1, t); A0 = B0; A1 = B1; }
    { float sacc = 0.f;
#pragma unroll
      for (int r = 0; r < 16; ++r) sacc += A0[r] + A1[r];
      l += sacc;
      pw0 = (u32x4){PKW(A0, 0), PKW(A0, 2), PKW(A0, 4), PKW(A0, 6)}; pw1 = (u32x4){PKW(A0, 8), PKW(A0, 10), PKW(A0, 12), PKW(A0, 14)};
      pw2 = (u32x4){PKW(A1, 0), PKW(A1, 2), PKW(A1, 4), PKW(A1, 6)}; pw3 = (u32x4){PKW(A1, 8), PKW(A1, 10), PKW(A1, 12), PKW(A1, 14)};
      const LAS unsigned char* vp_ = vp0 + vprev;
#pragma unroll
      for (int i = 0; i < 8; ++i) VRD(i);
      o0 = __builtin_amdgcn_mfma_f32_32x32x16_bf16(VFR(0), PAF(0), o0, 0, 0, 0); o1 = __builtin_amdgcn_mfma_f32_32x32x16_bf16(VFR(4), PAF(0), o1, 0, 0, 0);
      o0 = __builtin_amdgcn_mfma_f32_32x32x16_bf16(VFR(1), PAF(1), o0, 0, 0, 0); o1 = __builtin_amdgcn_mfma_f32_32x32x16_bf16(VFR(5), PAF(1), o1, 0, 0, 0);
      o0 = __builtin_amdgcn_mfma_f32_32x32x16_bf16(VFR(2), PAF(2), o0, 0, 0, 0); o1 = __builtin_amdgcn_mfma_f32_32x32x16_bf16(VFR(6), PAF(2), o1, 0, 0, 0);
      o0 = __builtin_amdgcn_mfma_f32_32x32x16_bf16(VFR(3), PAF(3), o0, 0, 0, 0); o1 = __builtin_amdgcn_mfma_f32_32x32x16_bf16(VFR(7), PAF(3), o1, 0, 0, 0); }
    wait_bar_n<0>();
    R.m = m; R.l = l; R.o[0] = o0; R.o[1] = o1;
    __builtin_amdgcn_s_setprio(0);
#undef TILE
#undef KLOAD
#undef ROWMAX
#undef DECIDE
#undef PKW
#undef VRD
#undef VFR
#undef PAF
#undef QKM
#undef GAPA
#undef GAPB
#undef PHASE_A
#undef KRD
#undef PHASE_B
#undef STEP
}
#undef SBAR
#undef PIN
#undef MX3
}
constexpr int MLA_STG_OFF = 98304;
__device__ __forceinline__ void p3_mla(const Ptrs& P, LAS unsigned char* lds, int vcu, int G, int tid, int wid) {
    using namespace att;
    for (int L = vcu; L < 2048; L += G) {
        int lane_u = tid & 63; asm volatile("" : "+v"(lane_u));
        const int lane = lane_u, r32 = lane & 31, hi = lane >> 5;
        int bh, qb;
        if (G == 256) { const int i = L >> 8, s8 = vcu & 7; bh = (vcu >> 3) + 32 * (i >> 1); qb = (i & 1) ? 15 - s8 : s8; }
        else { bh = L >> 4; qb = L & 15; }
        const int b = bh >> 3, h = bh & 7; const size_t rowb = (size_t)b * SEQ;
        const int q0 = qb * 256 + wid * 32, t = q0 + r32; const size_t row = rowb + t;
        bf16x8 qr[6];
#pragma unroll
        for (int d0 = 0; d0 < 6; ++d0) qr[d0] = *(const bf16x8*)(P.QM + row * 768 + h * 96 + d0 * 16 + hi * 8);
        SrcMLA src; src.init(P.KVM, P.kpe, rowb, h, wid, lane);
        Row R; row_reset(R);
        auto fix = [&](f32x16& p0, f32x16& p1, int tile) {
            if (tile * 64 + 63 > q0) {
                const int kb = tile * 64 + 4 * hi;
#pragma unroll
                for (int r = 0; r < 16; ++r) { const int kv = kb + (r & 3) + 8 * (r >> 2); if (kv > t) p0[r] = NEG_INF; if (kv + 32 > t) p1[r] = NEG_INF; } } };
        run_pipe(lds, src, 0, 4 * qb + 4, qr, R, fix, 0.f, 0x7fffffff, wid, lane);
        const float inv = 1.0f / swap_sum(R.l); float ss = 0.f;
        { bf16* const ob = P.ATT + (rowb + q0) * 1024 + h * 64;
          store_rows(lds + MLA_STG_OFF + wid * 4608, R.o[0], R.o[1], inv, ss, lane, [&](int r) -> bf16* { return ob + (size_t)r * 1024; }); }
        ss = swap_sum(ss);
        if (hi == 0) P.ssatt[row * 16 + h] = ss;
    }
}

constexpr int NSA_LB_OFF = 81920;
constexpr int NSA_OUT_OFF = 86016;
__device__ __forceinline__ float dpp_xor1(float x) { return __builtin_bit_cast(float, __builtin_amdgcn_update_dpp(0, __builtin_bit_cast(int, x), 0xB1, 0xF, 0xF, false)); }
__device__ __forceinline__ float dpp_xor2(float x) { return __builtin_bit_cast(float, __builtin_amdgcn_update_dpp(0, __builtin_bit_cast(int, x), 0x4E, 0xF, 0xF, false)); }
__device__ __forceinline__ unsigned dpp_xor1u(unsigned x) { return (unsigned)__builtin_amdgcn_update_dpp(0, (int)x, 0xB1, 0xF, 0xF, false); }
__device__ __forceinline__ unsigned dpp_xor2u(unsigned x) { return (unsigned)__builtin_amdgcn_update_dpp(0, (int)x, 0x4E, 0xF, 0xF, false); }
template <int STEP, int YOFF> __device__ __forceinline__ void add_bias(att::f32x16& p, const LAS float* lb, int D) {
#pragma unroll
    for (int r = 0; r < 16; ++r) { int d = D - STEP * ((r & 3) + 8 * (r >> 2) + YOFF); d = d < 0 ? 0 : (d > 127 ? 127 : d); p[r] += lb[d]; }
}
__device__ __forceinline__ void p3_nsa(const Ptrs& P, LAS unsigned char* lds, int vcu, int G, int tid, int wid) {
    using namespace att;
    LAS float* LB = (LAS float*)(lds + NSA_LB_OFF);
    for (int e = tid; e < 1024; e += NTHR) LB[e] = P.bias[e];
    __syncthreads();
    for (int L = vcu; L < 2048; L += G) {
        int bhk, c;
        if (G == 256) { const int i = L >> 8, sub = vcu & 7; bhk = vcu >> 3; const int base = 16 * (i >> 1); c = (i & 1) ? base + 15 - sub : base + sub; }
        else { bhk = L >> 6; c = L & 63; }
        int lane_u = tid & 63; asm volatile("" : "+v"(lane_u));
        const int lane = lane_u, r32 = lane & 31, hi = lane >> 5, ql = r32 >> 2, g = r32 & 3;
        const int b = bhk >> 1, hk = bhk & 1, hq = hk * 4 + g; const size_t rowb = (size_t)b * SEQ;
        const int t = c * 64 + wid * 8 + ql; const size_t row = rowb + t;
        const LAS float* lb = LB + hq * 128; const float b31 = lb[127];
        bf16x8 qr[4];
#pragma unroll
        for (int d0 = 0; d0 < 4; ++d0) qr[d0] = *(const bf16x8*)(P.U + row * DINP + C_QN + hq * 64 + d0 * 16 + hi * 8);
        float gate[3];
#pragma unroll
        for (int br = 0; br < 3; ++br) { const float x = bf2f(P.U[row * DINP + C_GATE + hq * 3 + br]); gate[br] = __builtin_amdgcn_rcpf(1.0f + __builtin_amdgcn_exp2f(-x * LOG2E)); }
        LAS float* outp = (LAS float*)(lds + NSA_OUT_OFF) + wid * 2048 + lane;
        unsigned mlo, mhi;
        {
            const int nv = t >= 31 ? ((t - 31) >> 4) + 1 : 0;
            int ln = lane_u; asm volatile("" : "+v"(ln));
            SrcCmp src; src.init(P.kcmp + (size_t)bhk * 256 * 64, P.vcmp + (size_t)bhk * 256 * 64, P.ovt, wid, ln);
            RowT<2> R; row_reset(R);
            auto fix = [&](f32x16& p0, f32x16& p1, int tile) {
                const int D = t - 31 - 16 * (64 * tile + 4 * hi);
                add_bias<16, 0>(p0, lb, D); add_bias<16, 32>(p1, lb, D);
                const int ib = 64 * tile + 4 * hi;
#pragma unroll
                for (int r = 0; r < 16; ++r) { const int i = ib + (r & 3) + 8 * (r >> 2); if (i >= nv) p0[r] = NEG_INF; if (i + 32 >= nv) p1[r] = NEG_INF; } };
            auto skip = [&](int) -> bool { return false; };
            run_tiles(lds, src, 0, (4 * c + 3 + 63) >> 6, qr, R, fix, skip, wid, lane);
            const float lt = swap_sum(R.l); const float inv = lt > 0.f ? 1.0f / lt : 0.f;
            { const float f = gate[0] * inv;
#pragma unroll
              for (int i = 0; i < 16; ++i) { outp[64 * i] = R.o[0][i] * f; outp[64 * (16 + i)] = R.o[1][i] * f; } }
            mlo = 0u; mhi = 0u;
            if (c <= 15) { const unsigned long long mk = (2ull << c) - 1ull; mlo = (unsigned)mk; mhi = (unsigned)(mk >> 32); }
            else {
                float cand[8];
#pragma unroll
                for (int rr = 0; rr < 8; ++rr) {
                    float v00 = R.o[2][rr] * inv, v01 = R.o[2][8 + rr] * inv, v10 = R.o[3][rr] * inv, v11 = R.o[3][8 + rr] * inv;
                    v00 += dpp_xor1(v00); v00 += dpp_xor2(v00); v01 += dpp_xor1(v01); v01 += dpp_xor2(v01); v10 += dpp_xor1(v10); v10 += dpp_xor2(v10); v11 += dpp_xor1(v11); v11 += dpp_xor2(v11);
                    cand[rr] = (g & 2) ? ((g & 1) ? v11 : v10) : ((g & 1) ? v01 : v00); }
                unsigned key[8];
#pragma unroll
                for (int rr = 0; rr < 8; ++rr) { const int j = 32 * (g >> 1) + (rr & 3) + 8 * (2 * (g & 1) + (rr >> 2)) + 4 * hi;
                    const bool ok = j >= 1 && j <= c - 2; key[rr] = ok ? ((__float_as_uint(fmaxf(cand[rr], 0.f)) & ~63u) | (unsigned)(63 - j)) : 0u; }
                unsigned long long mk = 1ull | (1ull << c) | (1ull << (c - 1));
                for (int round = 0; round < 13; ++round) {
                    unsigned best = key[0];
#pragma unroll
                    for (int rr = 1; rr < 8; ++rr) best = best > key[rr] ? best : key[rr];
                    { const unsigned o1 = dpp_xor1u(best); best = best > o1 ? best : o1; const unsigned o2 = dpp_xor2u(best); best = best > o2 ? best : o2;
                      auto rr2 = __builtin_amdgcn_permlane32_swap(best, best, false, false); best = rr2[0] > rr2[1] ? rr2[0] : rr2[1]; }
                    if (best != 0u) mk |= 1ull << (63u - (best & 63u));
#pragma unroll
                    for (int rr = 0; rr < 8; ++rr) key[rr] = (key[rr] == best) ? 0u : key[rr];
                }
                mlo = (unsigned)mk; mhi = (unsigned)(mk >> 32);
            }
        }
        {
            int ln = lane_u; asm volatile("" : "+v"(ln));
            SrcRows src; src.init(P.U + rowb * DINP + C_KVS + hk * 64, P.U + rowb * DINP + C_KVS + 128 + hk * 64, DINP, wid, ln);
            Row R; row_reset(R);
            auto fix = [&](f32x16& p0, f32x16& p1, int tile) {
                if (tile >= c - 2) { const int D = t - 64 * tile - 4 * hi; add_bias<1, 0>(p0, lb, D); asm volatile("" ::: "memory"); add_bias<1, 32>(p1, lb, D); }
                const bool sel = ((tile < 32 ? (mlo >> tile) : (mhi >> (tile - 32))) & 1u) != 0u;
                if (tile == c) { const int kb = tile * 64 + 4 * hi;
#pragma unroll
                    for (int r = 0; r < 16; ++r) { const int kv = kb + (r & 3) + 8 * (r >> 2); if (kv > t || !sel) p0[r] = NEG_INF; if (kv + 32 > t || !sel) p1[r] = NEG_INF; } }
                else if (!sel) {
#pragma unroll
                    for (int r = 0; r < 16; ++r) { p0[r] = NEG_INF; p1[r] = NEG_INF; } } };
            run_pipe(lds, src, 0, c + 1, qr, R, fix, b31, c - 2, wid, lane);
            const float f = gate[1] / swap_sum(R.l);
#pragma unroll
            for (int i = 0; i < 16; ++i) { outp[64 * i] += R.o[0][i] * f; outp[64 * (16 + i)] += R.o[1][i] * f; }
        }
        f32x16 out[2];
        {
            int ln = lane_u; asm volatile("" : "+v"(ln));
            SrcRows src; src.init(P.U + rowb * DINP + C_KVW + hk * 64, P.U + rowb * DINP + C_KVW + 128 + hk * 64, DINP, wid, ln);
            Row R; row_reset(R);
            auto fix = [&](f32x16& p0, f32x16& p1, int tile) {
                if (tile >= c - 2) { const int D = t - 64 * tile - 4 * hi; add_bias<1, 0>(p0, lb, D); asm volatile("" ::: "memory"); add_bias<1, 32>(p1, lb, D); }
                if (tile == c || tile == c - 8) { const int kb = tile * 64 + 4 * hi;
#pragma unroll
                    for (int r = 0; r < 16; ++r) { const int kv = kb + (r & 3) + 8 * (r >> 2); const int d0_ = t - kv, d1_ = d0_ - 32;
                        if (d0_ < 0 || d0_ >= 512) p0[r] = NEG_INF; if (d1_ < 0 || d1_ >= 512) p1[r] = NEG_INF; } } };
            run_pipe(lds, src, c >= 8 ? c - 8 : 0, c + 1, qr, R, fix, b31, c - 2, wid, lane);
            const float f = gate[2] / swap_sum(R.l);
#pragma unroll
            for (int i = 0; i < 16; ++i) { out[0][i] = outp[64 * i] + R.o[0][i] * f; out[1][i] = outp[64 * (16 + i)] + R.o[1][i] * f; }
        }
        { float ss = 0.f; bf16* const ob = P.ATT + (rowb + c * 64 + wid * 8) * 1024 + 512 + hk * 256;
            store_rows(lds + NSA_OUT_OFF + wid * 8192, out[0], out[1], 1.0f, ss, lane, [&](int r) -> bf16* { return ob + (size_t)(r >> 2) * 1024 + (r & 3) * 64; });
            ss = swap_sum(ss);
            if (hi == 0) P.ssatt[row * 16 + 8 + hq] = ss; }
    }
}

__global__ void __launch_bounds__(NTHR, 2) mega_fwd(Args args) {
    extern __shared__ __attribute__((aligned(16))) unsigned char lds_raw[];
    LAS unsigned char* lds = (LAS unsigned char*)lds_raw;
    volatile LAS unsigned* MISC = (volatile LAS unsigned*)(lds + MISC_OFF);
    const int wv0 = __builtin_amdgcn_readfirstlane((int)threadIdx.x >> 6);
#define LAUNDER_TID() int tid = wv0 * 64 + pg8::lane_id(); asm volatile("" : "+v"(tid)); const int lane = tid & 63, wave = __builtin_amdgcn_readfirstlane(tid >> 6); (void)lane; (void)wave
    const int G = gridDim.x, wg = blockIdx.x;
    const int vcu = (G % 8 == 0) ? (wg % 8) * (G / 8) + wg / 8 : wg;
    unsigned char* ws = args.ws;
    Ptrs P;
#pragma unroll
    for (int i = 0; i < 22; ++i) P.in[i] = args.in[i];
    P.out = args.out; P.ws = ws;
    P.Win = (bf16*)(ws + WS_WIN); P.Wuq = (bf16*)(ws + WS_WUQ); P.Wukv = (bf16*)(ws + WS_WUKV); P.Wout = (bf16*)(ws + WS_WOUT); P.Wgu = (bf16*)(ws + WS_WGU); P.Wdn = (bf16*)(ws + WS_WDN);
    P.rope = (f32x2v*)(ws + WS_ROPE); P.bias = (float*)(ws + WS_BIAS); P.bias1 = (float*)(ws + WS_BIAS1); P.rstdx = (float*)(ws + WS_RSTDX);
    P.ssqkv = (float*)(ws + WS_SSQKV); P.ssatt = (float*)(ws + WS_SSATT); P.ssh = (float*)(ws + WS_SSH);
    P.kcmp = (bf16*)(ws + WS_KCMP); P.vcmp = (bf16*)(ws + WS_VCMP); P.kpe = (bf16*)(ws + WS_KPE); P.ovt = (bf16*)(ws + WS_OVT); P.W1c = (bf16*)(ws + WS_W1C); P.W2t = (bf16*)(ws + WS_W2T);
    P.XB = (bf16*)(ws + WS_XB); P.U = (bf16*)(ws + WS_U); P.QM = (bf16*)(ws + WS_QM); P.KVM = (bf16*)(ws + WS_KVM); P.ATT = (bf16*)(ws + WS_ATT); P.H = (bf16*)(ws + WS_H); P.HID = (bf16*)(ws + WS_HID);
    gu32* ctl = (gu32*)(ws + WS_CTL);

    if (wv0 == 0) MISC[pg8::lane_id()] = 0u;
    __syncthreads();
    XcdBarrier bar; bar.bar = (unsigned*)(ctl + CW_BAR); bar.x = 0; bar.st = nullptr; bar.lead = false;
    if (N_LAUNCHES == 1) bar = xcd_barrier_post((unsigned*)(ctl + CW_BAR), MISC + 8);
#define GRID_BAR() do { if (N_LAUNCHES == 1) xcd_barrier(bar); } while (0)
    const int lo = args.ph_lo, hi = args.ph_hi;
#ifndef PHASE_MASK
#define PHASE_MASK 0xff
#endif
#define IN(k) (((PHASE_MASK >> (k)) & 1) && lo <= (k) && (k) < hi)
#define BOTH(k) (IN(k) && IN((k) + 1))
#ifndef REPEAT_MASK
#define REPEAT_MASK 0
#endif
#define REP(k) for (int rep_ = 0; rep_ < (((REPEAT_MASK >> (k)) & 1) ? 2 : 1); ++rep_)

    if (IN(0)) { REP(0) { LAUNDER_TID(); p0_prologue(P, lds, wg, G, wave, lane, tid); } if (BOTH(0)) GRID_BAR(); }

    if (IN(1)) {
        REP(1) {
        pg8::Gemm g{P.XB, P.Win, MT, DINP, 1024, 1024, 1024, 0}; pg8::StaticOrder S; S.init(MT, DINP, G, wg);
        EpiInProj E{P.U, P.rstdx, P.ssqkv};
        pg8::gemm_phase<EpiInProj, pg8::StaticOrder, true, true>(lds, g, S, E, wv0); }
        if (BOTH(1)) GRID_BAR();
    }

    if (IN(2)) {
        REP(2) {
        { LAUNDER_TID(); p2_kpe(P, wg, G, tid); }
        { pg8::Gemm g{P.U, P.W1c, 64 * 256, 256, 1024, 16 * DINP, 1024, DINP * 2}; CmpOrder S{G, wg, P.U, P.W1c};
          EpiCmp E{P.bias1, P.W2t, P.kcmp, P.vcmp};
          pg8::gemm_phase<EpiCmp, CmpOrder, false, true>(lds, g, S, E, wv0); }
        { const int gq = G > 64 ? G - 64 : G, cq = G > 64 ? wg - 64 : wg;
          if (cq >= 0) { pg8::Gemm g{P.U + C_CQ, P.Wuq, MT, 768, 256, DINP, 256, 0}; pg8::StaticOrder S; S.init(MT, 768, gq, cq);
            EpiQup E{P.QM, P.ssqkv, P.rope};
            pg8::gemm_phase<EpiQup, pg8::StaticOrder, true, true>(lds, g, S, E, wv0); } }
        { pg8::Gemm g{P.U + C_CKV, P.Wukv, MT, 1024, 128, DINP, 256, 0}; pg8::StaticOrder S; S.init(MT, 1024, G, wg);
          EpiKVup E{P.KVM, P.ssqkv};
          pg8::gemm_phase<EpiKVup, pg8::StaticOrder, true, true>(lds, g, S, E, wv0); }
        }
        if (BOTH(2)) GRID_BAR();
    }

    if (IN(3)) {
        REP(3) {
        REP(8) { LAUNDER_TID(); p3_mla(P, lds, vcu, G, tid, wave); }
        REP(9) { LAUNDER_TID(); p3_nsa(P, lds, vcu, G, tid, wave); }
        }
        if (BOTH(3)) GRID_BAR();
    }

    if (IN(4)) {
        REP(4) {
        { pg8::Gemm g{P.ATT, P.Wout, MT, 1024, 1024, 1024, 1024, 0}; OutOrder S; S.init(MT, 1024, G, wg); S.ssatt = P.ssatt; S.tab = (LAS float*)(lds + OUT_TAB_OFF);
          EpiOut E{P.XB, P.H, (unsigned char*)P.QM, P.ssh, (const LAS float*)(lds + OUT_TAB_OFF)};
          pg8::gemm_phase<EpiOut, OutOrder, true, true>(lds, g, S, E, wv0); }
        }
        if (BOTH(4)) GRID_BAR();
    }

    if (IN(5)) {
        REP(5) {
        pg8::Gemm g{P.QM, P.Wgu, MT, NGU, 512, 512, 512, 0}; GUOrder S; S.init(MT, NGU, G, wg); S.ssh = P.ssh; S.tab = (LAS float*)(lds + OUT_TAB_OFF);
        EpiGU E{(unsigned char*)P.HID, (const LAS float*)(lds + OUT_TAB_OFF)};
        pg8::gemm_phase<EpiGU, GUOrder, true, true, true>(lds, g, S, E, wv0); }
        if (BOTH(5)) GRID_BAR();
    }

    if (IN(6)) {
        REP(6) {
        pg8::Gemm g{P.HID, P.Wdn, MT, 1024, DFF / 2, DFF / 2, DFF / 2, 0}; pg8::StaticOrder S; S.init(MT, 1024, G, wg);
        EpiDown E{P.H, P.ATT, P.ssatt};
        pg8::gemm_phase<EpiDown, pg8::StaticOrder, true, true, true>(lds, g, S, E, wv0); }
        if (BOTH(6)) GRID_BAR();
    }

    if (IN(7)) { LAUNDER_TID(); p7_final(P, wg, G, wave, lane); }
#undef IN
#undef BOTH
#undef GRID_BAR
}

extern "C" void kernel_launch(void* const* d_in, const int* in_sizes, int n_in, void* d_out, int out_size, void* d_ws, size_t ws_size, hipStream_t stream) {
    static int grid = 0;
    if (grid == 0) {
        if (n_in != 22 || in_sizes[0] != MT * DM || out_size != MT * DM || ws_size < WS_END) { fprintf(stderr, "kernel_launch: unexpected shapes (n_in %d, in0 %d, out %d, ws %zu); nothing launched\n", n_in, n_in > 0 ? in_sizes[0] : -1, out_size, ws_size); grid = -1; return; }
        int dev = 0, cus = 0, per_cu = 0;
        if (hipGetDevice(&dev) != hipSuccess || hipDeviceGetAttribute(&cus, hipDeviceAttributeMultiprocessorCount, dev) != hipSuccess) { fprintf(stderr, "kernel_launch: device query failed\n"); grid = -1; return; }
        if (hipFuncSetAttribute((const void*)mega_fwd, hipFuncAttributeMaxDynamicSharedMemorySize, LDS_BYTES) != hipSuccess) { fprintf(stderr, "kernel_launch: hipFuncSetAttribute failed\n"); grid = -1; return; }
        if (hipOccupancyMaxActiveBlocksPerMultiprocessor(&per_cu, (const void*)mega_fwd, NTHR, LDS_BYTES) != hipSuccess || per_cu < 1)
            fprintf(stderr, "kernel_launch: note: occupancy query reports %d workgroups per CU\n", per_cu);
        (void)hipGetLastError();
        grid = cus;
    }
    if (grid < 0) return;
    if (hipMemsetAsync((char*)d_ws + WS_CTL, 0, CTL_ZERO_BYTES, stream) != hipSuccess) { fprintf(stderr, "kernel_launch: memset failed\n"); return; }
    Args a{};
    for (int i = 0; i < 22; ++i) a.in[i] = (const float*)d_in[i];
    a.out = (float*)d_out; a.ws = (unsigned char*)d_ws;
    for (int li = 0; li < N_LAUNCHES; ++li) {
        a.ph_lo = (N_LAUNCHES == 1) ? 0 : li; a.ph_hi = (N_LAUNCHES == 1) ? NPHASE : li + 1; a.li = li; a.pad = 0;
        hipLaunchKernelGGL(mega_fwd, dim3(grid), dim3(NTHR), LDS_BYTES, stream, a);
        const hipError_t le = hipPeekAtLastError();
        if (le != hipSuccess) { fprintf(stderr, "kernel_launch: launch %d failed: %s\n", li, hipGetErrorName(le)); break; }
    }
}
```

```cpp
#include <hip/hip_runtime.h>
#include <cstdio>
#include <cstdint>
namespace pg8 {
#define PG8_LAS __attribute__((address_space(3)))
typedef unsigned short bf16_t;
typedef short bf16x8 __attribute__((ext_vector_type(8)));
typedef float f32x4 __attribute__((ext_vector_type(4)));
typedef unsigned u32x4 __attribute__((ext_vector_type(4)));
constexpr int BM = 256, BK = 64, HALF = 128, HTB = HALF * BK * 2  , STAGE_BYTES = 8 * HTB, NXCD = 8, WGM = 8;

__host__ __device__ __forceinline__ int lds_byte(int r, int c) { const int st = (r >> 4) * 2 + (c >> 5), rr = r & 15, cc = c & 31, ob = rr * 64 + cc * 2; return st * 1024 + (ob ^ (((ob >> 9) & 1) << 5)); }
__host__ __device__ __forceinline__ void stage_rc(int b, int& R, int& C) { const int st = b / 1024, sb = b % 1024, swz = sb ^ (((sb >> 9) & 1) << 5); R = (st >> 1) * 16 + swz / 64; C = (st & 1) * 32 + (swz % 64) / 2; }
__host__ __device__ __forceinline__ int perm32(int rho) { const int n = rho >> 4, i = rho & 15; return 8 * (i >> 2) + 4 * n + (i & 3); }

struct Unit { int pm, pn, ui; };
struct Gemm { const bf16_t* A; const bf16_t* Bt; int M, N, K, lda, ldb, kstepA; };

struct StaticOrder {
    int nM, nN, nwg, G, c;
    __host__ __device__ void init(int M, int N, int G_, int c_) { nM = M / BM; nN = N / BM; nwg = nM * nN; G = G_; c = c_; }
    __host__ __device__ bool next(int i, Unit& u) const {
        const long L = (long)i * G + c; if (L >= nwg) return false;
        int wgid = (int)L; { const int q = nwg / NXCD, r = nwg % NXCD, xcd = wgid % NXCD, off = wgid / NXCD; wgid = (xcd < r ? xcd * (q + 1) : r * (q + 1) + (xcd - r) * q) + off; }
        const int nig = WGM * nN, gid = wgid / nig, fm = gid * WGM, gsz = (nM - fm) < WGM ? (nM - fm) : WGM;
        u.pm = fm + ((wgid % nig) % gsz); u.pn = (wgid % nig) / gsz; u.ui = i; return true;
    }
    struct Pre {};
    __device__ __forceinline__ Pre a_pre(const Unit&, int) const { return Pre{}; }
    __device__ __forceinline__ void a_post(const Unit&, const Pre&, int) const {}
    __device__ __forceinline__ void done(const Unit&) const {}
    __device__ __forceinline__ const char* a_base(const Gemm& g, const Unit& u, size_t tstepA) const { return (const char*)g.A + (size_t)u.pm * tstepA; }
    __device__ __forceinline__ const char* b_base(const Gemm& g, const Unit& u, size_t tstepB) const { return (const char*)g.Bt + (size_t)u.pn * tstepB; }
};

__device__ __forceinline__ unsigned cvt_pk_bf16(float lo, float hi) { unsigned r; asm volatile("v_cvt_pk_bf16_f32 %0, %1, %2" : "=v"(r) : "v"(lo), "v"(hi)); return r; }
typedef float f32x2 __attribute__((ext_vector_type(2)));
typedef int i32x8 __attribute__((ext_vector_type(8)));
typedef int i32x4 __attribute__((ext_vector_type(4)));
__device__ __forceinline__ i32x8 cat8(bf16x8 lo, bf16x8 hi) { const i32x4 a = __builtin_bit_cast(i32x4, lo), b = __builtin_bit_cast(i32x4, hi); return __builtin_shufflevector(a, b, 0, 1, 2, 3, 4, 5, 6, 7); }
__device__ __forceinline__ unsigned cvt_pk4_fp8(float a, float b, float c, float d) { int w = 0; w = __builtin_amdgcn_cvt_pk_fp8_f32(a, b, w, false); w = __builtin_amdgcn_cvt_pk_fp8_f32(c, d, w, true); return (unsigned)w; }
__device__ __forceinline__ void glds16(const char* sbase, unsigned voff, unsigned dst) { unsigned keep;
    asm volatile("s_mov_b32 %0, m0\n\ts_mov_b32 m0, %3\n\ts_nop 0\n\tglobal_load_lds_dwordx4 %1, %2\n\ts_mov_b32 m0, %0" : "=&s"(keep) : "v"(voff), "s"(sbase), "s"(dst) : "memory"); }
__device__ __forceinline__ int lane_id() { int r; asm volatile("v_mbcnt_lo_u32_b32 %0, -1, 0\n\tv_mbcnt_hi_u32_b32 %0, -1, %0" : "=v"(r)); return r; }
template <class Epi, class Sched, bool ALIGN_EPI = false, bool SP2 = false, bool FP8 = false>
__device__ __forceinline__ void gemm_phase(PG8_LAS unsigned char* lds, const Gemm g, const Sched& S, const Epi& E, const int wv  ) {
    int tid_ = wv * 64 + lane_id(); asm volatile("" : "+v"(tid_));
    const int tid = tid_, wid = __builtin_amdgcn_readfirstlane(tid >> 6), lane = tid & 63, wr = wid >> 2, wc = wid & 3, fr = lane & 15, fq = lane >> 4;
    const int K = g.K, nt = K / BK;
    unsigned voffA, voffB;
    { int R, C; stage_rc(tid * 16, R, C); const int Rb = Epi::PERM ? ((R & ~31) + perm32(R & 31)) : R;
      voffA = (unsigned)(R * g.lda + C) * 2u; voffB = (unsigned)(Rb * g.ldb + C) * 2u; }
    const size_t qstepA = (size_t)64 * g.lda * 2, qstepB = (size_t)64 * g.ldb * 2;
    const size_t kstepA = g.kstepA ? (size_t)g.kstepA : (size_t)(BK * 2), kstepB = (size_t)(BK * 2);
    const size_t hstepA = (size_t)HALF * g.lda * 2, hstepB = (size_t)HALF * g.ldb * 2;
    const size_t tstepA = 2 * hstepA, tstepB = 2 * hstepB;
    const unsigned ldsb = (unsigned)(uintptr_t)lds + (unsigned)wid * 1024u;
    const int aoff = lds_byte(wr * 64 + fr, fq * 8), boff = lds_byte(wc * 32 + fr, fq * 8);
#define PG8_SA(b, h) (((b) * 2 + (h)) * HTB)
#define PG8_SB(b, h) ((4 + (b) * 2 + (h)) * HTB)
#define qvoffA qstepA
#define qvoffB qstepB
#define PG8_STAGE(bufoff, gbase, voff) do { glds16((const char*)(gbase), voff, ldsb + (unsigned)(bufoff)); glds16((const char*)(gbase) + q##voff, voff, ldsb + (unsigned)(bufoff) + 8192u); } while (0)
#define PG8_LDA(dst, b, h) do { _Pragma("unroll") for (int m = 0; m < 4; ++m) _Pragma("unroll") for (int k = 0; k < 2; ++k) dst[m][k] = *(const PG8_LAS bf16x8*)(lds + PG8_SA(b, h) + aoff + m * 2048 + k * 1024); } while (0)
#define PG8_LDB(dst, b, h) do { _Pragma("unroll") for (int n = 0; n < 2; ++n) _Pragma("unroll") for (int k = 0; k < 2; ++k) dst[n][k] = *(const PG8_LAS bf16x8*)(lds + PG8_SB(b, h) + boff + n * 2048 + k * 1024); } while (0)
#define PG8_MMA(ai, bj, At, Bt) do { __builtin_amdgcn_s_setprio(1); _Pragma("unroll") for (int m = 0; m < 4; ++m) _Pragma("unroll") for (int n = 0; n < 2; ++n) { \
        if constexpr (FP8) acc[ai][bj][m][n] = __builtin_amdgcn_mfma_scale_f32_16x16x128_f8f6f4(cat8(Bt[n][0], Bt[n][1]), cat8(At[m][0], At[m][1]), acc[ai][bj][m][n], 0, 0, 0, 0, 0, 0); \
        else { _Pragma("unroll") for (int k = 0; k < 2; ++k) acc[ai][bj][m][n] = __builtin_amdgcn_mfma_f32_16x16x32_bf16(Bt[n][k], At[m][k], acc[ai][bj][m][n], 0, 0, 0); } } __builtin_amdgcn_s_setprio(0); } while (0)
#define PG8_WAIT_V(n) asm volatile("s_waitcnt vmcnt(" #n ")" ::: "memory")
#define PG8_WAIT_L(n) asm volatile("s_waitcnt lgkmcnt(" #n ")" ::: "memory")
#define PG8_BAR __builtin_amdgcn_s_barrier()
#define PG8_SCHED __builtin_amdgcn_sched_barrier(0)
    Unit cur, nxt; int ui = 0;
    if (!S.next(0, cur)) return;
    f32x4 acc[2][2][4][2];
#pragma unroll
    for (int a = 0; a < 2; ++a)
#pragma unroll
        for (int b = 0; b < 2; ++b)
#pragma unroll
            for (int m = 0; m < 4; ++m)
#pragma unroll
                for (int n = 0; n < 2; ++n) acc[a][b][m][n] = (f32x4){0.f, 0.f, 0.f, 0.f};
    bf16x8 At[4][2], B0[2][2], B1[2][2];
    const char* cA = S.a_base(g, cur, tstepA); const char* cB = S.b_base(g, cur, tstepB);
    S.a_post(cur, S.a_pre(cur, tid), tid);
    if constexpr (SP2) {
        PG8_STAGE(PG8_SB(0, 0), cB, voffB); PG8_STAGE(PG8_SB(0, 1), cB + hstepB, voffB); PG8_STAGE(PG8_SA(0, 0), cA, voffA); PG8_STAGE(PG8_SA(0, 1), cA + hstepA, voffA);
        if (wr == 1) PG8_BAR;
        PG8_WAIT_V(2); PG8_BAR;
        PG8_STAGE(PG8_SB(1, 0), cB + kstepB, voffB); PG8_STAGE(PG8_SA(1, 0), cA + kstepA, voffA); PG8_STAGE(PG8_SB(1, 1), cB + hstepB + kstepB, voffB);
        PG8_WAIT_V(6); PG8_BAR;
    } else {
        PG8_STAGE(PG8_SB(0, 0), cB, voffB); PG8_STAGE(PG8_SA(0, 0), cA, voffA); PG8_STAGE(PG8_SB(0, 1), cB + hstepB, voffB); PG8_STAGE(PG8_SA(0, 1), cA + hstepA, voffA);
        if (wr == 1) PG8_BAR;
        PG8_WAIT_V(4); PG8_BAR;
        PG8_STAGE(PG8_SB(1, 0), cB + kstepB, voffB); PG8_STAGE(PG8_SA(1, 0), cA + kstepA, voffA); PG8_STAGE(PG8_SB(1, 1), cB + hstepB + kstepB, voffB);
        PG8_WAIT_V(6); PG8_BAR;
    }
    for (;;) {
        const bool has_next = S.next(ui + 1, nxt);
        const char* nA = has_next ? S.a_base(g, nxt, tstepA) : cA; const char* nB = has_next ? S.b_base(g, nxt, tstepB) : cB;
        for (int t = 0; t < nt; t += 2) {
            if constexpr (Epi::MIDK) { if (t == (nt >> 1)) E.midk(acc, cur, wr, fr); }
            const bool last = (t == nt - 2);
            const char* a1 = cA + (size_t)(t + 1) * kstepA;
            const char* a2 = last ? nA : cA + (size_t)(t + 2) * kstepA; const char* b2 = last ? nB : cB + (size_t)(t + 2) * kstepB;
            const char* a3 = a2 + kstepA; const char* b3 = b2 + kstepB;
            if constexpr (SP2) {
            PG8_LDB(B0, 0, 0); PG8_LDB(B1, 0, 1); PG8_SCHED; PG8_LDA(At, 0, 0); PG8_STAGE(PG8_SA(1, 1), a1 + hstepA, voffA);
            PG8_WAIT_V(8); PG8_WAIT_L(0); PG8_BAR; PG8_MMA(0, 0, At, B0); PG8_MMA(0, 1, At, B1); PG8_BAR; PG8_SCHED;
            PG8_LDA(At, 0, 1); PG8_STAGE(PG8_SB(0, 0), b2, voffB); PG8_STAGE(PG8_SB(0, 1), b2 + hstepB, voffB); PG8_STAGE(PG8_SA(0, 0), a2, voffA);
            PG8_WAIT_V(8); PG8_WAIT_L(0); PG8_BAR; PG8_MMA(1, 0, At, B0); PG8_MMA(1, 1, At, B1); PG8_BAR; PG8_SCHED;
            PG8_LDB(B0, 1, 0); PG8_LDB(B1, 1, 1); PG8_SCHED; PG8_LDA(At, 1, 0); PG8_STAGE(PG8_SA(0, 1), a2 + hstepA, voffA);
            PG8_WAIT_V(8); PG8_WAIT_L(0); PG8_BAR; PG8_MMA(0, 0, At, B0); PG8_MMA(0, 1, At, B1); PG8_BAR; PG8_SCHED;
            PG8_LDA(At, 1, 1); PG8_STAGE(PG8_SB(1, 0), b3, voffB); PG8_STAGE(PG8_SB(1, 1), b3 + hstepB, voffB); PG8_STAGE(PG8_SA(1, 0), a3, voffA);
            PG8_WAIT_V(8); PG8_WAIT_L(0); PG8_BAR; PG8_MMA(1, 0, At, B0); PG8_MMA(1, 1, At, B1); PG8_BAR; PG8_SCHED;
            } else {
            PG8_LDB(B0, 0, 0); PG8_SCHED; PG8_LDA(At, 0, 0); PG8_STAGE(PG8_SA(1, 1), a1 + hstepA, voffA);
            PG8_WAIT_L(8); PG8_BAR; PG8_WAIT_L(0); PG8_MMA(0, 0, At, B0); PG8_BAR; PG8_SCHED;
            PG8_LDB(B1, 0, 1); PG8_STAGE(PG8_SB(0, 0), b2, voffB);
            PG8_BAR; PG8_WAIT_L(0); PG8_MMA(0, 1, At, B1); PG8_BAR;
            PG8_LDA(At, 0, 1); PG8_STAGE(PG8_SA(0, 0), a2, voffA);
            PG8_BAR; PG8_WAIT_L(0); PG8_MMA(1, 0, At, B0); PG8_BAR; PG8_SCHED;
            PG8_STAGE(PG8_SB(0, 1), b2 + hstepB, voffB);
            PG8_WAIT_V(6); PG8_BAR; PG8_MMA(1, 1, At, B1); PG8_BAR;
            PG8_LDB(B0, 1, 0); PG8_SCHED; PG8_LDA(At, 1, 0); PG8_STAGE(PG8_SA(0, 1), a2 + hstepA, voffA);
            PG8_WAIT_L(8); PG8_BAR; PG8_WAIT_L(0); PG8_MMA(0, 0, At, B0); PG8_BAR; PG8_SCHED;
            PG8_LDB(B1, 1, 1); PG8_STAGE(PG8_SB(1, 0), b3, voffB);
            PG8_BAR; PG8_WAIT_L(0); PG8_MMA(0, 1, At, B1); PG8_BAR;
            PG8_LDA(At, 1, 1); PG8_STAGE(PG8_SA(1, 0), a3, voffA);
            PG8_BAR; PG8_WAIT_L(0); PG8_MMA(1, 0, At, B0); PG8_BAR; PG8_SCHED;
            PG8_STAGE(PG8_SB(1, 1), b3 + hstepB, voffB);
            PG8_WAIT_V(6); PG8_BAR; PG8_MMA(1, 1, At, B1); PG8_BAR;
            }
        }
        if constexpr (ALIGN_EPI) { if (wr == 0) PG8_BAR; }
        int tid2 = wv * 64 + lane_id(); asm volatile("" : "+v"(tid2)); const int fr2 = tid2 & 15, fq2 = (tid2 >> 4) & 3;
        const typename Sched::Pre pre = S.a_pre(has_next ? nxt : cur, tid2);
        if constexpr (!Epi::AFTER_DRAIN) { E(acc, cur, wr, wc, fr2, fq2); S.done(cur); }
        if (has_next) S.a_post(nxt, pre, tid2);
        if (!has_next) break;
#pragma unroll
        for (int a = 0; a < 2; ++a)
#pragma unroll
            for (int b = 0; b < 2; ++b)
#pragma unroll
                for (int m = 0; m < 4; ++m)
#pragma unroll
                    for (int n = 0; n < 2; ++n) acc[a][b][m][n] = (f32x4){0.f, 0.f, 0.f, 0.f};
        cur = nxt; cA = nA; cB = nB; ++ui;
        if constexpr (ALIGN_EPI) { if (wr == 1) PG8_BAR; }
    }
    PG8_WAIT_V(0);
    if constexpr (!ALIGN_EPI) { if (wr == 0) PG8_BAR; }
    PG8_BAR;
    if constexpr (Epi::AFTER_DRAIN) { E.fused(acc, cur, wr, wc, fr, fq, lds, wid, lane); S.done(cur); }
#undef PG8_SA
#undef PG8_SB
#undef PG8_STAGE
#undef qvoffA
#undef qvoffB
#undef PG8_LDA
#undef PG8_LDB
#undef PG8_MMA
#undef PG8_WAIT_V
#undef PG8_WAIT_L
#undef PG8_BAR
#undef PG8_SCHED
}
}
#define GAS __attribute__((address_space(1)))
#define LAS __attribute__((address_space(3)))
typedef unsigned short bf16;
typedef unsigned v4u __attribute__((ext_vector_type(4)));
typedef float f32x4 __attribute__((ext_vector_type(4)));
typedef short bf16x8 __attribute__((ext_vector_type(8)));
typedef GAS unsigned gu32;
typedef GAS unsigned long long gu64;
#define RLX_AGENT __ATOMIC_RELAXED, __HIP_MEMORY_SCOPE_AGENT
#define LDS_WAIT() asm volatile("s_waitcnt lgkmcnt(0)" ::: "memory")
#define VM_WAIT() asm volatile("s_waitcnt vmcnt(0)" ::: "memory")
__device__ __forceinline__ unsigned long long rt() { return __builtin_amdgcn_s_memrealtime(); }
__device__ __forceinline__ unsigned f2bf(float f) { unsigned u = __builtin_bit_cast(unsigned, f); return (u + 0x7fffu + ((u >> 16) & 1u)) >> 16; }
__device__ __forceinline__ unsigned pk2(float lo, float hi) { return pg8::cvt_pk_bf16(lo, hi); }

#define XB_TMO      128
#define XB_XCNT(j)  (256  + 64 * (j))
#define XB_XSUB(j)  (1280 + 64 * (j))
#define XB_XGEN(j)  (2304 + 64 * (j))
#define XB_TOP      3328
#define XB_TOPGEN   3392
#define XCD_BAR_WORDS 3456
#define XB_SPIN_CAP (1u << 18)

__device__ __forceinline__ unsigned xb_ld(unsigned* p)              { return __hip_atomic_load(p, __ATOMIC_RELAXED, __HIP_MEMORY_SCOPE_AGENT); }
__device__ __forceinline__ unsigned xb_add(unsigned* p, unsigned v) { return __hip_atomic_fetch_add(p, v, __ATOMIC_RELAXED, __HIP_MEMORY_SCOPE_AGENT); }
__device__ __forceinline__ unsigned xb_xcc_id() { return (unsigned)__builtin_amdgcn_s_getreg((3 << 11) | 20) & 0xFu; }
#define XB_SPIN(cond, bar) do { unsigned _sp = 0; while (cond) { __builtin_amdgcn_s_sleep(1); \
    if ((++_sp & 255u) == 0u) { if (xb_ld(&(bar)[XB_TMO])) break; if (_sp > XB_SPIN_CAP) { atomicAdd(&(bar)[XB_TMO], 1u); break; } } } } while (0)

struct XcdBarrier {
    unsigned* bar; unsigned x; bool lead;
    volatile LAS unsigned* st;
};

__device__ __forceinline__ XcdBarrier xcd_barrier_post(unsigned* bar, volatile LAS unsigned* st) {
    XcdBarrier b; b.bar = bar; b.x = xb_xcc_id(); b.st = st; b.lead = __builtin_amdgcn_readfirstlane((int)threadIdx.x) < 64;
    if (threadIdx.x == 0) (void)xb_add(&bar[XB_XCNT(b.x)], 1u);
    return b;
}
__device__ __forceinline__ void xcd_barrier_complete(unsigned* bar, unsigned x, unsigned& nloc, unsigned& nx) {
    const unsigned G = gridDim.x * gridDim.y * gridDim.z;
    unsigned sum, cnt, mine, sp = 0u;
    for (;;) {
        sum = 0u; cnt = 0u; mine = 0u;
#pragma unroll
        for (unsigned j = 0; j < 16; ++j) { const unsigned c = xb_ld(&bar[XB_XCNT(j)]); sum += c; cnt += (c > 0u) ? 1u : 0u; mine = (j == x) ? c : mine; }
        if (sum == G) break;
        __builtin_amdgcn_s_sleep(1);
        if ((++sp & 255u) == 0u) { if (xb_ld(&bar[XB_TMO])) break; if (sp > XB_SPIN_CAP) { atomicAdd(&bar[XB_TMO], 1u); break; } }
    }
    nloc = mine > 0u ? mine : 1u; nx = cnt > 0u ? cnt : 1u;
}

__device__ __forceinline__ void xcd_barrier(const XcdBarrier& b) {
    asm volatile("s_waitcnt vmcnt(0)" ::: "memory");
    __syncthreads();
    if (b.lead && pg8::lane_id() == 0) {
        unsigned* bar = b.bar;
        __builtin_amdgcn_s_waitcnt(0);
        unsigned nloc = b.st[0], nx = b.st[1];
        if (nloc == 0u) { xcd_barrier_complete(bar, b.x, nloc, nx); b.st[0] = nloc; b.st[1] = nx; }
        const unsigned old = xb_add(&bar[XB_XSUB(b.x)], 1u);
        const unsigned gen = old / nloc;
        if (old + 1u == (gen + 1u) * nloc) {
            __builtin_amdgcn_fence(__ATOMIC_RELEASE, "agent");
            asm volatile("s_waitcnt vmcnt(0)" ::: "memory");
            const unsigned og = xb_add(&bar[XB_TOP], 1u);
            const unsigned tg = og / nx;
            if (og + 1u == (tg + 1u) * nx) xb_add(&bar[XB_TOPGEN], 1u);
            else XB_SPIN(xb_ld(&bar[XB_TOPGEN]) == tg, bar);
            __builtin_amdgcn_fence(__ATOMIC_ACQUIRE, "agent");
            xb_add(&bar[XB_XGEN(b.x)], 1u);
            asm volatile("s_waitcnt vmcnt(0)" ::: "memory");
        } else {
            XB_SPIN(xb_ld(&bar[XB_XGEN(b.x)]) == gen, bar);
            __builtin_amdgcn_fence(__ATOMIC_ACQUIRE, "agent");
            asm volatile("s_waitcnt vmcnt(0)" ::: "memory");
        }
    }
    __syncthreads();
}

constexpr int NB = 16, SEQ = 4096, DM = 1024, MT = NB * SEQ;
constexpr int DINP = 1792;
constexpr int C_CQ = 0, C_CKV = 256, C_KR = 384, C_QN = 416, C_KVC = 928, C_KVS = 1184, C_KVW = 1440, C_GATE = 1696, DIN = 1720;
constexpr int DFF = 2816, NGU = 2 * DFF;
constexpr int NCMP = 255;
constexpr float EPS = 1e-6f;
constexpr float LOG2E = 1.4426950408889634f;
constexpr float C2Q = 0.10206207261596575f * 1.4426950408889634f;
constexpr float C2N = 0.125f * 1.4426950408889634f;

constexpr int NWAVES = 8, NTHR = 512;
constexpr int NPHASE = 8;
#ifndef MK_N_LAUNCHES
#define MK_N_LAUNCHES 1
#endif
constexpr int N_LAUNCHES = MK_N_LAUNCHES;

constexpr size_t MiB = 1u << 20;
constexpr size_t WS_CTL = 0, CTL_ZERO_BYTES = 1 * MiB;
constexpr size_t WS_WIN = 2 * MiB, WS_WUQ = 6 * MiB, WS_WUKV = 7 * MiB, WS_WOUT = 8 * MiB, WS_WGU = 10 * MiB, WS_WDN = 21 * MiB;
constexpr size_t WS_ROPE = 27 * MiB, WS_BIAS = 27 * MiB + 512 * 1024, WS_BIAS1 = WS_BIAS + 8192;
constexpr size_t WS_RSTDX = 28 * MiB, WS_SSQKV = 29 * MiB, WS_SSATT = 31 * MiB, WS_SSH = 35 * MiB;
constexpr size_t WS_KCMP = 39 * MiB, WS_VCMP = 40 * MiB, WS_KPE = 41 * MiB, WS_OVT = 45 * MiB, WS_W1C = 46 * MiB, WS_W2T = 47 * MiB;
constexpr size_t WS_XB = 64 * MiB, WS_U = 192 * MiB, WS_QM = 420 * MiB, WS_KVM = 516 * MiB, WS_ATT = 644 * MiB, WS_H = 772 * MiB, WS_END = 900 * MiB;
constexpr size_t WS_HID = 64 * MiB;
static_assert(WS_U + (size_t)MT * DINP * 2 <= WS_QM && WS_HID + (size_t)MT * DFF * 2 <= WS_QM && WS_QM + (size_t)MT * 768 * 2 <= WS_KVM && WS_KVM + (size_t)MT * 1024 * 2 <= WS_ATT, "ws map");
constexpr int CW_TMO = 0, CW_BAR = 4096;

constexpr int LDS_BYTES = 163840;
constexpr int MISC_OFF = LDS_BYTES - 256;


typedef unsigned u32x4 __attribute__((ext_vector_type(4))); using pg8::Unit; using pg8::cvt_pk_bf16; using pg8::HALF; using pg8::BM;
typedef float f32x2v __attribute__((ext_vector_type(2)));
typedef unsigned u32x2 __attribute__((ext_vector_type(2)));
__device__ __forceinline__ float bf2f(unsigned short b) { return __builtin_bit_cast(float, (unsigned)b << 16); }
__device__ __forceinline__ float bflo(unsigned w) { return __builtin_bit_cast(float, w << 16); }
__device__ __forceinline__ float bfhi(unsigned w) { return __builtin_bit_cast(float, w & 0xffff0000u); }
__device__ __forceinline__ float sq4(const f32x4 v) { return (v[0] * v[0] + v[1] * v[1]) + (v[2] * v[2] + v[3] * v[3]); }

struct EpiInProj {
    static constexpr bool PERM = true, AFTER_DRAIN = false, MIDK = false;
    pg8::bf16_t* U; const float* rstd; float* ssq;
    __device__ __forceinline__ void operator()(const f32x4 (&acc)[2][2][4][2], const Unit& u, int wr, int wc, int fr, int fq) const {
        const int row0 = u.pm * BM + wr * 64 + fr, col0 = u.pn * BM + wc * 32 + 8 * fq;
#pragma unroll
        for (int ai = 0; ai < 2; ++ai) {
            float rr[4];
#pragma unroll
            for (int m = 0; m < 4; ++m) rr[m] = rstd[row0 + ai * HALF + m * 16];
            asm volatile("" ::: "memory");
#pragma unroll
            for (int m = 0; m < 4; ++m) {
                const int row = row0 + ai * HALF + m * 16; const float r = rr[m];
                pg8::bf16_t* rowp = U + (size_t)row * DINP + col0; float s0 = 0.f, s1 = 0.f;
#pragma unroll
                for (int bj = 0; bj < 2; ++bj) { const f32x4 v0 = acc[ai][bj][m][0] * r, v1 = acc[ai][bj][m][1] * r;
                    u32x4 w; w.x = cvt_pk_bf16(v0[0], v0[1]); w.y = cvt_pk_bf16(v0[2], v0[3]); w.z = cvt_pk_bf16(v1[0], v1[1]); w.w = cvt_pk_bf16(v1[2], v1[3]);
                    *(u32x4*)(rowp + bj * HALF) = w;
                    const float s = sq4(v0) + sq4(v1); if (bj == 0) s0 = s; else s1 = s; }
                if (u.pn < 2) {
                    float s = (u.pn == 0) ? (s0 + s1) : s0;
                    s += __shfl_xor(s, 16); s += __shfl_xor(s, 32);
                    if (fq == 0) ssq[(size_t)row * 8 + (u.pn == 0 ? 0 : 4) + wc] = s;
                }
            }
            asm volatile("" ::: "memory");
        }
    }
};
struct EpiQup {
    static constexpr bool PERM = true, AFTER_DRAIN = false, MIDK = false;
    pg8::bf16_t* Q; const float* ssq; const f32x2v* rope;
    __device__ __forceinline__ void operator()(const f32x4 (&acc)[2][2][4][2], const Unit& u, int wr, int wc, int fr, int fq) const {
        const int row0 = u.pm * BM + wr * 64 + fr, col0 = u.pn * BM + wc * 32 + 8 * fq;
#pragma unroll
        for (int ai = 0; ai < 2; ++ai)
#pragma unroll
            for (int m = 0; m < 4; ++m) {
                const int row = row0 + ai * HALF + m * 16; const int pos = row & (SEQ - 1);
                const f32x4 pp = *(const f32x4*)(ssq + (size_t)row * 8);
                const float r = __builtin_amdgcn_rsqf(((pp[0] + pp[1]) + (pp[2] + pp[3])) * (1.0f / 256.0f) + EPS) * C2Q;
#pragma unroll
                for (int bj = 0; bj < 2; ++bj) { const int c = col0 + bj * HALF; const int d = c % 96;
                    f32x4 v0 = acc[ai][bj][m][0] * r, v1 = acc[ai][bj][m][1] * r;
                    if (d >= 64) { const int i0 = (d - 64) >> 1; const f32x2v* rp = rope + pos * 16 + i0;
                        const f32x2v a = rp[0], b = rp[1], e = rp[2], f = rp[3];
                        f32x4 w0, w1;
                        w0[0] = v0[0] * a.x - v0[1] * a.y; w0[1] = v0[0] * a.y + v0[1] * a.x;
                        w0[2] = v0[2] * b.x - v0[3] * b.y; w0[3] = v0[2] * b.y + v0[3] * b.x;
                        w1[0] = v1[0] * e.x - v1[1] * e.y; w1[1] = v1[0] * e.y + v1[1] * e.x;
                        w1[2] = v1[2] * f.x - v1[3] * f.y; w1[3] = v1[2] * f.y + v1[3] * f.x;
                        v0 = w0; v1 = w1; }
                    u32x4 w; w.x = cvt_pk_bf16(v0[0], v0[1]); w.y = cvt_pk_bf16(v0[2], v0[3]); w.z = cvt_pk_bf16(v1[0], v1[1]); w.w = cvt_pk_bf16(v1[2], v1[3]);
                    *(u32x4*)(Q + (size_t)row * 768 + c) = w; }
                asm volatile("" ::: "memory");
            }
    }
};
struct EpiKVup {
    static constexpr bool PERM = true, AFTER_DRAIN = false, MIDK = false;
    pg8::bf16_t* KV; const float* ssq;
    __device__ __forceinline__ void operator()(const f32x4 (&acc)[2][2][4][2], const Unit& u, int wr, int wc, int fr, int fq) const {
        const int row0 = u.pm * BM + wr * 64 + fr, col0 = u.pn * BM + wc * 32 + 8 * fq;
#pragma unroll
        for (int ai = 0; ai < 2; ++ai) {
            f32x4 pq[4];
#pragma unroll
            for (int m = 0; m < 4; ++m) pq[m] = *(const f32x4*)(ssq + (size_t)(row0 + ai * HALF + m * 16) * 8 + 4);
            asm volatile("" ::: "memory");
#pragma unroll
            for (int m = 0; m < 4; ++m) {
                const int row = row0 + ai * HALF + m * 16;
                const f32x4 pp = pq[m];
                const float r = __builtin_amdgcn_rsqf(((pp[0] + pp[1]) + (pp[2] + pp[3])) * (1.0f / 128.0f) + EPS);
#pragma unroll
                for (int bj = 0; bj < 2; ++bj) { const f32x4 v0 = acc[ai][bj][m][0] * r, v1 = acc[ai][bj][m][1] * r;
                    u32x4 w; w.x = cvt_pk_bf16(v0[0], v0[1]); w.y = cvt_pk_bf16(v0[2], v0[3]); w.z = cvt_pk_bf16(v1[0], v1[1]); w.w = cvt_pk_bf16(v1[2], v1[3]);
                    *(u32x4*)(KV + (size_t)row * 1024 + col0 + bj * HALF) = w; }
            }
            asm volatile("" ::: "memory");
        }
    }
};
constexpr int OUT_TAB_OFF = 131072;
struct OutOrder : pg8::StaticOrder {
    const float* ssatt; LAS float* tab;
    struct Pre { f32x4 a, b; };
    __device__ __forceinline__ Pre a_pre(const Unit& u, int tid) const {
        const int row = tid >> 1, which = tid & 1;
        const unsigned off = (unsigned)(((u.pm * BM + row) * 16 + which * 8) * 4);
        const f32x4* pp = (const f32x4*)((const char*)ssatt + off); return Pre{pp[0], pp[1]};
    }
    __device__ __forceinline__ void a_post(const Unit& u, const Pre& p, int tid) const {
        const int row = tid >> 1, which = tid & 1; const f32x4 a = p.a, b = p.b;
        const float r = __builtin_amdgcn_rsqf((((a[0] + a[1]) + (a[2] + a[3])) + ((b[0] + b[1]) + (b[2] + b[3]))) * (1.0f / 512.0f) + EPS);
        const float o = __shfl_xor(r, 1);
        if (which == 0) { LAS float* t = tab + (u.ui & 1) * 512 + row * 2; t[0] = r / o; t[1] = o; }
    }
};
struct EpiOut {
    static constexpr bool PERM = true, AFTER_DRAIN = false, MIDK = true;
    const pg8::bf16_t* xb; pg8::bf16_t* H; unsigned char* H8; float* ssh; const LAS float* tab;
    __device__ __forceinline__ void midk(f32x4 (&acc)[2][2][4][2], const Unit& u, int wr, int fr) const {
        const LAS float* t = tab + (u.ui & 1) * 512 + (wr * 64 + fr) * 2;
#pragma unroll
        for (int ai = 0; ai < 2; ++ai)
#pragma unroll
            for (int m = 0; m < 4; ++m) { const float ratio = t[(ai * HALF + m * 16) * 2];
#pragma unroll
                for (int bj = 0; bj < 2; ++bj) { acc[ai][bj][m][0] *= ratio; acc[ai][bj][m][1] *= ratio; } }
    }
    __device__ __forceinline__ void operator()(const f32x4 (&acc)[2][2][4][2], const Unit& u, int wr, int wc, int fr, int fq) const {
        const int row0 = u.pm * BM + wr * 64 + fr, col0 = u.pn * BM + wc * 32 + 8 * fq;
        const LAS float* t = tab + (u.ui & 1) * 512 + (wr * 64 + fr) * 2 + 1;
#pragma unroll
        for (int ai = 0; ai < 2; ++ai) {
            u32x4 xr[4][2];
#pragma unroll
            for (int m = 0; m < 4; ++m)
#pragma unroll
                for (int bj = 0; bj < 2; ++bj) xr[m][bj] = *(const u32x4*)(xb + (size_t)(row0 + ai * HALF + m * 16) * DM + col0 + bj * HALF);
            asm volatile("" ::: "memory");
#pragma unroll
            for (int m = 0; m < 4; ++m) {
                const int row = row0 + ai * HALF + m * 16; const float r = t[(ai * HALF + m * 16) * 2];
                float s = 0.f;
#pragma unroll
                for (int bj = 0; bj < 2; ++bj) { const size_t off = (size_t)row * DM + col0 + bj * HALF;
                    const u32x4 xw = xr[m][bj];
                    f32x4 x0, x1; x0[0] = bflo(xw.x); x0[1] = bfhi(xw.x); x0[2] = bflo(xw.y); x0[3] = bfhi(xw.y); x1[0] = bflo(xw.z); x1[1] = bfhi(xw.z); x1[2] = bflo(xw.w); x1[3] = bfhi(xw.w);
                    const f32x4 v0 = x0 + acc[ai][bj][m][0] * r, v1 = x1 + acc[ai][bj][m][1] * r;
                    u32x4 w; w.x = cvt_pk_bf16(v0[0], v0[1]); w.y = cvt_pk_bf16(v0[2], v0[3]); w.z = cvt_pk_bf16(v1[0], v1[1]); w.w = cvt_pk_bf16(v1[2], v1[3]);
                    *(u32x4*)(H + off) = w; s += sq4(v0) + sq4(v1);
                    u32x2 w8; w8.x = pg8::cvt_pk4_fp8(v0[0], v0[1], v0[2], v0[3]); w8.y = pg8::cvt_pk4_fp8(v1[0], v1[1], v1[2], v1[3]); *(u32x2*)(H8 + off) = w8; }
                s += __shfl_xor(s, 16); s += __shfl_xor(s, 32);
                if (fq == 0) ssh[(size_t)row * 16 + u.pn * 4 + wc] = s;
            }
            asm volatile("" ::: "memory");
        }
    }
};
struct GUOrder : pg8::StaticOrder {
    const float* ssh; LAS float* tab;
    struct Pre { f32x4 a, b; };
    __device__ __forceinline__ Pre a_pre(const Unit& u, int tid) const {
        const int row = tid >> 1, which = tid & 1;
        const unsigned off = (unsigned)(((u.pm * BM + row) * 16 + which * 8) * 4);
        const f32x4* pp = (const f32x4*)((const char*)ssh + off); return Pre{pp[0], pp[1]};
    }
    __device__ __forceinline__ void a_post(const Unit& u, const Pre& p, int tid) const {
        const int row = tid >> 1, which = tid & 1; const f32x4 a = p.a, b = p.b;
        float s = ((a[0] + a[1]) + (a[2] + a[3])) + ((b[0] + b[1]) + (b[2] + b[3]));
        s += __shfl_xor(s, 1);
        if (which == 0) tab[(u.ui & 1) * 256 + row] = __builtin_amdgcn_rsqf(s * (1.0f / 1024.0f) + EPS) * (1.0f / 128.0f);
    }
};
struct EpiGU {
    static constexpr bool PERM = true, AFTER_DRAIN = false, MIDK = false;
    unsigned char* HID; const LAS float* tab;
    __device__ __forceinline__ void operator()(const f32x4 (&acc)[2][2][4][2], const Unit& u, int wr, int wc, int fr, int fq) const {
        const int row0 = u.pm * BM + wr * 64 + fr, col0 = u.pn * HALF + wc * 32 + 8 * fq;
        const LAS float* t = tab + (u.ui & 1) * 256 + wr * 64 + fr;
#pragma unroll
        for (int ai = 0; ai < 2; ++ai)
#pragma unroll
            for (int m = 0; m < 4; ++m) {
                const int row = row0 + ai * HALF + m * 16; const float r = t[ai * HALF + m * 16];
                const f32x2v rn2 = {-r * LOG2E, -r * LOG2E}, rr2 = {r * r, r * r}, one2 = {1.0f, 1.0f};
                float o[8];
#pragma unroll
                for (int n = 0; n < 2; ++n)
#pragma unroll
                    for (int e = 0; e < 4; e += 2) { const f32x2v a0 = {acc[ai][0][m][n][e], acc[ai][0][m][n][e + 1]}, a1 = {acc[ai][1][m][n][e], acc[ai][1][m][n][e + 1]};
                        const f32x2v tt = a0 * rn2; f32x2v ex; ex.x = __builtin_amdgcn_exp2f(tt.x); ex.y = __builtin_amdgcn_exp2f(tt.y);
                        const f32x2v dd = ex + one2; f32x2v rc; rc.x = __builtin_amdgcn_rcpf(dd.x); rc.y = __builtin_amdgcn_rcpf(dd.y);
                        const f32x2v oo = (a0 * a1) * (rc * rr2);
                        o[n * 4 + e] = __builtin_amdgcn_fmed3f(oo.x, -448.0f, 448.0f); o[n * 4 + e + 1] = __builtin_amdgcn_fmed3f(oo.y, -448.0f, 448.0f); }
                u32x2 w; w.x = pg8::cvt_pk4_fp8(o[0], o[1], o[2], o[3]); w.y = pg8::cvt_pk4_fp8(o[4], o[5], o[6], o[7]);
                *(u32x2*)(HID + (size_t)row * DFF + col0) = w;
            }
    }
};
struct EpiDown {
    static constexpr bool PERM = true, AFTER_DRAIN = false, MIDK = false;
    const pg8::bf16_t* H; pg8::bf16_t* H2; float* ss2;
    __device__ __forceinline__ void operator()(const f32x4 (&acc)[2][2][4][2], const Unit& u, int wr, int wc, int fr, int fq) const {
        const int row0 = u.pm * BM + wr * 64 + fr, col0 = u.pn * BM + wc * 32 + 8 * fq;
#pragma unroll
        for (int ai = 0; ai < 2; ++ai) {
            u32x4 hr[4][2];
#pragma unroll
            for (int m = 0; m < 4; ++m)
#pragma unroll
                for (int bj = 0; bj < 2; ++bj) hr[m][bj] = *(const u32x4*)(H + (size_t)(row0 + ai * HALF + m * 16) * DM + col0 + bj * HALF);
            asm volatile("" ::: "memory");
#pragma unroll
            for (int m = 0; m < 4; ++m) {
                const int row = row0 + ai * HALF + m * 16; float s = 0.f;
#pragma unroll
                for (int bj = 0; bj < 2; ++bj) { const size_t off = (size_t)row * DM + col0 + bj * HALF;
                    const u32x4 hw = hr[m][bj];
                    f32x4 h0, h1; h0[0] = bflo(hw.x); h0[1] = bfhi(hw.x); h0[2] = bflo(hw.y); h0[3] = bfhi(hw.y); h1[0] = bflo(hw.z); h1[1] = bfhi(hw.z); h1[2] = bflo(hw.w); h1[3] = bfhi(hw.w);
                    h0 += acc[ai][bj][m][0] * (1.0f / 128.0f); h1 += acc[ai][bj][m][1] * (1.0f / 128.0f);
                    u32x4 w; w.x = cvt_pk_bf16(h0[0], h0[1]); w.y = cvt_pk_bf16(h0[2], h0[3]); w.z = cvt_pk_bf16(h1[0], h1[1]); w.w = cvt_pk_bf16(h1[2], h1[3]);
                    *(u32x4*)(H2 + off) = w; s += sq4(h0) + sq4(h1); }
                s += __shfl_xor(s, 16); s += __shfl_xor(s, 32);
                if (fq == 0) ss2[(size_t)row * 16 + u.pn * 4 + wc] = s;
            }
            asm volatile("" ::: "memory");
        }
    }
};

struct Args { const float* in[22]; float* out; unsigned char* ws; int ph_lo, ph_hi, li, pad; };
enum { I_X = 0, I_GMIX, I_WIN, I_GQ, I_WUQ, I_GKV, I_WUKV, I_POSK, I_W1K, I_W2K, I_POSV, I_W1V, I_W2V, I_T5, I_GOM, I_GON, I_WOUT, I_GFFN, I_WG, I_WU, I_WD, I_GFIN };

__device__ __forceinline__ float wave_sum(float v) {
#pragma unroll
    for (int o = 1; o < 64; o <<= 1) v += __shfl_xor(v, o);
    return v;
}
typedef __bf16 bf16x2_t __attribute__((ext_vector_type(2)));
__device__ __forceinline__ float dot2(unsigned a, unsigned b, float c) { return __builtin_amdgcn_fdot2_f32_bf16(__builtin_bit_cast(bf16x2_t, a), __builtin_bit_cast(bf16x2_t, b), c, false); }

template <class F> __device__ __forceinline__ void tr_item(F f, bf16* WT, int ldk, int nblk, LAS float* scr, int item, int lane) {
    const int kb = item / nblk, nb = item % nblk, k0 = 64 * kb, n0 = 32 * nb;
#pragma unroll 8
    for (int i = 0; i < 32; ++i) { const int kk = 2 * i + (lane >> 5); scr[kk * 33 + (lane & 31)] = f(k0 + kk, n0 + (lane & 31)); }
    LDS_WAIT(); asm volatile("" ::: "memory");
    const int c = lane & 7;
#pragma unroll
    for (int j = 0; j < 4; ++j) { const int n = (lane >> 3) + 8 * j; const LAS float* s = scr + (8 * c) * 33 + n;
        v4u o; o.x = pk2(s[0 * 33], s[1 * 33]); o.y = pk2(s[2 * 33], s[3 * 33]); o.z = pk2(s[4 * 33], s[5 * 33]); o.w = pk2(s[6 * 33], s[7 * 33]);
        *(GAS v4u*)(WT + (size_t)(n0 + n) * ldk + k0 + 8 * c) = o; }
    LDS_WAIT(); asm volatile("" ::: "memory");
}
template <class F> __device__ __forceinline__ void tr_item8(F f, unsigned char* WT, int ldk, int nblk, LAS float* scr, int item, int lane) {
    const int kb = item / nblk, nb = item % nblk, k0 = 64 * kb, n0 = 32 * nb;
#pragma unroll 8
    for (int i = 0; i < 32; ++i) { const int kk = 2 * i + (lane >> 5); scr[kk * 33 + (lane & 31)] = f(k0 + kk, n0 + (lane & 31)); }
    LDS_WAIT(); asm volatile("" ::: "memory");
    const int c = lane & 7;
#pragma unroll
    for (int j = 0; j < 4; ++j) { const int n = (lane >> 3) + 8 * j; const LAS float* s = scr + (8 * c) * 33 + n;
        u32x2 o; o.x = pg8::cvt_pk4_fp8(s[0 * 33], s[1 * 33], s[2 * 33], s[3 * 33]); o.y = pg8::cvt_pk4_fp8(s[4 * 33], s[5 * 33], s[6 * 33], s[7 * 33]);
        *(GAS u32x2*)(WT + (size_t)(n0 + n) * ldk + k0 + 8 * c) = o; }
    LDS_WAIT(); asm volatile("" ::: "memory");
}
__device__ __forceinline__ int t5_bucket(int n) {
    if (n < 16) return n;
    int b = 16; b += n >= 19; b += n >= 21; b += n >= 24; b += n >= 27; b += n >= 31; b += n >= 35; b += n >= 40; b += n >= 46; b += n >= 52; b += n >= 59; b += n >= 67; b += n >= 77; b += n >= 87; b += n >= 99; b += n >= 113;
    return b;
}
__device__ __forceinline__ float gelu_tanh(float x) {
    const float y = 0.7978845608028654f * (x + 0.044715f * x * x * x);
    const float e = __builtin_amdgcn_exp2f(2.0f * LOG2E * y);
    const float th = 1.0f - 2.0f * __builtin_amdgcn_rcpf(e + 1.0f);
    return 0.5f * x * (1.0f + th);
}

struct Ptrs {
    const float* in[22]; float* out; unsigned char* ws;
    bf16 *Win, *Wuq, *Wukv, *Wout, *Wgu, *Wdn; f32x2v* rope; float *bias, *bias1, *rstdx, *ssqkv, *ssatt, *ssh;
    bf16 *kcmp, *vcmp, *kpe, *ovt, *W1c, *W2t, *XB, *U, *QM, *KVM, *ATT, *H, *HID;
};

__device__ __forceinline__ void p0_prologue(const Ptrs& P, LAS unsigned char* lds, int wg, int G, int wave, int lane, int tid) {
    LAS float* scr = (LAS float*)(lds + wave * 16384);
    const int gw = wg * NWAVES + wave, NGW = G * NWAVES;
    constexpr int I_IN = (1024 / 64) * (DINP / 32), I_UQ = (256 / 64) * (768 / 32), I_UKV = (256 / 64) * (1024 / 32), I_OUT = (1024 / 64) * (1024 / 32), I_GU = (1024 / 64) * (NGU / 32), I_DN = (DFF / 64) * (1024 / 32);
    constexpr int I_W1C = 2 * (1024 / 64) * (256 / 32), I_W2T = 2 * (128 / 64) * (64 / 32);
    constexpr int NITEMS = I_IN + I_UQ + I_UKV + I_OUT + I_GU + I_DN + I_W1C + I_W2T;
    for (int it = gw; it < NITEMS; it += NGW) {
        int r = it;
        if (r < I_IN) { const float* W = P.in[I_WIN]; const float* g = P.in[I_GMIX];
            tr_item([=](int k, int n) -> float { if (n >= DIN) return 0.f; const float s = (n >= C_QN && n < C_KVC) ? C2N : 1.0f; return W[(size_t)k * DIN + n] * g[k] * s; }, P.Win, 1024, DINP / 32, scr, r, lane); continue; } r -= I_IN;
        if (r < I_UQ) { const float* W = P.in[I_WUQ]; const float* g = P.in[I_GQ];
            tr_item([=](int k, int n) -> float { const int h = n / 96, d = n % 96; int src = n; if (d >= 64) { const int e = d - 64; src = h * 96 + 64 + (e & 1) * 16 + (e >> 1); } return W[(size_t)k * 768 + src] * g[k]; }, P.Wuq, 256, 768 / 32, scr, r, lane); continue; } r -= I_UQ;
        if (r < I_UKV) { const float* W = P.in[I_WUKV]; const float* g = P.in[I_GKV];
            tr_item([=](int k, int n) -> float { return k < 128 ? W[(size_t)k * 1024 + n] * g[k] : 0.f; }, P.Wukv, 256, 1024 / 32, scr, r, lane); continue; } r -= I_UKV;
        if (r < I_OUT) { const float* W = P.in[I_WOUT]; const float* g1 = P.in[I_GOM]; const float* g2 = P.in[I_GON];
            tr_item([=](int k, int n) -> float { return W[(size_t)k * 1024 + n] * (k < 512 ? g1[k] : g2[k - 512]); }, P.Wout, 1024, 1024 / 32, scr, r, lane); continue; } r -= I_OUT;
        if (r < I_GU) { const float* g = P.in[I_GFFN]; const bool up = ((r % (NGU / 32)) & 4) != 0;
            if (!up) { const float* W = P.in[I_WG]; tr_item8([=](int k, int n) -> float { return W[(size_t)k * DFF + (n >> 8) * 128 + (n & 127)] * (g[k] * 128.0f); }, (unsigned char*)P.Wgu, 1024, NGU / 32, scr, r, lane); }
            else { const float* W = P.in[I_WU]; tr_item8([=](int k, int n) -> float { return W[(size_t)k * DFF + (n >> 8) * 128 + (n & 127)] * (g[k] * 128.0f); }, (unsigned char*)P.Wgu, 1024, NGU / 32, scr, r, lane); }
            continue; } r -= I_GU;
        if (r < I_DN) { const float* W = P.in[I_WD];
            tr_item8([=](int k, int n) -> float { return W[(size_t)k * 1024 + n] * 128.0f; }, (unsigned char*)P.Wdn, DFF, 1024 / 32, scr, r, lane); continue; } r -= I_DN;
        if (r < I_W1C) { const int kv = r >= I_W1C / 2; if (kv) r -= I_W1C / 2;
            if (!kv) { const float* W = P.in[I_W1K]; tr_item([=](int k, int n) -> float { return W[(size_t)(k + ((n >> 7) << 10)) * 128 + (n & 127)]; }, P.W1c, 1024, 256 / 32, scr, r, lane); }
            else { const float* W = P.in[I_W1V]; tr_item([=](int k, int n) -> float { return W[(size_t)(k + ((n >> 7) << 10)) * 128 + (n & 127)]; }, P.W1c + 256 * 1024, 1024, 256 / 32, scr, r, lane); }
            continue; } r -= I_W1C;
        { const int kv = r >= I_W2T / 2; if (kv) r -= I_W2T / 2;
            if (!kv) { const float* W = P.in[I_W2K]; tr_item([=](int k, int n) -> float { return W[(size_t)k * 64 + n]; }, P.W2t, 128, 64 / 32, scr, r, lane); }
            else { const float* W = P.in[I_W2V]; tr_item([=](int k, int n) -> float { return W[(size_t)k * 64 + n]; }, P.W2t + 64 * 128, 128, 64 / 32, scr, r, lane); } }
    }
    const int gt = wg * NTHR + tid, NGT = G * NTHR;
    for (int e = gt; e < SEQ * 16; e += NGT) { const int pos = e >> 4, i = e & 15;
        const float inv = __builtin_amdgcn_exp2f(-(float)i * (13.287712379549449f / 16.0f));
        const float ang = (float)pos * inv;
        double rev = (double)ang * 0.15915494309189535; rev -= __builtin_floor(rev);
        const float fr = (float)rev;
        P.rope[e] = (f32x2v){__builtin_amdgcn_cosf(fr), __builtin_amdgcn_sinf(fr)}; }
    for (int e = gt; e < 8 * 128; e += NGT) { const int h = e >> 7, d = e & 127; P.bias[e] = P.in[I_T5][t5_bucket(d) * 8 + h] * LOG2E; }
    for (int e = gt; e < 256 * 64; e += NGT) { const int i = e >> 6, j = e & 63; float w = 0.f; if (j == (i >> 2)) w += ((i & 3) == 3) ? 1.f : 2.f; if ((i & 3) == 3 && j == (i >> 2) + 1) w += 1.f;
        P.ovt[e] = (bf16)(__float_as_uint(w) >> 16); }
    for (int o = gw; o < 256; o += NGW) { const int kv = o >> 7, j = o & 127; const float* pos = P.in[kv ? I_POSV : I_POSK]; const float* w1 = P.in[kv ? I_W1V : I_W1K];
        float s = 0.f; for (int k = lane; k < 2048; k += 64) s += pos[k] * w1[(size_t)k * 128 + j];
        s = wave_sum(s); if (lane == 0) P.bias1[o] = s; }
    for (int m0 = gw * 4; m0 < MT; m0 += NGW * 4) {
        f32x4 v[4][4];
#pragma unroll
        for (int q = 0; q < 4; ++q) { const GAS f32x4* xr = (const GAS f32x4*)(P.in[I_X] + (size_t)(m0 + q) * DM) + lane;
#pragma unroll
            for (int j = 0; j < 4; ++j) v[q][j] = __builtin_nontemporal_load(xr + 64 * j); }
#pragma unroll
        for (int q = 0; q < 4; ++q) { float s = 0.f;
#pragma unroll
            for (int j = 0; j < 4; ++j) s += sq4(v[q][j]);
            s = wave_sum(s);
            if (lane == 0) P.rstdx[m0 + q] = __builtin_amdgcn_rsqf(s * (1.0f / DM) + EPS);
            GAS unsigned long long* o8 = (GAS unsigned long long*)(P.XB + (size_t)(m0 + q) * DM) + lane;
#pragma unroll
            for (int j = 0; j < 4; ++j) o8[64 * j] = (unsigned long long)pk2(v[q][j][0], v[q][j][1]) | ((unsigned long long)pk2(v[q][j][2], v[q][j][3]) << 32); }
    }
}

__device__ __forceinline__ void p2_kpe(const Ptrs& P, int wg, int G, int tid) {
    const int gt = wg * NTHR + tid, NGT = G * NTHR;
    for (int e = gt; e < MT * 16; e += NGT) { const int row = e >> 4, i = e & 15; const int pos = row & (SEQ - 1);
        const float x1 = bf2f(P.U[(size_t)row * DINP + C_KR + i]), x2 = bf2f(P.U[(size_t)row * DINP + C_KR + 16 + i]);
        const f32x2v cs = P.rope[pos * 16 + i];
        *(unsigned*)(P.kpe + (size_t)row * 32 + 2 * i) = pk2(x1 * cs.x - x2 * cs.y, x1 * cs.y + x2 * cs.x); }
}
__device__ __forceinline__ void p7_final(const Ptrs& P, int wg, int G, int wave, int lane) {
    const int gw = wg * NWAVES + wave, NGW = G * NWAVES;
    const GAS f32x4* gp = (const GAS f32x4*)P.in[I_GFIN] + 2 * lane; f32x4 gg[4][2];
#pragma unroll
    for (int j = 0; j < 2; ++j) { gg[j][0] = gp[128 * j]; gg[j][1] = gp[128 * j + 1]; }
    for (int m0 = gw * 4; m0 < MT; m0 += NGW * 4) {
        u32x4 w0[4], w1[4]; float pv[4];
#pragma unroll
        for (int q = 0; q < 4; ++q) { const GAS u32x4* hr = (const GAS u32x4*)(P.ATT + (size_t)(m0 + q) * DM) + lane;
            w0[q] = hr[0]; w1[q] = hr[64]; pv[q] = (lane < 16) ? P.ssatt[(size_t)(m0 + q) * 16 + lane] : 0.f; }
#pragma unroll
        for (int q = 0; q < 4; ++q) {
            const float r = __builtin_amdgcn_rsqf(wave_sum(pv[q]) * (1.0f / DM) + EPS);
            GAS f32x4* o = (GAS f32x4*)(P.out + (size_t)(m0 + q) * DM) + 2 * lane;
            { const u32x4 w = w0[q]; f32x4 a, b; a[0] = bflo(w.x); a[1] = bfhi(w.x); a[2] = bflo(w.y); a[3] = bfhi(w.y); b[0] = bflo(w.z); b[1] = bfhi(w.z); b[2] = bflo(w.w); b[3] = bfhi(w.w);
              o[0] = a * r * gg[0][0]; o[1] = b * r * gg[0][1]; }
            { const u32x4 w = w1[q]; f32x4 a, b; a[0] = bflo(w.x); a[1] = bfhi(w.x); a[2] = bflo(w.y); a[3] = bfhi(w.y); b[0] = bflo(w.z); b[1] = bfhi(w.z); b[2] = bflo(w.w); b[3] = bfhi(w.w);
              o[128] = a * r * gg[1][0]; o[129] = b * r * gg[1][1]; } }
    }
}

struct CmpOrder {
    int G, c; const bf16* U; const bf16* W1c;
    __device__ __forceinline__ bool next(int i, Unit& u) const { const int un = c + i * G; if (un >= 64) return false; u.pm = un; u.pn = 0; u.ui = i; return true; }
    struct Pre {};
    __device__ __forceinline__ Pre a_pre(const Unit&, int) const { return Pre{}; }
    __device__ __forceinline__ void a_post(const Unit&, const Pre&, int) const {}
    __device__ __forceinline__ void done(const Unit&) const {}
    __device__ __forceinline__ const char* a_base(const pg8::Gemm&, const Unit& u, size_t) const { const int bh = u.pm >> 1, kv = u.pm & 1;
        return (const char*)(U + (size_t)(bh >> 1) * SEQ * DINP + C_KVC + kv * 128 + (bh & 1) * 64); }
    __device__ __forceinline__ const char* b_base(const pg8::Gemm&, const Unit& u, size_t) const { return (const char*)(W1c + (size_t)(u.pm & 1) * 256 * 1024); }
};
struct EpiCmp {
    static constexpr bool PERM = true, AFTER_DRAIN = true, MIDK = false;
    const float* bias1; const bf16* W2t; bf16* kcmp; bf16* vcmp;
    __device__ __forceinline__ void operator()(const f32x4 (&)[2][2][4][2], const Unit&, int, int, int, int) const {}
    __device__ __forceinline__ void fused(f32x4 (&acc)[2][2][4][2], const Unit& u, int wr, int wc, int fr, int fq, LAS unsigned char* lds, int wid, int lane) const {
        typedef short bf16x8_t __attribute__((ext_vector_type(8))); typedef float f32x16_t __attribute__((ext_vector_type(16)));
        const int bh = u.pm >> 1, kv = u.pm & 1; const int col = wc * 32 + 8 * fq;
        LAS float* OB = (LAS float*)lds;
#pragma unroll
        for (int ai = 0; ai < 2; ++ai)
#pragma unroll
            for (int m = 0; m < 4; ++m) { const int r = ai * HALF + wr * 64 + m * 16 + fr;
                *(LAS f32x4*)(OB + r * 132 + col) = acc[ai][1][m][0]; *(LAS f32x4*)(OB + r * 132 + col + 4) = acc[ai][1][m][1]; }
        const f32x4 bs0 = *(const f32x4*)(bias1 + kv * 128 + col), bs1 = *(const f32x4*)(bias1 + kv * 128 + col + 4);
        asm volatile("s_waitcnt lgkmcnt(0)" ::: "memory"); __builtin_amdgcn_s_barrier(); asm volatile("" ::: "memory");
#pragma unroll
        for (int ai = 0; ai < 2; ++ai)
#pragma unroll
            for (int m = 0; m < 4; ++m) { const int r = ai * HALF + wr * 64 + m * 16 + fr, r1 = r < 255 ? r + 1 : 255;
                const f32x4 b0 = *(const LAS f32x4*)(OB + r1 * 132 + col), b1 = *(const LAS f32x4*)(OB + r1 * 132 + col + 4);
                f32x4 h0 = acc[ai][0][m][0] + b0 + bs0, h1 = acc[ai][0][m][1] + b1 + bs1;
#pragma unroll
                for (int e = 0; e < 4; ++e) { h0[e] = gelu_tanh(h0[e]); h1[e] = gelu_tanh(h1[e]); }
                acc[ai][0][m][0] = h0; acc[ai][0][m][1] = h1; }
        asm volatile("s_waitcnt lgkmcnt(0)" ::: "memory"); __builtin_amdgcn_s_barrier(); asm volatile("" ::: "memory");
        LAS bf16* GB = (LAS bf16*)lds;
#pragma unroll
        for (int ai = 0; ai < 2; ++ai)
#pragma unroll
            for (int m = 0; m < 4; ++m) { const int r = ai * HALF + wr * 64 + m * 16 + fr; const f32x4 h0 = acc[ai][0][m][0], h1 = acc[ai][0][m][1];
                u32x4 w; w.x = pk2(h0[0], h0[1]); w.y = pk2(h0[2], h0[3]); w.z = pk2(h1[0], h1[1]); w.w = pk2(h1[2], h1[3]);
                *(LAS u32x4*)(GB + r * 136 + col) = w; }
        asm volatile("s_waitcnt lgkmcnt(0)" ::: "memory"); __builtin_amdgcn_s_barrier(); asm volatile("" ::: "memory");
        const int r32 = lane & 31, hi = lane >> 5, c = wid * 32 + r32;
        f32x16_t o[2]; o[0] = f32x16_t{}; o[1] = f32x16_t{};
        const bf16* w2 = W2t + (size_t)kv * 64 * 128;
#pragma unroll
        for (int s = 0; s < 8; ++s) { const bf16x8_t gb = *(const LAS bf16x8_t*)(GB + c * 136 + 16 * s + 8 * hi);
#pragma unroll
            for (int dt = 0; dt < 2; ++dt) { const bf16x8_t wa = *(const bf16x8_t*)(w2 + (size_t)(32 * dt + r32) * 128 + 16 * s + 8 * hi);
                o[dt] = __builtin_amdgcn_mfma_f32_32x32x16_bf16(wa, gb, o[dt], 0, 0, 0); } }
        if (c < NCMP) { bf16* op = (kv ? vcmp : kcmp) + ((size_t)bh * 256 + c) * 64 + 4 * hi;
#pragma unroll
            for (int dt = 0; dt < 2; ++dt)
#pragma unroll
                for (int k = 0; k < 4; ++k) *(unsigned long long*)(op + 32 * dt + 8 * k) = (unsigned long long)pk2(o[dt][4 * k], o[dt][4 * k + 1]) | ((unsigned long long)pk2(o[dt][4 * k + 2], o[dt][4 * k + 3]) << 32); }
        asm volatile("s_waitcnt lgkmcnt(0)" ::: "memory"); __builtin_amdgcn_s_barrier();
    }
};

namespace att {
typedef short bf16x8 __attribute__((ext_vector_type(8)));
typedef short s16x4 __attribute__((ext_vector_type(4)));
typedef float f32x16 __attribute__((ext_vector_type(16)));
typedef __attribute__((address_space(3))) const char* lds_cptr;
constexpr float THR = 8.0f;
constexpr float NEG_INF = -__builtin_inff();
__device__ __forceinline__ int crow(int r, int hi) { return (r & 3) + 8 * (r >> 2) + 4 * hi; }
__device__ __forceinline__ float swap_max(float x) { auto rr = __builtin_amdgcn_permlane32_swap(__float_as_uint(x), __float_as_uint(x), false, false); return fmaxf(__uint_as_float(rr[0]), __uint_as_float(rr[1])); }
__device__ __forceinline__ float swap_sum(float x) { auto rr = __builtin_amdgcn_permlane32_swap(__float_as_uint(x), __float_as_uint(x), false, false); return __uint_as_float(rr[0]) + __uint_as_float(rr[1]); }
__device__ __forceinline__ float partner32(float x, int hi) { auto rr = __builtin_amdgcn_permlane32_swap(__float_as_uint(x), __float_as_uint(x), false, false); return __uint_as_float(hi ? rr[0] : rr[1]); }
__device__ __forceinline__ unsigned partner32u(unsigned x, int hi) { auto rr = __builtin_amdgcn_permlane32_swap(x, x, false, false); return hi ? rr[0] : rr[1]; }
__device__ __forceinline__ void dma16(const void* g, LAS unsigned char* l) { unsigned keep; const unsigned dst = (unsigned)__builtin_amdgcn_readfirstlane((int)(unsigned)(uintptr_t)l);
    asm volatile("s_mov_b32 %0, m0\n\ts_mov_b32 m0, %2\n\ts_nop 0\n\tglobal_load_lds_dwordx4 %1, off\n\ts_mov_b32 m0, %0" : "=&s"(keep) : "v"(g), "s"(dst) : "memory"); }
template <int N> __device__ __forceinline__ void wait_bar() { if (N == 3) asm volatile("s_waitcnt vmcnt(3) lgkmcnt(0)\n\ts_barrier" ::: "memory"); else if (N == 2) asm volatile("s_waitcnt vmcnt(2) lgkmcnt(0)\n\ts_barrier" ::: "memory"); else asm volatile("s_waitcnt vmcnt(0) lgkmcnt(0)\n\ts_barrier" ::: "memory"); }

struct SrcMLA {
    static constexpr int DK = 96, NDMA = 3, NV = 1;
    const bf16* kn; const bf16* kp; const bf16* v;
    __device__ __forceinline__ void init(const bf16* KVM, const bf16* KPE, size_t rowb, int h, int wid, int lane) {
        kn = KVM + (rowb + lane) * 1024 + h * 128 + 8 * wid;
        kp = KPE + (rowb + lane) * 32 + 8 * (wid & 3);
        v = KVM + (rowb + 16 * (wid & 3) + (lane >> 2)) * 1024 + h * 128 + 64 + (wid >> 2) * 32 + (lane & 3) * 8; }
    static constexpr int NKD = 2;
    __device__ __forceinline__ void issueK(int tile, LAS unsigned char* ks, int wid) const {
        dma16(kn + (size_t)tile * 64 * 1024, ks + wid * 1024);
        dma16(kp + (size_t)tile * 64 * 32, ks + (8 + (wid & 3)) * 1024); }
    __device__ __forceinline__ void issueV(int tile, LAS unsigned char* vs, int wid) const { dma16(v + (size_t)tile * 64 * 1024, vs + wid * 1024); }
    __device__ __forceinline__ void issue(int tile, LAS unsigned char* ks, LAS unsigned char* vs, int wid) const { issueK(tile, ks, wid); issueV(tile, vs, wid); }
};
struct SrcRows {
    static constexpr int DK = 64, NDMA = 2, NV = 1;
    const bf16* k; const bf16* v; size_t pitch;
    __device__ __forceinline__ void init(const bf16* K0, const bf16* V0, size_t pitch_, int wid, int lane) {
        pitch = pitch_; k = K0 + (size_t)lane * pitch + 8 * wid; v = V0 + (size_t)(16 * (wid & 3) + (lane >> 2)) * pitch + (wid >> 2) * 32 + (lane & 3) * 8; }
    static constexpr int NKD = 1;
    __device__ __forceinline__ void issueK(int tile, LAS unsigned char* ks, int wid) const { dma16(k + (size_t)tile * 64 * pitch, ks + wid * 1024); }
    __device__ __forceinline__ void issueV(int tile, LAS unsigned char* vs, int wid) const { dma16(v + (size_t)tile * 64 * pitch, vs + wid * 1024); }
    __device__ __forceinline__ void issue(int tile, LAS unsigned char* ks, LAS unsigned char* vs, int wid) const { issueK(tile, ks, wid); issueV(tile, vs, wid); }
};

struct SrcCmp {
    static constexpr int DK = 64, NDMA = 3, NV = 2;
    const bf16* k; const bf16* v; const bf16* ov;
    __device__ __forceinline__ void init(const bf16* K0, const bf16* V0, const bf16* OV, int wid, int lane) {
        k = K0 + (size_t)lane * 64 + 8 * wid; const size_t vo = (size_t)(16 * (wid & 3) + (lane >> 2)) * 64 + (wid >> 2) * 32 + (lane & 3) * 8; v = V0 + vo; ov = OV + vo; }
    __device__ __forceinline__ void issue(int tile, LAS unsigned char* ks, LAS unsigned char* vs, int wid) const {
        dma16(k + (size_t)tile * 4096, ks + wid * 1024);
        dma16(v + (size_t)tile * 4096, vs + wid * 1024);
        dma16(ov + (size_t)tile * 4096, vs + 8192 + wid * 1024); }
};

template <int NV> struct RowT { float m, l; f32x16 o[2 * NV]; };
typedef RowT<1> Row;
template <int NV> __device__ __forceinline__ void row_reset(RowT<NV>& R) { R.m = -1e30f; R.l = 0.f;
#pragma unroll
    for (int i = 0; i < 2 * NV; ++i) R.o[i] = f32x16{}; }

template <int DK> __device__ __forceinline__ void qk_tile(f32x16& p0, f32x16& p1, LAS unsigned char* kslot, const bf16x8 (&qr)[DK / 16], int r32, int hi) {
    const LAS unsigned char* kb = kslot + hi * 1024 + r32 * 16;
    p0 = f32x16{}; p1 = f32x16{};
#pragma unroll
    for (int d0 = 0; d0 < DK / 16; ++d0) {
        const bf16x8 b0 = *(const LAS bf16x8*)(kb + d0 * 2048), b1 = *(const LAS bf16x8*)(kb + d0 * 2048 + 512);
        p0 = __builtin_amdgcn_mfma_f32_32x32x16_bf16(b0, qr[d0], p0, 0, 0, 0);
        p1 = __builtin_amdgcn_mfma_f32_32x32x16_bf16(b1, qr[d0], p1, 0, 0, 0); }
}
template <int NV> __device__ __forceinline__ void softmax_tile(f32x16& p0, f32x16& p1, RowT<NV>& R) {
    float a = fmaxf(fmaxf(p0[0], p0[1]), fmaxf(p1[0], p1[1]));
#pragma unroll
    for (int r = 2; r < 16; r += 2) a = fmaxf(a, fmaxf(fmaxf(p0[r], p0[r + 1]), fmaxf(p1[r], p1[r + 1])));
    const float mt = swap_max(a);
    if (__any(mt > R.m + THR)) { const float mn = fmaxf(R.m, mt), f = __builtin_amdgcn_exp2f(R.m - mn); R.m = mn; R.l *= f;
#pragma unroll
        for (int i = 0; i < 2 * NV; ++i) R.o[i] *= f; }
    const float m = R.m; float s = 0.f;
#pragma unroll
    for (int r = 0; r < 16; ++r) { p0[r] = __builtin_amdgcn_exp2f(p0[r] - m); p1[r] = __builtin_amdgcn_exp2f(p1[r] - m); s += p0[r] + p1[r]; }
    R.l += s;
}
template <int NV> __device__ __forceinline__ void pv_tile(const f32x16& p0, const f32x16& p1, RowT<NV>& R, LAS unsigned char* vslot, int lane, int hi) {
    bf16x8 pa[4];
#pragma unroll
    for (int k = 0; k < 4; ++k) { const f32x16& P = (k < 2) ? p0 : p1; const int b = (k & 1) * 8;
        u32x4 w; w.x = pk2(P[b], P[b + 1]); w.y = pk2(P[b + 2], P[b + 3]); w.z = pk2(P[b + 4], P[b + 5]); w.w = pk2(P[b + 6], P[b + 7]); pa[k] = __builtin_bit_cast(bf16x8, w); }
    const int vb = (int)(unsigned)(uintptr_t)vslot + ((lane >> 4) & 1) * 32 + (lane & 3) * 8 + (4 * hi + ((lane & 15) >> 2)) * 64;
#pragma unroll
    for (int d0 = 0; d0 < 2 * NV; ++d0) { s16x4 lo[4], hh[4];
#pragma unroll
        for (int ks = 0; ks < 4; ++ks) {
            asm volatile("ds_read_b64_tr_b16 %0,%1 offset:%c2" : "=&v"(lo[ks]) : "v"(vb), "i"(d0 * 4096 + ks * 1024) : "memory");
            asm volatile("ds_read_b64_tr_b16 %0,%1 offset:%c2" : "=&v"(hh[ks]) : "v"(vb), "i"(d0 * 4096 + ks * 1024 + 512) : "memory"); }
        asm volatile("s_waitcnt lgkmcnt(0)" ::: "memory"); __builtin_amdgcn_sched_barrier(0);
#pragma unroll
        for (int ks = 0; ks < 4; ++ks) { const bf16x8 vf = (bf16x8){lo[ks][0], lo[ks][1], lo[ks][2], lo[ks][3], hh[ks][0], hh[ks][1], hh[ks][2], hh[ks][3]};
            R.o[d0] = __builtin_amdgcn_mfma_f32_32x32x16_bf16(vf, pa[ks], R.o[d0], 0, 0, 0); } }
}

template <class RowPtr>
__device__ __forceinline__ void store_rows(LAS unsigned char* stg, const f32x16& o0, const f32x16& o1, float scale, float& ss, int lane, const RowPtr& rowptr) {
    const int r32 = lane & 31, hi = lane >> 5;
    LAS unsigned char* wp = stg + r32 * 144 + 8 * hi;
#pragma unroll
    for (int d0 = 0; d0 < 2; ++d0)
#pragma unroll
        for (int k = 0; k < 4; ++k) { const f32x16& o = d0 ? o1 : o0;
            const float v0 = o[4 * k] * scale, v1 = o[4 * k + 1] * scale, v2 = o[4 * k + 2] * scale, v3 = o[4 * k + 3] * scale;
            ss += (v0 * v0 + v1 * v1) + (v2 * v2 + v3 * v3);
            *(LAS unsigned long long*)(wp + 64 * d0 + 16 * k) = (unsigned long long)pk2(v0, v1) | ((unsigned long long)pk2(v2, v3) << 32); }
    asm volatile("s_waitcnt lgkmcnt(0)" ::: "memory");
#pragma unroll
    for (int i = 0; i < 4; ++i) { const int row = i * 8 + (lane >> 3), ch = lane & 7;
        const u32x4 v = *(const LAS u32x4*)(stg + row * 144 + ch * 16);
        __builtin_nontemporal_store(v, (u32x4*)(rowptr(row) + ch * 8)); }
}

template <class Src, class Fix, class Skip>
__device__ __forceinline__ void run_tiles(LAS unsigned char* ring, const Src& src, int kt0, int kt1, const bf16x8 (&qr)[Src::DK / 16], RowT<Src::NV>& R, const Fix& fix, const Skip& skip, int wid, int lane) {
    constexpr int KB = Src::DK * 128, SLOT = KB + 8192 * Src::NV;
    const int r32 = lane & 31, hi = lane >> 5; const int nt = kt1 - kt0;
    if (nt <= 0) return;
    src.issue(kt0, ring, ring + KB, wid);
    if (nt > 1) src.issue(kt0 + 1, ring + SLOT, ring + SLOT + KB, wid);
    int s_cur = 0, s_nn = 2 * SLOT;
    for (int i = 0; i < nt; ++i) {
        if (i + 1 < nt) wait_bar<Src::NDMA>(); else wait_bar<0>();
        if (i + 2 < nt) src.issue(kt0 + i + 2, ring + s_nn, ring + s_nn + KB, wid);
        const int tile = kt0 + i;
        if (!skip(tile)) {
            f32x16 p0, p1;
            qk_tile<Src::DK>(p0, p1, ring + s_cur, qr, r32, hi);
            fix(p0, p1, tile);
            softmax_tile(p0, p1, R);
            pv_tile(p0, p1, R, ring + s_cur + KB, lane, hi);
        }
        s_cur = (s_cur == 2 * SLOT) ? 0 : s_cur + SLOT; s_nn = (s_nn == 2 * SLOT) ? 0 : s_nn + SLOT;
    }
    asm volatile("s_waitcnt lgkmcnt(0)\n\ts_barrier" ::: "memory");
}
}


namespace att {
template <int N> __device__ __forceinline__ void wait_bar_n() {
    static_assert(N == 0 || N == 3 || N == 4 || N == 5 || N == 6 || N == 8, "wait_bar_n: add the count");
    if (N == 8) asm volatile("s_waitcnt vmcnt(8) lgkmcnt(0)\n\ts_barrier" ::: "memory"); else if (N == 6) asm volatile("s_waitcnt vmcnt(6) lgkmcnt(0)\n\ts_barrier" ::: "memory");
    else if (N == 5) asm volatile("s_waitcnt vmcnt(5) lgkmcnt(0)\n\ts_barrier" ::: "memory"); else if (N == 4) asm volatile("s_waitcnt vmcnt(4) lgkmcnt(0)\n\ts_barrier" ::: "memory");
    else if (N == 3) asm volatile("s_waitcnt vmcnt(3) lgkmcnt(0)\n\ts_barrier" ::: "memory"); else asm volatile("s_waitcnt vmcnt(0) lgkmcnt(0)\n\ts_barrier" ::: "memory"); }
typedef short v4i16_t __attribute__((ext_vector_type(4)));
typedef float f32x2_t __attribute__((ext_vector_type(2)));
__device__ __forceinline__ s16x4 vtr(const LAS unsigned char* p) { return __builtin_bit_cast(s16x4, __builtin_amdgcn_ds_read_tr16_b64_v4i16((LAS v4i16_t*)p)); }
__device__ __forceinline__ unsigned cvtpk(float lo, float hi) { f32x2_t v = {lo, hi}; bf16x2_t b = __builtin_convertvector(v, bf16x2_t); return __builtin_bit_cast(unsigned, b); }
#define SBAR() __builtin_amdgcn_sched_barrier(0)
#define PIN(x) asm volatile("" : "+v"(x))
#define MX3(a, b, c) __builtin_fmaxf(__builtin_fmaxf((a), (b)), (c))

template <class Src, class Fix>
__device__ __forceinline__ void run_pipe(LAS unsigned char* ring, const Src& src, int kt0, int kt1, const bf16x8 (&qr)[Src::DK / 16], Row& R, const Fix& fix, float bfar, int near_from, int wid, int lane) {
    constexpr int DK = Src::DK, NKS = DK / 16, NK = 2 * NKS, KB = DK * 128, VB = 8192, NKD = Src::NKD, NDMA = NKD + 1;
    const int NT = kt1 - kt0;
    constexpr bool ALT = false;
    if (wid >= 4) __builtin_amdgcn_s_setprio(1);
    const int r32 = lane & 31, hi = lane >> 5;
    LAS unsigned char* kring = ring; LAS unsigned char* vring = ring + 4 * KB;
    const LAS unsigned char* kp0 = kring + hi * 1024 + r32 * 16;
    const LAS unsigned char* vp0 = vring + ((lane >> 4) & 1) * 32 + (lane & 3) * 8 + (4 * hi + ((lane & 15) >> 2)) * 64;
#define TILE(tt) (kt0 + ((tt) < NT ? (tt) : NT - 1))
    src.issueK(TILE(0), kring, wid); src.issueV(TILE(0), vring, wid); src.issueK(TILE(1), kring + KB, wid); src.issueK(TILE(2), kring + 2 * KB, wid);
    src.issueK(TILE(3), kring + 3 * KB, wid); src.issueV(TILE(1), vring + VB, wid);
    bf16x8 kf[NK];
    f32x16 A0, A1, B0, B1, cin;
    float m = 0.f, l = 0.f, csh = 0.f; f32x16 o0 = f32x16{}, o1 = f32x16{};
    wait_bar_n<3 * NKD + 2>();
#define KLOAD(kslot) do { _Pragma("unroll") for (int d0 = 0; d0 < NKS; ++d0) { kf[2 * d0] = *(const LAS bf16x8*)(kp0 + (kslot) + d0 * 2048); kf[2 * d0 + 1] = *(const LAS bf16x8*)(kp0 + (kslot) + d0 * 2048 + 512); } } while (0)
#define ROWMAX(C0, C1, out) do { float a_ = MX3(C0[0], C0[1], C1[0]), b_ = MX3(C0[2], C0[3], C1[1]); a_ = MX3(a_, C1[2], C1[3]); \
        _Pragma("unroll") for (int r = 4; r < 16; r += 4) { a_ = MX3(a_, C0[r], C0[r + 1]); b_ = MX3(b_, C0[r + 2], C0[r + 3]); a_ = MX3(a_, C1[r], C1[r + 1]); b_ = MX3(b_, C1[r + 2], C1[r + 3]); } \
        out = swap_max(__builtin_fmaxf(a_, b_)); } while (0)
    KLOAD(0);
    A0 = f32x16{}; A1 = f32x16{};
#pragma unroll
    for (int d0 = 0; d0 < NKS; ++d0) { A0 = __builtin_amdgcn_mfma_f32_32x32x16_bf16(kf[2 * d0], qr[d0], A0, 0, 0, 0); A1 = __builtin_amdgcn_mfma_f32_32x32x16_bf16(kf[2 * d0 + 1], qr[d0], A1, 0, 0, 0); }
    fix(A0, A1, kt0);
    { float rm; ROWMAX(A0, A1, rm);
      const float sh0 = (kt0 < near_from) ? bfar : 0.f;
      const float dl = (rm > NEG_INF) ? rm + sh0 : 0.f; m = dl; const float c0 = sh0 - dl;
#pragma unroll
      for (int r = 0; r < 16; ++r) { A0[r] = __builtin_amdgcn_exp2f(A0[r] + c0); A1[r] = __builtin_amdgcn_exp2f(A1[r] + c0); }
      csh = (kt0 + 1 < near_from) ? bfar : 0.f;
#pragma unroll
      for (int r = 0; r < 16; ++r) cin[r] = csh - m;
      asm volatile("" : "+v"(cin)); }
    float fpend = 1.0f; bool resc = false;
    wait_bar_n<2 * NKD + 1>();
    src.issueK(TILE(4), kring, wid); src.issueV(TILE(2), vring + 2 * VB, wid);
    KLOAD(KB);
    wait_bar_n<2 * NDMA>();
    int kcur = KB, knext = 2 * KB, vprev = 0, vnext = 3 * VB;
    u32x4 pw0, pw1, pw2, pw3; s16x4 vlo[8], vhi[8];
#define PKW(P, b) cvtpk(P[b], P[(b) + 1])
#define VRD(i) do { vlo[i] = vtr(vp_ + (((i) >> 2) * 4096 + ((i) & 3) * 1024)); vhi[i] = vtr(vp_ + (((i) >> 2) * 4096 + ((i) & 3) * 1024 + 512)); } while (0)
#define VFR(i) (bf16x8){vlo[i][0], vlo[i][1], vlo[i][2], vlo[i][3], vhi[i][0], vhi[i][1], vhi[i][2], vhi[i][3]}
#define PAF(k) __builtin_bit_cast(bf16x8, pw##k)
#define QKM(i, C, first) C = __builtin_amdgcn_mfma_f32_32x32x16_bf16(kf[i], qr[(i) >> 1], (first) ? cin : C, 0, 0, 0)
#define GAPA(MF, a0_, a1_, a2_, a3_, W0, W1, PW) do { MF; sacc += a0_; sacc += a1_; sacc += a2_; sacc += a3_; PIN(sacc); W0; W1; PIN(PW); SBAR(); } while (0)
#define GAPB(MF, X, b) do { MF; X[b] = __builtin_amdgcn_exp2f(X[b]); X[(b) + 1] = __builtin_amdgcn_exp2f(X[(b) + 1]); X[(b) + 2] = __builtin_amdgcn_exp2f(X[(b) + 2]); X[(b) + 3] = __builtin_amdgcn_exp2f(X[(b) + 3]); PIN(X); SBAR(); } while (0)
#define PHASE_A(C0, C1, P0, P1) do { SBAR(); const LAS unsigned char* vp_ = vp0 + vprev; \
        VRD(0); SBAR(); float sacc = P0[0] + P0[1]; \
        GAPA(QKM(0, C0, true), P0[2], P0[3], P0[4], P0[5], pw0[0] = PKW(P0, 0), pw0[1] = PKW(P0, 2), pw0); \
        GAPA(QKM(1, C1, true), P0[6], P0[7], P0[8], P0[9], pw0[2] = PKW(P0, 4), pw0[3] = PKW(P0, 6), pw0); \
        VRD(1); SBAR(); GAPA(QKM(2, C0, false), P0[10], P0[11], P0[12], P0[13], pw1[0] = PKW(P0, 8), pw1[1] = PKW(P0, 10), pw1); \
        GAPA(QKM(3, C1, false), P0[14], P0[15], P1[0], P1[1], pw1[2] = PKW(P0, 12), pw1[3] = PKW(P0, 14), pw1); \
        VRD(2); SBAR(); GAPA(QKM(4, C0, false), P1[2], P1[3], P1[4], P1[5], pw2[0] = PKW(P1, 0), pw2[1] = PKW(P1, 2), pw2); \
        GAPA(QKM(5, C1, false), P1[6], P1[7], P1[8], P1[9], pw2[2] = PKW(P1, 4), pw2[3] = PKW(P1, 6), pw2); \
        VRD(3); SBAR(); GAPA(QKM(6, C0, false), P1[10], P1[11], P1[12], P1[13], pw3[0] = PKW(P1, 8), pw3[1] = PKW(P1, 10), pw3); \
        GAPA(QKM(7, C1, false), P1[14], P1[15], 0.f, 0.f, pw3[2] = PKW(P1, 12), pw3[3] = PKW(P1, 14), pw3); \
        if (NK > 8) { _Pragma("unroll") for (int i_ = 8; i_ < NK; i_ += 2) { QKM(i_, C0, false); QKM(i_ + 1, C1, false); } SBAR(); } \
        l += sacc; } while (0)
#define KRD(j) do { kf[2 * (j)] = *(const LAS bf16x8*)(kp0 + knext + (j) * 2048); kf[2 * (j) + 1] = *(const LAS bf16x8*)(kp0 + knext + (j) * 2048 + 512); SBAR(); } while (0)
#define PHASE_B(C0, C1) do { SBAR(); const LAS unsigned char* vp_ = vp0 + vprev; \
        VRD(4); SBAR(); GAPB(o0 = __builtin_amdgcn_mfma_f32_32x32x16_bf16(VFR(0), PAF(0), o0, 0, 0, 0), C0, 0); \
        VRD(5); SBAR(); GAPB(o0 = __builtin_amdgcn_mfma_f32_32x32x16_bf16(VFR(1), PAF(1), o0, 0, 0, 0), C0, 4); \
        VRD(6); SBAR(); KRD(0); GAPB(o0 = __builtin_amdgcn_mfma_f32_32x32x16_bf16(VFR(2), PAF(2), o0, 0, 0, 0), C0, 8); \
        VRD(7); SBAR(); KRD(1); GAPB(o0 = __builtin_amdgcn_mfma_f32_32x32x16_bf16(VFR(3), PAF(3), o0, 0, 0, 0), C0, 12); \
        KRD(2); GAPB(o1 = __builtin_amdgcn_mfma_f32_32x32x16_bf16(VFR(4), PAF(0), o1, 0, 0, 0), C1, 0); \
        KRD(3); GAPB(o1 = __builtin_amdgcn_mfma_f32_32x32x16_bf16(VFR(5), PAF(1), o1, 0, 0, 0), C1, 4); \
        if (NKS > 4) { KRD(4); } GAPB(o1 = __builtin_amdgcn_mfma_f32_32x32x16_bf16(VFR(6), PAF(2), o1, 0, 0, 0), C1, 8); \
        if (NKS > 5) { KRD(5); } GAPB(o1 = __builtin_amdgcn_mfma_f32_32x32x16_bf16(VFR(7), PAF(3), o1, 0, 0, 0), C1, 12); \
        } while (0)
#define DECIDE(C0, C1, tt) do { \
        fix(C0, C1, kt0 + (tt)); \
        float rm_; ROWMAX(C0, C1, rm_); resc = false; \
        const bool up_ = (rm_ > THR) || (l == 0.f && rm_ < -THR && rm_ > NEG_INF); \
        const float nsh_ = (kt0 + (tt) + 1 < near_from) ? bfar : 0.f; \
        if (__any(up_)) { const float dl_ = up_ ? rm_ : __builtin_fmaxf(rm_, 0.f); m += dl_; fpend = __builtin_amdgcn_exp2f(-dl_); l *= fpend; resc = true; \
            _Pragma("unroll") for (int r = 0; r < 16; ++r) { C0[r] -= dl_; C1[r] -= dl_; } \
            csh = nsh_; _Pragma("unroll") for (int r = 0; r < 16; ++r) cin[r] = csh - m; asm volatile("" : "+v"(cin)); } \
        else if (nsh_ != csh) { csh = nsh_; _Pragma("unroll") for (int r = 0; r < 16; ++r) cin[r] = csh - m; asm volatile("" : "+v"(cin)); } } while (0)
#define STEP(C0, C1, P0, P1, tt) do { \
        if (ALT && wid >= 4) asm volatile("s_barrier" ::: "memory"); \
        PHASE_A(C0, C1, P0, P1); \
        src.issueK(TILE((tt) + 4), kring + kcur, wid); src.issueV(TILE((tt) + 2), vring + vnext, wid); \
        DECIDE(C0, C1, tt); \
        PHASE_B(C0, C1); \
        if (ALT && wid < 4) asm volatile("s_waitcnt lgkmcnt(0)\n\ts_barrier" ::: "memory"); \
        wait_bar_n<2 * NDMA>();                                          \
        if (resc) { o0 *= fpend; o1 *= fpend; } \
        kcur = knext; knext = (knext == 3 * KB) ? 0 : knext + KB; \
        vprev = (vprev == 3 * VB) ? 0 : vprev + VB; vnext = (vnext == 3 * VB) ? 0 : vnext + VB; } while (0)
    int t = 1;
    for (; t + 1 < NT; t += 2) { STEP(B0, B1, A0, A1, t); STEP(A0, A1, B0, B1, t + 1); }
    if (t < NT) { STEP(B0, B1, A0, A1, t); A0 = B0; A1 = B1; }
    { float sacc = 0.f;
#pragma unroll
      for (int r = 0; r < 16; ++r) sacc += A0[r] + A1[r];
      l += sacc;
      pw0 = (u32x4){PKW(A0, 0), PKW(A0, 2), PKW(A0, 4), PKW(A0, 6)}; pw1 = (u32x4){PKW(A0, 8), PKW(A0, 10), PKW(A0, 12), PKW(A0, 14)};
      pw2 = (u32x4){PKW(A1, 0), PKW(A1, 2), PKW(A1, 4), PKW(A1, 6)}; pw3 = (u32x4){PKW(A1, 8), PKW(A1, 10), PKW(A1, 12), PKW(A1, 14)};
      const LAS unsigned char* vp_ = vp0 + vprev;
#pragma unroll
      for (int i = 0; i < 8; ++i) VRD(i);
      o0 = __builtin_amdgcn_mfma_f32_32x32x16_bf16(VFR(0), PAF(0), o0, 0, 0, 0); o1 = __builtin_amdgcn_mfma_f32_32x32x16_bf16(VFR(4), PAF(0), o1, 0, 0, 0);
      o0 = __builtin_amdgcn_mfma_f32_32x32x16_bf16(VFR(1), PAF(1), o0, 0, 0, 0); o1 = __builtin_amdgcn_mfma_f32_32x32x16_bf16(VFR(5), PAF(1), o1, 0, 0, 0);
      o0 = __builtin_amdgcn_mfma_f32_32x32x16_bf16(VFR(2), PAF(2), o0, 0, 0, 0); o1 = __builtin_amdgcn_mfma_f32_32x32x16_bf16(VFR(6), PAF(2), o1, 0, 0, 0);
      o0 = __builtin_amdgcn_mfma_f32_32x32x16_bf16(VFR(3), PAF(3), o0, 0, 0, 0); o1 = __builtin_amdgcn_mfma_f32_32x32x16_bf16(VFR(7), PAF(3), o1, 0, 0, 0); }
    wait_bar_n<0>();
    R.m = m; R.l = l; R.o[0] = o0; R.o[1] = o1;
    __builtin_amdgcn_s_setprio(0);
#undef TILE
#undef KLOAD
#undef ROWMAX
#undef DECIDE
#undef PKW
#undef VRD
#undef VFR
#undef PAF
#undef QKM
#undef GAPA
#undef GAPB
#undef PHASE_A
#undef KRD
#undef PHASE_B
#undef STEP
}
#undef SBAR
#undef PIN
#undef MX3
}
constexpr int MLA_STG_OFF = 98304;
__device__ __forceinline__ void p3_mla(const Ptrs& P, LAS unsigned char* lds, int vcu, int G, int tid, int wid) {
    using namespace att;
    for (int L = vcu; L < 2048; L += G) {
        int lane_u = tid & 63; asm volatile("" : "+v"(lane_u));
        const int lane = lane_u, r32 = lane & 31, hi = lane >> 5;
        int bh, qb;
        if (G == 256) { const int i = L >> 8, s8 = vcu & 7; bh = (vcu >> 3) + 32 * (i >> 1); qb = (i & 1) ? 15 - s8 : s8; }
        else { bh = L >> 4; qb = L & 15; }
        const int b = bh >> 3, h = bh & 7; const size_t rowb = (size_t)b * SEQ;
        const int q0 = qb * 256 + wid * 32, t = q0 + r32; const size_t row = rowb + t;
        bf16x8 qr[6];
#pragma unroll
        for (int d0 = 0; d0 < 6; ++d0) qr[d0] = *(const bf16x8*)(P.QM + row * 768 + h * 96 + d0 * 16 + hi * 8);
        SrcMLA src; src.init(P.KVM, P.kpe, rowb, h, wid, lane);
        Row R; row_reset(R);
        auto fix = [&](f32x16& p0, f32x16& p1, int tile) {
            if (tile * 64 + 63 > q0) {
                const int kb = tile * 64 + 4 * hi;
#pragma unroll
                for (int r = 0; r < 16; ++r) { const int kv = kb + (r & 3) + 8 * (r >> 2); if (kv > t) p0[r] = NEG_INF; if (kv + 32 > t) p1[r] = NEG_INF; } } };
        run_pipe(lds, src, 0, 4 * qb + 4, qr, R, fix, 0.f, 0x7fffffff, wid, lane);
        const float inv = 1.0f / swap_sum(R.l); float ss = 0.f;
        { bf16* const ob = P.ATT + (rowb + q0) * 1024 + h * 64;
          store_rows(lds + MLA_STG_OFF + wid * 4608, R.o[0], R.o[1], inv, ss, lane, [&](int r) -> bf16* { return ob + (size_t)r * 1024; }); }
        ss = swap_sum(ss);
        if (hi == 0) P.ssatt[row * 16 + h] = ss;
    }
}

constexpr int NSA_LB_OFF = 81920;
constexpr int NSA_OUT_OFF = 86016;
__device__ __forceinline__ float dpp_xor1(float x) { return __builtin_bit_cast(float, __builtin_amdgcn_update_dpp(0, __builtin_bit_cast(int, x), 0xB1, 0xF, 0xF, false)); }
__device__ __forceinline__ float dpp_xor2(float x) { return __builtin_bit_cast(float, __builtin_amdgcn_update_dpp(0, __builtin_bit_cast(int, x), 0x4E, 0xF, 0xF, false)); }
__device__ __forceinline__ unsigned dpp_xor1u(unsigned x) { return (unsigned)__builtin_amdgcn_update_dpp(0, (int)x, 0xB1, 0xF, 0xF, false); }
__device__ __forceinline__ unsigned dpp_xor2u(unsigned x) { return (unsigned)__builtin_amdgcn_update_dpp(0, (int)x, 0x4E, 0xF, 0xF, false); }
template <int STEP, int YOFF> __device__ __forceinline__ void add_bias(att::f32x16& p, const LAS float* lb, int D) {
#pragma unroll
    for (int r = 0; r < 16; ++r) { int d = D - STEP * ((r & 3) + 8 * (r >> 2) + YOFF); d = d < 0 ? 0 : (d > 127 ? 127 : d); p[r] += lb[d]; }
}
__device__ __forceinline__ void p3_nsa(const Ptrs& P, LAS unsigned char* lds, int vcu, int G, int tid, int wid) {
    using namespace att;
    LAS float* LB = (LAS float*)(lds + NSA_LB_OFF);
    for (int e = tid; e < 1024; e += NTHR) LB[e] = P.bias[e];
    __syncthreads();
    for (int L = vcu; L < 2048; L += G) {
        int bhk, c;
        if (G == 256) { const int i = L >> 8, sub = vcu & 7; bhk = vcu >> 3; const int base = 16 * (i >> 1); c = (i & 1) ? base + 15 - sub : base + sub; }
        else { bhk = L >> 6; c = L & 63; }
        int lane_u = tid & 63; asm volatile("" : "+v"(lane_u));
        const int lane = lane_u, r32 = lane & 31, hi = lane >> 5, ql = r32 >> 2, g = r32 & 3;
        const int b = bhk >> 1, hk = bhk & 1, hq = hk * 4 + g; const size_t rowb = (size_t)b * SEQ;
        const int t = c * 64 + wid * 8 + ql; const size_t row = rowb + t;
        const LAS float* lb = LB + hq * 128; const float b31 = lb[127];
        bf16x8 qr[4];
#pragma unroll
        for (int d0 = 0; d0 < 4; ++d0) qr[d0] = *(const bf16x8*)(P.U + row * DINP + C_QN + hq * 64 + d0 * 16 + hi * 8);
        float gate[3];
#pragma unroll
        for (int br = 0; br < 3; ++br) { const float x = bf2f(P.U[row * DINP + C_GATE + hq * 3 + br]); gate[br] = __builtin_amdgcn_rcpf(1.0f + __builtin_amdgcn_exp2f(-x * LOG2E)); }
        LAS float* outp = (LAS float*)(lds + NSA_OUT_OFF) + wid * 2048 + lane;
        unsigned mlo, mhi;
        {
            const int nv = t >= 31 ? ((t - 31) >> 4) + 1 : 0;
            int ln = lane_u; asm volatile("" : "+v"(ln));
            SrcCmp src; src.init(P.kcmp + (size_t)bhk * 256 * 64, P.vcmp + (size_t)bhk * 256 * 64, P.ovt, wid, ln);
            RowT<2> R; row_reset(R);
            auto fix = [&](f32x16& p0, f32x16& p1, int tile) {
                const int D = t - 31 - 16 * (64 * tile + 4 * hi);
                add_bias<16, 0>(p0, lb, D); add_bias<16, 32>(p1, lb, D);
                const int ib = 64 * tile + 4 * hi;
#pragma unroll
                for (int r = 0; r < 16; ++r) { const int i = ib + (r & 3) + 8 * (r >> 2); if (i >= nv) p0[r] = NEG_INF; if (i + 32 >= nv) p1[r] = NEG_INF; } };
            auto skip = [&](int) -> bool { return false; };
            run_tiles(lds, src, 0, (4 * c + 3 + 63) >> 6, qr, R, fix, skip, wid, lane);
            const float lt = swap_sum(R.l); const float inv = lt > 0.f ? 1.0f / lt : 0.f;
            { const float f = gate[0] * inv;
#pragma unroll
              for (int i = 0; i < 16; ++i) { outp[64 * i] = R.o[0][i] * f; outp[64 * (16 + i)] = R.o[1][i] * f; } }
            mlo = 0u; mhi = 0u;
            if (c <= 15) { const unsigned long long mk = (2ull << c) - 1ull; mlo = (unsigned)mk; mhi = (unsigned)(mk >> 32); }
            else {
                float cand[8];
#pragma unroll
                for (int rr = 0; rr < 8; ++rr) {
                    float v00 = R.o[2][rr] * inv, v01 = R.o[2][8 + rr] * inv, v10 = R.o[3][rr] * inv, v11 = R.o[3][8 + rr] * inv;
                    v00 += dpp_xor1(v00); v00 += dpp_xor2(v00); v01 += dpp_xor1(v01); v01 += dpp_xor2(v01); v10 += dpp_xor1(v10); v10 += dpp_xor2(v10); v11 += dpp_xor1(v11); v11 += dpp_xor2(v11);
                    cand[rr] = (g & 2) ? ((g & 1) ? v11 : v10) : ((g & 1) ? v01 : v00); }
                unsigned key[8];
#pragma unroll
                for (int rr = 0; rr < 8; ++rr) { const int j = 32 * (g >> 1) + (rr & 3) + 8 * (2 * (g & 1) + (rr >> 2)) + 4 * hi;
                    const bool ok = j >= 1 && j <= c - 2; key[rr] = ok ? ((__float_as_uint(fmaxf(cand[rr], 0.f)) & ~63u) | (unsigned)(63 - j)) : 0u; }
                unsigned long long mk = 1ull | (1ull << c) | (1ull << (c - 1));
                for (int round = 0; round < 13; ++round) {
                    unsigned best = key[0];
#pragma unroll
                    for (int rr = 1; rr < 8; ++rr) best = best > key[rr] ? best : key[rr];
                    { const unsigned o1 = dpp_xor1u(best); best = best > o1 ? best : o1; const unsigned o2 = dpp_xor2u(best); best = best > o2 ? best : o2;
                      auto rr2 = __builtin_amdgcn_permlane32_swap(best, best, false, false); best = rr2[0] > rr2[1] ? rr2[0] : rr2[1]; }
                    if (best != 0u) mk |= 1ull << (63u - (best & 63u));
#pragma unroll
                    for (int rr = 0; rr < 8; ++rr) key[rr] = (key[rr] == best) ? 0u : key[rr];
                }
                mlo = (unsigned)mk; mhi = (unsigned)(mk >> 32);
            }
        }
        {
            int ln = lane_u; asm volatile("" : "+v"(ln));
            SrcRows src; src.init(P.U + rowb * DINP + C_KVS + hk * 64, P.U + rowb * DINP + C_KVS + 128 + hk * 64, DINP, wid, ln);
            Row R; row_reset(R);
            auto fix = [&](f32x16& p0, f32x16& p1, int tile) {
                if (tile >= c - 2) { const int D = t - 64 * tile - 4 * hi; add_bias<1, 0>(p0, lb, D); asm volatile("" ::: "memory"); add_bias<1, 32>(p1, lb, D); }
                const bool sel = ((tile < 32 ? (mlo >> tile) : (mhi >> (tile - 32))) & 1u) != 0u;
                if (tile == c) { const int kb = tile * 64 + 4 * hi;
#pragma unroll
                    for (int r = 0; r < 16; ++r) { const int kv = kb + (r & 3) + 8 * (r >> 2); if (kv > t || !sel) p0[r] = NEG_INF; if (kv + 32 > t || !sel) p1[r] = NEG_INF; } }
                else if (!sel) {
#pragma unroll
                    for (int r = 0; r < 16; ++r) { p0[r] = NEG_INF; p1[r] = NEG_INF; } } };
            run_pipe(lds, src, 0, c + 1, qr, R, fix, b31, c - 2, wid, lane);
            const float f = gate[1] / swap_sum(R.l);
#pragma unroll
            for (int i = 0; i < 16; ++i) { outp[64 * i] += R.o[0][i] * f; outp[64 * (16 + i)] += R.o[1][i] * f; }
        }
        f32x16 out[2];
        {
            int ln = lane_u; asm volatile("" : "+v"(ln));
            SrcRows src; src.init(P.U + rowb * DINP + C_KVW + hk * 64, P.U + rowb * DINP + C_KVW + 128 + hk * 64, DINP, wid, ln);
            Row R; row_reset(R);
            auto fix = [&](f32x16& p0, f32x16& p1, int tile) {
                if (tile >= c - 2) { const int D = t - 64 * tile - 4 * hi; add_bias<1, 0>(p0, lb, D); asm volatile("" ::: "memory"); add_bias<1, 32>(p1, lb, D); }
                if (tile == c || tile == c - 8) { const int kb = tile * 64 + 4 * hi;
#pragma unroll
                    for (int r = 0; r < 16; ++r) { const int kv = kb + (r & 3) + 8 * (r >> 2); const int d0_ = t - kv, d1_ = d0_ - 32;
                        if (d0_ < 0 || d0_ >= 512) p0[r] = NEG_INF; if (d1_ < 0 || d1_ >= 512) p1[r] = NEG_INF; } } };
            run_pipe(lds, src, c >= 8 ? c - 8 : 0, c + 1, qr, R, fix, b31, c - 2, wid, lane);
            const float f = gate[2] / swap_sum(R.l);
#pragma unroll
            for (int i = 0; i < 16; ++i) { out[0][i] = outp[64 * i] + R.o[0][i] * f; out[1][i] = outp[64 * (16 + i)] + R.o[1][i] * f; }
        }
        { float ss = 0.f; bf16* const ob = P.ATT + (rowb + c * 64 + wid * 8) * 1024 + 512 + hk * 256;
            store_rows(lds + NSA_OUT_OFF + wid * 8192, out[0], out[1], 1.0f, ss, lane, [&](int r) -> bf16* { return ob + (size_t)(r >> 2) * 1024 + (r & 3) * 64; });
            ss = swap_sum(ss);
            if (hi == 0) P.ssatt[row * 16 + 8 + hq] = ss; }
    }
}

__global__ void __launch_bounds__(NTHR, 2) mega_fwd(Args args) {
    extern __shared__ __attribute__((aligned(16))) unsigned char lds_raw[];
    LAS unsigned char* lds = (LAS unsigned char*)lds_raw;
    volatile LAS unsigned* MISC = (volatile LAS unsigned*)(lds + MISC_OFF);
    const int wv0 = __builtin_amdgcn_readfirstlane((int)threadIdx.x >> 6);
#define LAUNDER_TID() int tid = wv0 * 64 + pg8::lane_id(); asm volatile("" : "+v"(tid)); const int lane = tid & 63, wave = __builtin_amdgcn_readfirstlane(tid >> 6); (void)lane; (void)wave
    const int G = gridDim.x, wg = blockIdx.x;
    const int vcu = (G % 8 == 0) ? (wg % 8) * (G / 8) + wg / 8 : wg;
    unsigned char* ws = args.ws;
    Ptrs P;
#pragma unroll
    for (int i = 0; i < 22; ++i) P.in[i] = args.in[i];
    P.out = args.out; P.ws = ws;
    P.Win = (bf16*)(ws + WS_WIN); P.Wuq = (bf16*)(ws + WS_WUQ); P.Wukv = (bf16*)(ws + WS_WUKV); P.Wout = (bf16*)(ws + WS_WOUT); P.Wgu = (bf16*)(ws + WS_WGU); P.Wdn = (bf16*)(ws + WS_WDN);
    P.rope = (f32x2v*)(ws + WS_ROPE); P.bias = (float*)(ws + WS_BIAS); P.bias1 = (float*)(ws + WS_BIAS1); P.rstdx = (float*)(ws + WS_RSTDX);
    P.ssqkv = (float*)(ws + WS_SSQKV); P.ssatt = (float*)(ws + WS_SSATT); P.ssh = (float*)(ws + WS_SSH);
    P.kcmp = (bf16*)(ws + WS_KCMP); P.vcmp = (bf16*)(ws + WS_VCMP); P.kpe = (bf16*)(ws + WS_KPE); P.ovt = (bf16*)(ws + WS_OVT); P.W1c = (bf16*)(ws + WS_W1C); P.W2t = (bf16*)(ws + WS_W2T);
    P.XB = (bf16*)(ws + WS_XB); P.U = (bf16*)(ws + WS_U); P.QM = (bf16*)(ws + WS_QM); P.KVM = (bf16*)(ws + WS_KVM); P.ATT = (bf16*)(ws + WS_ATT); P.H = (bf16*)(ws + WS_H); P.HID = (bf16*)(ws + WS_HID);
    gu32* ctl = (gu32*)(ws + WS_CTL);

    if (wv0 == 0) MISC[pg8::lane_id()] = 0u;
    __syncthreads();
    XcdBarrier bar; bar.bar = (unsigned*)(ctl + CW_BAR); bar.x = 0; bar.st = nullptr; bar.lead = false;
    if (N_LAUNCHES == 1) bar = xcd_barrier_post((unsigned*)(ctl + CW_BAR), MISC + 8);
#define GRID_BAR() do { if (N_LAUNCHES == 1) xcd_barrier(bar); } while (0)
    const int lo = args.ph_lo, hi = args.ph_hi;
#ifndef PHASE_MASK
#define PHASE_MASK 0xff
#endif
#define IN(k) (((PHASE_MASK >> (k)) & 1) && lo <= (k) && (k) < hi)
#define BOTH(k) (IN(k) && IN((k) + 1))
#ifndef REPEAT_MASK
#define REPEAT_MASK 0
#endif
#define REP(k) for (int rep_ = 0; rep_ < (((REPEAT_MASK >> (k)) & 1) ? 2 : 1); ++rep_)

    if (IN(0)) { REP(0) { LAUNDER_TID(); p0_prologue(P, lds, wg, G, wave, lane, tid); } if (BOTH(0)) GRID_BAR(); }

    if (IN(1)) {
        REP(1) {
        pg8::Gemm g{P.XB, P.Win, MT, DINP, 1024, 1024, 1024, 0}; pg8::StaticOrder S; S.init(MT, DINP, G, wg);
        EpiInProj E{P.U, P.rstdx, P.ssqkv};
        pg8::gemm_phase<EpiInProj, pg8::StaticOrder, true, true>(lds, g, S, E, wv0); }
        if (BOTH(1)) GRID_BAR();
    }

    if (IN(2)) {
        REP(2) {
        { LAUNDER_TID(); p2_kpe(P, wg, G, tid); }
        { pg8::Gemm g{P.U, P.W1c, 64 * 256, 256, 1024, 16 * DINP, 1024, DINP * 2}; CmpOrder S{G, wg, P.U, P.W1c};
          EpiCmp E{P.bias1, P.W2t, P.kcmp, P.vcmp};
          pg8::gemm_phase<EpiCmp, CmpOrder, false, true>(lds, g, S, E, wv0); }
        { const int gq = G > 64 ? G - 64 : G, cq = G > 64 ? wg - 64 : wg;
          if (cq >= 0) { pg8::Gemm g{P.U + C_CQ, P.Wuq, MT, 768, 256, DINP, 256, 0}; pg8::StaticOrder S; S.init(MT, 768, gq, cq);
            EpiQup E{P.QM, P.ssqkv, P.rope};
            pg8::gemm_phase<EpiQup, pg8::StaticOrder, true, true>(lds, g, S, E, wv0); } }
        { pg8::Gemm g{P.U + C_CKV, P.Wukv, MT, 1024, 128, DINP, 256, 0}; pg8::StaticOrder S; S.init(MT, 1024, G, wg);
          EpiKVup E{P.KVM, P.ssqkv};
          pg8::gemm_phase<EpiKVup, pg8::StaticOrder, true, true>(lds, g, S, E, wv0); }
        }
        if (BOTH(2)) GRID_BAR();
    }

    if (IN(3)) {
        REP(3) {
        REP(8) { LAUNDER_TID(); p3_mla(P, lds, vcu, G, tid, wave); }
        REP(9) { LAUNDER_TID(); p3_nsa(P, lds, vcu, G, tid, wave); }
        }
        if (BOTH(3)) GRID_BAR();
    }

    if (IN(4)) {
        REP(4) {
        { pg8::Gemm g{P.ATT, P.Wout, MT, 1024, 1024, 1024, 1024, 0}; OutOrder S; S.init(MT, 1024, G, wg); S.ssatt = P.ssatt; S.tab = (LAS float*)(lds + OUT_TAB_OFF);
          EpiOut E{P.XB, P.H, (unsigned char*)P.QM, P.ssh, (const LAS float*)(lds + OUT_TAB_OFF)};
          pg8::gemm_phase<EpiOut, OutOrder, true, true>(lds, g, S, E, wv0); }
        }
        if (BOTH(4)) GRID_BAR();
    }

    if (IN(5)) {
#define P5_BODY() { pg8::Gemm g{P.QM, P.Wgu, MT, NGU, 512, 512, 512, 0}; GUOrder S; S.init(MT, NGU, G, wg); S.ssh = P.ssh; S.tab = (LAS float*)(lds + OUT_TAB_OFF);     \
        EpiGU E{(unsigned char*)P.HID, (const LAS float*)(lds + OUT_TAB_OFF)}; \
        pg8::gemm_phase<EpiGU, GUOrder, true, true, true>(lds, g, S, E, wv0); }
        P5_BODY();
#if (REPEAT_MASK >> 5) & 1
        __syncthreads(); P5_BODY();
#endif
#undef P5_BODY
        if (BOTH(5)) GRID_BAR();
    }

    if (IN(6)) {
        REP(6) {
        pg8::Gemm g{P.HID, P.Wdn, MT, 1024, DFF / 2, DFF / 2, DFF / 2, 0}; pg8::StaticOrder S; S.init(MT, 1024, G, wg);
        EpiDown E{P.H, P.ATT, P.ssatt};
        pg8::gemm_phase<EpiDown, pg8::StaticOrder, true, true, true>(lds, g, S, E, wv0); }
        if (BOTH(6)) GRID_BAR();
    }

    if (IN(7)) { LAUNDER_TID(); p7_final(P, wg, G, wave, lane); }
#undef IN
#undef BOTH
#undef GRID_BAR
}

extern "C" void kernel_launch(void* const* d_in, const int* in_sizes, int n_in, void* d_out, int out_size, void* d_ws, size_t ws_size, hipStream_t stream) {
    static int grid = 0;
    if (grid == 0) {
        if (n_in != 22 || in_sizes[0] != MT * DM || out_size != MT * DM || ws_size < WS_END) { fprintf(stderr, "kernel_launch: unexpected shapes (n_in %d, in0 %d, out %d, ws %zu); nothing launched\n", n_in, n_in > 0 ? in_sizes[0] : -1, out_size, ws_size); grid = -1; return; }
        int dev = 0, cus = 0, per_cu = 0;
        if (hipGetDevice(&dev) != hipSuccess || hipDeviceGetAttribute(&cus, hipDeviceAttributeMultiprocessorCount, dev) != hipSuccess) { fprintf(stderr, "kernel_launch: device query failed\n"); grid = -1; return; }
        if (hipFuncSetAttribute((const void*)mega_fwd, hipFuncAttributeMaxDynamicSharedMemorySize, LDS_BYTES) != hipSuccess) { fprintf(stderr, "kernel_launch: hipFuncSetAttribute failed\n"); grid = -1; return; }
        if (hipOccupancyMaxActiveBlocksPerMultiprocessor(&per_cu, (const void*)mega_fwd, NTHR, LDS_BYTES) != hipSuccess || per_cu < 1)
            fprintf(stderr, "kernel_launch: note: occupancy query reports %d workgroups per CU\n", per_cu);
        (void)hipGetLastError();
        grid = cus;
    }
    if (grid < 0) return;
    if (hipMemsetAsync((char*)d_ws + WS_CTL, 0, CTL_ZERO_BYTES, stream) != hipSuccess) { fprintf(stderr, "kernel_launch: memset failed\n"); return; }
    Args a{};
    for (int i = 0; i < 22; ++i) a.in[i] = (const float*)d_in[i];
    a.out = (float*)d_out; a.ws = (unsigned char*)d_ws;
    for (int li = 0; li < N_LAUNCHES; ++li) {
        a.ph_lo = (N_LAUNCHES == 1) ? 0 : li; a.ph_hi = (N_LAUNCHES == 1) ? NPHASE : li + 1; a.li = li; a.pad = 0;
        hipLaunchKernelGGL(mega_fwd, dim3(grid), dim3(NTHR), LDS_BYTES, stream, a);
        const hipError_t le = hipPeekAtLastError();
        if (le != hipSuccess) { fprintf(stderr, "kernel_launch: launch %d failed: %s\n", li, hipGetErrorName(le)); break; }
    }
}
```

```cpp
#include <hip/hip_runtime.h>
#include <cstdio>
#include <cstdint>
namespace pg8 {
#define PG8_LAS __attribute__((address_space(3)))
typedef unsigned short bf16_t;
typedef short bf16x8 __attribute__((ext_vector_type(8)));
typedef float f32x4 __attribute__((ext_vector_type(4)));
typedef unsigned u32x4 __attribute__((ext_vector_type(4)));
constexpr int BM = 256, BK = 64, HALF = 128, HTB = HALF * BK * 2  , STAGE_BYTES = 8 * HTB, NXCD = 8, WGM = 8;

__host__ __device__ __forceinline__ int lds_byte(int r, int c) { const int st = (r >> 4) * 2 + (c >> 5), rr = r & 15, cc = c & 31, ob = rr * 64 + cc * 2; return st * 1024 + (ob ^ (((ob >> 9) & 1) << 5)); }
__host__ __device__ __forceinline__ void stage_rc(int b, int& R, int& C) { const int st = b / 1024, sb = b % 1024, swz = sb ^ (((sb >> 9) & 1) << 5); R = (st >> 1) * 16 + swz / 64; C = (st & 1) * 32 + (swz % 64) / 2; }
__host__ __device__ __forceinline__ int perm32(int rho) { const int n = rho >> 4, i = rho & 15; return 8 * (i >> 2) + 4 * n + (i & 3); }

struct Unit { int pm, pn, ui; };
struct Gemm { const bf16_t* A; const bf16_t* Bt; int M, N, K, lda, ldb, kstepA; };

struct StaticOrder {
    int nM, nN, nwg, G, c;
    __host__ __device__ void init(int M, int N, int G_, int c_) { nM = M / BM; nN = N / BM; nwg = nM * nN; G = G_; c = c_; }
    __host__ __device__ bool next(int i, Unit& u) const {
        const long L = (long)i * G + c; if (L >= nwg) return false;
        int wgid = (int)L; { const int q = nwg / NXCD, r = nwg % NXCD, xcd = wgid % NXCD, off = wgid / NXCD; wgid = (xcd < r ? xcd * (q + 1) : r * (q + 1) + (xcd - r) * q) + off; }
        const int nig = WGM * nN, gid = wgid / nig, fm = gid * WGM, gsz = (nM - fm) < WGM ? (nM - fm) : WGM;
        u.pm = fm + ((wgid % nig) % gsz); u.pn = (wgid % nig) / gsz; u.ui = i; return true;
    }
    struct Pre {};
    __device__ __forceinline__ Pre a_pre(const Unit&, int) const { return Pre{}; }
    __device__ __forceinline__ void a_post(const Unit&, const Pre&, int) const {}
    __device__ __forceinline__ void done(const Unit&) const {}
    __device__ __forceinline__ const char* a_base(const Gemm& g, const Unit& u, size_t tstepA) const { return (const char*)g.A + (size_t)u.pm * tstepA; }
    __device__ __forceinline__ const char* b_base(const Gemm& g, const Unit& u, size_t tstepB) const { return (const char*)g.Bt + (size_t)u.pn * tstepB; }
};

__device__ __forceinline__ unsigned cvt_pk_bf16(float lo, float hi) { unsigned r; asm volatile("v_cvt_pk_bf16_f32 %0, %1, %2" : "=v"(r) : "v"(lo), "v"(hi)); return r; }
typedef float f32x2 __attribute__((ext_vector_type(2)));
typedef int i32x8 __attribute__((ext_vector_type(8)));
typedef int i32x4 __attribute__((ext_vector_type(4)));
__device__ __forceinline__ i32x8 cat8(bf16x8 lo, bf16x8 hi) { const i32x4 a = __builtin_bit_cast(i32x4, lo), b = __builtin_bit_cast(i32x4, hi); return __builtin_shufflevector(a, b, 0, 1, 2, 3, 4, 5, 6, 7); }
__device__ __forceinline__ unsigned cvt_pk4_fp8(float a, float b, float c, float d) { int w = 0; w = __builtin_amdgcn_cvt_pk_fp8_f32(a, b, w, false); w = __builtin_amdgcn_cvt_pk_fp8_f32(c, d, w, true); return (unsigned)w; }
__device__ __forceinline__ void glds16(const char* sbase, unsigned voff, unsigned dst) { unsigned keep;
    asm volatile("s_mov_b32 %0, m0\n\ts_mov_b32 m0, %3\n\ts_nop 0\n\tglobal_load_lds_dwordx4 %1, %2\n\ts_mov_b32 m0, %0" : "=&s"(keep) : "v"(voff), "s"(sbase), "s"(dst) : "memory"); }
__device__ __forceinline__ int lane_id() { int r; asm volatile("v_mbcnt_lo_u32_b32 %0, -1, 0\n\tv_mbcnt_hi_u32_b32 %0, -1, %0" : "=v"(r)); return r; }
template <class Epi, class Sched, bool ALIGN_EPI = false, bool SP2 = false, bool FP8 = false>
__device__ __forceinline__ void gemm_phase(PG8_LAS unsigned char* lds, const Gemm g, const Sched& S, const Epi& E, const int wv  ) {
    int tid_ = wv * 64 + lane_id(); asm volatile("" : "+v"(tid_));
    const int tid = tid_, wid = __builtin_amdgcn_readfirstlane(tid >> 6), lane = tid & 63, wr = wid >> 2, wc = wid & 3, fr = lane & 15, fq = lane >> 4;
    const int K = g.K, nt = K / BK;
    unsigned voffA, voffB;
    { int R, C; stage_rc(tid * 16, R, C); const int Rb = Epi::PERM ? ((R & ~31) + perm32(R & 31)) : R;
      voffA = (unsigned)(R * g.lda + C) * 2u; voffB = (unsigned)(Rb * g.ldb + C) * 2u; }
    const size_t qstepA = (size_t)64 * g.lda * 2, qstepB = (size_t)64 * g.ldb * 2;
    const size_t kstepA = g.kstepA ? (size_t)g.kstepA : (size_t)(BK * 2), kstepB = (size_t)(BK * 2);
    const size_t hstepA = (size_t)HALF * g.lda * 2, hstepB = (size_t)HALF * g.ldb * 2;
    const size_t tstepA = 2 * hstepA, tstepB = 2 * hstepB;
    const unsigned ldsb = (unsigned)(uintptr_t)lds + (unsigned)wid * 1024u;
    const int aoff = lds_byte(wr * 64 + fr, fq * 8), boff = lds_byte(wc * 32 + fr, fq * 8);
#define PG8_SA(b, h) (((b) * 2 + (h)) * HTB)
#define PG8_SB(b, h) ((4 + (b) * 2 + (h)) * HTB)
#define qvoffA qstepA
#define qvoffB qstepB
#define PG8_STAGE(bufoff, gbase, voff) do { glds16((const char*)(gbase), voff, ldsb + (unsigned)(bufoff)); glds16((const char*)(gbase) + q##voff, voff, ldsb + (unsigned)(bufoff) + 8192u); } while (0)
#define PG8_LDA(dst, b, h) do { _Pragma("unroll") for (int m = 0; m < 4; ++m) _Pragma("unroll") for (int k = 0; k < 2; ++k) dst[m][k] = *(const PG8_LAS bf16x8*)(lds + PG8_SA(b, h) + aoff + m * 2048 + k * 1024); } while (0)
#define PG8_LDB(dst, b, h) do { _Pragma("unroll") for (int n = 0; n < 2; ++n) _Pragma("unroll") for (int k = 0; k < 2; ++k) dst[n][k] = *(const PG8_LAS bf16x8*)(lds + PG8_SB(b, h) + boff + n * 2048 + k * 1024); } while (0)
#define PG8_MMA(ai, bj, At, Bt) do { __builtin_amdgcn_s_setprio(1); _Pragma("unroll") for (int m = 0; m < 4; ++m) _Pragma("unroll") for (int n = 0; n < 2; ++n) { \
        if constexpr (FP8) acc[ai][bj][m][n] = __builtin_amdgcn_mfma_scale_f32_16x16x128_f8f6f4(cat8(Bt[n][0], Bt[n][1]), cat8(At[m][0], At[m][1]), acc[ai][bj][m][n], 0, 0, 0, 0, 0, 0); \
        else { _Pragma("unroll") for (int k = 0; k < 2; ++k) acc[ai][bj][m][n] = __builtin_amdgcn_mfma_f32_16x16x32_bf16(Bt[n][k], At[m][k], acc[ai][bj][m][n], 0, 0, 0); } } __builtin_amdgcn_s_setprio(0); } while (0)
#define PG8_WAIT_V(n) asm volatile("s_waitcnt vmcnt(" #n ")" ::: "memory")
#define PG8_WAIT_L(n) asm volatile("s_waitcnt lgkmcnt(" #n ")" ::: "memory")
#define PG8_BAR __builtin_amdgcn_s_barrier()
#define PG8_SCHED __builtin_amdgcn_sched_barrier(0)
    Unit cur, nxt; int ui = 0;
    if (!S.next(0, cur)) return;
    f32x4 acc[2][2][4][2];
#pragma unroll
    for (int a = 0; a < 2; ++a)
#pragma unroll
        for (int b = 0; b < 2; ++b)
#pragma unroll
            for (int m = 0; m < 4; ++m)
#pragma unroll
                for (int n = 0; n < 2; ++n) acc[a][b][m][n] = (f32x4){0.f, 0.f, 0.f, 0.f};
    bf16x8 At[4][2], B0[2][2], B1[2][2];
    const char* cA = S.a_base(g, cur, tstepA); const char* cB = S.b_base(g, cur, tstepB);
    S.a_post(cur, S.a_pre(cur, tid), tid);
    if constexpr (SP2) {
        PG8_STAGE(PG8_SB(0, 0), cB, voffB); PG8_STAGE(PG8_SB(0, 1), cB + hstepB, voffB); PG8_STAGE(PG8_SA(0, 0), cA, voffA); PG8_STAGE(PG8_SA(0, 1), cA + hstepA, voffA);
        if (wr == 1) PG8_BAR;
        PG8_WAIT_V(2); PG8_BAR;
        PG8_STAGE(PG8_SB(1, 0), cB + kstepB, voffB); PG8_STAGE(PG8_SA(1, 0), cA + kstepA, voffA); PG8_STAGE(PG8_SB(1, 1), cB + hstepB + kstepB, voffB);
        PG8_WAIT_V(6); PG8_BAR;
    } else {
        PG8_STAGE(PG8_SB(0, 0), cB, voffB); PG8_STAGE(PG8_SA(0, 0), cA, voffA); PG8_STAGE(PG8_SB(0, 1), cB + hstepB, voffB); PG8_STAGE(PG8_SA(0, 1), cA + hstepA, voffA);
        if (wr == 1) PG8_BAR;
        PG8_WAIT_V(4); PG8_BAR;
        PG8_STAGE(PG8_SB(1, 0), cB + kstepB, voffB); PG8_STAGE(PG8_SA(1, 0), cA + kstepA, voffA); PG8_STAGE(PG8_SB(1, 1), cB + hstepB + kstepB, voffB);
        PG8_WAIT_V(6); PG8_BAR;
    }
    for (;;) {
        const bool has_next = S.next(ui + 1, nxt);
        const char* nA = has_next ? S.a_base(g, nxt, tstepA) : cA; const char* nB = has_next ? S.b_base(g, nxt, tstepB) : cB;
        for (int t = 0; t < nt; t += 2) {
            if constexpr (Epi::MIDK) { if (t == (nt >> 1)) E.midk(acc, cur, wr, fr); }
            const bool last = (t == nt - 2);
            const char* a1 = cA + (size_t)(t + 1) * kstepA;
            const char* a2 = last ? nA : cA + (size_t)(t + 2) * kstepA; const char* b2 = last ? nB : cB + (size_t)(t + 2) * kstepB;
            const char* a3 = a2 + kstepA; const char* b3 = b2 + kstepB;
            if constexpr (SP2) {
            PG8_LDB(B0, 0, 0); PG8_LDB(B1, 0, 1); PG8_SCHED; PG8_LDA(At, 0, 0); PG8_STAGE(PG8_SA(1, 1), a1 + hstepA, voffA);
            PG8_WAIT_V(8); PG8_WAIT_L(0); PG8_BAR; PG8_MMA(0, 0, At, B0); PG8_MMA(0, 1, At, B1); PG8_BAR; PG8_SCHED;
            PG8_LDA(At, 0, 1); PG8_STAGE(PG8_SB(0, 0), b2, voffB); PG8_STAGE(PG8_SB(0, 1), b2 + hstepB, voffB); PG8_STAGE(PG8_SA(0, 0), a2, voffA);
            PG8_WAIT_V(8); PG8_WAIT_L(0); PG8_BAR; PG8_MMA(1, 0, At, B0); PG8_MMA(1, 1, At, B1); PG8_BAR; PG8_SCHED;
            PG8_LDB(B0, 1, 0); PG8_LDB(B1, 1, 1); PG8_SCHED; PG8_LDA(At, 1, 0); PG8_STAGE(PG8_SA(0, 1), a2 + hstepA, voffA);
            PG8_WAIT_V(8); PG8_WAIT_L(0); PG8_BAR; PG8_MMA(0, 0, At, B0); PG8_MMA(0, 1, At, B1); PG8_BAR; PG8_SCHED;
            PG8_LDA(At, 1, 1); PG8_STAGE(PG8_SB(1, 0), b3, voffB); PG8_STAGE(PG8_SB(1, 1), b3 + hstepB, voffB); PG8_STAGE(PG8_SA(1, 0), a3, voffA);
            PG8_WAIT_V(8); PG8_WAIT_L(0); PG8_BAR; PG8_MMA(1, 0, At, B0); PG8_MMA(1, 1, At, B1); PG8_BAR; PG8_SCHED;
            } else {
            PG8_LDB(B0, 0, 0); PG8_SCHED; PG8_LDA(At, 0, 0); PG8_STAGE(PG8_SA(1, 1), a1 + hstepA, voffA);
            PG8_WAIT_L(8); PG8_BAR; PG8_WAIT_L(0); PG8_MMA(0, 0, At, B0); PG8_BAR; PG8_SCHED;
            PG8_LDB(B1, 0, 1); PG8_STAGE(PG8_SB(0, 0), b2, voffB);
            PG8_BAR; PG8_WAIT_L(0); PG8_MMA(0, 1, At, B1); PG8_BAR;
            PG8_LDA(At, 0, 1); PG8_STAGE(PG8_SA(0, 0), a2, voffA);
            PG8_BAR; PG8_WAIT_L(0); PG8_MMA(1, 0, At, B0); PG8_BAR; PG8_SCHED;
            PG8_STAGE(PG8_SB(0, 1), b2 + hstepB, voffB);
            PG8_WAIT_V(6); PG8_BAR; PG8_MMA(1, 1, At, B1); PG8_BAR;
            PG8_LDB(B0, 1, 0); PG8_SCHED; PG8_LDA(At, 1, 0); PG8_STAGE(PG8_SA(0, 1), a2 + hstepA, voffA);
            PG8_WAIT_L(8); PG8_BAR; PG8_WAIT_L(0); PG8_MMA(0, 0, At, B0); PG8_BAR; PG8_SCHED;
            PG8_LDB(B1, 1, 1); PG8_STAGE(PG8_SB(1, 0), b3, voffB);
            PG8_BAR; PG8_WAIT_L(0); PG8_MMA(0, 1, At, B1); PG8_BAR;
            PG8_LDA(At, 1, 1); PG8_STAGE(PG8_SA(1, 0), a3, voffA);
            PG8_BAR; PG8_WAIT_L(0); PG8_MMA(1, 0, At, B0); PG8_BAR; PG8_SCHED;
            PG8_STAGE(PG8_SB(1, 1), b3 + hstepB, voffB);
            PG8_WAIT_V(6); PG8_BAR; PG8_MMA(1, 1, At, B1); PG8_BAR;
            }
        }
        if constexpr (ALIGN_EPI) { if (wr == 0) PG8_BAR; }
        int tid2 = wv * 64 + lane_id(); asm volatile("" : "+v"(tid2)); const int fr2 = tid2 & 15, fq2 = (tid2 >> 4) & 3;
        const typename Sched::Pre pre = S.a_pre(has_next ? nxt : cur, tid2);
        if constexpr (!Epi::AFTER_DRAIN) { E(acc, cur, wr, wc, fr2, fq2); S.done(cur); }
        if (has_next) S.a_post(nxt, pre, tid2);
        if (!has_next) break;
#pragma unroll
        for (int a = 0; a < 2; ++a)
#pragma unroll
            for (int b = 0; b < 2; ++b)
#pragma unroll
                for (int m = 0; m < 4; ++m)
#pragma unroll
                    for (int n = 0; n < 2; ++n) acc[a][b][m][n] = (f32x4){0.f, 0.f, 0.f, 0.f};
        cur = nxt; cA = nA; cB = nB; ++ui;
        if constexpr (ALIGN_EPI) { if (wr == 1) PG8_BAR; }
    }
    PG8_WAIT_V(0);
    if constexpr (!ALIGN_EPI) { if (wr == 0) PG8_BAR; }
    PG8_BAR;
    if constexpr (Epi::AFTER_DRAIN) { E.fused(acc, cur, wr, wc, fr, fq, lds, wid, lane); S.done(cur); }
#undef PG8_SA
#undef PG8_SB
#undef PG8_STAGE
#undef qvoffA
#undef qvoffB
#undef PG8_LDA
#undef PG8_LDB
#undef PG8_MMA
#undef PG8_WAIT_V
#undef PG8_WAIT_L
#undef PG8_BAR
#undef PG8_SCHED
}
}
#define GAS __attribute__((address_space(1)))
#define LAS __attribute__((address_space(3)))
typedef unsigned short bf16;
typedef unsigned v4u __attribute__((ext_vector_type(4)));
typedef float f32x4 __attribute__((ext_vector_type(4)));
typedef short bf16x8 __attribute__((ext_vector_type(8)));
typedef GAS unsigned gu32;
typedef GAS unsigned long long gu64;
#define RLX_AGENT __ATOMIC_RELAXED, __HIP_MEMORY_SCOPE_AGENT
#define LDS_WAIT() asm volatile("s_waitcnt lgkmcnt(0)" ::: "memory")
#define VM_WAIT() asm volatile("s_waitcnt vmcnt(0)" ::: "memory")
__device__ __forceinline__ unsigned long long rt() { return __builtin_amdgcn_s_memrealtime(); }
__device__ __forceinline__ unsigned f2bf(float f) { unsigned u = __builtin_bit_cast(unsigned, f); return (u + 0x7fffu + ((u >> 16) & 1u)) >> 16; }
__device__ __forceinline__ unsigned pk2(float lo, float hi) { return pg8::cvt_pk_bf16(lo, hi); }

#define XB_TMO      128
#define XB_XCNT(j)  (256  + 64 * (j))
#define XB_XSUB(j)  (1280 + 64 * (j))
#define XB_XGEN(j)  (2304 + 64 * (j))
#define XB_TOP      3328
#define XB_TOPGEN   3392
#define XCD_BAR_WORDS 3456
#define XB_SPIN_CAP (1u << 18)

__device__ __forceinline__ unsigned xb_ld(unsigned* p)              { return __hip_atomic_load(p, __ATOMIC_RELAXED, __HIP_MEMORY_SCOPE_AGENT); }
__device__ __forceinline__ unsigned xb_add(unsigned* p, unsigned v) { return __hip_atomic_fetch_add(p, v, __ATOMIC_RELAXED, __HIP_MEMORY_SCOPE_AGENT); }
__device__ __forceinline__ unsigned xb_xcc_id() { return (unsigned)__builtin_amdgcn_s_getreg((3 << 11) | 20) & 0xFu; }
#define XB_SPIN(cond, bar) do { unsigned _sp = 0; while (cond) { __builtin_amdgcn_s_sleep(1); \
    if ((++_sp & 255u) == 0u) { if (xb_ld(&(bar)[XB_TMO])) break; if (_sp > XB_SPIN_CAP) { atomicAdd(&(bar)[XB_TMO], 1u); break; } } } } while (0)

struct XcdBarrier {
    unsigned* bar; unsigned x; bool lead;
    volatile LAS unsigned* st;
};

__device__ __forceinline__ XcdBarrier xcd_barrier_post(unsigned* bar, volatile LAS unsigned* st) {
    XcdBarrier b; b.bar = bar; b.x = xb_xcc_id(); b.st = st; b.lead = __builtin_amdgcn_readfirstlane((int)threadIdx.x) < 64;
    if (threadIdx.x == 0) (void)xb_add(&bar[XB_XCNT(b.x)], 1u);
    return b;
}
__device__ __forceinline__ void xcd_barrier_complete(unsigned* bar, unsigned x, unsigned& nloc, unsigned& nx) {
    const unsigned G = gridDim.x * gridDim.y * gridDim.z;
    unsigned sum, cnt, mine, sp = 0u;
    for (;;) {
        sum = 0u; cnt = 0u; mine = 0u;
#pragma unroll
        for (unsigned j = 0; j < 16; ++j) { const unsigned c = xb_ld(&bar[XB_XCNT(j)]); sum += c; cnt += (c > 0u) ? 1u : 0u; mine = (j == x) ? c : mine; }
        if (sum == G) break;
        __builtin_amdgcn_s_sleep(1);
        if ((++sp & 255u) == 0u) { if (xb_ld(&bar[XB_TMO])) break; if (sp > XB_SPIN_CAP) { atomicAdd(&bar[XB_TMO], 1u); break; } }
    }
    nloc = mine > 0u ? mine : 1u; nx = cnt > 0u ? cnt : 1u;
}

__device__ __forceinline__ void xcd_barrier(const XcdBarrier& b) {
    asm volatile("s_waitcnt vmcnt(0)" ::: "memory");
    __syncthreads();
    if (b.lead && pg8::lane_id() == 0) {
        unsigned* bar = b.bar;
        __builtin_amdgcn_s_waitcnt(0);
        unsigned nloc = b.st[0], nx = b.st[1];
        if (nloc == 0u) { xcd_barrier_complete(bar, b.x, nloc, nx); b.st[0] = nloc; b.st[1] = nx; }
        const unsigned old = xb_add(&bar[XB_XSUB(b.x)], 1u);
        const unsigned gen = old / nloc;
        if (old + 1u == (gen + 1u) * nloc) {
            __builtin_amdgcn_fence(__ATOMIC_RELEASE, "agent");
            asm volatile("s_waitcnt vmcnt(0)" ::: "memory");
            const unsigned og = xb_add(&bar[XB_TOP], 1u);
            const unsigned tg = og / nx;
            if (og + 1u == (tg + 1u) * nx) xb_add(&bar[XB_TOPGEN], 1u);
            else XB_SPIN(xb_ld(&bar[XB_TOPGEN]) == tg, bar);
            __builtin_amdgcn_fence(__ATOMIC_ACQUIRE, "agent");
            xb_add(&bar[XB_XGEN(b.x)], 1u);
            asm volatile("s_waitcnt vmcnt(0)" ::: "memory");
        } else {
            XB_SPIN(xb_ld(&bar[XB_XGEN(b.x)]) == gen, bar);
            __builtin_amdgcn_fence(__ATOMIC_ACQUIRE, "agent");
            asm volatile("s_waitcnt vmcnt(0)" ::: "memory");
        }
    }
    __syncthreads();
}

constexpr int NB = 16, SEQ = 4096, DM = 1024, MT = NB * SEQ;
constexpr int DINP = 1792;
constexpr int C_CQ = 0, C_CKV = 256, C_KR = 384, C_QN = 416, C_KVC = 928, C_KVS = 1184, C_KVW = 1440, C_GATE = 1696, DIN = 1720;
constexpr int DFF = 2816, NGU = 2 * DFF;
constexpr int NCMP = 255;
constexpr float EPS = 1e-6f;
constexpr float LOG2E = 1.4426950408889634f;
constexpr float C2Q = 0.10206207261596575f * 1.4426950408889634f;
constexpr float C2N = 0.125f * 1.4426950408889634f;

constexpr int NWAVES = 8, NTHR = 512;
constexpr int NPHASE = 8;
#ifndef MK_N_LAUNCHES
#define MK_N_LAUNCHES 1
#endif
constexpr int N_LAUNCHES = MK_N_LAUNCHES;

constexpr size_t MiB = 1u << 20;
constexpr size_t WS_CTL = 0, CTL_ZERO_BYTES = 1 * MiB;
constexpr size_t WS_WIN = 2 * MiB, WS_WUQ = 6 * MiB, WS_WUKV = 7 * MiB, WS_WOUT = 8 * MiB, WS_WGU = 10 * MiB, WS_WDN = 21 * MiB;
constexpr size_t WS_ROPE = 27 * MiB, WS_BIAS = 27 * MiB + 512 * 1024, WS_BIAS1 = WS_BIAS + 8192;
constexpr size_t WS_RSTDX = 28 * MiB, WS_SSQKV = 29 * MiB, WS_SSATT = 31 * MiB, WS_SSH = 35 * MiB;
constexpr size_t WS_KCMP = 39 * MiB, WS_VCMP = 40 * MiB, WS_KPE = 41 * MiB, WS_OVT = 45 * MiB, WS_W1C = 46 * MiB, WS_W2T = 47 * MiB;
constexpr size_t WS_XB = 64 * MiB, WS_U = 192 * MiB, WS_QM = 420 * MiB, WS_KVM = 516 * MiB, WS_ATT = 644 * MiB, WS_H = 772 * MiB, WS_END = 900 * MiB;
constexpr size_t WS_HID = 64 * MiB;
static_assert(WS_U + (size_t)MT * DINP * 2 <= WS_QM && WS_HID + (size_t)MT * DFF * 2 <= WS_QM && WS_QM + (size_t)MT * 768 * 2 <= WS_KVM && WS_KVM + (size_t)MT * 1024 * 2 <= WS_ATT, "ws map");
constexpr int CW_TMO = 0, CW_BAR = 4096;

constexpr int LDS_BYTES = 163840;
constexpr int MISC_OFF = LDS_BYTES - 256;


typedef unsigned u32x4 __attribute__((ext_vector_type(4))); using pg8::Unit; using pg8::cvt_pk_bf16; using pg8::HALF; using pg8::BM;
typedef float f32x2v __attribute__((ext_vector_type(2)));
typedef unsigned u32x2 __attribute__((ext_vector_type(2)));
__device__ __forceinline__ float bf2f(unsigned short b) { return __builtin_bit_cast(float, (unsigned)b << 16); }
__device__ __forceinline__ float bflo(unsigned w) { return __builtin_bit_cast(float, w << 16); }
__device__ __forceinline__ float bfhi(unsigned w) { return __builtin_bit_cast(float, w & 0xffff0000u); }
__device__ __forceinline__ float sq4(const f32x4 v) { return (v[0] * v[0] + v[1] * v[1]) + (v[2] * v[2] + v[3] * v[3]); }

struct EpiInProj {
    static constexpr bool PERM = true, AFTER_DRAIN = false, MIDK = false;
    pg8::bf16_t* U; const float* rstd; float* ssq;
    __device__ __forceinline__ void operator()(const f32x4 (&acc)[2][2][4][2], const Unit& u, int wr, int wc, int fr, int fq) const {
        const int row0 = u.pm * BM + wr * 64 + fr, col0 = u.pn * BM + wc * 32 + 8 * fq;
#pragma unroll
        for (int ai = 0; ai < 2; ++ai) {
            float rr[4];
#pragma unroll
            for (int m = 0; m < 4; ++m) rr[m] = rstd[row0 + ai * HALF + m * 16];
            asm volatile("" ::: "memory");
#pragma unroll
            for (int m = 0; m < 4; ++m) {
                const int row = row0 + ai * HALF + m * 16; const float r = rr[m];
                pg8::bf16_t* rowp = U + (size_t)row * DINP + col0; float s0 = 0.f, s1 = 0.f;
#pragma unroll
                for (int bj = 0; bj < 2; ++bj) { const f32x4 v0 = acc[ai][bj][m][0] * r, v1 = acc[ai][bj][m][1] * r;
                    u32x4 w; w.x = cvt_pk_bf16(v0[0], v0[1]); w.y = cvt_pk_bf16(v0[2], v0[3]); w.z = cvt_pk_bf16(v1[0], v1[1]); w.w = cvt_pk_bf16(v1[2], v1[3]);
                    *(u32x4*)(rowp + bj * HALF) = w;
                    const float s = sq4(v0) + sq4(v1); if (bj == 0) s0 = s; else s1 = s; }
                if (u.pn < 2) {
                    float s = (u.pn == 0) ? (s0 + s1) : s0;
                    s += __shfl_xor(s, 16); s += __shfl_xor(s, 32);
                    if (fq == 0) ssq[(size_t)row * 8 + (u.pn == 0 ? 0 : 4) + wc] = s;
                }
            }
            asm volatile("" ::: "memory");
        }
    }
};
struct EpiQup {
    static constexpr bool PERM = true, AFTER_DRAIN = false, MIDK = false;
    pg8::bf16_t* Q; const float* ssq; const f32x2v* rope;
    __device__ __forceinline__ void operator()(const f32x4 (&acc)[2][2][4][2], const Unit& u, int wr, int wc, int fr, int fq) const {
        const int row0 = u.pm * BM + wr * 64 + fr, col0 = u.pn * BM + wc * 32 + 8 * fq;
#pragma unroll
        for (int ai = 0; ai < 2; ++ai)
#pragma unroll
            for (int m = 0; m < 4; ++m) {
                const int row = row0 + ai * HALF + m * 16; const int pos = row & (SEQ - 1);
                const f32x4 pp = *(const f32x4*)(ssq + (size_t)row * 8);
                const float r = __builtin_amdgcn_rsqf(((pp[0] + pp[1]) + (pp[2] + pp[3])) * (1.0f / 256.0f) + EPS) * C2Q;
#pragma unroll
                for (int bj = 0; bj < 2; ++bj) { const int c = col0 + bj * HALF; const int d = c % 96;
                    f32x4 v0 = acc[ai][bj][m][0] * r, v1 = acc[ai][bj][m][1] * r;
                    if (d >= 64) { const int i0 = (d - 64) >> 1; const f32x2v* rp = rope + pos * 16 + i0;
                        const f32x2v a = rp[0], b = rp[1], e = rp[2], f = rp[3];
                        f32x4 w0, w1;
                        w0[0] = v0[0] * a.x - v0[1] * a.y; w0[1] = v0[0] * a.y + v0[1] * a.x;
                        w0[2] = v0[2] * b.x - v0[3] * b.y; w0[3] = v0[2] * b.y + v0[3] * b.x;
                        w1[0] = v1[0] * e.x - v1[1] * e.y; w1[1] = v1[0] * e.y + v1[1] * e.x;
                        w1[2] = v1[2] * f.x - v1[3] * f.y; w1[3] = v1[2] * f.y + v1[3] * f.x;
                        v0 = w0; v1 = w1; }
                    u32x4 w; w.x = cvt_pk_bf16(v0[0], v0[1]); w.y = cvt_pk_bf16(v0[2], v0[3]); w.z = cvt_pk_bf16(v1[0], v1[1]); w.w = cvt_pk_bf16(v1[2], v1[3]);
                    *(u32x4*)(Q + (size_t)row * 768 + c) = w; }
                asm volatile("" ::: "memory");
            }
    }
};
struct EpiKVup {
    static constexpr bool PERM = true, AFTER_DRAIN = false, MIDK = false;
    pg8::bf16_t* KV; const float* ssq;
    __device__ __forceinline__ void operator()(const f32x4 (&acc)[2][2][4][2], const Unit& u, int wr, int wc, int fr, int fq) const {
        const int row0 = u.pm * BM + wr * 64 + fr, col0 = u.pn * BM + wc * 32 + 8 * fq;
#pragma unroll
        for (int ai = 0; ai < 2; ++ai) {
            f32x4 pq[4];
#pragma unroll
            for (int m = 0; m < 4; ++m) pq[m] = *(const f32x4*)(ssq + (size_t)(row0 + ai * HALF + m * 16) * 8 + 4);
            asm volatile("" ::: "memory");
#pragma unroll
            for (int m = 0; m < 4; ++m) {
                const int row = row0 + ai * HALF + m * 16;
                const f32x4 pp = pq[m];
                const float r = __builtin_amdgcn_rsqf(((pp[0] + pp[1]) + (pp[2] + pp[3])) * (1.0f / 128.0f) + EPS);
#pragma unroll
                for (int bj = 0; bj < 2; ++bj) { const f32x4 v0 = acc[ai][bj][m][0] * r, v1 = acc[ai][bj][m][1] * r;
                    u32x4 w; w.x = cvt_pk_bf16(v0[0], v0[1]); w.y = cvt_pk_bf16(v0[2], v0[3]); w.z = cvt_pk_bf16(v1[0], v1[1]); w.w = cvt_pk_bf16(v1[2], v1[3]);
                    *(u32x4*)(KV + (size_t)row * 1024 + col0 + bj * HALF) = w; }
            }
            asm volatile("" ::: "memory");
        }
    }
};
constexpr int OUT_TAB_OFF = 131072;
struct OutOrder : pg8::StaticOrder {
    const float* ssatt; LAS float* tab;
    struct Pre { f32x4 a, b; };
    __device__ __forceinline__ Pre a_pre(const Unit& u, int tid) const {
        const int row = tid >> 1, which = tid & 1;
        const unsigned off = (unsigned)(((u.pm * BM + row) * 16 + which * 8) * 4);
        const f32x4* pp = (const f32x4*)((const char*)ssatt + off); return Pre{pp[0], pp[1]};
    }
    __device__ __forceinline__ void a_post(const Unit& u, const Pre& p, int tid) const {
        const int row = tid >> 1, which = tid & 1; const f32x4 a = p.a, b = p.b;
        const float r = __builtin_amdgcn_rsqf((((a[0] + a[1]) + (a[2] + a[3])) + ((b[0] + b[1]) + (b[2] + b[3]))) * (1.0f / 512.0f) + EPS);
        const float o = __shfl_xor(r, 1);
        if (which == 0) { LAS float* t = tab + (u.ui & 1) * 512 + row * 2; t[0] = r / o; t[1] = o; }
    }
};
struct EpiOut {
    static constexpr bool PERM = true, AFTER_DRAIN = false, MIDK = true;
    const pg8::bf16_t* xb; pg8::bf16_t* H; unsigned char* H8; float* ssh; const LAS float* tab;
    __device__ __forceinline__ void midk(f32x4 (&acc)[2][2][4][2], const Unit& u, int wr, int fr) const {
        const LAS float* t = tab + (u.ui & 1) * 512 + (wr * 64 + fr) * 2;
#pragma unroll
        for (int ai = 0; ai < 2; ++ai)
#pragma unroll
            for (int m = 0; m < 4; ++m) { const float ratio = t[(ai * HALF + m * 16) * 2];
#pragma unroll
                for (int bj = 0; bj < 2; ++bj) { acc[ai][bj][m][0] *= ratio; acc[ai][bj][m][1] *= ratio; } }
    }
    __device__ __forceinline__ void operator()(const f32x4 (&acc)[2][2][4][2], const Unit& u, int wr, int wc, int fr, int fq) const {
        const int row0 = u.pm * BM + wr * 64 + fr, col0 = u.pn * BM + wc * 32 + 8 * fq;
        const LAS float* t = tab + (u.ui & 1) * 512 + (wr * 64 + fr) * 2 + 1;
#pragma unroll
        for (int ai = 0; ai < 2; ++ai) {
            u32x4 xr[4][2];
#pragma unroll
            for (int m = 0; m < 4; ++m)
#pragma unroll
                for (int bj = 0; bj < 2; ++bj) xr[m][bj] = *(const u32x4*)(xb + (size_t)(row0 + ai * HALF + m * 16) * DM + col0 + bj * HALF);
            asm volatile("" ::: "memory");
#pragma unroll
            for (int m = 0; m < 4; ++m) {
                const int row = row0 + ai * HALF + m * 16; const float r = t[(ai * HALF + m * 16) * 2];
                float s = 0.f;
#pragma unroll
                for (int bj = 0; bj < 2; ++bj) { const size_t off = (size_t)row * DM + col0 + bj * HALF;
                    const u32x4 xw = xr[m][bj];
                    f32x4 x0, x1; x0[0] = bflo(xw.x); x0[1] = bfhi(xw.x); x0[2] = bflo(xw.y); x0[3] = bfhi(xw.y); x1[0] = bflo(xw.z); x1[1] = bfhi(xw.z); x1[2] = bflo(xw.w); x1[3] = bfhi(xw.w);
                    const f32x4 v0 = x0 + acc[ai][bj][m][0] * r, v1 = x1 + acc[ai][bj][m][1] * r;
                    u32x4 w; w.x = cvt_pk_bf16(v0[0], v0[1]); w.y = cvt_pk_bf16(v0[2], v0[3]); w.z = cvt_pk_bf16(v1[0], v1[1]); w.w = cvt_pk_bf16(v1[2], v1[3]);
                    *(u32x4*)(H + off) = w; s += sq4(v0) + sq4(v1);
                    u32x2 w8; w8.x = pg8::cvt_pk4_fp8(v0[0], v0[1], v0[2], v0[3]); w8.y = pg8::cvt_pk4_fp8(v1[0], v1[1], v1[2], v1[3]); *(u32x2*)(H8 + off) = w8; }
                s += __shfl_xor(s, 16); s += __shfl_xor(s, 32);
                if (fq == 0) ssh[(size_t)row * 16 + u.pn * 4 + wc] = s;
            }
            asm volatile("" ::: "memory");
        }
    }
};
struct GUOrder : pg8::StaticOrder {
    const float* ssh; LAS float* tab;
    struct Pre { f32x4 a, b; };
    __device__ __forceinline__ Pre a_pre(const Unit& u, int tid) const {
        const int row = tid >> 1, which = tid & 1;
        const unsigned off = (unsigned)(((u.pm * BM + row) * 16 + which * 8) * 4);
        const f32x4* pp = (const f32x4*)((const char*)ssh + off); return Pre{pp[0], pp[1]};
    }
    __device__ __forceinline__ void a_post(const Unit& u, const Pre& p, int tid) const {
        const int row = tid >> 1, which = tid & 1; const f32x4 a = p.a, b = p.b;
        float s = ((a[0] + a[1]) + (a[2] + a[3])) + ((b[0] + b[1]) + (b[2] + b[3]));
        s += __shfl_xor(s, 1);
        if (which == 0) tab[(u.ui & 1) * 256 + row] = __builtin_amdgcn_rsqf(s * (1.0f / 1024.0f) + EPS) * (1.0f / 128.0f);
    }
};
struct EpiGU {
    static constexpr bool PERM = true, AFTER_DRAIN = false, MIDK = false;
    unsigned char* HID; const LAS float* tab;
    __device__ __forceinline__ void operator()(const f32x4 (&acc)[2][2][4][2], const Unit& u, int wr, int wc, int fr, int fq) const {
        const int row0 = u.pm * BM + wr * 64 + fr, col0 = u.pn * HALF + wc * 32 + 8 * fq;
        const LAS float* t = tab + (u.ui & 1) * 256 + wr * 64 + fr;
#pragma unroll
        for (int ai = 0; ai < 2; ++ai)
#pragma unroll
            for (int m = 0; m < 4; ++m) {
                const int row = row0 + ai * HALF + m * 16; const float r = t[ai * HALF + m * 16];
                const f32x2v rn2 = {-r * LOG2E, -r * LOG2E}, rr2 = {r * r, r * r}, one2 = {1.0f, 1.0f};
                float o[8];
#pragma unroll
                for (int n = 0; n < 2; ++n)
#pragma unroll
                    for (int e = 0; e < 4; e += 2) { const f32x2v a0 = {acc[ai][0][m][n][e], acc[ai][0][m][n][e + 1]}, a1 = {acc[ai][1][m][n][e], acc[ai][1][m][n][e + 1]};
                        const f32x2v tt = a0 * rn2; f32x2v ex; ex.x = __builtin_amdgcn_exp2f(tt.x); ex.y = __builtin_amdgcn_exp2f(tt.y);
                        const f32x2v dd = ex + one2; f32x2v rc; rc.x = __builtin_amdgcn_rcpf(dd.x); rc.y = __builtin_amdgcn_rcpf(dd.y);
                        const f32x2v oo = (a0 * a1) * (rc * rr2);
                        o[n * 4 + e] = __builtin_amdgcn_fmed3f(oo.x, -448.0f, 448.0f); o[n * 4 + e + 1] = __builtin_amdgcn_fmed3f(oo.y, -448.0f, 448.0f); }
                u32x2 w; w.x = pg8::cvt_pk4_fp8(o[0], o[1], o[2], o[3]); w.y = pg8::cvt_pk4_fp8(o[4], o[5], o[6], o[7]);
                *(u32x2*)(HID + (size_t)row * DFF + col0) = w;
            }
    }
};
struct EpiDown {
    static constexpr bool PERM = true, AFTER_DRAIN = false, MIDK = false;
    const pg8::bf16_t* H; pg8::bf16_t* H2; float* ss2;
    __device__ __forceinline__ void operator()(const f32x4 (&acc)[2][2][4][2], const Unit& u, int wr, int wc, int fr, int fq) const {
        const int row0 = u.pm * BM + wr * 64 + fr, col0 = u.pn * BM + wc * 32 + 8 * fq;
#pragma unroll
        for (int ai = 0; ai < 2; ++ai) {
            u32x4 hr[4][2];
#pragma unroll
            for (int m = 0; m < 4; ++m)
#pragma unroll
                for (int bj = 0; bj < 2; ++bj) hr[m][bj] = *(const u32x4*)(H + (size_t)(row0 + ai * HALF + m * 16) * DM + col0 + bj * HALF);
            asm volatile("" ::: "memory");
#pragma unroll
            for (int m = 0; m < 4; ++m) {
                const int row = row0 + ai * HALF + m * 16; float s = 0.f;
#pragma unroll
                for (int bj = 0; bj < 2; ++bj) { const size_t off = (size_t)row * DM + col0 + bj * HALF;
                    const u32x4 hw = hr[m][bj];
                    f32x4 h0, h1; h0[0] = bflo(hw.x); h0[1] = bfhi(hw.x); h0[2] = bflo(hw.y); h0[3] = bfhi(hw.y); h1[0] = bflo(hw.z); h1[1] = bfhi(hw.z); h1[2] = bflo(hw.w); h1[3] = bfhi(hw.w);
                    h0 += acc[ai][bj][m][0] * (1.0f / 128.0f); h1 += acc[ai][bj][m][1] * (1.0f / 128.0f);
                    u32x4 w; w.x = cvt_pk_bf16(h0[0], h0[1]); w.y = cvt_pk_bf16(h0[2], h0[3]); w.z = cvt_pk_bf16(h1[0], h1[1]); w.w = cvt_pk_bf16(h1[2], h1[3]);
                    *(u32x4*)(H2 + off) = w; s += sq4(h0) + sq4(h1); }
                s += __shfl_xor(s, 16); s += __shfl_xor(s, 32);
                if (fq == 0) ss2[(size_t)row * 16 + u.pn * 4 + wc] = s;
            }
            asm volatile("" ::: "memory");
        }
    }
};

struct Args { const float* in[22]; float* out; unsigned char* ws; int ph_lo, ph_hi, li, pad; };
enum { I_X = 0, I_GMIX, I_WIN, I_GQ, I_WUQ, I_GKV, I_WUKV, I_POSK, I_W1K, I_W2K, I_POSV, I_W1V, I_W2V, I_T5, I_GOM, I_GON, I_WOUT, I_GFFN, I_WG, I_WU, I_WD, I_GFIN };

__device__ __forceinline__ float wave_sum(float v) {
#pragma unroll
    for (int o = 1; o < 64; o <<= 1) v += __shfl_xor(v, o);
    return v;
}
typedef __bf16 bf16x2_t __attribute__((ext_vector_type(2)));
__device__ __forceinline__ float dot2(unsigned a, unsigned b, float c) { return __builtin_amdgcn_fdot2_f32_bf16(__builtin_bit_cast(bf16x2_t, a), __builtin_bit_cast(bf16x2_t, b), c, false); }

template <class F> __device__ __forceinline__ void tr_item(F f, bf16* WT, int ldk, int nblk, LAS float* scr, int item, int lane) {
    const int kb = item / nblk, nb = item % nblk, k0 = 64 * kb, n0 = 32 * nb;
#pragma unroll 8
    for (int i = 0; i < 32; ++i) { const int kk = 2 * i + (lane >> 5); scr[kk * 33 + (lane & 31)] = f(k0 + kk, n0 + (lane & 31)); }
    LDS_WAIT(); asm volatile("" ::: "memory");
    const int c = lane & 7;
#pragma unroll
    for (int j = 0; j < 4; ++j) { const int n = (lane >> 3) + 8 * j; const LAS float* s = scr + (8 * c) * 33 + n;
        v4u o; o.x = pk2(s[0 * 33], s[1 * 33]); o.y = pk2(s[2 * 33], s[3 * 33]); o.z = pk2(s[4 * 33], s[5 * 33]); o.w = pk2(s[6 * 33], s[7 * 33]);
        *(GAS v4u*)(WT + (size_t)(n0 + n) * ldk + k0 + 8 * c) = o; }
    LDS_WAIT(); asm volatile("" ::: "memory");
}
template <class F> __device__ __forceinline__ void tr_item8(F f, unsigned char* WT, int ldk, int nblk, LAS float* scr, int item, int lane) {
    const int kb = item / nblk, nb = item % nblk, k0 = 64 * kb, n0 = 32 * nb;
#pragma unroll 8
    for (int i = 0; i < 32; ++i) { const int kk = 2 * i + (lane >> 5); scr[kk * 33 + (lane & 31)] = f(k0 + kk, n0 + (lane & 31)); }
    LDS_WAIT(); asm volatile("" ::: "memory");
    const int c = lane & 7;
#pragma unroll
    for (int j = 0; j < 4; ++j) { const int n = (lane >> 3) + 8 * j; const LAS float* s = scr + (8 * c) * 33 + n;
        u32x2 o; o.x = pg8::cvt_pk4_fp8(s[0 * 33], s[1 * 33], s[2 * 33], s[3 * 33]); o.y = pg8::cvt_pk4_fp8(s[4 * 33], s[5 * 33], s[6 * 33], s[7 * 33]);
        *(GAS u32x2*)(WT + (size_t)(n0 + n) * ldk + k0 + 8 * c) = o; }
    LDS_WAIT(); asm volatile("" ::: "memory");
}
__device__ __forceinline__ int t5_bucket(int n) {
    if (n < 16) return n;
    int b = 16; b += n >= 19; b += n >= 21; b += n >= 24; b += n >= 27; b += n >= 31; b += n >= 35; b += n >= 40; b += n >= 46; b += n >= 52; b += n >= 59; b += n >= 67; b += n >= 77; b += n >= 87; b += n >= 99; b += n >= 113;
    return b;
}
__device__ __forceinline__ float gelu_tanh(float x) {
    const float y = 0.7978845608028654f * (x + 0.044715f * x * x * x);
    const float e = __builtin_amdgcn_exp2f(2.0f * LOG2E * y);
    const float th = 1.0f - 2.0f * __builtin_amdgcn_rcpf(e + 1.0f);
    return 0.5f * x * (1.0f + th);
}

struct Ptrs {
    const float* in[22]; float* out; unsigned char* ws;
    bf16 *Win, *Wuq, *Wukv, *Wout, *Wgu, *Wdn; f32x2v* rope; float *bias, *bias1, *rstdx, *ssqkv, *ssatt, *ssh;
    bf16 *kcmp, *vcmp, *kpe, *ovt, *W1c, *W2t, *XB, *U, *QM, *KVM, *ATT, *H, *HID;
};

__device__ __forceinline__ void p0_prologue(const Ptrs& P, LAS unsigned char* lds, int wg, int G, int wave, int lane, int tid) {
    LAS float* scr = (LAS float*)(lds + wave * 16384);
    const int gw = wg * NWAVES + wave, NGW = G * NWAVES;
    constexpr int I_IN = (1024 / 64) * (DINP / 32), I_UQ = (256 / 64) * (768 / 32), I_UKV = (256 / 64) * (1024 / 32), I_OUT = (1024 / 64) * (1024 / 32), I_GU = (1024 / 64) * (NGU / 32), I_DN = (DFF / 64) * (1024 / 32);
    constexpr int I_W1C = 2 * (1024 / 64) * (256 / 32), I_W2T = 2 * (128 / 64) * (64 / 32);
    constexpr int NITEMS = I_IN + I_UQ + I_UKV + I_OUT + I_GU + I_DN + I_W1C + I_W2T;
    for (int it = gw; it < NITEMS; it += NGW) {
        int r = it;
        if (r < I_IN) { const float* W = P.in[I_WIN]; const float* g = P.in[I_GMIX];
            tr_item([=](int k, int n) -> float { if (n >= DIN) return 0.f; const float s = (n >= C_QN && n < C_KVC) ? C2N : 1.0f; return W[(size_t)k * DIN + n] * g[k] * s; }, P.Win, 1024, DINP / 32, scr, r, lane); continue; } r -= I_IN;
        if (r < I_UQ) { const float* W = P.in[I_WUQ]; const float* g = P.in[I_GQ];
            tr_item([=](int k, int n) -> float { const int h = n / 96, d = n % 96; int src = n; if (d >= 64) { const int e = d - 64; src = h * 96 + 64 + (e & 1) * 16 + (e >> 1); } return W[(size_t)k * 768 + src] * g[k]; }, P.Wuq, 256, 768 / 32, scr, r, lane); continue; } r -= I_UQ;
        if (r < I_UKV) { const float* W = P.in[I_WUKV]; const float* g = P.in[I_GKV];
            tr_item([=](int k, int n) -> float { return k < 128 ? W[(size_t)k * 1024 + n] * g[k] : 0.f; }, P.Wukv, 256, 1024 / 32, scr, r, lane); continue; } r -= I_UKV;
        if (r < I_OUT) { const float* W = P.in[I_WOUT]; const float* g1 = P.in[I_GOM]; const float* g2 = P.in[I_GON];
            tr_item([=](int k, int n) -> float { return W[(size_t)k * 1024 + n] * (k < 512 ? g1[k] : g2[k - 512]); }, P.Wout, 1024, 1024 / 32, scr, r, lane); continue; } r -= I_OUT;
        if (r < I_GU) { const float* g = P.in[I_GFFN]; const bool up = ((r % (NGU / 32)) & 4) != 0;
            if (!up) { const float* W = P.in[I_WG]; tr_item8([=](int k, int n) -> float { return W[(size_t)k * DFF + (n >> 8) * 128 + (n & 127)] * (g[k] * 128.0f); }, (unsigned char*)P.Wgu, 1024, NGU / 32, scr, r, lane); }
            else { const float* W = P.in[I_WU]; tr_item8([=](int k, int n) -> float { return W[(size_t)k * DFF + (n >> 8) * 128 + (n & 127)] * (g[k] * 128.0f); }, (unsigned char*)P.Wgu, 1024, NGU / 32, scr, r, lane); }
            continue; } r -= I_GU;
        if (r < I_DN) { const float* W = P.in[I_WD];
            tr_item8([=](int k, int n) -> float { return W[(size_t)k * 1024 + n] * 128.0f; }, (unsigned char*)P.Wdn, DFF, 1024 / 32, scr, r, lane); continue; } r -= I_DN;
        if (r < I_W1C) { const int kv = r >= I_W1C / 2; if (kv) r -= I_W1C / 2;
            if (!kv) { const float* W = P.in[I_W1K]; tr_item([=](int k, int n) -> float { return W[(size_t)(k + ((n >> 7) << 10)) * 128 + (n & 127)]; }, P.W1c, 1024, 256 / 32, scr, r, lane); }
            else { const float* W = P.in[I_W1V]; tr_item([=](int k, int n) -> float { return W[(size_t)(k + ((n >> 7) << 10)) * 128 + (n & 127)]; }, P.W1c + 256 * 1024, 1024, 256 / 32, scr, r, lane); }
            continue; } r -= I_W1C;
        { const int kv = r >= I_W2T / 2; if (kv) r -= I_W2T / 2;
            if (!kv) { const float* W = P.in[I_W2K]; tr_item([=](int k, int n) -> float { return W[(size_t)k * 64 + n]; }, P.W2t, 128, 64 / 32, scr, r, lane); }
            else { const float* W = P.in[I_W2V]; tr_item([=](int k, int n) -> float { return W[(size_t)k * 64 + n]; }, P.W2t + 64 * 128, 128, 64 / 32, scr, r, lane); } }
    }
    const int gt = wg * NTHR + tid, NGT = G * NTHR;
    for (int e = gt; e < SEQ * 16; e += NGT) { const int pos = e >> 4, i = e & 15;
        const float inv = __builtin_amdgcn_exp2f(-(float)i * (13.287712379549449f / 16.0f));
        const float ang = (float)pos * inv;
        double rev = (double)ang * 0.15915494309189535; rev -= __builtin_floor(rev);
        const float fr = (float)rev;
        P.rope[e] = (f32x2v){__builtin_amdgcn_cosf(fr), __builtin_amdgcn_sinf(fr)}; }
    for (int e = gt; e < 8 * 128; e += NGT) { const int h = e >> 7, d = e & 127; P.bias[e] = P.in[I_T5][t5_bucket(d) * 8 + h] * LOG2E; }
    for (int e = gt; e < 256 * 64; e += NGT) { const int i = e >> 6, j = e & 63; float w = 0.f; if (j == (i >> 2)) w += ((i & 3) == 3) ? 1.f : 2.f; if ((i & 3) == 3 && j == (i >> 2) + 1) w += 1.f;
        P.ovt[e] = (bf16)(__float_as_uint(w) >> 16); }
    for (int o = gw; o < 256; o += NGW) { const int kv = o >> 7, j = o & 127; const float* pos = P.in[kv ? I_POSV : I_POSK]; const float* w1 = P.in[kv ? I_W1V : I_W1K];
        float s = 0.f; for (int k = lane; k < 2048; k += 64) s += pos[k] * w1[(size_t)k * 128 + j];
        s = wave_sum(s); if (lane == 0) P.bias1[o] = s; }
    for (int m0 = gw * 4; m0 < MT; m0 += NGW * 4) {
        f32x4 v[4][4];
#pragma unroll
        for (int q = 0; q < 4; ++q) { const GAS f32x4* xr = (const GAS f32x4*)(P.in[I_X] + (size_t)(m0 + q) * DM) + lane;
#pragma unroll
            for (int j = 0; j < 4; ++j) v[q][j] = __builtin_nontemporal_load(xr + 64 * j); }
#pragma unroll
        for (int q = 0; q < 4; ++q) { float s = 0.f;
#pragma unroll
            for (int j = 0; j < 4; ++j) s += sq4(v[q][j]);
            s = wave_sum(s);
            if (lane == 0) P.rstdx[m0 + q] = __builtin_amdgcn_rsqf(s * (1.0f / DM) + EPS);
            GAS unsigned long long* o8 = (GAS unsigned long long*)(P.XB + (size_t)(m0 + q) * DM) + lane;
#pragma unroll
            for (int j = 0; j < 4; ++j) o8[64 * j] = (unsigned long long)pk2(v[q][j][0], v[q][j][1]) | ((unsigned long long)pk2(v[q][j][2], v[q][j][3]) << 32); }
    }
}

__device__ __forceinline__ void p2_kpe(const Ptrs& P, int wg, int G, int tid) {
    const int gt = wg * NTHR + tid, NGT = G * NTHR;
    for (int e = gt; e < MT * 16; e += NGT) { const int row = e >> 4, i = e & 15; const int pos = row & (SEQ - 1);
        const float x1 = bf2f(P.U[(size_t)row * DINP + C_KR + i]), x2 = bf2f(P.U[(size_t)row * DINP + C_KR + 16 + i]);
        const f32x2v cs = P.rope[pos * 16 + i];
        *(unsigned*)(P.kpe + (size_t)row * 32 + 2 * i) = pk2(x1 * cs.x - x2 * cs.y, x1 * cs.y + x2 * cs.x); }
}
__device__ __forceinline__ void p7_final(const Ptrs& P, int wg, int G, int wave, int lane) {
    const int gw = wg * NWAVES + wave, NGW = G * NWAVES;
    const GAS f32x4* gp = (const GAS f32x4*)P.in[I_GFIN] + 2 * lane; f32x4 gg[4][2];
#pragma unroll
    for (int j = 0; j < 2; ++j) { gg[j][0] = gp[128 * j]; gg[j][1] = gp[128 * j + 1]; }
    for (int m0 = gw * 4; m0 < MT; m0 += NGW * 4) {
        u32x4 w0[4], w1[4]; float pv[4];
#pragma unroll
        for (int q = 0; q < 4; ++q) { const GAS u32x4* hr = (const GAS u32x4*)(P.ATT + (size_t)(m0 + q) * DM) + lane;
            w0[q] = hr[0]; w1[q] = hr[64]; pv[q] = (lane < 16) ? P.ssatt[(size_t)(m0 + q) * 16 + lane] : 0.f; }
#pragma unroll
        for (int q = 0; q < 4; ++q) {
            const float r = __builtin_amdgcn_rsqf(wave_sum(pv[q]) * (1.0f / DM) + EPS);
            GAS f32x4* o = (GAS f32x4*)(P.out + (size_t)(m0 + q) * DM) + 2 * lane;
            { const u32x4 w = w0[q]; f32x4 a, b; a[0] = bflo(w.x); a[1] = bfhi(w.x); a[2] = bflo(w.y); a[3] = bfhi(w.y); b[0] = bflo(w.z); b[1] = bfhi(w.z); b[2] = bflo(w.w); b[3] = bfhi(w.w);
              o[0] = a * r * gg[0][0]; o[1] = b * r * gg[0][1]; }
            { const u32x4 w = w1[q]; f32x4 a, b; a[0] = bflo(w.x); a[1] = bfhi(w.x); a[2] = bflo(w.y); a[3] = bfhi(w.y); b[0] = bflo(w.z); b[1] = bfhi(w.z); b[2] = bflo(w.w); b[3] = bfhi(w.w);
              o[128] = a * r * gg[1][0]; o[129] = b * r * gg[1][1]; } }
    }
}

struct CmpOrder {
    int G, c; const bf16* U; const bf16* W1c;
    __device__ __forceinline__ bool next(int i, Unit& u) const { const int un = c + i * G; if (un >= 64) return false; u.pm = un; u.pn = 0; u.ui = i; return true; }
    struct Pre {};
    __device__ __forceinline__ Pre a_pre(const Unit&, int) const { return Pre{}; }
    __device__ __forceinline__ void a_post(const Unit&, const Pre&, int) const {}
    __device__ __forceinline__ void done(const Unit&) const {}
    __device__ __forceinline__ const char* a_base(const pg8::Gemm&, const Unit& u, size_t) const { const int bh = u.pm >> 1, kv = u.pm & 1;
        return (const char*)(U + (size_t)(bh >> 1) * SEQ * DINP + C_KVC + kv * 128 + (bh & 1) * 64); }
    __device__ __forceinline__ const char* b_base(const pg8::Gemm&, const Unit& u, size_t) const { return (const char*)(W1c + (size_t)(u.pm & 1) * 256 * 1024); }
};
struct EpiCmp {
    static constexpr bool PERM = true, AFTER_DRAIN = true, MIDK = false;
    const float* bias1; const bf16* W2t; bf16* kcmp; bf16* vcmp;
    __device__ __forceinline__ void operator()(const f32x4 (&)[2][2][4][2], const Unit&, int, int, int, int) const {}
    __device__ __forceinline__ void fused(f32x4 (&acc)[2][2][4][2], const Unit& u, int wr, int wc, int fr, int fq, LAS unsigned char* lds, int wid, int lane) const {
        typedef short bf16x8_t __attribute__((ext_vector_type(8))); typedef float f32x16_t __attribute__((ext_vector_type(16)));
        const int bh = u.pm >> 1, kv = u.pm & 1; const int col = wc * 32 + 8 * fq;
        LAS float* OB = (LAS float*)lds;
#pragma unroll
        for (int ai = 0; ai < 2; ++ai)
#pragma unroll
            for (int m = 0; m < 4; ++m) { const int r = ai * HALF + wr * 64 + m * 16 + fr;
                *(LAS f32x4*)(OB + r * 132 + col) = acc[ai][1][m][0]; *(LAS f32x4*)(OB + r * 132 + col + 4) = acc[ai][1][m][1]; }
        const f32x4 bs0 = *(const f32x4*)(bias1 + kv * 128 + col), bs1 = *(const f32x4*)(bias1 + kv * 128 + col + 4);
        asm volatile("s_waitcnt lgkmcnt(0)" ::: "memory"); __builtin_amdgcn_s_barrier(); asm volatile("" ::: "memory");
#pragma unroll
        for (int ai = 0; ai < 2; ++ai)
#pragma unroll
            for (int m = 0; m < 4; ++m) { const int r = ai * HALF + wr * 64 + m * 16 + fr, r1 = r < 255 ? r + 1 : 255;
                const f32x4 b0 = *(const LAS f32x4*)(OB + r1 * 132 + col), b1 = *(const LAS f32x4*)(OB + r1 * 132 + col + 4);
                f32x4 h0 = acc[ai][0][m][0] + b0 + bs0, h1 = acc[ai][0][m][1] + b1 + bs1;
#pragma unroll
                for (int e = 0; e < 4; ++e) { h0[e] = gelu_tanh(h0[e]); h1[e] = gelu_tanh(h1[e]); }
                acc[ai][0][m][0] = h0; acc[ai][0][m][1] = h1; }
        asm volatile("s_waitcnt lgkmcnt(0)" ::: "memory"); __builtin_amdgcn_s_barrier(); asm volatile("" ::: "memory");
        LAS bf16* GB = (LAS bf16*)lds;
#pragma unroll
        for (int ai = 0; ai < 2; ++ai)
#pragma unroll
            for (int m = 0; m < 4; ++m) { const int r = ai * HALF + wr * 64 + m * 16 + fr; const f32x4 h0 = acc[ai][0][m][0], h1 = acc[ai][0][m][1];
                u32x4 w; w.x = pk2(h0[0], h0[1]); w.y = pk2(h0[2], h0[3]); w.z = pk2(h1[0], h1[1]); w.w = pk2(h1[2], h1[3]);
                *(LAS u32x4*)(GB + r * 136 + col) = w; }
        asm volatile("s_waitcnt lgkmcnt(0)" ::: "memory"); __builtin_amdgcn_s_barrier(); asm volatile("" ::: "memory");
        const int r32 = lane & 31, hi = lane >> 5, c = wid * 32 + r32;
        f32x16_t o[2]; o[0] = f32x16_t{}; o[1] = f32x16_t{};
        const bf16* w2 = W2t + (size_t)kv * 64 * 128;
#pragma unroll
        for (int s = 0; s < 8; ++s) { const bf16x8_t gb = *(const LAS bf16x8_t*)(GB + c * 136 + 16 * s + 8 * hi);
#pragma unroll
            for (int dt = 0; dt < 2; ++dt) { const bf16x8_t wa = *(const bf16x8_t*)(w2 + (size_t)(32 * dt + r32) * 128 + 16 * s + 8 * hi);
                o[dt] = __builtin_amdgcn_mfma_f32_32x32x16_bf16(wa, gb, o[dt], 0, 0, 0); } }
        if (c < NCMP) { bf16* op = (kv ? vcmp : kcmp) + ((size_t)bh * 256 + c) * 64 + 4 * hi;
#pragma unroll
            for (int dt = 0; dt < 2; ++dt)
#pragma unroll
                for (int k = 0; k < 4; ++k) *(unsigned long long*)(op + 32 * dt + 8 * k) = (unsigned long long)pk2(o[dt][4 * k], o[dt][4 * k + 1]) | ((unsigned long long)pk2(o[dt][4 * k + 2], o[dt][4 * k + 3]) << 32); }
        asm volatile("s_waitcnt lgkmcnt(0)" ::: "memory"); __builtin_amdgcn_s_barrier();
    }
};

namespace att {
typedef short bf16x8 __attribute__((ext_vector_type(8)));
typedef short s16x4 __attribute__((ext_vector_type(4)));
typedef float f32x16 __attribute__((ext_vector_type(16)));
typedef __attribute__((address_space(3))) const char* lds_cptr;
constexpr float THR = 8.0f;
constexpr float NEG_INF = -__builtin_inff();
__device__ __forceinline__ int crow(int r, int hi) { return (r & 3) + 8 * (r >> 2) + 4 * hi; }
__device__ __forceinline__ float swap_max(float x) { auto rr = __builtin_amdgcn_permlane32_swap(__float_as_uint(x), __float_as_uint(x), false, false); return fmaxf(__uint_as_float(rr[0]), __uint_as_float(rr[1])); }
__device__ __forceinline__ float swap_sum(float x) { auto rr = __builtin_amdgcn_permlane32_swap(__float_as_uint(x), __float_as_uint(x), false, false); return __uint_as_float(rr[0]) + __uint_as_float(rr[1]); }
__device__ __forceinline__ float partner32(float x, int hi) { auto rr = __builtin_amdgcn_permlane32_swap(__float_as_uint(x), __float_as_uint(x), false, false); return __uint_as_float(hi ? rr[0] : rr[1]); }
__device__ __forceinline__ unsigned partner32u(unsigned x, int hi) { auto rr = __builtin_amdgcn_permlane32_swap(x, x, false, false); return hi ? rr[0] : rr[1]; }
__device__ __forceinline__ void dma16(const void* g, LAS unsigned char* l) { unsigned keep; const unsigned dst = (unsigned)__builtin_amdgcn_readfirstlane((int)(unsigned)(uintptr_t)l);
    asm volatile("s_mov_b32 %0, m0\n\ts_mov_b32 m0, %2\n\ts_nop 0\n\tglobal_load_lds_dwordx4 %1, off\n\ts_mov_b32 m0, %0" : "=&s"(keep) : "v"(g), "s"(dst) : "memory"); }
template <int N> __device__ __forceinline__ void wait_bar() { if (N == 3) asm volatile("s_waitcnt vmcnt(3) lgkmcnt(0)\n\ts_barrier" ::: "memory"); else if (N == 2) asm volatile("s_waitcnt vmcnt(2) lgkmcnt(0)\n\ts_barrier" ::: "memory"); else asm volatile("s_waitcnt vmcnt(0) lgkmcnt(0)\n\ts_barrier" ::: "memory"); }

struct SrcMLA {
    static constexpr int DK = 96, NDMA = 3, NV = 1;
    const bf16* kn; const bf16* kp; const bf16* v;
    __device__ __forceinline__ void init(const bf16* KVM, const bf16* KPE, size_t rowb, int h, int wid, int lane) {
        kn = KVM + (rowb + lane) * 1024 + h * 128 + 8 * wid;
        kp = KPE + (rowb + lane) * 32 + 8 * (wid & 3);
        v = KVM + (rowb + 16 * (wid & 3) + (lane >> 2)) * 1024 + h * 128 + 64 + (wid >> 2) * 32 + (lane & 3) * 8; }
    static constexpr int NKD = 2;
    __device__ __forceinline__ void issueK(int tile, LAS unsigned char* ks, int wid) const {
        dma16(kn + (size_t)tile * 64 * 1024, ks + wid * 1024);
        dma16(kp + (size_t)tile * 64 * 32, ks + (8 + (wid & 3)) * 1024); }
    __device__ __forceinline__ void issueV(int tile, LAS unsigned char* vs, int wid) const { dma16(v + (size_t)tile * 64 * 1024, vs + wid * 1024); }
    __device__ __forceinline__ void issue(int tile, LAS unsigned char* ks, LAS unsigned char* vs, int wid) const { issueK(tile, ks, wid); issueV(tile, vs, wid); }
};
struct SrcRows {
    static constexpr int DK = 64, NDMA = 2, NV = 1;
    const bf16* k; const bf16* v; size_t pitch;
    __device__ __forceinline__ void init(const bf16* K0, const bf16* V0, size_t pitch_, int wid, int lane) {
        pitch = pitch_; k = K0 + (size_t)lane * pitch + 8 * wid; v = V0 + (size_t)(16 * (wid & 3) + (lane >> 2)) * pitch + (wid >> 2) * 32 + (lane & 3) * 8; }
    static constexpr int NKD = 1;
    __device__ __forceinline__ void issueK(int tile, LAS unsigned char* ks, int wid) const { dma16(k + (size_t)tile * 64 * pitch, ks + wid * 1024); }
    __device__ __forceinline__ void issueV(int tile, LAS unsigned char* vs, int wid) const { dma16(v + (size_t)tile * 64 * pitch, vs + wid * 1024); }
    __device__ __forceinline__ void issue(int tile, LAS unsigned char* ks, LAS unsigned char* vs, int wid) const { issueK(tile, ks, wid); issueV(tile, vs, wid); }
};

struct SrcCmp {
    static constexpr int DK = 64, NDMA = 3, NV = 2;
    const bf16* k; const bf16* v; const bf16* ov;
    __device__ __forceinline__ void init(const bf16* K0, const bf16* V0, const bf16* OV, int wid, int lane) {
        k = K0 + (size_t)lane * 64 + 8 * wid; const size_t vo = (size_t)(16 * (wid & 3) + (lane >> 2)) * 64 + (wid >> 2) * 32 + (lane & 3) * 8; v = V0 + vo; ov = OV + vo; }
    __device__ __forceinline__ void issue(int tile, LAS unsigned char* ks, LAS unsigned char* vs, int wid) const {
        dma16(k + (size_t)tile * 4096, ks + wid * 1024);
        dma16(v + (size_t)tile * 4096, vs + wid * 1024);
        dma16(ov + (size_t)tile * 4096, vs + 8192 + wid * 1024); }
};

template <int NV> struct RowT { float m, l; f32x16 o[2 * NV]; };
typedef RowT<1> Row;
template <int NV> __device__ __forceinline__ void row_reset(RowT<NV>& R) { R.m = -1e30f; R.l = 0.f;
#pragma unroll
    for (int i = 0; i < 2 * NV; ++i) R.o[i] = f32x16{}; }

template <int DK> __device__ __forceinline__ void qk_tile(f32x16& p0, f32x16& p1, LAS unsigned char* kslot, const bf16x8 (&qr)[DK / 16], int r32, int hi) {
    const LAS unsigned char* kb = kslot + hi * 1024 + r32 * 16;
    p0 = f32x16{}; p1 = f32x16{};
#pragma unroll
    for (int d0 = 0; d0 < DK / 16; ++d0) {
        const bf16x8 b0 = *(const LAS bf16x8*)(kb + d0 * 2048), b1 = *(const LAS bf16x8*)(kb + d0 * 2048 + 512);
        p0 = __builtin_amdgcn_mfma_f32_32x32x16_bf16(b0, qr[d0], p0, 0, 0, 0);
        p1 = __builtin_amdgcn_mfma_f32_32x32x16_bf16(b1, qr[d0], p1, 0, 0, 0); }
}
template <int NV> __device__ __forceinline__ void softmax_tile(f32x16& p0, f32x16& p1, RowT<NV>& R) {
    float a = fmaxf(fmaxf(p0[0], p0[1]), fmaxf(p1[0], p1[1]));
#pragma unroll
    for (int r = 2; r < 16; r += 2) a = fmaxf(a, fmaxf(fmaxf(p0[r], p0[r + 1]), fmaxf(p1[r], p1[r + 1])));
    const float mt = swap_max(a);
    if (__any(mt > R.m + THR)) { const float mn = fmaxf(R.m, mt), f = __builtin_amdgcn_exp2f(R.m - mn); R.m = mn; R.l *= f;
#pragma unroll
        for (int i = 0; i < 2 * NV; ++i) R.o[i] *= f; }
    const float m = R.m; float s = 0.f;
#pragma unroll
    for (int r = 0; r < 16; ++r) { p0[r] = __builtin_amdgcn_exp2f(p0[r] - m); p1[r] = __builtin_amdgcn_exp2f(p1[r] - m); s += p0[r] + p1[r]; }
    R.l += s;
}
template <int NV> __device__ __forceinline__ void pv_tile(const f32x16& p0, const f32x16& p1, RowT<NV>& R, LAS unsigned char* vslot, int lane, int hi) {
    bf16x8 pa[4];
#pragma unroll
    for (int k = 0; k < 4; ++k) { const f32x16& P = (k < 2) ? p0 : p1; const int b = (k & 1) * 8;
        u32x4 w; w.x = pk2(P[b], P[b + 1]); w.y = pk2(P[b + 2], P[b + 3]); w.z = pk2(P[b + 4], P[b + 5]); w.w = pk2(P[b + 6], P[b + 7]); pa[k] = __builtin_bit_cast(bf16x8, w); }
    const int vb = (int)(unsigned)(uintptr_t)vslot + ((lane >> 4) & 1) * 32 + (lane & 3) * 8 + (4 * hi + ((lane & 15) >> 2)) * 64;
#pragma unroll
    for (int d0 = 0; d0 < 2 * NV; ++d0) { s16x4 lo[4], hh[4];
#pragma unroll
        for (int ks = 0; ks < 4; ++ks) {
            asm volatile("ds_read_b64_tr_b16 %0,%1 offset:%c2" : "=&v"(lo[ks]) : "v"(vb), "i"(d0 * 4096 + ks * 1024) : "memory");
            asm volatile("ds_read_b64_tr_b16 %0,%1 offset:%c2" : "=&v"(hh[ks]) : "v"(vb), "i"(d0 * 4096 + ks * 1024 + 512) : "memory"); }
        asm volatile("s_waitcnt lgkmcnt(0)" ::: "memory"); __builtin_amdgcn_sched_barrier(0);
#pragma unroll
        for (int ks = 0; ks < 4; ++ks) { const bf16x8 vf = (bf16x8){lo[ks][0], lo[ks][1], lo[ks][2], lo[ks][3], hh[ks][0], hh[ks][1], hh[ks][2], hh[ks][3]};
            R.o[d0] = __builtin_amdgcn_mfma_f32_32x32x16_bf16(vf, pa[ks], R.o[d0], 0, 0, 0); } }
}

template <class RowPtr>
__device__ __forceinline__ void store_rows(LAS unsigned char* stg, const f32x16& o0, const f32x16& o1, float scale, float& ss, int lane, const RowPtr& rowptr) {
    const int r32 = lane & 31, hi = lane >> 5;
    LAS unsigned char* wp = stg + r32 * 144 + 8 * hi;
#pragma unroll
    for (int d0 = 0; d0 < 2; ++d0)
#pragma unroll
        for (int k = 0; k < 4; ++k) { const f32x16& o = d0 ? o1 : o0;
            const float v0 = o[4 * k] * scale, v1 = o[4 * k + 1] * scale, v2 = o[4 * k + 2] * scale, v3 = o[4 * k + 3] * scale;
            ss += (v0 * v0 + v1 * v1) + (v2 * v2 + v3 * v3);
            *(LAS unsigned long long*)(wp + 64 * d0 + 16 * k) = (unsigned long long)pk2(v0, v1) | ((unsigned long long)pk2(v2, v3) << 32); }
    asm volatile("s_waitcnt lgkmcnt(0)" ::: "memory");
#pragma unroll
    for (int i = 0; i < 4; ++i) { const int row = i * 8 + (lane >> 3), ch = lane & 7;
        const u32x4 v = *(const LAS u32x4*)(stg + row * 144 + ch * 16);
        __builtin_nontemporal_store(v, (u32x4*)(rowptr(row) + ch * 8)); }
}

template <class Src, class Fix, class Skip>
__device__ __forceinline__ void run_tiles(LAS unsigned char* ring, const Src& src, int kt0, int kt1, const bf16x8 (&qr)[Src::DK / 16], RowT<Src::NV>& R, const Fix& fix, const Skip& skip, int wid, int lane) {
    constexpr int KB = Src::DK * 128, SLOT = KB + 8192 * Src::NV;
    const int r32 = lane & 31, hi = lane >> 5; const int nt = kt1 - kt0;
    if (nt <= 0) return;
    src.issue(kt0, ring, ring + KB, wid);
    if (nt > 1) src.issue(kt0 + 1, ring + SLOT, ring + SLOT + KB, wid);
    int s_cur = 0, s_nn = 2 * SLOT;
    for (int i = 0; i < nt; ++i) {
        if (i + 1 < nt) wait_bar<Src::NDMA>(); else wait_bar<0>();
        if (i + 2 < nt) src.issue(kt0 + i + 2, ring + s_nn, ring + s_nn + KB, wid);
        const int tile = kt0 + i;
        if (!skip(tile)) {
            f32x16 p0, p1;
            qk_tile<Src::DK>(p0, p1, ring + s_cur, qr, r32, hi);
            fix(p0, p1, tile);
            softmax_tile(p0, p1, R);
            pv_tile(p0, p1, R, ring + s_cur + KB, lane, hi);
        }
        s_cur = (s_cur == 2 * SLOT) ? 0 : s_cur + SLOT; s_nn = (s_nn == 2 * SLOT) ? 0 : s_nn + SLOT;
    }
    asm volatile("s_waitcnt lgkmcnt(0)\n\ts_barrier" ::: "memory");
}
}


namespace att {
template <int N> __device__ __forceinline__ void wait_bar_n() {
    static_assert(N == 0 || N == 3 || N == 4 || N == 5 || N == 6 || N == 8, "wait_bar_n: add the count");
    if (N == 8) asm volatile("s_waitcnt vmcnt(8) lgkmcnt(0)\n\ts_barrier" ::: "memory"); else if (N == 6) asm volatile("s_waitcnt vmcnt(6) lgkmcnt(0)\n\ts_barrier" ::: "memory");
    else if (N == 5) asm volatile("s_waitcnt vmcnt(5) lgkmcnt(0)\n\ts_barrier" ::: "memory"); else if (N == 4) asm volatile("s_waitcnt vmcnt(4) lgkmcnt(0)\n\ts_barrier" ::: "memory");
    else if (N == 3) asm volatile("s_waitcnt vmcnt(3) lgkmcnt(0)\n\ts_barrier" ::: "memory"); else asm volatile("s_waitcnt vmcnt(0) lgkmcnt(0)\n\ts_barrier" ::: "memory"); }
typedef short v4i16_t __attribute__((ext_vector_type(4)));
typedef float f32x2_t __attribute__((ext_vector_type(2)));
__device__ __forceinline__ s16x4 vtr(const LAS unsigned char* p) { return __builtin_bit_cast(s16x4, __builtin_amdgcn_ds_read_tr16_b64_v4i16((LAS v4i16_t*)p)); }
__device__ __forceinline__ unsigned cvtpk(float lo, float hi) { f32x2_t v = {lo, hi}; bf16x2_t b = __builtin_convertvector(v, bf16x2_t); return __builtin_bit_cast(unsigned, b); }
#define SBAR() __builtin_amdgcn_sched_barrier(0)
#define PIN(x) asm volatile("" : "+v"(x))
#define MX3(a, b, c) __builtin_fmaxf(__builtin_fmaxf((a), (b)), (c))

template <class Src, class Fix>
__device__ __forceinline__ void run_pipe(LAS unsigned char* ring, const Src& src, int kt0, int kt1, int kt1w, const bf16x8 (&qr)[Src::DK / 16], Row& R, const Fix& fix, float bfar, int near_from, int wid, int lane) {
    constexpr int DK = Src::DK, NKS = DK / 16, NK = 2 * NKS, KB = DK * 128, VB = 8192, NKD = Src::NKD, NDMA = NKD + 1;
    const int NT = kt1 - kt0, NTW = kt1w - kt0;
    constexpr bool ALT = false;
    if (wid >= 4) __builtin_amdgcn_s_setprio(1);
    const int r32 = lane & 31, hi = lane >> 5;
    LAS unsigned char* kring = ring; LAS unsigned char* vring = ring + 4 * KB;
    const LAS unsigned char* kp0 = kring + hi * 1024 + r32 * 16;
    const LAS unsigned char* vp0 = vring + ((lane >> 4) & 1) * 32 + (lane & 3) * 8 + (4 * hi + ((lane & 15) >> 2)) * 64;
#define TILE(tt) (kt0 + ((tt) < NT ? (tt) : NT - 1))
    src.issueK(TILE(0), kring, wid); src.issueV(TILE(0), vring, wid); src.issueK(TILE(1), kring + KB, wid); src.issueK(TILE(2), kring + 2 * KB, wid);
    src.issueK(TILE(3), kring + 3 * KB, wid); src.issueV(TILE(1), vring + VB, wid);
    bf16x8 kf[NK];
    f32x16 A0, A1, B0, B1, cin;
    float m = 0.f, l = 0.f, csh = 0.f; f32x16 o0 = f32x16{}, o1 = f32x16{};
    wait_bar_n<3 * NKD + 2>();
#define KLOAD(kslot) do { _Pragma("unroll") for (int d0 = 0; d0 < NKS; ++d0) { kf[2 * d0] = *(const LAS bf16x8*)(kp0 + (kslot) + d0 * 2048); kf[2 * d0 + 1] = *(const LAS bf16x8*)(kp0 + (kslot) + d0 * 2048 + 512); } } while (0)
#define ROWMAX(C0, C1, out) do { float a_ = MX3(C0[0], C0[1], C1[0]), b_ = MX3(C0[2], C0[3], C1[1]); a_ = MX3(a_, C1[2], C1[3]); \
        _Pragma("unroll") for (int r = 4; r < 16; r += 4) { a_ = MX3(a_, C0[r], C0[r + 1]); b_ = MX3(b_, C0[r + 2], C0[r + 3]); a_ = MX3(a_, C1[r], C1[r + 1]); b_ = MX3(b_, C1[r + 2], C1[r + 3]); } \
        out = swap_max(__builtin_fmaxf(a_, b_)); } while (0)
    KLOAD(0);
    A0 = f32x16{}; A1 = f32x16{};
#pragma unroll
    for (int d0 = 0; d0 < NKS; ++d0) { A0 = __builtin_amdgcn_mfma_f32_32x32x16_bf16(kf[2 * d0], qr[d0], A0, 0, 0, 0); A1 = __builtin_amdgcn_mfma_f32_32x32x16_bf16(kf[2 * d0 + 1], qr[d0], A1, 0, 0, 0); }
    fix(A0, A1, kt0);
    { float rm; ROWMAX(A0, A1, rm);
      const float sh0 = (kt0 < near_from) ? bfar : 0.f;
      const float dl = (rm > NEG_INF) ? rm + sh0 : 0.f; m = dl; const float c0 = sh0 - dl;
#pragma unroll
      for (int r = 0; r < 16; ++r) { A0[r] = __builtin_amdgcn_exp2f(A0[r] + c0); A1[r] = __builtin_amdgcn_exp2f(A1[r] + c0); }
      csh = (kt0 + 1 < near_from) ? bfar : 0.f;
#pragma unroll
      for (int r = 0; r < 16; ++r) cin[r] = csh - m;
      asm volatile("" : "+v"(cin)); }
    float fpend = 1.0f; bool resc = false;
    wait_bar_n<2 * NKD + 1>();
    src.issueK(TILE(4), kring, wid); src.issueV(TILE(2), vring + 2 * VB, wid);
    KLOAD(KB);
    wait_bar_n<2 * NDMA>();
    int kcur = KB, knext = 2 * KB, vprev = 0, vnext = 3 * VB;
    u32x4 pw0, pw1, pw2, pw3; s16x4 vlo[8], vhi[8];
#define PKW(P, b) cvtpk(P[b], P[(b) + 1])
#define VRD(i) do { vlo[i] = vtr(vp_ + (((i) >> 2) * 4096 + ((i) & 3) * 1024)); vhi[i] = vtr(vp_ + (((i) >> 2) * 4096 + ((i) & 3) * 1024 + 512)); } while (0)
#define VFR(i) (bf16x8){vlo[i][0], vlo[i][1], vlo[i][2], vlo[i][3], vhi[i][0], vhi[i][1], vhi[i][2], vhi[i][3]}
#define PAF(k) __builtin_bit_cast(bf16x8, pw##k)
#define QKM(i, C, first) C = __builtin_amdgcn_mfma_f32_32x32x16_bf16(kf[i], qr[(i) >> 1], (first) ? cin : C, 0, 0, 0)
#define GAPA(MF, a0_, a1_, a2_, a3_, W0, W1, PW) do { MF; sacc += a0_; sacc += a1_; sacc += a2_; sacc += a3_; PIN(sacc); W0; W1; PIN(PW); SBAR(); } while (0)
#define GAPB(MF, X, b) do { MF; X[b] = __builtin_amdgcn_exp2f(X[b]); X[(b) + 1] = __builtin_amdgcn_exp2f(X[(b) + 1]); X[(b) + 2] = __builtin_amdgcn_exp2f(X[(b) + 2]); X[(b) + 3] = __builtin_amdgcn_exp2f(X[(b) + 3]); PIN(X); SBAR(); } while (0)
#define PHASE_A(C0, C1, P0, P1) do { SBAR(); const LAS unsigned char* vp_ = vp0 + vprev; \
        VRD(0); SBAR(); float sacc = P0[0] + P0[1]; \
        GAPA(QKM(0, C0, true), P0[2], P0[3], P0[4], P0[5], pw0[0] = PKW(P0, 0), pw0[1] = PKW(P0, 2), pw0); \
        GAPA(QKM(1, C1, true), P0[6], P0[7], P0[8], P0[9], pw0[2] = PKW(P0, 4), pw0[3] = PKW(P0, 6), pw0); \
        VRD(1); SBAR(); GAPA(QKM(2, C0, false), P0[10], P0[11], P0[12], P0[13], pw1[0] = PKW(P0, 8), pw1[1] = PKW(P0, 10), pw1); \
        GAPA(QKM(3, C1, false), P0[14], P0[15], P1[0], P1[1], pw1[2] = PKW(P0, 12), pw1[3] = PKW(P0, 14), pw1); \
        VRD(2); SBAR(); GAPA(QKM(4, C0, false), P1[2], P1[3], P1[4], P1[5], pw2[0] = PKW(P1, 0), pw2[1] = PKW(P1, 2), pw2); \
        GAPA(QKM(5, C1, false), P1[6], P1[7], P1[8], P1[9], pw2[2] = PKW(P1, 4), pw2[3] = PKW(P1, 6), pw2); \
        VRD(3); SBAR(); GAPA(QKM(6, C0, false), P1[10], P1[11], P1[12], P1[13], pw3[0] = PKW(P1, 8), pw3[1] = PKW(P1, 10), pw3); \
        GAPA(QKM(7, C1, false), P1[14], P1[15], 0.f, 0.f, pw3[2] = PKW(P1, 12), pw3[3] = PKW(P1, 14), pw3); \
        if (NK > 8) { _Pragma("unroll") for (int i_ = 8; i_ < NK; i_ += 2) { QKM(i_, C0, false); QKM(i_ + 1, C1, false); } SBAR(); } \
        l += sacc; } while (0)
#define KRD(j) do { kf[2 * (j)] = *(const LAS bf16x8*)(kp0 + knext + (j) * 2048); kf[2 * (j) + 1] = *(const LAS bf16x8*)(kp0 + knext + (j) * 2048 + 512); SBAR(); } while (0)
#define PHASE_B(C0, C1) do { SBAR(); const LAS unsigned char* vp_ = vp0 + vprev; \
        VRD(4); SBAR(); GAPB(o0 = __builtin_amdgcn_mfma_f32_32x32x16_bf16(VFR(0), PAF(0), o0, 0, 0, 0), C0, 0); \
        VRD(5); SBAR(); GAPB(o0 = __builtin_amdgcn_mfma_f32_32x32x16_bf16(VFR(1), PAF(1), o0, 0, 0, 0), C0, 4); \
        VRD(6); SBAR(); KRD(0); GAPB(o0 = __builtin_amdgcn_mfma_f32_32x32x16_bf16(VFR(2), PAF(2), o0, 0, 0, 0), C0, 8); \
        VRD(7); SBAR(); KRD(1); GAPB(o0 = __builtin_amdgcn_mfma_f32_32x32x16_bf16(VFR(3), PAF(3), o0, 0, 0, 0), C0, 12); \
        KRD(2); GAPB(o1 = __builtin_amdgcn_mfma_f32_32x32x16_bf16(VFR(4), PAF(0), o1, 0, 0, 0), C1, 0); \
        KRD(3); GAPB(o1 = __builtin_amdgcn_mfma_f32_32x32x16_bf16(VFR(5), PAF(1), o1, 0, 0, 0), C1, 4); \
        if (NKS > 4) { KRD(4); } GAPB(o1 = __builtin_amdgcn_mfma_f32_32x32x16_bf16(VFR(6), PAF(2), o1, 0, 0, 0), C1, 8); \
        if (NKS > 5) { KRD(5); } GAPB(o1 = __builtin_amdgcn_mfma_f32_32x32x16_bf16(VFR(7), PAF(3), o1, 0, 0, 0), C1, 12); \
        } while (0)
#define DECIDE(C0, C1, tt) do { \
        fix(C0, C1, kt0 + (tt)); \
        float rm_; ROWMAX(C0, C1, rm_); resc = false; \
        const bool up_ = (rm_ > THR) || (l == 0.f && rm_ < -THR && rm_ > NEG_INF); \
        const float nsh_ = (kt0 + (tt) + 1 < near_from) ? bfar : 0.f; \
        if (__any(up_)) { const float dl_ = up_ ? rm_ : __builtin_fmaxf(rm_, 0.f); m += dl_; fpend = __builtin_amdgcn_exp2f(-dl_); l *= fpend; resc = true; \
            _Pragma("unroll") for (int r = 0; r < 16; ++r) { C0[r] -= dl_; C1[r] -= dl_; } \
            csh = nsh_; _Pragma("unroll") for (int r = 0; r < 16; ++r) cin[r] = csh - m; asm volatile("" : "+v"(cin)); } \
        else if (nsh_ != csh) { csh = nsh_; _Pragma("unroll") for (int r = 0; r < 16; ++r) cin[r] = csh - m; asm volatile("" : "+v"(cin)); } } while (0)
#define STEP(C0, C1, P0, P1, tt) do { \
        if (ALT && wid >= 4) asm volatile("s_barrier" ::: "memory"); \
        PHASE_A(C0, C1, P0, P1); \
        src.issueK(TILE((tt) + 4), kring + kcur, wid); src.issueV(TILE((tt) + 2), vring + vnext, wid); \
        DECIDE(C0, C1, tt); \
        PHASE_B(C0, C1); \
        if (ALT && wid < 4) asm volatile("s_waitcnt lgkmcnt(0)\n\ts_barrier" ::: "memory"); \
        wait_bar_n<2 * NDMA>();                                          \
        if (resc) { o0 *= fpend; o1 *= fpend; } \
        kcur = knext; knext = (knext == 3 * KB) ? 0 : knext + KB; \
        vprev = (vprev == 3 * VB) ? 0 : vprev + VB; vnext = (vnext == 3 * VB) ? 0 : vnext + VB; } while (0)
    int t = 1;
    for (; t + 1 < NTW; t += 2) { STEP(B0, B1, A0, A1, t); STEP(A0, A1, B0, B1, t + 1); }
    if (t < NTW) { STEP(B0, B1, A0, A1, t); A0 = B0; A1 = B1; }
    { float sacc = 0.f;
#pragma unroll
      for (int r = 0; r < 16; ++r) sacc += A0[r] + A1[r];
      l += sacc;
      pw0 = (u32x4){PKW(A0, 0), PKW(A0, 2), PKW(A0, 4), PKW(A0, 6)}; pw1 = (u32x4){PKW(A0, 8), PKW(A0, 10), PKW(A0, 12), PKW(A0, 14)};
      pw2 = (u32x4){PKW(A1, 0), PKW(A1, 2), PKW(A1, 4), PKW(A1, 6)}; pw3 = (u32x4){PKW(A1, 8), PKW(A1, 10), PKW(A1, 12), PKW(A1, 14)};
      const LAS unsigned char* vp_ = vp0 + vprev;
#pragma unroll
      for (int i = 0; i < 8; ++i) VRD(i);
      o0 = __builtin_amdgcn_mfma_f32_32x32x16_bf16(VFR(0), PAF(0), o0, 0, 0, 0); o1 = __builtin_amdgcn_mfma_f32_32x32x16_bf16(VFR(4), PAF(0), o1, 0, 0, 0);
      o0 = __builtin_amdgcn_mfma_f32_32x32x16_bf16(VFR(1), PAF(1), o0, 0, 0, 0); o1 = __builtin_amdgcn_mfma_f32_32x32x16_bf16(VFR(5), PAF(1), o1, 0, 0, 0);
      o0 = __builtin_amdgcn_mfma_f32_32x32x16_bf16(VFR(2), PAF(2), o0, 0, 0, 0); o1 = __builtin_amdgcn_mfma_f32_32x32x16_bf16(VFR(6), PAF(2), o1, 0, 0, 0);
      o0 = __builtin_amdgcn_mfma_f32_32x32x16_bf16(VFR(3), PAF(3), o0, 0, 0, 0); o1 = __builtin_amdgcn_mfma_f32_32x32x16_bf16(VFR(7), PAF(3), o1, 0, 0, 0); }
    for (int tt = NTW; tt < NT; ++tt) {
        src.issueK(TILE(tt + 4), kring + kcur, wid); src.issueV(TILE(tt + 2), vring + vnext, wid);
        wait_bar_n<2 * NDMA>();
        kcur = knext; knext = (knext == 3 * KB) ? 0 : knext + KB; vprev = (vprev == 3 * VB) ? 0 : vprev + VB; vnext = (vnext == 3 * VB) ? 0 : vnext + VB; }
    wait_bar_n<0>();
    R.m = m; R.l = l; R.o[0] = o0; R.o[1] = o1;
    __builtin_amdgcn_s_setprio(0);
#undef TILE
#undef KLOAD
#undef ROWMAX
#undef DECIDE
#undef PKW
#undef VRD
#undef VFR
#undef PAF
#undef QKM
#undef GAPA
#undef GAPB
#undef PHASE_A
#undef KRD
#undef PHASE_B
#undef STEP
}
#undef SBAR
#undef PIN
#undef MX3
}
constexpr int MLA_STG_OFF = 98304;
__device__ __forceinline__ void p3_mla(const Ptrs& P, LAS unsigned char* lds, int vcu, int G, int tid, int wid) {
    using namespace att;
    for (int L = vcu; L < 2048; L += G) {
        int lane_u = tid & 63; asm volatile("" : "+v"(lane_u));
        const int lane = lane_u, r32 = lane & 31, hi = lane >> 5;
        int bh, qb;
        if (G == 256) { const int i = L >> 8, s8 = vcu & 7; bh = (vcu >> 3) + 32 * (i >> 1); qb = (i & 1) ? 15 - s8 : s8; }
        else { bh = L >> 4; qb = L & 15; }
        const int b = bh >> 3, h = bh & 7; const size_t rowb = (size_t)b * SEQ;
        const int q0 = qb * 256 + wid * 32, t = q0 + r32; const size_t row = rowb + t;
        bf16x8 qr[6];
#pragma unroll
        for (int d0 = 0; d0 < 6; ++d0) qr[d0] = *(const bf16x8*)(P.QM + row * 768 + h * 96 + d0 * 16 + hi * 8);
        SrcMLA src; src.init(P.KVM, P.kpe, rowb, h, wid, lane);
        Row R; row_reset(R);
        auto fix = [&](f32x16& p0, f32x16& p1, int tile) {
            if (tile * 64 + 63 > q0) {
                const int kb = tile * 64 + 4 * hi;
#pragma unroll
                for (int r = 0; r < 16; ++r) { const int kv = kb + (r & 3) + 8 * (r >> 2); if (kv > t) p0[r] = NEG_INF; if (kv + 32 > t) p1[r] = NEG_INF; } } };
        run_pipe(lds, src, 0, 4 * qb + 4, 4 * qb + (wid >> 1) + 1, qr, R, fix, 0.f, 0x7fffffff, wid, lane);
        const float inv = 1.0f / swap_sum(R.l); float ss = 0.f;
        { bf16* const ob = P.ATT + (rowb + q0) * 1024 + h * 64;
          store_rows(lds + MLA_STG_OFF + wid * 4608, R.o[0], R.o[1], inv, ss, lane, [&](int r) -> bf16* { return ob + (size_t)r * 1024; }); }
        ss = swap_sum(ss);
        if (hi == 0) P.ssatt[row * 16 + h] = ss;
    }
}

constexpr int NSA_LB_OFF = 81920;
constexpr int NSA_OUT_OFF = 86016;
__device__ __forceinline__ float dpp_xor1(float x) { return __builtin_bit_cast(float, __builtin_amdgcn_update_dpp(0, __builtin_bit_cast(int, x), 0xB1, 0xF, 0xF, false)); }
__device__ __forceinline__ float dpp_xor2(float x) { return __builtin_bit_cast(float, __builtin_amdgcn_update_dpp(0, __builtin_bit_cast(int, x), 0x4E, 0xF, 0xF, false)); }
__device__ __forceinline__ unsigned dpp_xor1u(unsigned x) { return (unsigned)__builtin_amdgcn_update_dpp(0, (int)x, 0xB1, 0xF, 0xF, false); }
__device__ __forceinline__ unsigned dpp_xor2u(unsigned x) { return (unsigned)__builtin_amdgcn_update_dpp(0, (int)x, 0x4E, 0xF, 0xF, false); }
template <int STEP, int YOFF> __device__ __forceinline__ void add_bias(att::f32x16& p, const LAS float* lb, int D) {
#pragma unroll
    for (int r = 0; r < 16; ++r) { int d = D - STEP * ((r & 3) + 8 * (r >> 2) + YOFF); d = d < 0 ? 0 : (d > 127 ? 127 : d); p[r] += lb[d]; }
}
__device__ __forceinline__ void p3_nsa(const Ptrs& P, LAS unsigned char* lds, int vcu, int G, int tid, int wid) {
    using namespace att;
    LAS float* LB = (LAS float*)(lds + NSA_LB_OFF);
    for (int e = tid; e < 1024; e += NTHR) LB[e] = P.bias[e];
    __syncthreads();
    for (int L = vcu; L < 2048; L += G) {
        int bhk, c;
        if (G == 256) { const int i = L >> 8, sub = vcu & 7; bhk = vcu >> 3; const int base = 16 * (i >> 1); c = (i & 1) ? base + 15 - sub : base + sub; }
        else { bhk = L >> 6; c = L & 63; }
        int lane_u = tid & 63; asm volatile("" : "+v"(lane_u));
        const int lane = lane_u, r32 = lane & 31, hi = lane >> 5, ql = r32 >> 2, g = r32 & 3;
        const int b = bhk >> 1, hk = bhk & 1, hq = hk * 4 + g; const size_t rowb = (size_t)b * SEQ;
        const int t = c * 64 + wid * 8 + ql; const size_t row = rowb + t;
        const LAS float* lb = LB + hq * 128; const float b31 = lb[127];
        bf16x8 qr[4];
#pragma unroll
        for (int d0 = 0; d0 < 4; ++d0) qr[d0] = *(const bf16x8*)(P.U + row * DINP + C_QN + hq * 64 + d0 * 16 + hi * 8);
        float gate[3];
#pragma unroll
        for (int br = 0; br < 3; ++br) { const float x = bf2f(P.U[row * DINP + C_GATE + hq * 3 + br]); gate[br] = __builtin_amdgcn_rcpf(1.0f + __builtin_amdgcn_exp2f(-x * LOG2E)); }
        LAS float* outp = (LAS float*)(lds + NSA_OUT_OFF) + wid * 2048 + lane;
        unsigned mlo, mhi;
        {
            const int nv = t >= 31 ? ((t - 31) >> 4) + 1 : 0;
            int ln = lane_u; asm volatile("" : "+v"(ln));
            SrcCmp src; src.init(P.kcmp + (size_t)bhk * 256 * 64, P.vcmp + (size_t)bhk * 256 * 64, P.ovt, wid, ln);
            RowT<2> R; row_reset(R);
            auto fix = [&](f32x16& p0, f32x16& p1, int tile) {
                const int D = t - 31 - 16 * (64 * tile + 4 * hi);
                add_bias<16, 0>(p0, lb, D); add_bias<16, 32>(p1, lb, D);
                const int ib = 64 * tile + 4 * hi;
#pragma unroll
                for (int r = 0; r < 16; ++r) { const int i = ib + (r & 3) + 8 * (r >> 2); if (i >= nv) p0[r] = NEG_INF; if (i + 32 >= nv) p1[r] = NEG_INF; } };
            auto skip = [&](int) -> bool { return false; };
            run_tiles(lds, src, 0, (4 * c + 3 + 63) >> 6, qr, R, fix, skip, wid, lane);
            const float lt = swap_sum(R.l); const float inv = lt > 0.f ? 1.0f / lt : 0.f;
            { const float f = gate[0] * inv;
#pragma unroll
              for (int i = 0; i < 16; ++i) { outp[64 * i] = R.o[0][i] * f; outp[64 * (16 + i)] = R.o[1][i] * f; } }
            mlo = 0u; mhi = 0u;
            if (c <= 15) { const unsigned long long mk = (2ull << c) - 1ull; mlo = (unsigned)mk; mhi = (unsigned)(mk >> 32); }
            else {
                float cand[8];
#pragma unroll
                for (int rr = 0; rr < 8; ++rr) {
                    float v00 = R.o[2][rr] * inv, v01 = R.o[2][8 + rr] * inv, v10 = R.o[3][rr] * inv, v11 = R.o[3][8 + rr] * inv;
                    v00 += dpp_xor1(v00); v00 += dpp_xor2(v00); v01 += dpp_xor1(v01); v01 += dpp_xor2(v01); v10 += dpp_xor1(v10); v10 += dpp_xor2(v10); v11 += dpp_xor1(v11); v11 += dpp_xor2(v11);
                    cand[rr] = (g & 2) ? ((g & 1) ? v11 : v10) : ((g & 1) ? v01 : v00); }
                unsigned key[8];
#pragma unroll
                for (int rr = 0; rr < 8; ++rr) { const int j = 32 * (g >> 1) + (rr & 3) + 8 * (2 * (g & 1) + (rr >> 2)) + 4 * hi;
                    const bool ok = j >= 1 && j <= c - 2; key[rr] = ok ? ((__float_as_uint(fmaxf(cand[rr], 0.f)) & ~63u) | (unsigned)(63 - j)) : 0u; }
                unsigned long long mk = 1ull | (1ull << c) | (1ull << (c - 1));
                for (int round = 0; round < 13; ++round) {
                    unsigned best = key[0];
#pragma unroll
                    for (int rr = 1; rr < 8; ++rr) best = best > key[rr] ? best : key[rr];
                    { const unsigned o1 = dpp_xor1u(best); best = best > o1 ? best : o1; const unsigned o2 = dpp_xor2u(best); best = best > o2 ? best : o2;
                      auto rr2 = __builtin_amdgcn_permlane32_swap(best, best, false, false); best = rr2[0] > rr2[1] ? rr2[0] : rr2[1]; }
                    if (best != 0u) mk |= 1ull << (63u - (best & 63u));
#pragma unroll
                    for (int rr = 0; rr < 8; ++rr) key[rr] = (key[rr] == best) ? 0u : key[rr];
                }
                mlo = (unsigned)mk; mhi = (unsigned)(mk >> 32);
            }
        }
        {
            int ln = lane_u; asm volatile("" : "+v"(ln));
            SrcRows src; src.init(P.U + rowb * DINP + C_KVS + hk * 64, P.U + rowb * DINP + C_KVS + 128 + hk * 64, DINP, wid, ln);
            Row R; row_reset(R);
            auto fix = [&](f32x16& p0, f32x16& p1, int tile) {
                if (tile >= c - 2) { const int D = t - 64 * tile - 4 * hi; add_bias<1, 0>(p0, lb, D); asm volatile("" ::: "memory"); add_bias<1, 32>(p1, lb, D); }
                const bool sel = ((tile < 32 ? (mlo >> tile) : (mhi >> (tile - 32))) & 1u) != 0u;
                if (tile == c) { const int kb = tile * 64 + 4 * hi;
#pragma unroll
                    for (int r = 0; r < 16; ++r) { const int kv = kb + (r & 3) + 8 * (r >> 2); if (kv > t || !sel) p0[r] = NEG_INF; if (kv + 32 > t || !sel) p1[r] = NEG_INF; } }
                else if (!sel) {
#pragma unroll
                    for (int r = 0; r < 16; ++r) { p0[r] = NEG_INF; p1[r] = NEG_INF; } } };
            run_pipe(lds, src, 0, c + 1, c + 1, qr, R, fix, b31, c - 2, wid, lane);
            const float f = gate[1] / swap_sum(R.l);
#pragma unroll
            for (int i = 0; i < 16; ++i) { outp[64 * i] += R.o[0][i] * f; outp[64 * (16 + i)] += R.o[1][i] * f; }
        }
        f32x16 out[2];
        {
            int ln = lane_u; asm volatile("" : "+v"(ln));
            SrcRows src; src.init(P.U + rowb * DINP + C_KVW + hk * 64, P.U + rowb * DINP + C_KVW + 128 + hk * 64, DINP, wid, ln);
            Row R; row_reset(R);
            auto fix = [&](f32x16& p0, f32x16& p1, int tile) {
                if (tile >= c - 2) { const int D = t - 64 * tile - 4 * hi; add_bias<1, 0>(p0, lb, D); asm volatile("" ::: "memory"); add_bias<1, 32>(p1, lb, D); }
                if (tile == c || tile == c - 8) { const int kb = tile * 64 + 4 * hi;
#pragma unroll
                    for (int r = 0; r < 16; ++r) { const int kv = kb + (r & 3) + 8 * (r >> 2); const int d0_ = t - kv, d1_ = d0_ - 32;
                        if (d0_ < 0 || d0_ >= 512) p0[r] = NEG_INF; if (d1_ < 0 || d1_ >= 512) p1[r] = NEG_INF; } } };
            run_pipe(lds, src, c >= 8 ? c - 8 : 0, c + 1, c + 1, qr, R, fix, b31, c - 2, wid, lane);
            const float f = gate[2] / swap_sum(R.l);
#pragma unroll
            for (int i = 0; i < 16; ++i) { out[0][i] = outp[64 * i] + R.o[0][i] * f; out[1][i] = outp[64 * (16 + i)] + R.o[1][i] * f; }
        }
        { float ss = 0.f; bf16* const ob = P.ATT + (rowb + c * 64 + wid * 8) * 1024 + 512 + hk * 256;
            store_rows(lds + NSA_OUT_OFF + wid * 8192, out[0], out[1], 1.0f, ss, lane, [&](int r) -> bf16* { return ob + (size_t)(r >> 2) * 1024 + (r & 3) * 64; });
            ss = swap_sum(ss);
            if (hi == 0) P.ssatt[row * 16 + 8 + hq] = ss; }
    }
}

__global__ void __launch_bounds__(NTHR, 2) mega_fwd(Args args) {
    extern __shared__ __attribute__((aligned(16))) unsigned char lds_raw[];
    LAS unsigned char* lds = (LAS unsigned char*)lds_raw;
    volatile LAS unsigned* MISC = (volatile LAS unsigned*)(lds + MISC_OFF);
    const int wv0 = __builtin_amdgcn_readfirstlane((int)threadIdx.x >> 6);
#define LAUNDER_TID() int tid = wv0 * 64 + pg8::lane_id(); asm volatile("" : "+v"(tid)); const int lane = tid & 63, wave = __builtin_amdgcn_readfirstlane(tid >> 6); (void)lane; (void)wave
    const int G = gridDim.x, wg = blockIdx.x;
    const int vcu = (G % 8 == 0) ? (wg % 8) * (G / 8) + wg / 8 : wg;
    unsigned char* ws = args.ws;
    Ptrs P;
#pragma unroll
    for (int i = 0; i < 22; ++i) P.in[i] = args.in[i];
    P.out = args.out; P.ws = ws;
    P.Win = (bf16*)(ws + WS_WIN); P.Wuq = (bf16*)(ws + WS_WUQ); P.Wukv = (bf16*)(ws + WS_WUKV); P.Wout = (bf16*)(ws + WS_WOUT); P.Wgu = (bf16*)(ws + WS_WGU); P.Wdn = (bf16*)(ws + WS_WDN);
    P.rope = (f32x2v*)(ws + WS_ROPE); P.bias = (float*)(ws + WS_BIAS); P.bias1 = (float*)(ws + WS_BIAS1); P.rstdx = (float*)(ws + WS_RSTDX);
    P.ssqkv = (float*)(ws + WS_SSQKV); P.ssatt = (float*)(ws + WS_SSATT); P.ssh = (float*)(ws + WS_SSH);
    P.kcmp = (bf16*)(ws + WS_KCMP); P.vcmp = (bf16*)(ws + WS_VCMP); P.kpe = (bf16*)(ws + WS_KPE); P.ovt = (bf16*)(ws + WS_OVT); P.W1c = (bf16*)(ws + WS_W1C); P.W2t = (bf16*)(ws + WS_W2T);
    P.XB = (bf16*)(ws + WS_XB); P.U = (bf16*)(ws + WS_U); P.QM = (bf16*)(ws + WS_QM); P.KVM = (bf16*)(ws + WS_KVM); P.ATT = (bf16*)(ws + WS_ATT); P.H = (bf16*)(ws + WS_H); P.HID = (bf16*)(ws + WS_HID);
    gu32* ctl = (gu32*)(ws + WS_CTL);

    if (wv0 == 0) MISC[pg8::lane_id()] = 0u;
    __syncthreads();
    XcdBarrier bar; bar.bar = (unsigned*)(ctl + CW_BAR); bar.x = 0; bar.st = nullptr; bar.lead = false;
    if (N_LAUNCHES == 1) bar = xcd_barrier_post((unsigned*)(ctl + CW_BAR), MISC + 8);
#define GRID_BAR() do { if (N_LAUNCHES == 1) xcd_barrier(bar); } while (0)
    const int lo = args.ph_lo, hi = args.ph_hi;
#ifndef PHASE_MASK
#define PHASE_MASK 0xff
#endif
#define IN(k) (((PHASE_MASK >> (k)) & 1) && lo <= (k) && (k) < hi)
#define BOTH(k) (IN(k) && IN((k) + 1))
#ifndef REPEAT_MASK
#define REPEAT_MASK 0
#endif
#define REP(k) for (int rep_ = 0; rep_ < (((REPEAT_MASK >> (k)) & 1) ? 2 : 1); ++rep_)

    if (IN(0)) { REP(0) { LAUNDER_TID(); p0_prologue(P, lds, wg, G, wave, lane, tid); } if (BOTH(0)) GRID_BAR(); }

    if (IN(1)) {
        REP(1) {
        pg8::Gemm g{P.XB, P.Win, MT, DINP, 1024, 1024, 1024, 0}; pg8::StaticOrder S; S.init(MT, DINP, G, wg);
        EpiInProj E{P.U, P.rstdx, P.ssqkv};
        pg8::gemm_phase<EpiInProj, pg8::StaticOrder, true, true>(lds, g, S, E, wv0); }
        if (BOTH(1)) GRID_BAR();
    }

    if (IN(2)) {
        REP(2) {
        { LAUNDER_TID(); p2_kpe(P, wg, G, tid); }
        { pg8::Gemm g{P.U, P.W1c, 64 * 256, 256, 1024, 16 * DINP, 1024, DINP * 2}; CmpOrder S{G, wg, P.U, P.W1c};
          EpiCmp E{P.bias1, P.W2t, P.kcmp, P.vcmp};
          pg8::gemm_phase<EpiCmp, CmpOrder, false, true>(lds, g, S, E, wv0); }
        { const int gq = G > 64 ? G - 64 : G, cq = G > 64 ? wg - 64 : wg;
          if (cq >= 0) { pg8::Gemm g{P.U + C_CQ, P.Wuq, MT, 768, 256, DINP, 256, 0}; pg8::StaticOrder S; S.init(MT, 768, gq, cq);
            EpiQup E{P.QM, P.ssqkv, P.rope};
            pg8::gemm_phase<EpiQup, pg8::StaticOrder, true, true>(lds, g, S, E, wv0); } }
        { pg8::Gemm g{P.U + C_CKV, P.Wukv, MT, 1024, 128, DINP, 256, 0}; pg8::StaticOrder S; S.init(MT, 1024, G, wg);
          EpiKVup E{P.KVM, P.ssqkv};
          pg8::gemm_phase<EpiKVup, pg8::StaticOrder, true, true>(lds, g, S, E, wv0); }
        }
        if (BOTH(2)) GRID_BAR();
    }

    if (IN(3)) {
        REP(3) {
        REP(8) { LAUNDER_TID(); p3_mla(P, lds, vcu, G, tid, wave); }
        REP(9) { LAUNDER_TID(); p3_nsa(P, lds, vcu, G, tid, wave); }
        }
        if (BOTH(3)) GRID_BAR();
    }

    if (IN(4)) {
        REP(4) {
        { pg8::Gemm g{P.ATT, P.Wout, MT, 1024, 1024, 1024, 1024, 0}; OutOrder S; S.init(MT, 1024, G, wg); S.ssatt = P.ssatt; S.tab = (LAS float*)(lds + OUT_TAB_OFF);
          EpiOut E{P.XB, P.H, (unsigned char*)P.QM, P.ssh, (const LAS float*)(lds + OUT_TAB_OFF)};
          pg8::gemm_phase<EpiOut, OutOrder, true, true>(lds, g, S, E, wv0); }
        }
        if (BOTH(4)) GRID_BAR();
    }

    if (IN(5)) {
#define P5_BODY() { pg8::Gemm g{P.QM, P.Wgu, MT, NGU, 512, 512, 512, 0}; GUOrder S; S.init(MT, NGU, G, wg); S.ssh = P.ssh; S.tab = (LAS float*)(lds + OUT_TAB_OFF);     \
        EpiGU E{(unsigned char*)P.HID, (const LAS float*)(lds + OUT_TAB_OFF)}; \
        pg8::gemm_phase<EpiGU, GUOrder, true, true, true>(lds, g, S, E, wv0); }
        P5_BODY();
#if (REPEAT_MASK >> 5) & 1
        __syncthreads(); P5_BODY();
#endif
#undef P5_BODY
        if (BOTH(5)) GRID_BAR();
    }

    if (IN(6)) {
        REP(6) {
        pg8::Gemm g{P.HID, P.Wdn, MT, 1024, DFF / 2, DFF / 2, DFF / 2, 0}; pg8::StaticOrder S; S.init(MT, 1024, G, wg);
        EpiDown E{P.H, P.ATT, P.ssatt};
        pg8::gemm_phase<EpiDown, pg8::StaticOrder, true, true, true>(lds, g, S, E, wv0); }
        if (BOTH(6)) GRID_BAR();
    }

    if (IN(7)) { LAUNDER_TID(); p7_final(P, wg, G, wave, lane); }
#undef IN
#undef BOTH
#undef GRID_BAR
}

extern "C" void kernel_launch(void* const* d_in, const int* in_sizes, int n_in, void* d_out, int out_size, void* d_ws, size_t ws_size, hipStream_t stream) {
    static int grid = 0;
    if (grid == 0) {
        if (n_in != 22 || in_sizes[0] != MT * DM || out_size != MT * DM || ws_size < WS_END) { fprintf(stderr, "kernel_launch: unexpected shapes (n_in %d, in0 %d, out %d, ws %zu); nothing launched\n", n_in, n_in > 0 ? in_sizes[0] : -1, out_size, ws_size); grid = -1; return; }
        int dev = 0, cus = 0, per_cu = 0;
        if (hipGetDevice(&dev) != hipSuccess || hipDeviceGetAttribute(&cus, hipDeviceAttributeMultiprocessorCount, dev) != hipSuccess) { fprintf(stderr, "kernel_launch: device query failed\n"); grid = -1; return; }
        if (hipFuncSetAttribute((const void*)mega_fwd, hipFuncAttributeMaxDynamicSharedMemorySize, LDS_BYTES) != hipSuccess) { fprintf(stderr, "kernel_launch: hipFuncSetAttribute failed\n"); grid = -1; return; }
        if (hipOccupancyMaxActiveBlocksPerMultiprocessor(&per_cu, (const void*)mega_fwd, NTHR, LDS_BYTES) != hipSuccess || per_cu < 1)
            fprintf(stderr, "kernel_launch: note: occupancy query reports %d workgroups per CU\n", per_cu);
        (void)hipGetLastError();
        grid = cus;
    }
    if (grid < 0) return;
    if (hipMemsetAsync((char*)d_ws + WS_CTL, 0, CTL_ZERO_BYTES, stream) != hipSuccess) { fprintf(stderr, "kernel_launch: memset failed\n"); return; }
    Args a{};
    for (int i = 0; i < 22; ++i) a.in[i] = (const float*)d_in[i];
    a.out = (float*)d_out; a.ws = (unsigned char*)d_ws;
    for (int li = 0; li < N_LAUNCHES; ++li) {
        a.ph_lo = (N_LAUNCHES == 1) ? 0 : li; a.ph_hi = (N_LAUNCHES == 1) ? NPHASE : li + 1; a.li = li; a.pad = 0;
        hipLaunchKernelGGL(mega_fwd, dim3(grid), dim3(NTHR), LDS_BYTES, stream, a);
        const hipError_t le = hipPeekAtLastError();
        if (le != hipSuccess) { fprintf(stderr, "kernel_launch: launch %d failed: %s\n", li, hipGetErrorName(le)); break; }
    }
}
```
